# Optimizing an MI355X kernel written in HIP

```python
import math
import jax
import jax.numpy as jnp
from jax import lax
import numpy as np

D_MODEL = 1024
BATCH = 8
SEQ = 4096
DEPTH = 4

N_MIXERS = 3
N_POOL_LAYERS = len(range(0, DEPTH, N_MIXERS))
N_SC_LAYERS = len(range(1, DEPTH, N_MIXERS))
N_CF_LAYERS = len(range(2, DEPTH, N_MIXERS))

POOL_WINDOWS = (2, 4, 8, 16)
N_POOL_GROUPS = len(POOL_WINDOWS)
POOL_GROUP_DIM = D_MODEL // N_POOL_GROUPS
MAX_POOL = max(POOL_WINDOWS)

SHORT_CONV_WIDTH = 3
CONFORMER_KERNEL = 31

N_EXPERTS = 32
TOP_K = 4
EXPERT_DIM = D_MODEL
SWIGLU_LIMIT = 7.0
SWIGLU_ALPHA = 1.702
EXPERT_BLOCK = 128

DEEPNORM_ALPHA = (2.0 * DEPTH) ** 0.25
DEEPNORM_BETA = (8.0 * DEPTH) ** -0.25
LN_EPS = 1e-5

kernel_name = "hybrid_pool_shortconv_conformer_moe_deepnorm"


def layer_norm(x, g, b):
    xf = x.astype(jnp.float32)
    mu = jnp.mean(xf, axis=-1, keepdims=True)
    xc = xf - mu
    var = jnp.mean(xc * xc, axis=-1, keepdims=True)
    y = xc * lax.rsqrt(var + LN_EPS) * g.astype(jnp.float32) + b.astype(jnp.float32)
    return y.astype(x.dtype)


def causal_depthwise_conv(u, w):
    k = w.shape[0]
    return lax.conv_general_dilated(
        u, w[:, None, :].astype(u.dtype), window_strides=(1,), padding=[(k - 1, 0)],
        dimension_numbers=("NWC", "WIO", "NWC"), feature_group_count=u.shape[-1])


def pool_mixer(x, w_groups, scale):
    seq = x.shape[1]
    xf = x.astype(jnp.float32)
    csum = jnp.pad(jnp.cumsum(xf, axis=1), ((0, 0), (MAX_POOL, 0), (0, 0)))
    outs = []
    for g, win_len in enumerate(POOL_WINDOWS):
        sl = slice(g * POOL_GROUP_DIM, (g + 1) * POOL_GROUP_DIM)
        window_sum = csum[:, MAX_POOL:, sl] - csum[:, MAX_POOL - win_len:MAX_POOL - win_len + seq, sl]
        count = jnp.minimum(jnp.arange(1, seq + 1, dtype=jnp.float32), float(win_len))
        diff = window_sum / count[None, :, None] - xf[..., sl]
        outs.append(jnp.einsum("bsc,ce->bse", diff.astype(x.dtype), w_groups[g]))
    return jnp.concatenate(outs, axis=-1) * scale


def short_conv_mixer(x, w_in, conv_w, w_out):
    proj = jnp.einsum("bsd,de->bse", x, w_in)
    gate_b, gate_c, h = jnp.split(proj, 3, axis=-1)
    u = causal_depthwise_conv(gate_c * h, conv_w)
    return jnp.einsum("bsd,de->bse", gate_b * u, w_out)


def conformer_conv_mixer(x, w_in, b_in, dw_w, dw_b, ln_g, ln_b, w_out, b_out):
    a, gate = jnp.split(jnp.einsum("bsd,de->bse", x, w_in) + b_in, 2, axis=-1)
    u = a * jax.nn.sigmoid(gate)
    u = causal_depthwise_conv(u, dw_w) + dw_b
    u = jax.nn.silu(layer_norm(u, ln_g, ln_b))
    return jnp.einsum("bsd,de->bse", u, w_out) + b_out


def expert_ffn(xb, w_gu, b_gu, w_dn, b_dn):
    h = xb @ w_gu + b_gu
    g = jnp.minimum(h[..., 0::2], SWIGLU_LIMIT)
    up = jnp.clip(h[..., 1::2], -SWIGLU_LIMIT, SWIGLU_LIMIT)
    glu = g * jax.nn.sigmoid(SWIGLU_ALPHA * g)
    return ((up + 1.0) * glu) @ w_dn + b_dn


def moe_ffn(x, router_w, router_b, w_gu, b_gu, w_dn, b_dn):
    bsz, seq, d = x.shape
    n_tok = bsz * seq
    x2d = x.reshape(n_tok, d)
    logits = jnp.dot(x2d.astype(jnp.float32), router_w.astype(jnp.float32)) + router_b.astype(jnp.float32)
    top_vals, top_idx = lax.top_k(logits, TOP_K)
    gates = jax.nn.softmax(top_vals, axis=-1)

    n_assign = n_tok * TOP_K
    flat_e = top_idx.reshape(n_assign).astype(jnp.int32)
    flat_tok = jnp.arange(n_assign, dtype=jnp.int32) // TOP_K
    order = jnp.argsort(flat_e)
    sorted_e = flat_e[order]
    sorted_tok = flat_tok[order]

    counts = jnp.bincount(flat_e, length=N_EXPERTS).astype(jnp.int32)
    padded_counts = ((counts + EXPERT_BLOCK - 1) // EXPERT_BLOCK) * EXPERT_BLOCK
    padded_end = jnp.cumsum(padded_counts)
    padded_start = padded_end - padded_counts
    group_start = jnp.cumsum(counts) - counts
    rank = jnp.arange(n_assign, dtype=jnp.int32) - group_start[sorted_e]
    dest = padded_start[sorted_e] + rank

    n_blocks = -(-n_assign // EXPERT_BLOCK) + N_EXPERTS
    n_pad = n_blocks * EXPERT_BLOCK
    row_tok = jnp.zeros((n_pad,), jnp.int32).at[dest].set(sorted_tok)
    block_start = jnp.arange(n_blocks, dtype=jnp.int32) * EXPERT_BLOCK
    block_expert = jnp.minimum(jnp.searchsorted(padded_end, block_start, side="right"),
                               N_EXPERTS - 1).astype(jnp.int32)

    xs = x2d[row_tok].reshape(n_blocks, EXPERT_BLOCK, d)

    def run_block(args):
        xb, e = args
        return expert_ffn(xb, w_gu[e], b_gu[e], w_dn[e], b_dn[e])

    ys = lax.map(run_block, (xs, block_expert)).reshape(n_pad, d)
    assign_row = jnp.zeros((n_assign,), jnp.int32).at[order].set(dest)
    y = ys[assign_row].reshape(n_tok, TOP_K, d)
    out = jnp.einsum("tk,tkd->td", gates.astype(y.dtype), y)
    return out.reshape(bsz, seq, d)


def setup_inputs(seed: int = 0) -> dict:
    key = jax.random.key(seed)
    keys = iter(jax.random.split(key, 32))

    def nrm(shape, scale):
        return scale * jax.random.normal(next(keys), shape, jnp.float32)

    d, f = D_MODEL, EXPERT_DIM
    return {
        "x": nrm((BATCH, SEQ, d), 1.0),
        "pool_w": nrm((N_POOL_LAYERS, N_POOL_GROUPS, POOL_GROUP_DIM, POOL_GROUP_DIM),
                      DEEPNORM_BETA * POOL_GROUP_DIM ** -0.5),
        "pool_scale": 1.0 + nrm((N_POOL_LAYERS, d), 0.1),
        "sc_w_in": nrm((N_SC_LAYERS, d, 3 * d), d ** -0.5),
        "sc_conv_w": nrm((N_SC_LAYERS, SHORT_CONV_WIDTH, d), SHORT_CONV_WIDTH ** -0.5),
        "sc_w_out": nrm((N_SC_LAYERS, d, d), DEEPNORM_BETA * d ** -0.5),
        "cf_w_in": nrm((N_CF_LAYERS, d, 2 * d), d ** -0.5),
        "cf_b_in": nrm((N_CF_LAYERS, 2 * d), 0.02),
        "cf_dw_w": nrm((N_CF_LAYERS, CONFORMER_KERNEL, d), CONFORMER_KERNEL ** -0.5),
        "cf_dw_b": nrm((N_CF_LAYERS, d), 0.02),
        "cf_ln_g": 1.0 + nrm((N_CF_LAYERS, d), 0.02),
        "cf_ln_b": nrm((N_CF_LAYERS, d), 0.02),
        "cf_w_out": nrm((N_CF_LAYERS, d, d), DEEPNORM_BETA * d ** -0.5),
        "cf_b_out": nrm((N_CF_LAYERS, d), 0.02),
        "mix_ln_g": 1.0 + nrm((DEPTH, d), 0.02),
        "mix_ln_b": nrm((DEPTH, d), 0.02),
        "router_w": nrm((DEPTH, d, N_EXPERTS), d ** -0.5),
        "router_b": nrm((DEPTH, N_EXPERTS), 0.01),
        "moe_w_gu": nrm((DEPTH, N_EXPERTS, d, 2 * f), d ** -0.5),
        "moe_b_gu": nrm((DEPTH, N_EXPERTS, 2 * f), 0.02),
        "moe_w_dn": nrm((DEPTH, N_EXPERTS, f, d), DEEPNORM_BETA * f ** -0.5),
        "moe_b_dn": nrm((DEPTH, N_EXPERTS, d), 0.02),
        "ffn_ln_g": 1.0 + nrm((DEPTH, d), 0.02),
        "ffn_ln_b": nrm((DEPTH, d), 0.02),
    }


def reference(x, pool_w, pool_scale, sc_w_in, sc_conv_w, sc_w_out,
              cf_w_in, cf_b_in, cf_dw_w, cf_dw_b, cf_ln_g, cf_ln_b, cf_w_out, cf_b_out,
              mix_ln_g, mix_ln_b, router_w, router_b, moe_w_gu, moe_b_gu, moe_w_dn, moe_b_dn,
              ffn_ln_g, ffn_ln_b):
    ia, ib, ic = 0, 0, 0
    for layer in range(DEPTH):
        kind = layer % N_MIXERS
        if kind == 0:
            h = pool_mixer(x, pool_w[ia], pool_scale[ia])
            ia += 1
        elif kind == 1:
            h = short_conv_mixer(x, sc_w_in[ib], sc_conv_w[ib], sc_w_out[ib])
            ib += 1
        else:
            h = conformer_conv_mixer(x, cf_w_in[ic], cf_b_in[ic], cf_dw_w[ic], cf_dw_b[ic],
                                     cf_ln_g[ic], cf_ln_b[ic], cf_w_out[ic], cf_b_out[ic])
            ic += 1
        x = layer_norm(DEEPNORM_ALPHA * x + h, mix_ln_g[layer], mix_ln_b[layer])
        h = moe_ffn(x, router_w[layer], router_b[layer], moe_w_gu[layer], moe_b_gu[layer],
                    moe_w_dn[layer], moe_b_dn[layer])
        x = layer_norm(DEEPNORM_ALPHA * x + h, ffn_ln_g[layer], ffn_ln_b[layer])
    return x
```

```cpp
#include <hip/hip_runtime.h>
#include <cstdio>
#include <cstdint>

#define GAS __attribute__((address_space(1)))
#define LAS __attribute__((address_space(3)))
typedef unsigned short bf16;
typedef unsigned v4u __attribute__((ext_vector_type(4)));
typedef unsigned v2u __attribute__((ext_vector_type(2)));
typedef float f32x4 __attribute__((ext_vector_type(4)));
typedef short bf16x8 __attribute__((ext_vector_type(8)));

template <class V> __device__ __forceinline__ V gld(const void* p) { return *(const GAS V*)p; }
template <class V> __device__ __forceinline__ void gst(void* p, V v) { *(GAS V*)p = v; }

constexpr int T = 32768, D = 1024, SEQ = 4096, NE = 32, TOPK = 4, NA = T * TOPK, DEPTH = 4;
constexpr int MAXTILES = NA / 256 + NE;
constexpr int NPAD = MAXTILES * 256;
constexpr float LN_EPS = 1e-5f;
constexpr float ALPHA = 1.681792830507429f;
constexpr int NWAVES = 8, NTHR = 512;
constexpr int MAXU = 17;

constexpr size_t MiB = 1u << 20;
constexpr size_t WS_CTL = 0, CTL_ZERO_BYTES = 1 * MiB;
constexpr size_t WS_IDX = 1 * MiB;
constexpr size_t WS_GATE = 1 * MiB + 512 * 1024;
constexpr size_t WS_RTOK = 2 * MiB;
constexpr size_t WS_RDST = 3 * MiB;
constexpr size_t WS_RGATE = 4 * MiB;
constexpr size_t WS_WPOOL = 5 * MiB;
constexpr size_t WS_WSCIN = 6 * MiB;
constexpr size_t WS_WSCOUT = 12 * MiB;
constexpr size_t WS_WCFIN = 14 * MiB;
constexpr size_t WS_WCFOUT = 18 * MiB;
constexpr size_t WS_WGU = 32 * MiB;
constexpr size_t WS_WDN = 544 * MiB;
constexpr size_t WS_XB = 800 * MiB;
constexpr size_t WS_ZB = 928 * MiB;
constexpr size_t WS_XAB = 1056 * MiB;
constexpr size_t WS_X1B = 1120 * MiB;
constexpr size_t WS_M1 = 1184 * MiB;
constexpr size_t WS_M2 = 1248 * MiB;
constexpr size_t WS_M3 = 1312 * MiB;
constexpr size_t WS_ACT = 1376 * MiB;
constexpr size_t WS_Y = 1648 * MiB;
constexpr size_t WS_END = 1904 * MiB;
constexpr int CW_BAR = 4096;
constexpr int CW_CNT = 8192;
constexpr int CW_CUR = 8192 + 256;

constexpr int RING_OFF = 0, RING_BYTES = 131072;
constexpr int TOK_OFF = RING_BYTES;
constexpr int UT_OFF = TOK_OFF + MAXU * 1024;
constexpr int TS_OFF = UT_OFF + (MAXU + 1) * 16;
constexpr int MISC_OFF = TS_OFF + 36 * 4;
constexpr int LDS_BYTES = MISC_OFF + 128 * 4;
static_assert(LDS_BYTES <= 160 * 1024 && (MISC_OFF % 16) == 0, "LDS map");

#define LDS_WAIT() asm volatile("s_waitcnt lgkmcnt(0)" ::: "memory")
#define VM_WAIT() asm volatile("s_waitcnt vmcnt(0)" ::: "memory")

__device__ __forceinline__ unsigned cvt_pk_bf16(float lo, float hi) { unsigned r; asm volatile("v_cvt_pk_bf16_f32 %0, %1, %2" : "=v"(r) : "v"(lo), "v"(hi)); return r; }
__device__ __forceinline__ float bf_lo(unsigned u) { return __uint_as_float(u << 16); }
__device__ __forceinline__ float bf_hi(unsigned u) { return __uint_as_float(u & 0xffff0000u); }
__device__ __forceinline__ float sigmoidf_(float x) { return __builtin_amdgcn_rcpf(1.0f + __expf(-x)); }
__device__ __forceinline__ float wave_sum(float v) {
#pragma unroll
    for (int o = 1; o < 64; o <<= 1) v += __shfl_xor(v, o);
    return v;
}

#define XB_TMO      128
#define XB_XCNT(j)  (256  + 64 * (j))
#define XB_XSUB(j)  (1280 + 64 * (j))
#define XB_XGEN(j)  (2304 + 64 * (j))
#define XB_TOP      3328
#define XB_TOPGEN   3392
#define XCD_BAR_WORDS 3456
#define XB_SPIN_CAP (1u << 18)

__device__ __forceinline__ unsigned xb_ld(unsigned* p)              { return __hip_atomic_load((GAS unsigned*)p, __ATOMIC_RELAXED, __HIP_MEMORY_SCOPE_AGENT); }
__device__ __forceinline__ unsigned xb_add(unsigned* p, unsigned v) { return __hip_atomic_fetch_add((GAS unsigned*)p, v, __ATOMIC_RELAXED, __HIP_MEMORY_SCOPE_AGENT); }
__device__ __forceinline__ unsigned xb_xcc_id() { return (unsigned)__builtin_amdgcn_s_getreg((3 << 11) | 20) & 0xFu; }
#define XB_SPIN(cond, bar) do { unsigned _sp = 0; while (cond) { __builtin_amdgcn_s_sleep(1); \
    if ((++_sp & 255u) == 0u) { if (xb_ld(&(bar)[XB_TMO])) break; if (_sp > XB_SPIN_CAP) { (void)xb_add(&(bar)[XB_TMO], 1u); break; } } } } while (0)

struct XcdBarrier { unsigned* bar; unsigned x; volatile LAS unsigned* st; };

__device__ __forceinline__ XcdBarrier xcd_barrier_post(unsigned* bar, volatile LAS unsigned* st) {
    XcdBarrier b; b.bar = bar; b.x = xb_xcc_id(); b.st = st;
    if (threadIdx.x == 0) (void)xb_add(&bar[XB_XCNT(b.x)], 1u);
    return b;
}
__device__ __forceinline__ void xcd_barrier_complete(unsigned* bar, unsigned x, unsigned& nloc, unsigned& nx) {
    const unsigned G = gridDim.x * gridDim.y * gridDim.z;
    unsigned sum, cnt, mine, sp = 0u;
    for (;;) {
        sum = 0u; cnt = 0u; mine = 0u;
#pragma unroll
        for (unsigned j = 0; j < 16; ++j) { const unsigned c = xb_ld(&bar[XB_XCNT(j)]); sum += c; cnt += (c > 0u) ? 1u : 0u; mine = (j == x) ? c : mine; }
        if (sum == G) break;
        __builtin_amdgcn_s_sleep(1);
        if ((++sp & 255u) == 0u) { if (xb_ld(&bar[XB_TMO])) break; if (sp > XB_SPIN_CAP) { (void)xb_add(&bar[XB_TMO], 1u); break; } }
    }
    nloc = mine > 0u ? mine : 1u; nx = cnt > 0u ? cnt : 1u;
}
__device__ __forceinline__ void xcd_barrier(const XcdBarrier& b) {
    asm volatile("s_waitcnt vmcnt(0)" ::: "memory");
    __syncthreads();
    if (threadIdx.x == 0) {
        unsigned* bar = b.bar;
        __builtin_amdgcn_s_waitcnt(0);
        unsigned nloc = b.st[0], nx = b.st[1];
        if (nloc == 0u) { xcd_barrier_complete(bar, b.x, nloc, nx); b.st[0] = nloc; b.st[1] = nx; }
        const unsigned old = xb_add(&bar[XB_XSUB(b.x)], 1u);
        const unsigned gen = old / nloc;
        if (old + 1u == (gen + 1u) * nloc) {
            __builtin_amdgcn_fence(__ATOMIC_RELEASE, "agent");
            asm volatile("s_waitcnt vmcnt(0)" ::: "memory");
            const unsigned og = xb_add(&bar[XB_TOP], 1u);
            const unsigned tg = og / nx;
            if (og + 1u == (tg + 1u) * nx) xb_add(&bar[XB_TOPGEN], 1u);
            else XB_SPIN(xb_ld(&bar[XB_TOPGEN]) == tg, bar);
            __builtin_amdgcn_fence(__ATOMIC_ACQUIRE, "agent");
            xb_add(&bar[XB_XGEN(b.x)], 1u);
            asm volatile("s_waitcnt vmcnt(0)" ::: "memory");
        } else {
            XB_SPIN(xb_ld(&bar[XB_XGEN(b.x)]) == gen, bar);
            __builtin_amdgcn_fence(__ATOMIC_ACQUIRE, "agent");
            asm volatile("s_waitcnt vmcnt(0)" ::: "memory");
        }
    }
    __syncthreads();
}

namespace pg8 {
constexpr int BM = 256, BK = 64, HALF = 128, HTB = HALF * BK * 2, STAGE_BYTES = 8 * HTB, NXCD = 8, WGM = 8;
__host__ __device__ __forceinline__ int lds_byte(int r, int c) { const int st = (r >> 4) * 2 + (c >> 5), rr = r & 15, cc = c & 31, ob = rr * 64 + cc * 2; return st * 1024 + (ob ^ (((ob >> 9) & 1) << 5)); }
__host__ __device__ __forceinline__ void stage_rc(int b, int& R, int& C) { const int st = b / 1024, sb = b % 1024, swz = sb ^ (((sb >> 9) & 1) << 5); R = (st >> 1) * 16 + swz / 64; C = (st & 1) * 32 + (swz % 64) / 2; }
__host__ __device__ __forceinline__ int perm32(int rho) { const int n = rho >> 4, i = rho & 15; return 8 * (i >> 2) + 4 * n + (i & 3); }

struct Unit { int pm, pn, e; };
struct GemmP {
    const char* A; unsigned lda2;
    unsigned acol_pn;
    const char* Bt; size_t b_estride;
    int K;
};

__device__ __forceinline__ void unit_of(int L, int nM, int nN, int& pm, int& pn) {
    const int nwg = nM * nN;
    int wgid = L; { const int q = nwg / NXCD, r = nwg % NXCD, xcd = wgid % NXCD, off = wgid / NXCD; wgid = (xcd < r ? xcd * (q + 1) : r * (q + 1) + (xcd - r) * q) + off; }
    const int nig = WGM * nN, gid = wgid / nig, fm = gid * WGM, gsz = (nM - fm) < WGM ? (nM - fm) : WGM;
    pm = fm + ((wgid % nig) % gsz); pn = (wgid % nig) / gsz;
}
__device__ __forceinline__ int build_units(LAS unsigned char* lds, const int tid, int nM, int nN, int G, int c, bool moe, const int* row_tok) {
    LAS int* UT = (LAS int*)(lds + UT_OFF); LAS const int* TS = (LAS const int*)(lds + TS_OFF); LAS int* TOK = (LAS int*)(lds + TOK_OFF);
    const int nwg = nM * nN;
    int n_my = (nwg > c) ? (nwg - c + G - 1) / G : 0; if (n_my > MAXU) n_my = MAXU;
    if (tid < n_my) {
        int pm, pn; unit_of(tid * G + c, nM, nN, pm, pn);
        int e = 0; if (moe) { while (e < NE - 1 && TS[e + 1] <= pm) ++e; }
        UT[4 * tid + 0] = pm; UT[4 * tid + 1] = pn; UT[4 * tid + 2] = e; UT[4 * tid + 3] = 0;
    }
    __syncthreads();
    if (row_tok) {
        for (int idx = tid; idx < n_my * 256; idx += NTHR) { const int i = idx >> 8, r = idx & 255; TOK[idx] = gld<int>(row_tok + UT[4 * i] * 256 + r); }
    }
    __syncthreads();
    return n_my;
}
__device__ __forceinline__ Unit read_unit(LAS const int* UT, int i) {
    Unit u; u.pm = __builtin_amdgcn_readfirstlane(UT[4 * i]); u.pn = __builtin_amdgcn_readfirstlane(UT[4 * i + 1]); u.e = __builtin_amdgcn_readfirstlane(UT[4 * i + 2]); return u;
}
template <bool GATHER>
__device__ __forceinline__ void a_offsets(unsigned (&v)[2][2], const GemmP& g, const Unit& u, int ui, const int (&Rr)[2], const int (&Cc2)[2], LAS const int* TOK) {
#pragma unroll
    for (int h = 0; h < 2; ++h)
#pragma unroll
        for (int i = 0; i < 2; ++i) {
            const int row = GATHER ? TOK[ui * 256 + h * HALF + Rr[i]] : (u.pm * BM + h * HALF + Rr[i]);
            v[h][i] = (unsigned)row * g.lda2 + (unsigned)Cc2[i] + (unsigned)u.pn * g.acol_pn;
        }
}

template <bool GATHER, class Epi>
__device__ __forceinline__ void gemm_phase(LAS unsigned char* lds, const int tid, const GemmP g, const int n_my, const Epi& E) {
    const int wid = __builtin_amdgcn_readfirstlane(tid >> 6), lane = tid & 63, wr = wid >> 2, wc = wid & 3, fr = lane & 15, fq = lane >> 4;
    const int K = g.K, nt = K / BK;
    if (n_my <= 0) return;
    int Rr[2], Cc2[2]; unsigned voffB[2];
#pragma unroll
    for (int i = 0; i < 2; ++i) { int R, C; stage_rc(tid * 16 + i * 8192, R, C); const int Rb = Epi::PERM ? ((R & ~31) + perm32(R & 31)) : R;
        Rr[i] = R; Cc2[i] = C * 2; voffB[i] = (unsigned)(Rb * K + C) * 2u; }
    const size_t kstep = (size_t)(BK * 2);
    const size_t hstep = (size_t)HALF * K * 2;
    const size_t tstepB = 2 * hstep;
    const unsigned ldsw = (unsigned)wid * 1024u;
    const int aoff = lds_byte(wr * 64 + fr, fq * 8), boff = lds_byte(wc * 32 + fr, fq * 8);
    LAS const int* UT = (LAS const int*)(lds + UT_OFF); LAS const int* TOK = (LAS const int*)(lds + TOK_OFF);
#define PG8_SA(b, h) (((b) * 2 + (h)) * HTB)
#define PG8_SB(b, h) ((4 + (b) * 2 + (h)) * HTB)
#define PG8_STAGE(bufoff, gbase, voff) do { _Pragma("unroll") for (int _i = 0; _i < 2; ++_i) \
        __builtin_amdgcn_global_load_lds((const unsigned*)((const char*)(gbase) + (voff)[_i]), (LAS unsigned*)(lds + (bufoff) + ldsw + _i * 8192), 16, 0, 0); } while (0)
#define PG8_LDA(dst, b, h) do { _Pragma("unroll") for (int m = 0; m < 4; ++m) _Pragma("unroll") for (int k = 0; k < 2; ++k) dst[m][k] = *(const LAS bf16x8*)(lds + PG8_SA(b, h) + aoff + m * 2048 + k * 1024); } while (0)
#define PG8_LDB(dst, b, h) do { _Pragma("unroll") for (int n = 0; n < 2; ++n) _Pragma("unroll") for (int k = 0; k < 2; ++k) dst[n][k] = *(const LAS bf16x8*)(lds + PG8_SB(b, h) + boff + n * 2048 + k * 1024); } while (0)
#define PG8_MMA(ai, bj, At, Bt) do { __builtin_amdgcn_s_setprio(1); _Pragma("unroll") for (int m = 0; m < 4; ++m) _Pragma("unroll") for (int n = 0; n < 2; ++n) _Pragma("unroll") for (int k = 0; k < 2; ++k) \
        acc[ai][bj][m][n] = __builtin_amdgcn_mfma_f32_16x16x32_bf16(Bt[n][k], At[m][k], acc[ai][bj][m][n], 0, 0, 0); __builtin_amdgcn_s_setprio(0); } while (0)
#define PG8_WAIT_V(n) asm volatile("s_waitcnt vmcnt(" #n ")" ::: "memory")
#define PG8_WAIT_L(n) asm volatile("s_waitcnt lgkmcnt(" #n ")" ::: "memory")
#define PG8_BAR __builtin_amdgcn_s_barrier()
#define PG8_SCHED __builtin_amdgcn_sched_barrier(0)
    Unit cur = read_unit(UT, 0), nxt; int ui = 0;
    f32x4 acc[2][2][4][2];
#pragma unroll
    for (int a = 0; a < 2; ++a)
#pragma unroll
        for (int b = 0; b < 2; ++b)
#pragma unroll
            for (int m = 0; m < 4; ++m)
#pragma unroll
                for (int n = 0; n < 2; ++n) acc[a][b][m][n] = (f32x4){0.f, 0.f, 0.f, 0.f};
    bf16x8 At[4][2], B0[2][2], B1[2][2];
    unsigned vAc[2][2], vAn[2][2];
    a_offsets<GATHER>(vAc, g, cur, 0, Rr, Cc2, TOK);
    const char* const Ab = g.A;
    const char* cB = g.Bt + (size_t)cur.e * g.b_estride + (size_t)cur.pn * tstepB;
    PG8_STAGE(PG8_SB(0, 0), cB, voffB); PG8_STAGE(PG8_SB(0, 1), cB + hstep, voffB); PG8_STAGE(PG8_SA(0, 0), Ab, vAc[0]); PG8_STAGE(PG8_SA(0, 1), Ab, vAc[1]);
    if (wr == 1) PG8_BAR;
    PG8_WAIT_V(2); PG8_BAR;
    PG8_STAGE(PG8_SB(1, 0), cB + kstep, voffB); PG8_STAGE(PG8_SA(1, 0), Ab + kstep, vAc[0]); PG8_STAGE(PG8_SB(1, 1), cB + hstep + kstep, voffB);
    PG8_WAIT_V(6); PG8_BAR;
    for (;;) {
        const bool has_next = (ui + 1 < n_my);
        nxt = cur; if (has_next) nxt = read_unit(UT, ui + 1);
        const char* nB = has_next ? g.Bt + (size_t)nxt.e * g.b_estride + (size_t)nxt.pn * tstepB : cB;
        for (int t = 0; t < nt; t += 2) {
            const bool last = (t == nt - 2);
            const char* a1 = Ab + (size_t)(t + 1) * kstep;
            const char* a2 = last ? Ab : Ab + (size_t)(t + 2) * kstep; const char* b2 = last ? nB : cB + (size_t)(t + 2) * kstep;
            const char* a3 = a2 + kstep; const char* b3 = b2 + kstep;
            unsigned o2[2][2];
            if (last) {
                if (has_next) a_offsets<GATHER>(vAn, g, nxt, ui + 1, Rr, Cc2, TOK);
                else { vAn[0][0] = vAc[0][0]; vAn[0][1] = vAc[0][1]; vAn[1][0] = vAc[1][0]; vAn[1][1] = vAc[1][1]; }
                o2[0][0] = vAn[0][0]; o2[0][1] = vAn[0][1]; o2[1][0] = vAn[1][0]; o2[1][1] = vAn[1][1];
            } else { o2[0][0] = vAc[0][0]; o2[0][1] = vAc[0][1]; o2[1][0] = vAc[1][0]; o2[1][1] = vAc[1][1]; }
            PG8_LDB(B0, 0, 0); PG8_LDB(B1, 0, 1); PG8_SCHED; PG8_LDA(At, 0, 0); PG8_STAGE(PG8_SA(1, 1), a1, vAc[1]);
            PG8_WAIT_V(8); PG8_WAIT_L(0); PG8_BAR; PG8_MMA(0, 0, At, B0); PG8_MMA(0, 1, At, B1); PG8_BAR; PG8_SCHED;
            PG8_LDA(At, 0, 1); PG8_STAGE(PG8_SB(0, 0), b2, voffB); PG8_STAGE(PG8_SB(0, 1), b2 + hstep, voffB); PG8_STAGE(PG8_SA(0, 0), a2, o2[0]);
            PG8_WAIT_V(8); PG8_WAIT_L(0); PG8_BAR; PG8_MMA(1, 0, At, B0); PG8_MMA(1, 1, At, B1); PG8_BAR; PG8_SCHED;
            PG8_LDB(B0, 1, 0); PG8_LDB(B1, 1, 1); PG8_SCHED; PG8_LDA(At, 1, 0); PG8_STAGE(PG8_SA(0, 1), a2, o2[1]);
            PG8_WAIT_V(8); PG8_WAIT_L(0); PG8_BAR; PG8_MMA(0, 0, At, B0); PG8_MMA(0, 1, At, B1); PG8_BAR; PG8_SCHED;
            PG8_LDA(At, 1, 1); PG8_STAGE(PG8_SB(1, 0), b3, voffB); PG8_STAGE(PG8_SB(1, 1), b3 + hstep, voffB); PG8_STAGE(PG8_SA(1, 0), a3, o2[0]);
            PG8_WAIT_V(8); PG8_WAIT_L(0); PG8_BAR; PG8_MMA(1, 0, At, B0); PG8_MMA(1, 1, At, B1); PG8_BAR; PG8_SCHED;
        }
        if (wr == 0) PG8_BAR;
        E(acc, cur, wr, wc, fr, fq);
        if (!has_next) break;
#pragma unroll
        for (int a = 0; a < 2; ++a)
#pragma unroll
            for (int b = 0; b < 2; ++b)
#pragma unroll
                for (int m = 0; m < 4; ++m)
#pragma unroll
                    for (int n = 0; n < 2; ++n) acc[a][b][m][n] = (f32x4){0.f, 0.f, 0.f, 0.f};
        cur = nxt; cB = nB; ++ui;
        vAc[0][0] = vAn[0][0]; vAc[0][1] = vAn[0][1]; vAc[1][0] = vAn[1][0]; vAc[1][1] = vAn[1][1];
        if (wr == 1) PG8_BAR;
    }
    PG8_WAIT_V(0);
    PG8_BAR;
#undef PG8_SA
#undef PG8_SB
#undef PG8_STAGE
#undef PG8_LDA
#undef PG8_LDB
#undef PG8_MMA
#undef PG8_WAIT_V
#undef PG8_WAIT_L
#undef PG8_BAR
#undef PG8_SCHED
}

struct EpiOut {
    static constexpr bool PERM = false;
    const float* xin; float* z; const float* bias; const float* scale;
    __device__ __forceinline__ void operator()(const f32x4 (&acc)[2][2][4][2], const Unit& u, int wr, int wc, int fr, int fq) const {
        const int row0 = u.pm * BM + wr * 64 + fr, col0 = u.pn * BM + wc * 32 + 4 * fq;
        f32x4 bv[2][2], sv[2][2];
#pragma unroll
        for (int bj = 0; bj < 2; ++bj)
#pragma unroll
            for (int n = 0; n < 2; ++n) {
                bv[bj][n] = bias ? gld<f32x4>(bias + col0 + bj * HALF + n * 16) : (f32x4){0.f, 0.f, 0.f, 0.f};
                sv[bj][n] = scale ? gld<f32x4>(scale + col0 + bj * HALF + n * 16) : (f32x4){1.f, 1.f, 1.f, 1.f};
            }
#pragma unroll
        for (int ai = 0; ai < 2; ++ai)
#pragma unroll
            for (int m = 0; m < 4; ++m) { const size_t off = (size_t)(row0 + ai * HALF + m * 16) * D + col0;
#pragma unroll
                for (int bj = 0; bj < 2; ++bj)
#pragma unroll
                    for (int n = 0; n < 2; ++n) { const f32x4 xi = gld<f32x4>(xin + off + bj * HALF + n * 16);
                        gst<f32x4>(z + off + bj * HALF + n * 16, xi * ALPHA + (acc[ai][bj][m][n] + bv[bj][n]) * sv[bj][n]); }
                asm volatile("" ::: "memory"); }
    }
};
struct EpiPair {
    static constexpr bool PERM = true;
    bf16* O1; bf16* O2; const float* bias; int mode;
    __device__ __forceinline__ void operator()(const f32x4 (&acc)[2][2][4][2], const Unit& u, int wr, int wc, int fr, int fq) const {
        const int row0 = u.pm * BM + wr * 64 + fr;
        if (u.pn < 8) {
            const int j0 = u.pn * HALF + wc * 32 + 8 * fq;
            f32x4 b1[2], b2[2];
#pragma unroll
            for (int n = 0; n < 2; ++n) { b1[n] = mode ? gld<f32x4>(bias + j0 + 4 * n) : (f32x4){0.f, 0.f, 0.f, 0.f}; b2[n] = mode ? gld<f32x4>(bias + 1024 + j0 + 4 * n) : (f32x4){0.f, 0.f, 0.f, 0.f}; }
#pragma unroll
            for (int ai = 0; ai < 2; ++ai)
#pragma unroll
                for (int m = 0; m < 4; ++m) { bf16* rowp = O1 + (size_t)(row0 + ai * HALF + m * 16) * D + j0; f32x4 r[2];
#pragma unroll
                    for (int n = 0; n < 2; ++n) { const f32x4 g1 = acc[ai][0][m][n] + b1[n], g2 = acc[ai][1][m][n] + b2[n];
                        if (mode) { r[n][0] = g1[0] * sigmoidf_(g2[0]); r[n][1] = g1[1] * sigmoidf_(g2[1]); r[n][2] = g1[2] * sigmoidf_(g2[2]); r[n][3] = g1[3] * sigmoidf_(g2[3]); }
                        else r[n] = g1 * g2; }
                    v4u w; w.x = cvt_pk_bf16(r[0][0], r[0][1]); w.y = cvt_pk_bf16(r[0][2], r[0][3]); w.z = cvt_pk_bf16(r[1][0], r[1][1]); w.w = cvt_pk_bf16(r[1][2], r[1][3]);
                    gst<v4u>(rowp, w); }
        } else {
            const int c0 = (u.pn - 8) * BM + wc * 32 + 8 * fq;
#pragma unroll
            for (int ai = 0; ai < 2; ++ai)
#pragma unroll
                for (int m = 0; m < 4; ++m) { bf16* rowp = O2 + (size_t)(row0 + ai * HALF + m * 16) * D + c0;
#pragma unroll
                    for (int bj = 0; bj < 2; ++bj) { const f32x4 v0 = acc[ai][bj][m][0], v1 = acc[ai][bj][m][1];
                        v4u w; w.x = cvt_pk_bf16(v0[0], v0[1]); w.y = cvt_pk_bf16(v0[2], v0[3]); w.z = cvt_pk_bf16(v1[0], v1[1]); w.w = cvt_pk_bf16(v1[2], v1[3]);
                        gst<v4u>(rowp + bj * HALF, w); } }
        }
    }
};
struct EpiSwiglu {
    static constexpr bool PERM = true;
    bf16* act; const float* bgu;
    __device__ __forceinline__ void operator()(const f32x4 (&acc)[2][2][4][2], const Unit& u, int wr, int wc, int fr, int fq) const {
        const int row0 = u.pm * BM + wr * 64 + fr, j0 = u.pn * HALF + wc * 32 + 8 * fq;
        const float* bp = bgu + (size_t)u.e * 2048 + 2 * j0;
        float gb[8], ub[8];
#pragma unroll
        for (int i = 0; i < 4; ++i) { const f32x4 b = gld<f32x4>(bp + 4 * i); gb[2 * i] = b[0]; ub[2 * i] = b[1]; gb[2 * i + 1] = b[2]; ub[2 * i + 1] = b[3]; }
#pragma unroll
        for (int ai = 0; ai < 2; ++ai)
#pragma unroll
            for (int m = 0; m < 4; ++m) { bf16* rowp = act + (size_t)(row0 + ai * HALF + m * 16) * D + j0; float r[8];
#pragma unroll
                for (int n = 0; n < 2; ++n)
#pragma unroll
                    for (int q = 0; q < 4; ++q) { const int j = 4 * n + q;
                        const float gg = fminf(acc[ai][0][m][n][q] + gb[j], 7.0f);
                        const float uu = fminf(fmaxf(acc[ai][1][m][n][q] + ub[j], -7.0f), 7.0f);
                        r[j] = (uu + 1.0f) * (gg * sigmoidf_(1.702f * gg)); }
                v4u w; w.x = cvt_pk_bf16(r[0], r[1]); w.y = cvt_pk_bf16(r[2], r[3]); w.z = cvt_pk_bf16(r[4], r[5]); w.w = cvt_pk_bf16(r[6], r[7]);
                gst<v4u>(rowp, w); }
    }
};
struct EpiMoe2 {
    static constexpr bool PERM = true;
    bf16* Y; const float* bdn; const int* rowdst; const float* rowgate;
    __device__ __forceinline__ void operator()(const f32x4 (&acc)[2][2][4][2], const Unit& u, int wr, int wc, int fr, int fq) const {
        const int pos0 = u.pm * BM + wr * 64 + fr, c0 = u.pn * BM + wc * 32 + 8 * fq;
        const float* bp = bdn + (size_t)u.e * D + c0;
        f32x4 bv[2][2];
#pragma unroll
        for (int bj = 0; bj < 2; ++bj)
#pragma unroll
            for (int n = 0; n < 2; ++n) bv[bj][n] = gld<f32x4>(bp + bj * HALF + 4 * n);
        int dst[2][4]; float gt[2][4];
#pragma unroll
        for (int ai = 0; ai < 2; ++ai)
#pragma unroll
            for (int m = 0; m < 4; ++m) { const int pos = pos0 + ai * HALF + m * 16; dst[ai][m] = gld<int>(rowdst + pos); gt[ai][m] = gld<float>(rowgate + pos); }
#pragma unroll
        for (int ai = 0; ai < 2; ++ai)
#pragma unroll
            for (int m = 0; m < 4; ++m) {
                if (dst[ai][m] >= 0) { bf16* rowp = Y + (size_t)dst[ai][m] * D + c0; const float s = gt[ai][m];
#pragma unroll
                    for (int bj = 0; bj < 2; ++bj) { const f32x4 v0 = (acc[ai][bj][m][0] + bv[bj][0]) * s, v1 = (acc[ai][bj][m][1] + bv[bj][1]) * s;
                        v4u w; w.x = cvt_pk_bf16(v0[0], v0[1]); w.y = cvt_pk_bf16(v0[2], v0[3]); w.z = cvt_pk_bf16(v1[0], v1[1]); w.w = cvt_pk_bf16(v1[2], v1[3]);
                        gst<v4u>(rowp + bj * HALF, w); } } }
    }
};
}

__device__ __forceinline__ int chq(int lane, int q) { return (q >> 1) * 512 + 8 * lane + (q & 1) * 4; }
__device__ __forceinline__ v4u pack8(const float* v) { v4u w; w.x = cvt_pk_bf16(v[0], v[1]); w.y = cvt_pk_bf16(v[2], v[3]); w.z = cvt_pk_bf16(v[4], v[5]); w.w = cvt_pk_bf16(v[6], v[7]); return w; }
__device__ __forceinline__ void unpack8(const v4u w, float* v) { v[0] = bf_lo(w.x); v[1] = bf_hi(w.x); v[2] = bf_lo(w.y); v[3] = bf_hi(w.y); v[4] = bf_lo(w.z); v[5] = bf_hi(w.z); v[6] = bf_lo(w.w); v[7] = bf_hi(w.w); }

__device__ __forceinline__ int drow_of(int mode, int c) {
    if (mode == 1) { const int j = c >> 1, p = c & 1; return (j >> 7) * 256 + p * 128 + (j & 127); }
    if (mode == 2) { if (c < 1024) return 2048 + c; const int j = (c - 1024) & 1023, p = (c - 1024) >> 10; return (j >> 7) * 256 + p * 128 + (j & 127); }
    if (mode == 3) { const int j = c & 1023, p = c >> 10; return (j >> 7) * 256 + p * 128 + (j & 127); }
    return c;
}
__device__ __forceinline__ void transpose_item(const float* W, int K, int N, bf16* WT, int mode, LAS float* scr, int item, int lane) {
    const int nblk = N / 32, kb = item / nblk, nb = item % nblk, k0 = 64 * kb, n0 = 32 * nb;
    float tmp[32];
#pragma unroll
    for (int i = 0; i < 32; ++i) { const int kk = 2 * i + (lane >> 5); tmp[i] = gld<float>(W + (size_t)(k0 + kk) * N + n0 + (lane & 31)); }
#pragma unroll
    for (int i = 0; i < 32; ++i) { const int kk = 2 * i + (lane >> 5); scr[kk * 33 + (lane & 31)] = tmp[i]; }
    LDS_WAIT(); asm volatile("" ::: "memory");
    const int c = lane & 7;
#pragma unroll
    for (int j = 0; j < 4; ++j) { const int n = (lane >> 3) + 8 * j; const LAS float* s = scr + (8 * c) * 33 + n;
        v4u o; o.x = cvt_pk_bf16(s[0 * 33], s[1 * 33]); o.y = cvt_pk_bf16(s[2 * 33], s[3 * 33]); o.z = cvt_pk_bf16(s[4 * 33], s[5 * 33]); o.w = cvt_pk_bf16(s[6 * 33], s[7 * 33]);
        gst<v4u>(WT + (size_t)drow_of(mode, n0 + n) * K + k0 + 8 * c, o); }
    LDS_WAIT(); asm volatile("" ::: "memory");
}

struct Args { const float* in[24]; float* out; unsigned char* ws; };

#define PHASE_BEGIN() \
    int tid = threadIdx.x; asm volatile("" : "+v"(tid)); \
    const int lane = tid & 63, wave = __builtin_amdgcn_readfirstlane(tid >> 6); \
    unsigned char* ws_ = args.ws; asm volatile("" : "+s"(ws_)); unsigned char* ws = (unsigned char*)(GAS unsigned char*)ws_; \
    unsigned* ctl = (unsigned*)(ws + WS_CTL); \
    const int gw = vcu * NWAVES + wave, NGW = G * NWAVES; (void)gw; (void)NGW; (void)lane; (void)ctl;

__global__ void __launch_bounds__(NTHR, 2) mega_fwd(Args args) {
    extern __shared__ __attribute__((aligned(16))) unsigned char lds_raw[];
    LAS unsigned char* lds = (LAS unsigned char*)lds_raw;
    volatile LAS unsigned* MISC = (volatile LAS unsigned*)(lds + MISC_OFF);
    const int G = gridDim.x, bx = blockIdx.x;
    const int vcu = (G % 8 == 0) ? (bx % 8) * (G / 8) + bx / 8 : bx;
    if (threadIdx.x < 128) MISC[threadIdx.x] = 0u;
    __syncthreads();
    (void)xcd_barrier_post((unsigned*)(args.ws + WS_CTL) + CW_BAR, MISC + 0);
#define GRID_BAR() do { XcdBarrier b_; unsigned* bp_ = (unsigned*)(args.ws + WS_CTL) + CW_BAR; asm volatile("" : "+s"(bp_)); b_.bar = (unsigned*)(GAS unsigned*)bp_; b_.x = xb_xcc_id(); b_.st = MISC; xcd_barrier(b_); } while (0)

    {
        PHASE_BEGIN();
        bf16* WPOOL = (bf16*)(ws + WS_WPOOL); bf16* WSCIN = (bf16*)(ws + WS_WSCIN); bf16* WSCOUT = (bf16*)(ws + WS_WSCOUT);
        bf16* WCFIN = (bf16*)(ws + WS_WCFIN); bf16* WCFOUT = (bf16*)(ws + WS_WCFOUT); bf16* WGU = (bf16*)(ws + WS_WGU); bf16* WDN = (bf16*)(ws + WS_WDN);
        LAS float* scr = (LAS float*)(lds + RING_OFF + wave * 16384);
        constexpr int I_GU = 16 * 64, I_DN = 16 * 32, I_POOL = 4 * 8, I_SCIN = 16 * 96, I_SQ = 16 * 32, I_CFIN = 16 * 64;
        constexpr int N_GU = 128 * I_GU, N_DN = 128 * I_DN, N_POOL = 8 * I_POOL;
        constexpr int NITEMS = N_GU + N_DN + N_POOL + I_SCIN + I_SQ + I_CFIN + I_SQ;
        for (int it = gw; it < NITEMS; it += NGW) {
            int r = it;
            if (r < N_GU) { const int mt = r / I_GU; transpose_item(args.in[18] + (size_t)mt * 1024 * 2048, 1024, 2048, WGU + (size_t)mt * 2048 * 1024, 1, scr, r % I_GU, lane); continue; } r -= N_GU;
            if (r < N_DN) { const int mt = r / I_DN; transpose_item(args.in[20] + (size_t)mt * 1024 * 1024, 1024, 1024, WDN + (size_t)mt * 1024 * 1024, 0, scr, r % I_DN, lane); continue; } r -= N_DN;
            if (r < N_POOL) { const int mt = r / I_POOL; transpose_item(args.in[1] + (size_t)mt * 256 * 256, 256, 256, WPOOL + (size_t)mt * 256 * 256, 0, scr, r % I_POOL, lane); continue; } r -= N_POOL;
            if (r < I_SCIN) { transpose_item(args.in[3], 1024, 3072, WSCIN, 2, scr, r, lane); continue; } r -= I_SCIN;
            if (r < I_SQ) { transpose_item(args.in[5], 1024, 1024, WSCOUT, 0, scr, r, lane); continue; } r -= I_SQ;
            if (r < I_CFIN) { transpose_item(args.in[6], 1024, 2048, WCFIN, 3, scr, r, lane); continue; } r -= I_CFIN;
            transpose_item(args.in[12], 1024, 1024, WCFOUT, 0, scr, r, lane);
        }
    }
    GRID_BAR();

    for (int layer = 0; layer < DEPTH; ++layer) {
        const int kind = layer % 3;

        if (kind == 0) {
            PHASE_BEGIN();
            const float* xin = (layer == 0) ? args.in[0] : (const float*)args.out;
            bf16* M3 = (bf16*)(ws + WS_M3);
            for (int t = gw; t < T; t += NGW) {
                const int s = t & (SEQ - 1);
#pragma unroll
                for (int g = 0; g < 4; ++g) {
                    const int w = 2 << g, c = 256 * g + 4 * lane;
                    const int nv = (s + 1 < w) ? s + 1 : w;
                    const f32x4 xt = gld<f32x4>(xin + (size_t)t * D + c);
                    f32x4 sum = xt;
                    for (int j = 1; j < nv; ++j) sum += gld<f32x4>(xin + (size_t)(t - j) * D + c);
                    const float inv = 1.0f / (float)nv;
                    const f32x4 df = sum * inv - xt;
                    v2u o; o.x = cvt_pk_bf16(df[0], df[1]); o.y = cvt_pk_bf16(df[2], df[3]);
                    gst<v2u>(M3 + (size_t)t * D + c, o);
                }
            }
        } else {
            {
                PHASE_BEGIN();
                bf16* M1 = (bf16*)(ws + WS_M1); bf16* M2 = (bf16*)(ws + WS_M2);
                const int nN = (kind == 1) ? 12 : 8;
                const int n_my = pg8::build_units(lds, tid, T / 256, nN, G, bx, false, nullptr);
                pg8::GemmP gp; gp.A = (const char*)(ws + WS_XAB); gp.lda2 = D * 2; gp.acol_pn = 0; gp.Bt = (const char*)(ws + ((kind == 1) ? WS_WSCIN : WS_WCFIN)); gp.b_estride = 0; gp.K = 1024;
                pg8::EpiPair E; E.O1 = (kind == 1) ? M2 : M1; E.O2 = M1; E.bias = args.in[7]; E.mode = (kind == 1) ? 0 : 1;
                pg8::gemm_phase<false, pg8::EpiPair>(lds, tid, gp, n_my, E);
            }
            GRID_BAR();
            if (kind == 1) {
                PHASE_BEGIN();
                const bf16* M1 = (const bf16*)(ws + WS_M1); const bf16* M2 = (const bf16*)(ws + WS_M2); bf16* M3 = (bf16*)(ws + WS_M3);
                const float* cw = args.in[4];
                float wk[3][16];
#pragma unroll
                for (int k = 0; k < 3; ++k)
#pragma unroll
                    for (int q = 0; q < 4; ++q) { const f32x4 v = gld<f32x4>(cw + k * D + chq(lane, q)); wk[k][4 * q] = v[0]; wk[k][4 * q + 1] = v[1]; wk[k][4 * q + 2] = v[2]; wk[k][4 * q + 3] = v[3]; }
                for (int t = gw; t < T; t += NGW) {
                    const int s = t & (SEQ - 1);
                    float acc[16];
#pragma unroll
                    for (int i = 0; i < 16; ++i) acc[i] = 0.f;
#pragma unroll
                    for (int k = 0; k < 3; ++k) {
                        if (s - 2 + k >= 0) {
#pragma unroll
                            for (int j = 0; j < 2; ++j) { float v[8]; unpack8(gld<v4u>(M2 + (size_t)(t - 2 + k) * D + j * 512 + 8 * lane), v);
#pragma unroll
                                for (int i = 0; i < 8; ++i) acc[8 * j + i] += wk[k][8 * j + i] * v[i]; }
                        }
                    }
#pragma unroll
                    for (int j = 0; j < 2; ++j) { float gb[8], o[8]; unpack8(gld<v4u>(M1 + (size_t)t * D + j * 512 + 8 * lane), gb);
#pragma unroll
                        for (int i = 0; i < 8; ++i) o[i] = gb[i] * acc[8 * j + i];
                        gst<v4u>(M3 + (size_t)t * D + j * 512 + 8 * lane, pack8(o)); }
                }
            } else {
                PHASE_BEGIN();
                const bf16* M1 = (const bf16*)(ws + WS_M1); bf16* M3 = (bf16*)(ws + WS_M3);
                LAS float* wl = (LAS float*)(lds + RING_OFF);
                const float* dw = args.in[8];
                for (int idx = tid; idx < 31 * 1024; idx += NTHR) { const int k = idx >> 10, c = idx & 1023; const int j = c >> 9, r = c & 511, l = r >> 3, q = 2 * j + ((r & 7) >> 2);
                    wl[((k * 4 + q) * 64 + l) * 4 + (c & 3)] = gld<float>(dw + idx); }
                __syncthreads();
                float db[16], lg[16], lb[16];
#pragma unroll
                for (int q = 0; q < 4; ++q) { const f32x4 a = gld<f32x4>(args.in[9] + chq(lane, q)), b = gld<f32x4>(args.in[10] + chq(lane, q)), c = gld<f32x4>(args.in[11] + chq(lane, q));
#pragma unroll
                    for (int i = 0; i < 4; ++i) { db[4 * q + i] = a[i]; lg[4 * q + i] = b[i]; lb[4 * q + i] = c[i]; } }
                for (int t = gw; t < T; t += NGW) {
                    const int s = t & (SEQ - 1);
                    float acc[16];
#pragma unroll
                    for (int i = 0; i < 16; ++i) acc[i] = db[i];
                    const int k0 = (s >= 30) ? 0 : 30 - s;
                    for (int k = k0; k < 31; ++k) {
                        const bf16* urow = M1 + (size_t)(t - 30 + k) * D;
                        float v[16]; unpack8(gld<v4u>(urow + 8 * lane), v); unpack8(gld<v4u>(urow + 512 + 8 * lane), v + 8);
#pragma unroll
                        for (int q = 0; q < 4; ++q) { const f32x4 w4 = *(const LAS f32x4*)(wl + ((k * 4 + q) * 64 + lane) * 4);
#pragma unroll
                            for (int i = 0; i < 4; ++i) acc[4 * q + i] += w4[i] * v[4 * q + i]; }
                    }
                    float sm = 0.f;
#pragma unroll
                    for (int i = 0; i < 16; ++i) sm += acc[i];
                    const float mean = wave_sum(sm) * (1.0f / D);
                    float sq = 0.f;
#pragma unroll
                    for (int i = 0; i < 16; ++i) { acc[i] -= mean; sq += acc[i] * acc[i]; }
                    const float rstd = 1.0f / sqrtf(wave_sum(sq) * (1.0f / D) + LN_EPS);
                    float o[16];
#pragma unroll
                    for (int i = 0; i < 16; ++i) { const float y = acc[i] * rstd * lg[i] + lb[i]; o[i] = y * sigmoidf_(y); }
                    gst<v4u>(M3 + (size_t)t * D + 8 * lane, pack8(o));
                    gst<v4u>(M3 + (size_t)t * D + 512 + 8 * lane, pack8(o + 8));
                }
                __syncthreads();
            }
        }
        GRID_BAR();

        {
            PHASE_BEGIN();
            const int n_my = pg8::build_units(lds, tid, T / 256, 4, G, bx, false, nullptr);
            pg8::GemmP gp; gp.A = (const char*)(ws + WS_M3); gp.lda2 = D * 2; gp.b_estride = 0;
            pg8::EpiOut E; E.xin = (layer == 0) ? args.in[0] : (const float*)args.out; E.z = (float*)(ws + WS_ZB); E.bias = nullptr; E.scale = nullptr;
            if (kind == 0) { gp.acol_pn = 512; gp.Bt = (const char*)(ws + WS_WPOOL + (size_t)(layer / 3) * 1024 * 256 * 2); gp.K = 256; E.scale = args.in[2] + (layer / 3) * D; }
            else if (kind == 1) { gp.acol_pn = 0; gp.Bt = (const char*)(ws + WS_WSCOUT); gp.K = 1024; }
            else { gp.acol_pn = 0; gp.Bt = (const char*)(ws + WS_WCFOUT); gp.K = 1024; E.bias = args.in[13]; }
            pg8::gemm_phase<false, pg8::EpiOut>(lds, tid, gp, n_my, E);
        }
        GRID_BAR();

        {
            PHASE_BEGIN();
            const float* ZB = (const float*)(ws + WS_ZB); float* XB = (float*)(ws + WS_XB); bf16* X1b = (bf16*)(ws + WS_X1B);
            int* TIDX = (int*)(ws + WS_IDX); float* TGATE = (float*)(ws + WS_GATE);
            unsigned* CNT = ctl + CW_CNT + layer * NE;
            LAS float* rwl = (LAS float*)(lds + RING_OFF);
            const float* rw = args.in[16] + (size_t)layer * D * NE;
            for (int idx = tid; idx < D * 8; idx += NTHR) { const int c = idx >> 3, eg = idx & 7; const int j = c >> 9, r = c & 511, l = r >> 3, ci = j * 8 + (r & 7);
                *(LAS f32x4*)(rwl + ((ci * 8 + eg) * 64 + l) * 4) = gld<f32x4>(rw + c * NE + eg * 4); }
            if (tid < NE) MISC[32 + tid] = 0u;
            __syncthreads();
            float lg[16], lb[16];
#pragma unroll
            for (int q = 0; q < 4; ++q) { const f32x4 b = gld<f32x4>(args.in[14] + layer * D + chq(lane, q)), c = gld<f32x4>(args.in[15] + layer * D + chq(lane, q));
#pragma unroll
                for (int i = 0; i < 4; ++i) { lg[4 * q + i] = b[i]; lb[4 * q + i] = c[i]; } }
            const float rbias = gld<float>(args.in[17] + layer * NE + ((lane >> 1) & 31));
            for (int tb = vcu; tb < T / 128; tb += G) {
                for (int ti = 0; ti < 16; ++ti) {
                    const int t = tb * 128 + wave * 16 + ti;
                    float v[16];
#pragma unroll
                    for (int q = 0; q < 4; ++q) { const f32x4 z = gld<f32x4>(ZB + (size_t)t * D + chq(lane, q)); v[4 * q] = z[0]; v[4 * q + 1] = z[1]; v[4 * q + 2] = z[2]; v[4 * q + 3] = z[3]; }
                    float sm = 0.f;
#pragma unroll
                    for (int i = 0; i < 16; ++i) sm += v[i];
                    const float mean = wave_sum(sm) * (1.0f / D);
                    float sq = 0.f;
#pragma unroll
                    for (int i = 0; i < 16; ++i) { v[i] -= mean; sq += v[i] * v[i]; }
                    const float rstd = 1.0f / sqrtf(wave_sum(sq) * (1.0f / D) + LN_EPS);
#pragma unroll
                    for (int i = 0; i < 16; ++i) v[i] = v[i] * rstd * lg[i] + lb[i];
#pragma unroll
                    for (int q = 0; q < 4; ++q) gst<f32x4>(XB + (size_t)t * D + chq(lane, q), (f32x4){v[4 * q], v[4 * q + 1], v[4 * q + 2], v[4 * q + 3]});
                    gst<v4u>(X1b + (size_t)t * D + 8 * lane, pack8(v));
                    gst<v4u>(X1b + (size_t)t * D + 512 + 8 * lane, pack8(v + 8));
                    float p[32];
#pragma unroll
                    for (int e = 0; e < 32; ++e) p[e] = 0.f;
#pragma unroll
                    for (int ci = 0; ci < 16; ++ci)
#pragma unroll
                        for (int eg = 0; eg < 8; ++eg) { const f32x4 w4 = *(const LAS f32x4*)(rwl + ((ci * 8 + eg) * 64 + lane) * 4);
#pragma unroll
                            for (int i = 0; i < 4; ++i) p[4 * eg + i] += v[ci] * w4[i]; }
#pragma unroll
                    for (int i = 0; i < 16; ++i) { const bool hi = (lane & 32) != 0; const float snd = hi ? p[i] : p[i + 16]; const float keep = hi ? p[i + 16] : p[i]; p[i] = keep + __shfl_xor(snd, 32); }
#pragma unroll
                    for (int i = 0; i < 8; ++i) { const bool hi = (lane & 16) != 0; const float snd = hi ? p[i] : p[i + 8]; const float keep = hi ? p[i + 8] : p[i]; p[i] = keep + __shfl_xor(snd, 16); }
#pragma unroll
                    for (int i = 0; i < 4; ++i) { const bool hi = (lane & 8) != 0; const float snd = hi ? p[i] : p[i + 4]; const float keep = hi ? p[i + 4] : p[i]; p[i] = keep + __shfl_xor(snd, 8); }
#pragma unroll
                    for (int i = 0; i < 2; ++i) { const bool hi = (lane & 4) != 0; const float snd = hi ? p[i] : p[i + 2]; const float keep = hi ? p[i + 2] : p[i]; p[i] = keep + __shfl_xor(snd, 4); }
                    { const bool hi = (lane & 2) != 0; const float snd = hi ? p[0] : p[1]; const float keep = hi ? p[1] : p[0]; p[0] = keep + __shfl_xor(snd, 2); }
                    float logit = p[0] + __shfl_xor(p[0], 1) + rbias;
                    const int myexp = (lane >> 1) & 31;
                    float tv[4]; int tix[4];
#pragma unroll
                    for (int r = 0; r < 4; ++r) {
                        float bvv = logit; int bi = myexp;
#pragma unroll
                        for (int o = 1; o < 64; o <<= 1) { const float ov = __shfl_xor(bvv, o); const int oi = __shfl_xor(bi, o); if (ov > bvv || (ov == bvv && oi < bi)) { bvv = ov; bi = oi; } }
                        tv[r] = bvv; tix[r] = bi;
                        if (myexp == bi) logit = -3.0e38f;
                    }
                    const float e1 = __expf(tv[1] - tv[0]), e2 = __expf(tv[2] - tv[0]), e3 = __expf(tv[3] - tv[0]);
                    const float inv = 1.0f / (1.0f + e1 + e2 + e3);
                    if (lane < 4) {
                        const int ix = lane == 0 ? tix[0] : lane == 1 ? tix[1] : lane == 2 ? tix[2] : tix[3];
                        const float gv = (lane == 0 ? 1.0f : lane == 1 ? e1 : lane == 2 ? e2 : e3) * inv;
                        gst<int>(TIDX + t * 4 + lane, ix); gst<float>(TGATE + t * 4 + lane, gv);
                        __hip_atomic_fetch_add((LAS unsigned*)(lds + MISC_OFF) + 32 + ix, 1u, __ATOMIC_RELAXED, __HIP_MEMORY_SCOPE_WORKGROUP);
                    }
                }
            }
            __syncthreads();
            if (tid < NE) { const unsigned c = MISC[32 + tid]; if (c) (void)xb_add(CNT + tid, c); }
        }
        GRID_BAR();

        {
            PHASE_BEGIN();
            const int* TIDX = (const int*)(ws + WS_IDX); const float* TGATE = (const float*)(ws + WS_GATE);
            int* RTOK = (int*)(ws + WS_RTOK); int* RDST = (int*)(ws + WS_RDST); float* RGATE = (float*)(ws + WS_RGATE);
            unsigned* CNT = ctl + CW_CNT + layer * NE; unsigned* CUR = ctl + CW_CUR + layer * NE;
            LAS int* TS = (LAS int*)(lds + TS_OFF);
            if (tid == 0) { int a = 0; for (int e = 0; e < NE; ++e) { TS[e] = a; a += (int)((xb_ld(CNT + e) + 255u) >> 8); } TS[NE] = a; }
            for (int tb = vcu; tb < T / 128; tb += G) {
                __syncthreads();
                if (tid < NE) MISC[32 + tid] = 0u;
                __syncthreads();
                const int t = tb * 128 + (tid >> 2), k = tid & 3;
                const int e = gld<int>(TIDX + t * 4 + k); const float gv = gld<float>(TGATE + t * 4 + k);
                const unsigned rank = __hip_atomic_fetch_add((LAS unsigned*)(lds + MISC_OFF) + 32 + e, 1u, __ATOMIC_RELAXED, __HIP_MEMORY_SCOPE_WORKGROUP);
                __syncthreads();
                if (tid < NE) { const unsigned c = MISC[32 + tid]; MISC[64 + tid] = c ? xb_add(CUR + tid, c) : 0u; }
                __syncthreads();
                const int pos = TS[e] * 256 + (int)MISC[64 + e] + (int)rank;
                gst<int>(RTOK + pos, t); gst<int>(RDST + pos, t * 4 + k); gst<float>(RGATE + pos, gv);
            }
            __syncthreads();
            for (int e = vcu; e < NE; e += G) {
                const int beg = TS[e] * 256 + (int)xb_ld(CNT + e), end = TS[e + 1] * 256;
                for (int p = beg + tid; p < end; p += NTHR) { gst<int>(RTOK + p, 0); gst<int>(RDST + p, -1); gst<float>(RGATE + p, 0.f); }
            }
        }
        GRID_BAR();

        {
            PHASE_BEGIN();
            unsigned* CNT = ctl + CW_CNT + layer * NE;
            LAS int* TS = (LAS int*)(lds + TS_OFF);
            __syncthreads();
            if (tid == 0) { int a = 0; for (int e = 0; e < NE; ++e) { TS[e] = a; a += (int)((xb_ld(CNT + e) + 255u) >> 8); } TS[NE] = a; }
            __syncthreads();
            const int nM = TS[NE];
            const int n_my = pg8::build_units(lds, tid, nM, 8, G, bx, true, (const int*)(ws + WS_RTOK));
            pg8::GemmP gp; gp.A = (const char*)(ws + WS_X1B); gp.lda2 = D * 2; gp.acol_pn = 0; gp.Bt = (const char*)(ws + WS_WGU + (size_t)layer * NE * 2048 * 1024 * 2); gp.b_estride = (size_t)2048 * 1024 * 2; gp.K = 1024;
            pg8::EpiSwiglu E; E.act = (bf16*)(ws + WS_ACT); E.bgu = args.in[19] + (size_t)layer * NE * 2048;
            pg8::gemm_phase<true, pg8::EpiSwiglu>(lds, tid, gp, n_my, E);
        }
        GRID_BAR();

        {
            PHASE_BEGIN();
            LAS int* TS = (LAS int*)(lds + TS_OFF);
            const int nM = TS[NE];
            const int n_my = pg8::build_units(lds, tid, nM, 4, G, bx, true, nullptr);
            pg8::GemmP gp; gp.A = (const char*)(ws + WS_ACT); gp.lda2 = D * 2; gp.acol_pn = 0; gp.Bt = (const char*)(ws + WS_WDN + (size_t)layer * NE * 1024 * 1024 * 2); gp.b_estride = (size_t)1024 * 1024 * 2; gp.K = 1024;
            pg8::EpiMoe2 E; E.Y = (bf16*)(ws + WS_Y); E.bdn = args.in[21] + (size_t)layer * NE * D; E.rowdst = (const int*)(ws + WS_RDST); E.rowgate = (const float*)(ws + WS_RGATE);
            pg8::gemm_phase<false, pg8::EpiMoe2>(lds, tid, gp, n_my, E);
        }
        GRID_BAR();

        {
            PHASE_BEGIN();
            const float* XB = (const float*)(ws + WS_XB); const bf16* Y = (const bf16*)(ws + WS_Y); float* XA = args.out; bf16* XAb = (bf16*)(ws + WS_XAB);
            float lg[16], lb[16];
#pragma unroll
            for (int q = 0; q < 4; ++q) { const f32x4 b = gld<f32x4>(args.in[22] + layer * D + chq(lane, q)), c = gld<f32x4>(args.in[23] + layer * D + chq(lane, q));
#pragma unroll
                for (int i = 0; i < 4; ++i) { lg[4 * q + i] = b[i]; lb[4 * q + i] = c[i]; } }
            for (int t = gw; t < T; t += NGW) {
                float v[16];
#pragma unroll
                for (int q = 0; q < 4; ++q) { const f32x4 z = gld<f32x4>(XB + (size_t)t * D + chq(lane, q)); v[4 * q] = z[0] * ALPHA; v[4 * q + 1] = z[1] * ALPHA; v[4 * q + 2] = z[2] * ALPHA; v[4 * q + 3] = z[3] * ALPHA; }
                float h[16];
#pragma unroll
                for (int i = 0; i < 16; ++i) h[i] = 0.f;
#pragma unroll
                for (int k = 0; k < 4; ++k) { const bf16* yr = Y + (size_t)(t * 4 + k) * D; float y[16]; unpack8(gld<v4u>(yr + 8 * lane), y); unpack8(gld<v4u>(yr + 512 + 8 * lane), y + 8);
#pragma unroll
                    for (int i = 0; i < 16; ++i) h[i] += y[i]; }
                float sm = 0.f;
#pragma unroll
                for (int i = 0; i < 16; ++i) { v[i] += h[i]; sm += v[i]; }
                const float mean = wave_sum(sm) * (1.0f / D);
                float sq = 0.f;
#pragma unroll
                for (int i = 0; i < 16; ++i) { v[i] -= mean; sq += v[i] * v[i]; }
                const float rstd = 1.0f / sqrtf(wave_sum(sq) * (1.0f / D) + LN_EPS);
#pragma unroll
                for (int i = 0; i < 16; ++i) v[i] = v[i] * rstd * lg[i] + lb[i];
#pragma unroll
                for (int q = 0; q < 4; ++q) gst<f32x4>(XA + (size_t)t * D + chq(lane, q), (f32x4){v[4 * q], v[4 * q + 1], v[4 * q + 2], v[4 * q + 3]});
                gst<v4u>(XAb + (size_t)t * D + 8 * lane, pack8(v));
                gst<v4u>(XAb + (size_t)t * D + 512 + 8 * lane, pack8(v + 8));
            }
        }
        if (layer + 1 < DEPTH) GRID_BAR();
    }
}

extern "C" void kernel_launch(void* const* d_in, const int* in_sizes, int n_in, void* d_out, int out_size, void* d_ws, size_t ws_size, hipStream_t stream) {
    static int grid = 0;
    if (grid == 0) {
        if (n_in != 24 || out_size != T * D || ws_size < WS_END) { fprintf(stderr, "kernel_launch: unexpected shapes (n_in %d out %d ws %zu)\n", n_in, out_size, ws_size); grid = -1; return; }
        if (hipFuncSetAttribute((const void*)mega_fwd, hipFuncAttributeMaxDynamicSharedMemorySize, LDS_BYTES) != hipSuccess) { fprintf(stderr, "kernel_launch: hipFuncSetAttribute failed\n"); grid = -1; return; }
        int dev = 0, cus = 0, per_cu = 0;
        (void)hipGetDevice(&dev); (void)hipDeviceGetAttribute(&cus, hipDeviceAttributeMultiprocessorCount, dev);
        if (hipOccupancyMaxActiveBlocksPerMultiprocessor(&per_cu, (const void*)mega_fwd, NTHR, LDS_BYTES) != hipSuccess || per_cu < 1) fprintf(stderr, "kernel_launch: occupancy query reports %d blocks per CU\n", per_cu);
        (void)hipGetLastError();
        grid = 256; if (cus > 0 && cus < grid) grid = cus;
    }
    if (grid < 0) return;
    (void)hipMemsetAsync((char*)d_ws + WS_CTL, 0, CTL_ZERO_BYTES, stream);
    Args a{};
    for (int i = 0; i < 24; ++i) a.in[i] = (const float*)d_in[i];
    a.out = (float*)d_out; a.ws = (unsigned char*)d_ws;
    hipLaunchKernelGGL(mega_fwd, dim3(grid), dim3(NTHR), LDS_BYTES, stream, a);
    const hipError_t le = hipPeekAtLastError();
    if (le != hipSuccess) fprintf(stderr, "kernel_launch: launch failed: %s\n", hipGetErrorName(le));
}
```

```cpp
#include <hip/hip_runtime.h>
#include <cstdio>
#include <cstdint>

#define GAS __attribute__((address_space(1)))
#define LAS __attribute__((address_space(3)))
typedef unsigned short bf16;
typedef unsigned v4u __attribute__((ext_vector_type(4)));
typedef unsigned v2u __attribute__((ext_vector_type(2)));
typedef float f32x4 __attribute__((ext_vector_type(4)));
typedef short bf16x8 __attribute__((ext_vector_type(8)));

template <class V> __device__ __forceinline__ V gld(const void* p) { return *(const GAS V*)p; }
template <class V> __device__ __forceinline__ void gst(void* p, V v) { *(GAS V*)p = v; }

#ifndef REP_P0
#define REP_P0 1
#endif
#ifndef REP_MOE1
#define REP_MOE1 1
#endif
#ifndef REP_MOE2
#define REP_MOE2 1
#endif
#ifndef REP_THIN
#define REP_THIN 1
#endif
#ifndef REP_MIXG
#define REP_MIXG 1
#endif
constexpr int T = 32768, D = 1024, SEQ = 4096, NE = 32, TOPK = 4, NA = T * TOPK, DEPTH = 4;
constexpr int MAXTILES = NA / 256 + NE;
constexpr int NPAD = MAXTILES * 256;
constexpr float LN_EPS = 1e-5f;
constexpr float ALPHA = 1.681792830507429f;
constexpr int NWAVES = 8, NTHR = 512;
constexpr int MAXU = 17;

constexpr size_t MiB = 1u << 20;
constexpr size_t WS_CTL = 0, CTL_ZERO_BYTES = 1 * MiB;
constexpr size_t WS_IDX = 1 * MiB;
constexpr size_t WS_GATE = 1 * MiB + 512 * 1024;
constexpr size_t WS_RTOK = 2 * MiB;
constexpr size_t WS_RDST = 3 * MiB;
constexpr size_t WS_RGATE = 4 * MiB;
constexpr size_t WS_WPOOL = 5 * MiB;
constexpr size_t WS_WSCIN = 6 * MiB;
constexpr size_t WS_WSCOUT = 12 * MiB;
constexpr size_t WS_WCFIN = 14 * MiB;
constexpr size_t WS_WCFOUT = 18 * MiB;
constexpr size_t WS_WGU = 32 * MiB;
constexpr size_t WS_WDN = 544 * MiB;
constexpr size_t WS_ZB = 800 * MiB;
constexpr size_t WS_XAB = 864 * MiB;
constexpr size_t WS_X1B = 928 * MiB;
constexpr size_t WS_M1 = 992 * MiB;
constexpr size_t WS_M2 = 1056 * MiB;
constexpr size_t WS_M3 = 1120 * MiB;
constexpr size_t WS_ACT = 1184 * MiB;
constexpr size_t WS_Y = 1456 * MiB;
constexpr size_t WS_END = 1712 * MiB;
constexpr int CW_BAR = 4096;
constexpr int CW_CNT = 8192;
constexpr int CW_CUR = 8192 + 256;

constexpr int RING_OFF = 0, RING_BYTES = 131072;
constexpr int TOK_OFF = RING_BYTES;
constexpr int UT_OFF = TOK_OFF + MAXU * 1024;
constexpr int TS_OFF = UT_OFF + (2 * MAXU + 2) * 16;
constexpr int MISC_OFF = TS_OFF + 36 * 4;
constexpr int LDS_BYTES = MISC_OFF + 128 * 4;
static_assert(LDS_BYTES <= 160 * 1024 && (MISC_OFF % 16) == 0, "LDS map");

#define LDS_WAIT() asm volatile("s_waitcnt lgkmcnt(0)" ::: "memory")
#define VM_WAIT() asm volatile("s_waitcnt vmcnt(0)" ::: "memory")

__device__ __forceinline__ unsigned cvt_pk_bf16(float lo, float hi) { unsigned r; asm volatile("v_cvt_pk_bf16_f32 %0, %1, %2" : "=v"(r) : "v"(lo), "v"(hi)); return r; }
__device__ __forceinline__ float bf_lo(unsigned u) { return __uint_as_float(u << 16); }
__device__ __forceinline__ float bf_hi(unsigned u) { return __uint_as_float(u & 0xffff0000u); }
__device__ __forceinline__ float sigmoidf_(float x) { return __builtin_amdgcn_rcpf(1.0f + __expf(-x)); }
__device__ __forceinline__ float wave_sum(float v) {
#pragma unroll
    for (int o = 1; o < 64; o <<= 1) v += __shfl_xor(v, o);
    return v;
}

#define XB_TMO      128
#define XB_XCNT(j)  (256  + 64 * (j))
#define XB_XSUB(j)  (1280 + 64 * (j))
#define XB_XGEN(j)  (2304 + 64 * (j))
#define XB_TOP      3328
#define XB_TOPGEN   3392
#define XCD_BAR_WORDS 3456
#define XB_SPIN_CAP (1u << 18)

__device__ __forceinline__ unsigned xb_ld(unsigned* p)              { return __hip_atomic_load((GAS unsigned*)p, __ATOMIC_RELAXED, __HIP_MEMORY_SCOPE_AGENT); }
__device__ __forceinline__ unsigned xb_add(unsigned* p, unsigned v) { return __hip_atomic_fetch_add((GAS unsigned*)p, v, __ATOMIC_RELAXED, __HIP_MEMORY_SCOPE_AGENT); }
__device__ __forceinline__ unsigned xb_xcc_id() { return (unsigned)__builtin_amdgcn_s_getreg((3 << 11) | 20) & 0xFu; }
#define XB_SPIN(cond, bar) do { unsigned _sp = 0; while (cond) { __builtin_amdgcn_s_sleep(1); \
    if ((++_sp & 255u) == 0u) { if (xb_ld(&(bar)[XB_TMO])) break; if (_sp > XB_SPIN_CAP) { (void)xb_add(&(bar)[XB_TMO], 1u); break; } } } } while (0)

struct XcdBarrier { unsigned* bar; unsigned x; volatile LAS unsigned* st; };

__device__ __forceinline__ XcdBarrier xcd_barrier_post(unsigned* bar, volatile LAS unsigned* st) {
    XcdBarrier b; b.bar = bar; b.x = xb_xcc_id(); b.st = st;
    if (threadIdx.x == 0) (void)xb_add(&bar[XB_XCNT(b.x)], 1u);
    return b;
}
__device__ __forceinline__ void xcd_barrier_complete(unsigned* bar, unsigned x, unsigned& nloc, unsigned& nx) {
    const unsigned G = gridDim.x * gridDim.y * gridDim.z;
    unsigned sum, cnt, mine, sp = 0u;
    for (;;) {
        sum = 0u; cnt = 0u; mine = 0u;
#pragma unroll
        for (unsigned j = 0; j < 16; ++j) { const unsigned c = xb_ld(&bar[XB_XCNT(j)]); sum += c; cnt += (c > 0u) ? 1u : 0u; mine = (j == x) ? c : mine; }
        if (sum == G) break;
        __builtin_amdgcn_s_sleep(1);
        if ((++sp & 255u) == 0u) { if (xb_ld(&bar[XB_TMO])) break; if (sp > XB_SPIN_CAP) { (void)xb_add(&bar[XB_TMO], 1u); break; } }
    }
    nloc = mine > 0u ? mine : 1u; nx = cnt > 0u ? cnt : 1u;
}
__device__ __forceinline__ void xcd_barrier(const XcdBarrier& b) {
    asm volatile("s_waitcnt vmcnt(0)" ::: "memory");
    __syncthreads();
    if (threadIdx.x == 0) {
        unsigned* bar = b.bar;
        __builtin_amdgcn_s_waitcnt(0);
        unsigned nloc = b.st[0], nx = b.st[1];
        if (nloc == 0u) { xcd_barrier_complete(bar, b.x, nloc, nx); b.st[0] = nloc; b.st[1] = nx; }
        const unsigned old = xb_add(&bar[XB_XSUB(b.x)], 1u);
        const unsigned gen = old / nloc;
        if (old + 1u == (gen + 1u) * nloc) {
            __builtin_amdgcn_fence(__ATOMIC_RELEASE, "agent");
            asm volatile("s_waitcnt vmcnt(0)" ::: "memory");
            const unsigned og = xb_add(&bar[XB_TOP], 1u);
            const unsigned tg = og / nx;
            if (og + 1u == (tg + 1u) * nx) xb_add(&bar[XB_TOPGEN], 1u);
            else XB_SPIN(xb_ld(&bar[XB_TOPGEN]) == tg, bar);
            __builtin_amdgcn_fence(__ATOMIC_ACQUIRE, "agent");
            xb_add(&bar[XB_XGEN(b.x)], 1u);
            asm volatile("s_waitcnt vmcnt(0)" ::: "memory");
        } else {
            XB_SPIN(xb_ld(&bar[XB_XGEN(b.x)]) == gen, bar);
            __builtin_amdgcn_fence(__ATOMIC_ACQUIRE, "agent");
            asm volatile("s_waitcnt vmcnt(0)" ::: "memory");
        }
    }
    __syncthreads();
}

namespace pg8 {
constexpr int BM = 256, BK = 64, HALF = 128, HTB = HALF * BK * 2, STAGE_BYTES = 8 * HTB, NXCD = 8, WGM = 8;
__host__ __device__ __forceinline__ int lds_byte(int r, int c) { const int st = (r >> 4) * 2 + (c >> 5), rr = r & 15, cc = c & 31, ob = rr * 64 + cc * 2; return st * 1024 + (ob ^ (((ob >> 9) & 1) << 5)); }
__host__ __device__ __forceinline__ void stage_rc(int b, int& R, int& C) { const int st = b / 1024, sb = b % 1024, swz = sb ^ (((sb >> 9) & 1) << 5); R = (st >> 1) * 16 + swz / 64; C = (st & 1) * 32 + (swz % 64) / 2; }
__host__ __device__ __forceinline__ int perm32(int rho) { const int n = rho >> 4, i = rho & 15; return 8 * (i >> 2) + 4 * n + (i & 3); }

struct Unit { int pm, pn, e; };
struct GemmP {
    const char* A; unsigned lda2;
    unsigned acol_pn;
    const char* Bt; size_t b_estride;
    int K;
};

__device__ __forceinline__ void unit_of(int L, int nM, int nN, int& pm, int& pn) {
    const int nwg = nM * nN;
    int wgid = L; { const int q = nwg / NXCD, r = nwg % NXCD, xcd = wgid % NXCD, off = wgid / NXCD; wgid = (xcd < r ? xcd * (q + 1) : r * (q + 1) + (xcd - r) * q) + off; }
    const int nig = WGM * nN, gid = wgid / nig, fm = gid * WGM, gsz = (nM - fm) < WGM ? (nM - fm) : WGM;
    pm = fm + ((wgid % nig) % gsz); pn = (wgid % nig) / gsz;
}
__device__ __forceinline__ int build_units(LAS unsigned char* lds, const int tid, int nM, int nN, int G, int c, bool moe, const int* row_tok, const int dup = 1) {
    LAS int* UT = (LAS int*)(lds + UT_OFF); LAS const int* TS = (LAS const int*)(lds + TS_OFF); LAS int* TOK = (LAS int*)(lds + TOK_OFF);
    const int nwg = nM * nN;
    int n_my = (nwg > c) ? (nwg - c + G - 1) / G : 0; if (n_my > MAXU) n_my = MAXU;
    if (tid < n_my) {
        int pm, pn; unit_of(tid * G + c, nM, nN, pm, pn);
        int e = 0; if (moe) { while (e < NE - 1 && TS[e + 1] <= pm) ++e; }
        UT[4 * tid + 0] = pm; UT[4 * tid + 1] = pn; UT[4 * tid + 2] = e; UT[4 * tid + 3] = 0;
    }
    __syncthreads();
    if (row_tok) {
        for (int idx = tid; idx < n_my * 256; idx += NTHR) { const int i = idx >> 8, r = idx & 255; TOK[idx] = gld<int>(row_tok + UT[4 * i] * 256 + r); }
    }
    __syncthreads();
    if (dup > 1) { if (tid < n_my) { UT[4 * (tid + n_my) + 0] = UT[4 * tid]; UT[4 * (tid + n_my) + 1] = UT[4 * tid + 1]; UT[4 * (tid + n_my) + 2] = UT[4 * tid + 2]; UT[4 * (tid + n_my) + 3] = 0; } __syncthreads(); return 2 * n_my; }
    return n_my;
}
__device__ __forceinline__ Unit read_unit(LAS const int* UT, int i) {
    Unit u; u.pm = __builtin_amdgcn_readfirstlane(UT[4 * i]); u.pn = __builtin_amdgcn_readfirstlane(UT[4 * i + 1]); u.e = __builtin_amdgcn_readfirstlane(UT[4 * i + 2]); return u;
}
template <bool GATHER>
__device__ __forceinline__ void a_offsets(unsigned (&v)[2][2], const GemmP& g, const Unit& u, int ui, const int (&Rr)[2], const int (&Cc2)[2], LAS const int* TOK, const int tokn) {
#pragma unroll
    for (int h = 0; h < 2; ++h)
#pragma unroll
        for (int i = 0; i < 2; ++i) {
            const int row = GATHER ? TOK[(ui >= tokn ? ui - tokn : ui) * 256 + h * HALF + Rr[i]] : (u.pm * BM + h * HALF + Rr[i]);
            v[h][i] = (unsigned)row * g.lda2 + (unsigned)Cc2[i] + (unsigned)u.pn * g.acol_pn;
        }
}

template <bool GATHER, class Epi>
__device__ __forceinline__ void gemm_phase(LAS unsigned char* lds, const int tid, const GemmP g, const int n_my, const Epi& E, const int tokn = 1 << 20) {
    const int wid = __builtin_amdgcn_readfirstlane(tid >> 6), lane = tid & 63, wr = wid >> 2, wc = wid & 3, fr = lane & 15, fq = lane >> 4;
    const int K = g.K, nt = K / BK;
    if (n_my <= 0) return;
    int Rr[2], Cc2[2]; unsigned voffB[2];
#pragma unroll
    for (int i = 0; i < 2; ++i) { int R, C; stage_rc(tid * 16 + i * 8192, R, C); const int Rb = Epi::PERM ? ((R & ~31) + perm32(R & 31)) : R;
        Rr[i] = R; Cc2[i] = C * 2; voffB[i] = (unsigned)(Rb * K + C) * 2u; }
    const size_t kstep = (size_t)(BK * 2);
    const size_t hstep = (size_t)HALF * K * 2;
    const size_t tstepB = 2 * hstep;
    const unsigned ldsw = (unsigned)wid * 1024u;
    const int aoff = lds_byte(wr * 64 + fr, fq * 8), boff = lds_byte(wc * 32 + fr, fq * 8);
    LAS const int* UT = (LAS const int*)(lds + UT_OFF); LAS const int* TOK = (LAS const int*)(lds + TOK_OFF);
#define PG8_SA(b, h) (((b) * 2 + (h)) * HTB)
#define PG8_SB(b, h) ((4 + (b) * 2 + (h)) * HTB)
#define PG8_STAGE(bufoff, gbase, voff) do { _Pragma("unroll") for (int _i = 0; _i < 2; ++_i) \
        __builtin_amdgcn_global_load_lds((const unsigned*)((const char*)(gbase) + (voff)[_i]), (LAS unsigned*)(lds + (bufoff) + ldsw + _i * 8192), 16, 0, 0); } while (0)
#define PG8_LDA(dst, b, h) do { _Pragma("unroll") for (int m = 0; m < 4; ++m) _Pragma("unroll") for (int k = 0; k < 2; ++k) dst[m][k] = *(const LAS bf16x8*)(lds + PG8_SA(b, h) + aoff + m * 2048 + k * 1024); } while (0)
#define PG8_LDB(dst, b, h) do { _Pragma("unroll") for (int n = 0; n < 2; ++n) _Pragma("unroll") for (int k = 0; k < 2; ++k) dst[n][k] = *(const LAS bf16x8*)(lds + PG8_SB(b, h) + boff + n * 2048 + k * 1024); } while (0)
#define PG8_MMA(ai, bj, At, Bt) do { __builtin_amdgcn_s_setprio(1); _Pragma("unroll") for (int m = 0; m < 4; ++m) _Pragma("unroll") for (int n = 0; n < 2; ++n) _Pragma("unroll") for (int k = 0; k < 2; ++k) \
        acc[ai][bj][m][n] = __builtin_amdgcn_mfma_f32_16x16x32_bf16(Bt[n][k], At[m][k], acc[ai][bj][m][n], 0, 0, 0); __builtin_amdgcn_s_setprio(0); } while (0)
#define PG8_WAIT_V(n) asm volatile("s_waitcnt vmcnt(" #n ")" ::: "memory")
#define PG8_WAIT_L(n) asm volatile("s_waitcnt lgkmcnt(" #n ")" ::: "memory")
#define PG8_BAR __builtin_amdgcn_s_barrier()
#define PG8_SCHED __builtin_amdgcn_sched_barrier(0)
    Unit cur = read_unit(UT, 0), nxt; int ui = 0;
    f32x4 acc[2][2][4][2];
#pragma unroll
    for (int a = 0; a < 2; ++a)
#pragma unroll
        for (int b = 0; b < 2; ++b)
#pragma unroll
            for (int m = 0; m < 4; ++m)
#pragma unroll
                for (int n = 0; n < 2; ++n) acc[a][b][m][n] = (f32x4){0.f, 0.f, 0.f, 0.f};
    bf16x8 At[4][2], B0[2][2], B1[2][2];
    unsigned vAc[2][2], vAn[2][2];
    a_offsets<GATHER>(vAc, g, cur, 0, Rr, Cc2, TOK, tokn);
    const char* const Ab = g.A;
    const char* cB = g.Bt + (size_t)cur.e * g.b_estride + (size_t)cur.pn * tstepB;
    PG8_STAGE(PG8_SB(0, 0), cB, voffB); PG8_STAGE(PG8_SB(0, 1), cB + hstep, voffB); PG8_STAGE(PG8_SA(0, 0), Ab, vAc[0]); PG8_STAGE(PG8_SA(0, 1), Ab, vAc[1]);
    if (wr == 1) PG8_BAR;
    PG8_WAIT_V(2); PG8_BAR;
    PG8_STAGE(PG8_SB(1, 0), cB + kstep, voffB); PG8_STAGE(PG8_SA(1, 0), Ab + kstep, vAc[0]); PG8_STAGE(PG8_SB(1, 1), cB + hstep + kstep, voffB);
    PG8_WAIT_V(6); PG8_BAR;
    for (;;) {
        const bool has_next = (ui + 1 < n_my);
        nxt = cur; if (has_next) nxt = read_unit(UT, ui + 1);
        const char* nB = has_next ? g.Bt + (size_t)nxt.e * g.b_estride + (size_t)nxt.pn * tstepB : cB;
        for (int t = 0; t < nt; t += 2) {
            const bool last = (t == nt - 2);
            const char* a1 = Ab + (size_t)(t + 1) * kstep;
            const char* a2 = last ? Ab : Ab + (size_t)(t + 2) * kstep; const char* b2 = last ? nB : cB + (size_t)(t + 2) * kstep;
            const char* a3 = a2 + kstep; const char* b3 = b2 + kstep;
            unsigned o2[2][2];
            if (last) {
                if (has_next) a_offsets<GATHER>(vAn, g, nxt, ui + 1, Rr, Cc2, TOK, tokn);
                else { vAn[0][0] = vAc[0][0]; vAn[0][1] = vAc[0][1]; vAn[1][0] = vAc[1][0]; vAn[1][1] = vAc[1][1]; }
                o2[0][0] = vAn[0][0]; o2[0][1] = vAn[0][1]; o2[1][0] = vAn[1][0]; o2[1][1] = vAn[1][1];
            } else { o2[0][0] = vAc[0][0]; o2[0][1] = vAc[0][1]; o2[1][0] = vAc[1][0]; o2[1][1] = vAc[1][1]; }
            PG8_LDB(B0, 0, 0); PG8_LDB(B1, 0, 1); PG8_SCHED; PG8_LDA(At, 0, 0); PG8_STAGE(PG8_SA(1, 1), a1, vAc[1]);
            PG8_WAIT_V(8); PG8_WAIT_L(0); PG8_BAR; PG8_MMA(0, 0, At, B0); PG8_MMA(0, 1, At, B1); PG8_BAR; PG8_SCHED;
            PG8_LDA(At, 0, 1); PG8_STAGE(PG8_SB(0, 0), b2, voffB); PG8_STAGE(PG8_SB(0, 1), b2 + hstep, voffB); PG8_STAGE(PG8_SA(0, 0), a2, o2[0]);
            PG8_WAIT_V(8); PG8_WAIT_L(0); PG8_BAR; PG8_MMA(1, 0, At, B0); PG8_MMA(1, 1, At, B1); PG8_BAR; PG8_SCHED;
            PG8_LDB(B0, 1, 0); PG8_LDB(B1, 1, 1); PG8_SCHED; PG8_LDA(At, 1, 0); PG8_STAGE(PG8_SA(0, 1), a2, o2[1]);
            PG8_WAIT_V(8); PG8_WAIT_L(0); PG8_BAR; PG8_MMA(0, 0, At, B0); PG8_MMA(0, 1, At, B1); PG8_BAR; PG8_SCHED;
            PG8_LDA(At, 1, 1); PG8_STAGE(PG8_SB(1, 0), b3, voffB); PG8_STAGE(PG8_SB(1, 1), b3 + hstep, voffB); PG8_STAGE(PG8_SA(1, 0), a3, o2[0]);
            PG8_WAIT_V(8); PG8_WAIT_L(0); PG8_BAR; PG8_MMA(1, 0, At, B0); PG8_MMA(1, 1, At, B1); PG8_BAR; PG8_SCHED;
        }
        if (wr == 0) PG8_BAR;
        E(acc, cur, wr, wc, fr, fq);
        if (!has_next) break;
#pragma unroll
        for (int a = 0; a < 2; ++a)
#pragma unroll
            for (int b = 0; b < 2; ++b)
#pragma unroll
                for (int m = 0; m < 4; ++m)
#pragma unroll
                    for (int n = 0; n < 2; ++n) acc[a][b][m][n] = (f32x4){0.f, 0.f, 0.f, 0.f};
        cur = nxt; cB = nB; ++ui;
        vAc[0][0] = vAn[0][0]; vAc[0][1] = vAn[0][1]; vAc[1][0] = vAn[1][0]; vAc[1][1] = vAn[1][1];
        if (wr == 1) PG8_BAR;
    }
    PG8_WAIT_V(0);
    PG8_BAR;
#undef PG8_SA
#undef PG8_SB
#undef PG8_STAGE
#undef PG8_LDA
#undef PG8_LDB
#undef PG8_MMA
#undef PG8_WAIT_V
#undef PG8_WAIT_L
#undef PG8_BAR
#undef PG8_SCHED
}

struct EpiOut {
    static constexpr bool PERM = true;
    const bf16* xres; bf16* z; const float* bias; const float* scale;
    __device__ __forceinline__ void operator()(const f32x4 (&acc)[2][2][4][2], const Unit& u, int wr, int wc, int fr, int fq) const {
        const int row0 = u.pm * BM + wr * 64 + fr, c0 = u.pn * BM + wc * 32 + 8 * fq;
        f32x4 bv[2][2], sv[2][2];
#pragma unroll
        for (int bj = 0; bj < 2; ++bj)
#pragma unroll
            for (int n = 0; n < 2; ++n) {
                bv[bj][n] = bias ? gld<f32x4>(bias + c0 + bj * HALF + 4 * n) : (f32x4){0.f, 0.f, 0.f, 0.f};
                sv[bj][n] = scale ? gld<f32x4>(scale + c0 + bj * HALF + 4 * n) : (f32x4){1.f, 1.f, 1.f, 1.f};
            }
#pragma unroll
        for (int ai = 0; ai < 2; ++ai)
#pragma unroll
            for (int m = 0; m < 4; ++m) { const size_t off = (size_t)(row0 + ai * HALF + m * 16) * D + c0;
#pragma unroll
                for (int bj = 0; bj < 2; ++bj) { const v4u xr = gld<v4u>(xres + off + bj * HALF);
                    const f32x4 x0 = (f32x4){bf_lo(xr.x), bf_hi(xr.x), bf_lo(xr.y), bf_hi(xr.y)}, x1 = (f32x4){bf_lo(xr.z), bf_hi(xr.z), bf_lo(xr.w), bf_hi(xr.w)};
                    const f32x4 o0 = x0 * ALPHA + (acc[ai][bj][m][0] + bv[bj][0]) * sv[bj][0], o1 = x1 * ALPHA + (acc[ai][bj][m][1] + bv[bj][1]) * sv[bj][1];
                    v4u w; w.x = cvt_pk_bf16(o0[0], o0[1]); w.y = cvt_pk_bf16(o0[2], o0[3]); w.z = cvt_pk_bf16(o1[0], o1[1]); w.w = cvt_pk_bf16(o1[2], o1[3]);
                    gst<v4u>(z + off + bj * HALF, w); }
                asm volatile("" ::: "memory"); }
    }
};
struct EpiPair {
    static constexpr bool PERM = true;
    bf16* O1; bf16* O2; const float* bias; int mode;
    __device__ __forceinline__ void operator()(const f32x4 (&acc)[2][2][4][2], const Unit& u, int wr, int wc, int fr, int fq) const {
        const int row0 = u.pm * BM + wr * 64 + fr;
        if (u.pn < 8) {
            const int j0 = u.pn * HALF + wc * 32 + 8 * fq;
            f32x4 b1[2], b2[2];
#pragma unroll
            for (int n = 0; n < 2; ++n) { b1[n] = mode ? gld<f32x4>(bias + j0 + 4 * n) : (f32x4){0.f, 0.f, 0.f, 0.f}; b2[n] = mode ? gld<f32x4>(bias + 1024 + j0 + 4 * n) : (f32x4){0.f, 0.f, 0.f, 0.f}; }
#pragma unroll
            for (int ai = 0; ai < 2; ++ai)
#pragma unroll
                for (int m = 0; m < 4; ++m) { bf16* rowp = O1 + (size_t)(row0 + ai * HALF + m * 16) * D + j0; f32x4 r[2];
#pragma unroll
                    for (int n = 0; n < 2; ++n) { const f32x4 g1 = acc[ai][0][m][n] + b1[n], g2 = acc[ai][1][m][n] + b2[n];
                        if (mode) { r[n][0] = g1[0] * sigmoidf_(g2[0]); r[n][1] = g1[1] * sigmoidf_(g2[1]); r[n][2] = g1[2] * sigmoidf_(g2[2]); r[n][3] = g1[3] * sigmoidf_(g2[3]); }
                        else r[n] = g1 * g2; }
                    v4u w; w.x = cvt_pk_bf16(r[0][0], r[0][1]); w.y = cvt_pk_bf16(r[0][2], r[0][3]); w.z = cvt_pk_bf16(r[1][0], r[1][1]); w.w = cvt_pk_bf16(r[1][2], r[1][3]);
                    gst<v4u>(rowp, w); }
        } else {
            const int c0 = (u.pn - 8) * BM + wc * 32 + 8 * fq;
#pragma unroll
            for (int ai = 0; ai < 2; ++ai)
#pragma unroll
                for (int m = 0; m < 4; ++m) { bf16* rowp = O2 + (size_t)(row0 + ai * HALF + m * 16) * D + c0;
#pragma unroll
                    for (int bj = 0; bj < 2; ++bj) { const f32x4 v0 = acc[ai][bj][m][0], v1 = acc[ai][bj][m][1];
                        v4u w; w.x = cvt_pk_bf16(v0[0], v0[1]); w.y = cvt_pk_bf16(v0[2], v0[3]); w.z = cvt_pk_bf16(v1[0], v1[1]); w.w = cvt_pk_bf16(v1[2], v1[3]);
                        gst<v4u>(rowp + bj * HALF, w); } }
        }
    }
};
struct EpiSwiglu {
    static constexpr bool PERM = true;
    bf16* act; const float* bgu;
    __device__ __forceinline__ void operator()(const f32x4 (&acc)[2][2][4][2], const Unit& u, int wr, int wc, int fr, int fq) const {
        const int row0 = u.pm * BM + wr * 64 + fr, j0 = u.pn * HALF + wc * 32 + 8 * fq;
        const float* bp = bgu + (size_t)u.e * 2048 + 2 * j0;
        float gb[8], ub[8];
#pragma unroll
        for (int i = 0; i < 4; ++i) { const f32x4 b = gld<f32x4>(bp + 4 * i); gb[2 * i] = b[0]; ub[2 * i] = b[1]; gb[2 * i + 1] = b[2]; ub[2 * i + 1] = b[3]; }
#pragma unroll
        for (int ai = 0; ai < 2; ++ai)
#pragma unroll
            for (int m = 0; m < 4; ++m) { bf16* rowp = act + (size_t)(row0 + ai * HALF + m * 16) * D + j0; float r[8];
#pragma unroll
                for (int n = 0; n < 2; ++n)
#pragma unroll
                    for (int q = 0; q < 4; ++q) { const int j = 4 * n + q;
                        const float gg = fminf(acc[ai][0][m][n][q] + gb[j], 7.0f);
                        const float uu = fminf(fmaxf(acc[ai][1][m][n][q] + ub[j], -7.0f), 7.0f);
                        r[j] = (uu + 1.0f) * (gg * sigmoidf_(1.702f * gg)); }
                v4u w; w.x = cvt_pk_bf16(r[0], r[1]); w.y = cvt_pk_bf16(r[2], r[3]); w.z = cvt_pk_bf16(r[4], r[5]); w.w = cvt_pk_bf16(r[6], r[7]);
                gst<v4u>(rowp, w); }
    }
};
struct EpiMoe2 {
    static constexpr bool PERM = true;
    bf16* Y; const float* bdn; const int* rowdst; const float* rowgate;
    __device__ __forceinline__ void operator()(const f32x4 (&acc)[2][2][4][2], const Unit& u, int wr, int wc, int fr, int fq) const {
        const int pos0 = u.pm * BM + wr * 64 + fr, c0 = u.pn * BM + wc * 32 + 8 * fq;
        const float* bp = bdn + (size_t)u.e * D + c0;
        f32x4 bv[2][2];
#pragma unroll
        for (int bj = 0; bj < 2; ++bj)
#pragma unroll
            for (int n = 0; n < 2; ++n) bv[bj][n] = gld<f32x4>(bp + bj * HALF + 4 * n);
        int dst[2][4]; float gt[2][4];
#pragma unroll
        for (int ai = 0; ai < 2; ++ai)
#pragma unroll
            for (int m = 0; m < 4; ++m) { const int pos = pos0 + ai * HALF + m * 16; dst[ai][m] = gld<int>(rowdst + pos); gt[ai][m] = gld<float>(rowgate + pos); }
#pragma unroll
        for (int ai = 0; ai < 2; ++ai)
#pragma unroll
            for (int m = 0; m < 4; ++m) {
                if (dst[ai][m] >= 0) { bf16* rowp = Y + (size_t)dst[ai][m] * D + c0; const float s = gt[ai][m];
#pragma unroll
                    for (int bj = 0; bj < 2; ++bj) { const f32x4 v0 = (acc[ai][bj][m][0] + bv[bj][0]) * s, v1 = (acc[ai][bj][m][1] + bv[bj][1]) * s;
                        v4u w; w.x = cvt_pk_bf16(v0[0], v0[1]); w.y = cvt_pk_bf16(v0[2], v0[3]); w.z = cvt_pk_bf16(v1[0], v1[1]); w.w = cvt_pk_bf16(v1[2], v1[3]);
                        gst<v4u>(rowp + bj * HALF, w); } } }
    }
};
}

__device__ __forceinline__ int chq(int lane, int q) { return (q >> 1) * 512 + 8 * lane + (q & 1) * 4; }
__device__ __forceinline__ v4u pack8(const float* v) { v4u w; w.x = cvt_pk_bf16(v[0], v[1]); w.y = cvt_pk_bf16(v[2], v[3]); w.z = cvt_pk_bf16(v[4], v[5]); w.w = cvt_pk_bf16(v[6], v[7]); return w; }
__device__ __forceinline__ void unpack8(const v4u w, float* v) { v[0] = bf_lo(w.x); v[1] = bf_hi(w.x); v[2] = bf_lo(w.y); v[3] = bf_hi(w.y); v[4] = bf_lo(w.z); v[5] = bf_hi(w.z); v[6] = bf_lo(w.w); v[7] = bf_hi(w.w); }

__device__ __forceinline__ int drow_of(int mode, int c) {
    if (mode == 1) { const int j = c >> 1, p = c & 1; return (j >> 7) * 256 + p * 128 + (j & 127); }
    if (mode == 2) { if (c < 1024) return 2048 + c; const int j = (c - 1024) & 1023, p = (c - 1024) >> 10; return (j >> 7) * 256 + p * 128 + (j & 127); }
    if (mode == 3) { const int j = c & 1023, p = c >> 10; return (j >> 7) * 256 + p * 128 + (j & 127); }
    return c;
}
__device__ __forceinline__ void transpose_item(const float* W, int K, int N, bf16* WT, int mode, LAS float* scr, int item, int lane) {
    const int nblk = N / 32, kb = item / nblk, nb = item % nblk, k0 = 64 * kb, n0 = 32 * nb;
    float tmp[32];
#pragma unroll
    for (int i = 0; i < 32; ++i) { const int kk = 2 * i + (lane >> 5); tmp[i] = gld<float>(W + (size_t)(k0 + kk) * N + n0 + (lane & 31)); }
#pragma unroll
    for (int i = 0; i < 32; ++i) { const int kk = 2 * i + (lane >> 5); scr[kk * 33 + (lane & 31)] = tmp[i]; }
    LDS_WAIT(); asm volatile("" ::: "memory");
    const int c = lane & 7;
#pragma unroll
    for (int j = 0; j < 4; ++j) { const int n = (lane >> 3) + 8 * j; const LAS float* s = scr + (8 * c) * 33 + n;
        v4u o; o.x = cvt_pk_bf16(s[0 * 33], s[1 * 33]); o.y = cvt_pk_bf16(s[2 * 33], s[3 * 33]); o.z = cvt_pk_bf16(s[4 * 33], s[5 * 33]); o.w = cvt_pk_bf16(s[6 * 33], s[7 * 33]);
        gst<v4u>(WT + (size_t)drow_of(mode, n0 + n) * K + k0 + 8 * c, o); }
    LDS_WAIT(); asm volatile("" ::: "memory");
}

struct Args { const float* in[24]; float* out; unsigned char* ws; };

#define PHASE_BEGIN() \
    int tid = threadIdx.x; asm volatile("" : "+v"(tid)); \
    const int lane = tid & 63, wave = __builtin_amdgcn_readfirstlane(tid >> 6); \
    unsigned char* ws_ = args.ws; asm volatile("" : "+s"(ws_)); unsigned char* ws = (unsigned char*)(GAS unsigned char*)ws_; \
    unsigned* ctl = (unsigned*)(ws + WS_CTL); \
    const int gw = vcu * NWAVES + wave, NGW = G * NWAVES; (void)gw; (void)NGW; (void)lane; (void)ctl;

__device__ __forceinline__ float butterfly32(float (&p)[32], int lane) {
#pragma unroll
    for (int i = 0; i < 16; ++i) { const bool hi = (lane & 32) != 0; const float snd = hi ? p[i] : p[i + 16]; const float keep = hi ? p[i + 16] : p[i]; p[i] = keep + __shfl_xor(snd, 32); }
#pragma unroll
    for (int i = 0; i < 8; ++i) { const bool hi = (lane & 16) != 0; const float snd = hi ? p[i] : p[i + 8]; const float keep = hi ? p[i + 8] : p[i]; p[i] = keep + __shfl_xor(snd, 16); }
#pragma unroll
    for (int i = 0; i < 4; ++i) { const bool hi = (lane & 8) != 0; const float snd = hi ? p[i] : p[i + 4]; const float keep = hi ? p[i + 4] : p[i]; p[i] = keep + __shfl_xor(snd, 8); }
#pragma unroll
    for (int i = 0; i < 2; ++i) { const bool hi = (lane & 4) != 0; const float snd = hi ? p[i] : p[i + 2]; const float keep = hi ? p[i + 2] : p[i]; p[i] = keep + __shfl_xor(snd, 4); }
    { const bool hi = (lane & 2) != 0; const float snd = hi ? p[0] : p[1]; const float keep = hi ? p[1] : p[0]; p[0] = keep + __shfl_xor(snd, 2); }
    return p[0] + __shfl_xor(p[0], 1);
}
__device__ __forceinline__ void ln16(float (&v)[16], const float (&lg)[16], const float (&lb)[16]) {
    float sm = 0.f;
#pragma unroll
    for (int i = 0; i < 16; ++i) sm += v[i];
    const float mean = wave_sum(sm) * (1.0f / D);
    float sq = 0.f;
#pragma unroll
    for (int i = 0; i < 16; ++i) { v[i] -= mean; sq += v[i] * v[i]; }
    const float rstd = 1.0f / sqrtf(wave_sum(sq) * (1.0f / D) + LN_EPS);
#pragma unroll
    for (int i = 0; i < 16; ++i) v[i] = v[i] * rstd * lg[i] + lb[i];
}
template <bool F32IN>
__device__ __forceinline__ void pool_diff_run(const float* xf, const bf16* xb, bf16* M3, int t0, int lane) {
    const int s0 = t0 & (SEQ - 1);
#pragma unroll
    for (int g = 0; g < 4; ++g) {
        const int w = 2 << g, c = 256 * g + 4 * lane;
        f32x4 r[31];
#pragma unroll
        for (int j = 0; j < w + 15; ++j) {
            const int dt = j - (w - 1);
            if (dt >= 0 || s0 != 0) {
                const size_t o = (size_t)(t0 + dt) * D + c;
                if (F32IN) r[j] = gld<f32x4>(xf + o);
                else { const v2u q = gld<v2u>(xb + o); r[j] = (f32x4){bf_lo(q.x), bf_hi(q.x), bf_lo(q.y), bf_hi(q.y)}; }
            } else r[j] = (f32x4){0.f, 0.f, 0.f, 0.f};
        }
#pragma unroll
        for (int i = 0; i < 16; ++i) {
            f32x4 sum = r[i];
#pragma unroll
            for (int j = 1; j < w; ++j) sum += r[i + j];
            const int nv = (s0 + i + 1 < w) ? s0 + i + 1 : w;
            const f32x4 df = sum * (1.0f / (float)nv) - r[i + w - 1];
            v2u o; o.x = cvt_pk_bf16(df[0], df[1]); o.y = cvt_pk_bf16(df[2], df[3]);
            gst<v2u>(M3 + (size_t)(t0 + i) * D + c, o);
        }
    }
}

__global__ void __launch_bounds__(NTHR, 2) mega_fwd(Args args) {
    extern __shared__ __attribute__((aligned(16))) unsigned char lds_raw[];
    LAS unsigned char* lds = (LAS unsigned char*)lds_raw;
    volatile LAS unsigned* MISC = (volatile LAS unsigned*)(lds + MISC_OFF);
    const int G = gridDim.x, bx = blockIdx.x;
    const int vcu = (G % 8 == 0) ? (bx % 8) * (G / 8) + bx / 8 : bx;
    if (threadIdx.x < 128) MISC[threadIdx.x] = 0u;
    __syncthreads();
    (void)xcd_barrier_post((unsigned*)(args.ws + WS_CTL) + CW_BAR, MISC + 0);
#define GRID_BAR() do { XcdBarrier b_; unsigned* bp_ = (unsigned*)(args.ws + WS_CTL) + CW_BAR; asm volatile("" : "+s"(bp_)); b_.bar = (unsigned*)(GAS unsigned*)bp_; b_.x = xb_xcc_id(); b_.st = MISC; xcd_barrier(b_); } while (0)

    {
        PHASE_BEGIN();
        bf16* WPOOL = (bf16*)(ws + WS_WPOOL); bf16* WSCIN = (bf16*)(ws + WS_WSCIN); bf16* WSCOUT = (bf16*)(ws + WS_WSCOUT);
        bf16* WCFIN = (bf16*)(ws + WS_WCFIN); bf16* WCFOUT = (bf16*)(ws + WS_WCFOUT); bf16* WGU = (bf16*)(ws + WS_WGU); bf16* WDN = (bf16*)(ws + WS_WDN);
        LAS float* scr = (LAS float*)(lds + RING_OFF + wave * 16384);
        constexpr int I_GU = 16 * 64, I_DN = 16 * 32, I_POOL = 4 * 8, I_SCIN = 16 * 96, I_SQ = 16 * 32, I_CFIN = 16 * 64;
        constexpr int N_GU = 128 * I_GU, N_DN = 128 * I_DN, N_POOL = 8 * I_POOL;
        constexpr int NITEMS = N_GU + N_DN + N_POOL + I_SCIN + I_SQ + I_CFIN + I_SQ;
        for (int rep = 0; rep < REP_P0; ++rep)
        for (int it = gw; it < NITEMS; it += NGW) {
            int r = it;
            if (r < N_GU) { const int mt = r / I_GU; transpose_item(args.in[18] + (size_t)mt * 1024 * 2048, 1024, 2048, WGU + (size_t)mt * 2048 * 1024, 1, scr, r % I_GU, lane); continue; } r -= N_GU;
            if (r < N_DN) { const int mt = r / I_DN; transpose_item(args.in[20] + (size_t)mt * 1024 * 1024, 1024, 1024, WDN + (size_t)mt * 1024 * 1024, 0, scr, r % I_DN, lane); continue; } r -= N_DN;
            if (r < N_POOL) { const int mt = r / I_POOL; transpose_item(args.in[1] + (size_t)mt * 256 * 256, 256, 256, WPOOL + (size_t)mt * 256 * 256, 0, scr, r % I_POOL, lane); continue; } r -= N_POOL;
            if (r < I_SCIN) { transpose_item(args.in[3], 1024, 3072, WSCIN, 2, scr, r, lane); continue; } r -= I_SCIN;
            if (r < I_SQ) { transpose_item(args.in[5], 1024, 1024, WSCOUT, 0, scr, r, lane); continue; } r -= I_SQ;
            if (r < I_CFIN) { transpose_item(args.in[6], 1024, 2048, WCFIN, 3, scr, r, lane); continue; } r -= I_CFIN;
            transpose_item(args.in[12], 1024, 1024, WCFOUT, 0, scr, r, lane);
        }
        const float* x0 = args.in[0]; bf16* XAb = (bf16*)(ws + WS_XAB);
        for (int t = gw; t < T; t += NGW) {
            float v[16];
#pragma unroll
            for (int q = 0; q < 4; ++q) { const f32x4 z = gld<f32x4>(x0 + (size_t)t * D + chq(lane, q)); v[4 * q] = z[0]; v[4 * q + 1] = z[1]; v[4 * q + 2] = z[2]; v[4 * q + 3] = z[3]; }
            gst<v4u>(XAb + (size_t)t * D + 8 * lane, pack8(v));
            gst<v4u>(XAb + (size_t)t * D + 512 + 8 * lane, pack8(v + 8));
        }
    }
    GRID_BAR();

    for (int layer = 0; layer < DEPTH; ++layer) {
        const int kind = layer % 3;

        if (kind == 0) {
            PHASE_BEGIN();
            bf16* M3 = (bf16*)(ws + WS_M3); const bf16* xb = (const bf16*)(ws + WS_XAB);
            for (int rep = 0; rep < REP_THIN; ++rep)
            for (int tb = vcu; tb < T / 128; tb += G) {
                const int t0 = tb * 128 + wave * 16;
                if (layer == 0) pool_diff_run<true>(args.in[0], xb, M3, t0, lane);
                else pool_diff_run<false>(args.in[0], xb, M3, t0, lane);
            }
        } else {
            {
                PHASE_BEGIN();
                bf16* M1 = (bf16*)(ws + WS_M1); bf16* M2 = (bf16*)(ws + WS_M2);
                const int nN = (kind == 1) ? 12 : 8;
                const int n_my = pg8::build_units(lds, tid, T / 256, nN, G, bx, false, nullptr, REP_MIXG);
                pg8::GemmP gp; gp.A = (const char*)(ws + WS_XAB); gp.lda2 = D * 2; gp.acol_pn = 0; gp.Bt = (const char*)(ws + ((kind == 1) ? WS_WSCIN : WS_WCFIN)); gp.b_estride = 0; gp.K = 1024;
                pg8::EpiPair E; E.O1 = (kind == 1) ? M2 : M1; E.O2 = M1; E.bias = args.in[7]; E.mode = (kind == 1) ? 0 : 1;
                pg8::gemm_phase<false, pg8::EpiPair>(lds, tid, gp, n_my, E);
            }
            GRID_BAR();
            if (kind == 1) {
                PHASE_BEGIN();
                const bf16* M1 = (const bf16*)(ws + WS_M1); const bf16* M2 = (const bf16*)(ws + WS_M2); bf16* M3 = (bf16*)(ws + WS_M3);
                const float* cw = args.in[4];
                float wk[3][16];
#pragma unroll
                for (int k = 0; k < 3; ++k)
#pragma unroll
                    for (int q = 0; q < 4; ++q) { const f32x4 v = gld<f32x4>(cw + k * D + chq(lane, q)); wk[k][4 * q] = v[0]; wk[k][4 * q + 1] = v[1]; wk[k][4 * q + 2] = v[2]; wk[k][4 * q + 3] = v[3]; }
                for (int rep = 0; rep < REP_THIN; ++rep)
                for (int tb = vcu; tb < T / 128; tb += G) {
                    const int t0 = tb * 128 + wave * 16, s0 = t0 & (SEQ - 1);
                    float p2[16], p1[16];
                    if (s0 != 0) { unpack8(gld<v4u>(M2 + (size_t)(t0 - 2) * D + 8 * lane), p2); unpack8(gld<v4u>(M2 + (size_t)(t0 - 2) * D + 512 + 8 * lane), p2 + 8);
                                   unpack8(gld<v4u>(M2 + (size_t)(t0 - 1) * D + 8 * lane), p1); unpack8(gld<v4u>(M2 + (size_t)(t0 - 1) * D + 512 + 8 * lane), p1 + 8); }
                    else {
#pragma unroll
                        for (int i = 0; i < 16; ++i) { p2[i] = 0.f; p1[i] = 0.f; } }
                    for (int i0 = 0; i0 < 16; i0 += 4) {
                        v4u cv[4][2], gv[4][2];
#pragma unroll
                        for (int u = 0; u < 4; ++u)
#pragma unroll
                            for (int j = 0; j < 2; ++j) { const size_t o = (size_t)(t0 + i0 + u) * D + j * 512 + 8 * lane; cv[u][j] = gld<v4u>(M2 + o); gv[u][j] = gld<v4u>(M1 + o); }
#pragma unroll
                        for (int u = 0; u < 4; ++u) {
                            float c[16], gb[16], o[16];
                            unpack8(cv[u][0], c); unpack8(cv[u][1], c + 8); unpack8(gv[u][0], gb); unpack8(gv[u][1], gb + 8);
#pragma unroll
                            for (int i = 0; i < 16; ++i) { o[i] = gb[i] * (wk[0][i] * p2[i] + wk[1][i] * p1[i] + wk[2][i] * c[i]); p2[i] = p1[i]; p1[i] = c[i]; }
                            gst<v4u>(M3 + (size_t)(t0 + i0 + u) * D + 8 * lane, pack8(o));
                            gst<v4u>(M3 + (size_t)(t0 + i0 + u) * D + 512 + 8 * lane, pack8(o + 8));
                        }
                    }
                }
            } else {
                PHASE_BEGIN();
                const bf16* U = (const bf16*)(ws + WS_M1); bf16* M3 = (bf16*)(ws + WS_M3);
                const int c = 128 * wave + 2 * lane;
                float wk0[31], wk1[31];
#pragma unroll
                for (int k = 0; k < 31; ++k) { const v2u q = gld<v2u>(args.in[8] + k * D + c); wk0[k] = __uint_as_float(q.x); wk1[k] = __uint_as_float(q.y); }
                const v2u qb = gld<v2u>(args.in[9] + c), qg = gld<v2u>(args.in[10] + c), ql = gld<v2u>(args.in[11] + c);
                const float db0 = __uint_as_float(qb.x), db1 = __uint_as_float(qb.y), lg0 = __uint_as_float(qg.x), lg1 = __uint_as_float(qg.y), lb0 = __uint_as_float(ql.x), lb1 = __uint_as_float(ql.y);
                LAS float* part = (LAS float*)(lds + RING_OFF);
                LAS float* stat = part + 256;
                for (int rep = 0; rep < REP_THIN; ++rep)
                for (int run = vcu; run < T / 16; run += G) {
                    const int t0 = run * 16, s0 = t0 & (SEQ - 1);
                    unsigned r[46];
#pragma unroll
                    for (int j = 0; j < 46; ++j) r[j] = (s0 + j - 30 >= 0) ? gld<unsigned>(U + (size_t)(t0 + j - 30) * D + c) : 0u;
                    float a0[16], a1[16];
#pragma unroll
                    for (int i = 0; i < 16; ++i) { a0[i] = db0; a1[i] = db1; }
#pragma unroll
                    for (int j = 0; j < 46; ++j) { const float x0 = bf_lo(r[j]), x1 = bf_hi(r[j]);
#pragma unroll
                        for (int i = 0; i < 16; ++i) { const int k = j - i; if (k >= 0 && k <= 30) { a0[i] += wk0[k] * x0; a1[i] += wk1[k] * x1; } } }
                    float st[32];
#pragma unroll
                    for (int i = 0; i < 16; ++i) { st[2 * i] = a0[i] + a1[i]; st[2 * i + 1] = a0[i] * a0[i] + a1[i] * a1[i]; }
                    const float tot = butterfly32(st, lane);
                    if ((lane & 1) == 0) part[wave * 32 + (lane >> 1)] = tot;
                    __syncthreads();
                    if (tid < 16) { float S = 0.f, Q = 0.f;
#pragma unroll
                        for (int w8 = 0; w8 < 8; ++w8) { S += part[w8 * 32 + 2 * tid]; Q += part[w8 * 32 + 2 * tid + 1]; }
                        const float mean = S * (1.0f / D); const float var = fmaxf(Q * (1.0f / D) - mean * mean, 0.f);
                        stat[2 * tid] = mean; stat[2 * tid + 1] = 1.0f / sqrtf(var + LN_EPS); }
                    __syncthreads();
#pragma unroll
                    for (int i = 0; i < 16; ++i) { const float mean = stat[2 * i], rstd = stat[2 * i + 1];
                        const float y0 = (a0[i] - mean) * rstd * lg0 + lb0, y1 = (a1[i] - mean) * rstd * lg1 + lb1;
                        gst<unsigned>(M3 + (size_t)(t0 + i) * D + c, cvt_pk_bf16(y0 * sigmoidf_(y0), y1 * sigmoidf_(y1))); }
                }
                __syncthreads();
            }
        }
        GRID_BAR();

        {
            PHASE_BEGIN();
            const int n_my = pg8::build_units(lds, tid, T / 256, 4, G, bx, false, nullptr, REP_MIXG);
            pg8::GemmP gp; gp.A = (const char*)(ws + WS_M3); gp.lda2 = D * 2; gp.b_estride = 0;
            pg8::EpiOut E; E.xres = (const bf16*)(ws + WS_XAB); E.z = (bf16*)(ws + WS_ZB); E.bias = nullptr; E.scale = nullptr;
            if (kind == 0) { gp.acol_pn = 512; gp.Bt = (const char*)(ws + WS_WPOOL + (size_t)(layer / 3) * 1024 * 256 * 2); gp.K = 256; E.scale = args.in[2] + (layer / 3) * D; }
            else if (kind == 1) { gp.acol_pn = 0; gp.Bt = (const char*)(ws + WS_WSCOUT); gp.K = 1024; }
            else { gp.acol_pn = 0; gp.Bt = (const char*)(ws + WS_WCFOUT); gp.K = 1024; E.bias = args.in[13]; }
            pg8::gemm_phase<false, pg8::EpiOut>(lds, tid, gp, n_my, E);
        }
        GRID_BAR();

        {
            PHASE_BEGIN();
            const bf16* Zb = (const bf16*)(ws + WS_ZB); bf16* X1b = (bf16*)(ws + WS_X1B);
            int* TIDX = (int*)(ws + WS_IDX); float* TGATE = (float*)(ws + WS_GATE);
            unsigned* CNT = ctl + CW_CNT + layer * NE;
            LAS float* rwl = (LAS float*)(lds + RING_OFF);
            const float* rw = args.in[16] + (size_t)layer * D * NE;
            for (int idx = tid; idx < D * 8; idx += NTHR) { const int c = idx >> 3, eg = idx & 7; const int j = c >> 9, r = c & 511, l = r >> 3, ci = j * 8 + (r & 7);
                *(LAS f32x4*)(rwl + ((ci * 8 + eg) * 64 + l) * 4) = gld<f32x4>(rw + c * NE + eg * 4); }
            if (tid < NE) MISC[32 + tid] = 0u;
            __syncthreads();
            float lg[16], lb[16];
#pragma unroll
            for (int q = 0; q < 4; ++q) { const f32x4 b = gld<f32x4>(args.in[14] + layer * D + chq(lane, q)), c = gld<f32x4>(args.in[15] + layer * D + chq(lane, q));
#pragma unroll
                for (int i = 0; i < 4; ++i) { lg[4 * q + i] = b[i]; lb[4 * q + i] = c[i]; } }
            const int myexp = (lane >> 1) & 31;
            const float rbias = gld<float>(args.in[17] + layer * NE + myexp);
            for (int tb = vcu; tb < T / 128; tb += G) {
                const int t0 = tb * 128 + wave * 16;
                v4u zn0 = gld<v4u>(Zb + (size_t)t0 * D + 8 * lane), zn1 = gld<v4u>(Zb + (size_t)t0 * D + 512 + 8 * lane);
                for (int ti = 0; ti < 16; ++ti) {
                    const int t = t0 + ti;
                    float v[16]; unpack8(zn0, v); unpack8(zn1, v + 8);
                    if (ti + 1 < 16) { zn0 = gld<v4u>(Zb + (size_t)(t + 1) * D + 8 * lane); zn1 = gld<v4u>(Zb + (size_t)(t + 1) * D + 512 + 8 * lane); }
                    ln16(v, lg, lb);
                    gst<v4u>(X1b + (size_t)t * D + 8 * lane, pack8(v));
                    gst<v4u>(X1b + (size_t)t * D + 512 + 8 * lane, pack8(v + 8));
                    float p[32];
#pragma unroll
                    for (int e = 0; e < 32; ++e) p[e] = 0.f;
#pragma unroll
                    for (int ci = 0; ci < 16; ++ci)
#pragma unroll
                        for (int eg = 0; eg < 8; ++eg) { const f32x4 w4 = *(const LAS f32x4*)(rwl + ((ci * 8 + eg) * 64 + lane) * 4);
#pragma unroll
                            for (int i = 0; i < 4; ++i) p[4 * eg + i] += v[ci] * w4[i]; }
                    const float logit = butterfly32(p, lane) + rbias;
                    int rank = 0;
#pragma unroll
                    for (int e = 0; e < 32; ++e) { const float se = __uint_as_float((unsigned)__builtin_amdgcn_readlane((int)__float_as_uint(logit), 2 * e)); rank += (se > logit || (se == logit && e < myexp)) ? 1 : 0; }
                    float tv[4]; int tix[4];
#pragma unroll
                    for (int r = 0; r < 4; ++r) { const unsigned long long mk = __ballot(rank == r); const int src = (int)__builtin_ctzll(mk | (1ull << 63));
                        tv[r] = __uint_as_float((unsigned)__builtin_amdgcn_readlane((int)__float_as_uint(logit), src)); tix[r] = src >> 1; }
                    const float e1 = __expf(tv[1] - tv[0]), e2 = __expf(tv[2] - tv[0]), e3 = __expf(tv[3] - tv[0]);
                    const float inv = 1.0f / (1.0f + e1 + e2 + e3);
                    if (lane < 4) {
                        const int ix = lane == 0 ? tix[0] : lane == 1 ? tix[1] : lane == 2 ? tix[2] : tix[3];
                        const float gv = (lane == 0 ? 1.0f : lane == 1 ? e1 : lane == 2 ? e2 : e3) * inv;
                        gst<int>(TIDX + t * 4 + lane, ix); gst<float>(TGATE + t * 4 + lane, gv);
                        __hip_atomic_fetch_add((LAS unsigned*)(lds + MISC_OFF) + 32 + ix, 1u, __ATOMIC_RELAXED, __HIP_MEMORY_SCOPE_WORKGROUP);
                    }
                }
            }
            __syncthreads();
            if (tid < NE) { const unsigned c = MISC[32 + tid]; if (c) (void)xb_add(CNT + tid, c); }
        }
        GRID_BAR();

        {
            PHASE_BEGIN();
            const int* TIDX = (const int*)(ws + WS_IDX); const float* TGATE = (const float*)(ws + WS_GATE);
            int* RTOK = (int*)(ws + WS_RTOK); int* RDST = (int*)(ws + WS_RDST); float* RGATE = (float*)(ws + WS_RGATE);
            unsigned* CNT = ctl + CW_CNT + layer * NE; unsigned* CUR = ctl + CW_CUR + layer * NE;
            LAS int* TS = (LAS int*)(lds + TS_OFF);
            if (tid == 0) { int a = 0; for (int e = 0; e < NE; ++e) { TS[e] = a; a += (int)((xb_ld(CNT + e) + 255u) >> 8); } TS[NE] = a; }
            for (int tb = vcu; tb < T / 128; tb += G) {
                __syncthreads();
                if (tid < NE) MISC[32 + tid] = 0u;
                __syncthreads();
                const int t = tb * 128 + (tid >> 2), k = tid & 3;
                const int e = gld<int>(TIDX + t * 4 + k); const float gv = gld<float>(TGATE + t * 4 + k);
                const unsigned rank = __hip_atomic_fetch_add((LAS unsigned*)(lds + MISC_OFF) + 32 + e, 1u, __ATOMIC_RELAXED, __HIP_MEMORY_SCOPE_WORKGROUP);
                __syncthreads();
                if (tid < NE) { const unsigned c = MISC[32 + tid]; MISC[64 + tid] = c ? xb_add(CUR + tid, c) : 0u; }
                __syncthreads();
                const int pos = TS[e] * 256 + (int)MISC[64 + e] + (int)rank;
                gst<int>(RTOK + pos, t); gst<int>(RDST + pos, t * 4 + k); gst<float>(RGATE + pos, gv);
            }
            __syncthreads();
            for (int e = vcu; e < NE; e += G) {
                const int beg = TS[e] * 256 + (int)xb_ld(CNT + e), end = TS[e + 1] * 256;
                for (int p = beg + tid; p < end; p += NTHR) { gst<int>(RTOK + p, 0); gst<int>(RDST + p, -1); gst<float>(RGATE + p, 0.f); }
            }
        }
        GRID_BAR();

        {
            PHASE_BEGIN();
            unsigned* CNT = ctl + CW_CNT + layer * NE;
            LAS int* TS = (LAS int*)(lds + TS_OFF);
            __syncthreads();
            if (tid == 0) { int a = 0; for (int e = 0; e < NE; ++e) { TS[e] = a; a += (int)((xb_ld(CNT + e) + 255u) >> 8); } TS[NE] = a; }
            __syncthreads();
            const int nM = TS[NE];
            const int n_my = pg8::build_units(lds, tid, nM, 8, G, bx, true, (const int*)(ws + WS_RTOK), REP_MOE1);
            pg8::GemmP gp; gp.A = (const char*)(ws + WS_X1B); gp.lda2 = D * 2; gp.acol_pn = 0; gp.Bt = (const char*)(ws + WS_WGU + (size_t)layer * NE * 2048 * 1024 * 2); gp.b_estride = (size_t)2048 * 1024 * 2; gp.K = 1024;
            pg8::EpiSwiglu E; E.act = (bf16*)(ws + WS_ACT); E.bgu = args.in[19] + (size_t)layer * NE * 2048;
            pg8::gemm_phase<true, pg8::EpiSwiglu>(lds, tid, gp, n_my, E, REP_MOE1 > 1 ? n_my / 2 : (1 << 20));
        }
        GRID_BAR();

        {
            PHASE_BEGIN();
            LAS int* TS = (LAS int*)(lds + TS_OFF);
            const int nM = TS[NE];
            const int n_my = pg8::build_units(lds, tid, nM, 4, G, bx, true, nullptr, REP_MOE2);
            pg8::GemmP gp; gp.A = (const char*)(ws + WS_ACT); gp.lda2 = D * 2; gp.acol_pn = 0; gp.Bt = (const char*)(ws + WS_WDN + (size_t)layer * NE * 1024 * 1024 * 2); gp.b_estride = (size_t)1024 * 1024 * 2; gp.K = 1024;
            pg8::EpiMoe2 E; E.Y = (bf16*)(ws + WS_Y); E.bdn = args.in[21] + (size_t)layer * NE * D; E.rowdst = (const int*)(ws + WS_RDST); E.rowgate = (const float*)(ws + WS_RGATE);
            pg8::gemm_phase<false, pg8::EpiMoe2>(lds, tid, gp, n_my, E);
        }
        GRID_BAR();

        {
            PHASE_BEGIN();
            const bf16* X1b = (const bf16*)(ws + WS_X1B); const bf16* Y = (const bf16*)(ws + WS_Y); float* OUT = args.out; bf16* XAb = (bf16*)(ws + WS_XAB);
            float lg[16], lb[16];
#pragma unroll
            for (int q = 0; q < 4; ++q) { const f32x4 b = gld<f32x4>(args.in[22] + layer * D + chq(lane, q)), c = gld<f32x4>(args.in[23] + layer * D + chq(lane, q));
#pragma unroll
                for (int i = 0; i < 4; ++i) { lg[4 * q + i] = b[i]; lb[4 * q + i] = c[i]; } }
            for (int rep = 0; rep < REP_THIN; ++rep)
            for (int tb = vcu; tb < T / 128; tb += G) {
                const int t0 = tb * 128 + wave * 16;
                v4u nx[2], ny[4][2];
#pragma unroll
                for (int j = 0; j < 2; ++j) { nx[j] = gld<v4u>(X1b + (size_t)t0 * D + j * 512 + 8 * lane);
#pragma unroll
                    for (int k = 0; k < 4; ++k) ny[k][j] = gld<v4u>(Y + (size_t)(t0 * 4 + k) * D + j * 512 + 8 * lane); }
                for (int ti = 0; ti < 16; ++ti) {
                    const int t = t0 + ti;
                    float v[16], h[16];
                    unpack8(nx[0], v); unpack8(nx[1], v + 8);
#pragma unroll
                    for (int i = 0; i < 16; ++i) { v[i] *= ALPHA; h[i] = 0.f; }
#pragma unroll
                    for (int k = 0; k < 4; ++k) { float y[16]; unpack8(ny[k][0], y); unpack8(ny[k][1], y + 8);
#pragma unroll
                        for (int i = 0; i < 16; ++i) h[i] += y[i]; }
                    if (ti + 1 < 16) {
#pragma unroll
                        for (int j = 0; j < 2; ++j) { nx[j] = gld<v4u>(X1b + (size_t)(t + 1) * D + j * 512 + 8 * lane);
#pragma unroll
                            for (int k = 0; k < 4; ++k) ny[k][j] = gld<v4u>(Y + (size_t)((t + 1) * 4 + k) * D + j * 512 + 8 * lane); } }
#pragma unroll
                    for (int i = 0; i < 16; ++i) v[i] += h[i];
                    ln16(v, lg, lb);
                    if (layer == DEPTH - 1) {
#pragma unroll
                        for (int q = 0; q < 4; ++q) gst<f32x4>(OUT + (size_t)t * D + chq(lane, q), (f32x4){v[4 * q], v[4 * q + 1], v[4 * q + 2], v[4 * q + 3]});
                    } else {
                        gst<v4u>(XAb + (size_t)t * D + 8 * lane, pack8(v));
                        gst<v4u>(XAb + (size_t)t * D + 512 + 8 * lane, pack8(v + 8));
                    }
                }
            }
        }
        if (layer + 1 < DEPTH) GRID_BAR();
    }
}

extern "C" void kernel_launch(void* const* d_in, const int* in_sizes, int n_in, void* d_out, int out_size, void* d_ws, size_t ws_size, hipStream_t stream) {
    static int grid = 0;
    if (grid == 0) {
        if (n_in != 24 || out_size != T * D || ws_size < WS_END) { fprintf(stderr, "kernel_launch: unexpected shapes (n_in %d out %d ws %zu)\n", n_in, out_size, ws_size); grid = -1; return; }
        if (hipFuncSetAttribute((const void*)mega_fwd, hipFuncAttributeMaxDynamicSharedMemorySize, LDS_BYTES) != hipSuccess) { fprintf(stderr, "kernel_launch: hipFuncSetAttribute failed\n"); grid = -1; return; }
        int dev = 0, cus = 0, per_cu = 0;
        (void)hipGetDevice(&dev); (void)hipDeviceGetAttribute(&cus, hipDeviceAttributeMultiprocessorCount, dev);
        if (hipOccupancyMaxActiveBlocksPerMultiprocessor(&per_cu, (const void*)mega_fwd, NTHR, LDS_BYTES) != hipSuccess || per_cu < 1) fprintf(stderr, "kernel_launch: occupancy query reports %d blocks per CU\n", per_cu);
        (void)hipGetLastError();
        grid = 256; if (cus > 0 && cus < grid) grid = cus;
    }
    if (grid < 0) return;
    (void)hipMemsetAsync((char*)d_ws + WS_CTL, 0, CTL_ZERO_BYTES, stream);
    Args a{};
    for (int i = 0; i < 24; ++i) a.in[i] = (const float*)d_in[i];
    a.out = (float*)d_out; a.ws = (unsigned char*)d_ws;
    hipLaunchKernelGGL(mega_fwd, dim3(grid), dim3(NTHR), LDS_BYTES, stream, a);
    const hipError_t le = hipPeekAtLastError();
    if (le != hipSuccess) fprintf(stderr, "kernel_launch: launch failed: %s\n", hipGetErrorName(le));
}
```

```cpp
#include <hip/hip_runtime.h>
#include <cstdio>
#include <cstdint>

#define GAS __attribute__((address_space(1)))
#define LAS __attribute__((address_space(3)))
typedef unsigned short bf16;
typedef unsigned v4u __attribute__((ext_vector_type(4)));
typedef unsigned v2u __attribute__((ext_vector_type(2)));
typedef float f32x4 __attribute__((ext_vector_type(4)));
typedef short bf16x8 __attribute__((ext_vector_type(8)));
typedef int v4i __attribute__((ext_vector_type(4)));
typedef int v8i __attribute__((ext_vector_type(8)));

template <class V> __device__ __forceinline__ V gld(const void* p) { return *(const GAS V*)p; }
template <class V> __device__ __forceinline__ void gst(void* p, V v) { *(GAS V*)p = v; }

#ifndef REP_P0
#define REP_P0 1
#endif
#ifndef REP_MOE1
#define REP_MOE1 1
#endif
#ifndef REP_MOE2
#define REP_MOE2 1
#endif
#ifndef REP_THIN
#define REP_THIN 1
#endif
#ifndef REP_MIXG
#define REP_MIXG 1
#endif
constexpr int T = 32768, D = 1024, SEQ = 4096, NE = 32, TOPK = 4, NA = T * TOPK, DEPTH = 4;
constexpr int MAXTILES = NA / 256 + NE;
constexpr int NPAD = MAXTILES * 256;
constexpr float LN_EPS = 1e-5f;
constexpr float ALPHA = 1.681792830507429f;
constexpr int NWAVES = 8, NTHR = 512;
constexpr int MAXU = 17;
constexpr float SX8 = 16.0f, SACT8 = 4.0f, SW8 = 256.0f;
constexpr int E8_X = 0x7B7B7B7B  , E8_ACT = 0x7D7D7D7D  , E8_W = 0x77777777  ;

constexpr size_t MiB = 1u << 20;
constexpr size_t WS_CTL = 0, CTL_ZERO_BYTES = 1 * MiB;
constexpr size_t WS_IDX = 1 * MiB;
constexpr size_t WS_GATE = 1 * MiB + 512 * 1024;
constexpr size_t WS_RTOK = 2 * MiB;
constexpr size_t WS_RDST = 3 * MiB;
constexpr size_t WS_RGATE = 4 * MiB;
constexpr size_t WS_WPOOL = 5 * MiB;
constexpr size_t WS_WSCIN = 6 * MiB;
constexpr size_t WS_WSCOUT = 12 * MiB;
constexpr size_t WS_WCFIN = 14 * MiB;
constexpr size_t WS_WCFOUT = 18 * MiB;
constexpr size_t WS_WGU = 32 * MiB;
constexpr size_t WS_WDN = 544 * MiB;
constexpr size_t WS_X18 = 704 * MiB;
constexpr size_t WS_ZB = 800 * MiB;
constexpr size_t WS_XAB = 864 * MiB;
constexpr size_t WS_X1B = 928 * MiB;
constexpr size_t WS_M1 = 992 * MiB;
constexpr size_t WS_M2 = 1056 * MiB;
constexpr size_t WS_M3 = 1120 * MiB;
constexpr size_t WS_ACT = 1184 * MiB;
constexpr size_t WS_Y = 1456 * MiB;
constexpr size_t WS_END = 1712 * MiB;
constexpr int CW_BAR = 4096;
constexpr int CW_CNT = 8192;
constexpr int CW_CUR = 8192 + 256;

constexpr int RING_OFF = 0, RING_BYTES = 131072;
constexpr int TOK_OFF = RING_BYTES;
constexpr int UT_OFF = TOK_OFF + MAXU * 1024;
constexpr int TS_OFF = UT_OFF + (2 * MAXU + 2) * 16;
constexpr int MISC_OFF = TS_OFF + 36 * 4;
constexpr int LDS_BYTES = MISC_OFF + 128 * 4;
static_assert(LDS_BYTES <= 160 * 1024 && (MISC_OFF % 16) == 0, "LDS map");

#define LDS_WAIT() asm volatile("s_waitcnt lgkmcnt(0)" ::: "memory")
#define VM_WAIT() asm volatile("s_waitcnt vmcnt(0)" ::: "memory")

__device__ __forceinline__ unsigned cvt_pk_bf16(float lo, float hi) { unsigned r; asm volatile("v_cvt_pk_bf16_f32 %0, %1, %2" : "=v"(r) : "v"(lo), "v"(hi)); return r; }
__device__ __forceinline__ v2u pack8_fp8(const float* v) { int a = __builtin_amdgcn_cvt_pk_fp8_f32(v[0], v[1], 0, false); a = __builtin_amdgcn_cvt_pk_fp8_f32(v[2], v[3], a, true);
    int b = __builtin_amdgcn_cvt_pk_fp8_f32(v[4], v[5], 0, false); b = __builtin_amdgcn_cvt_pk_fp8_f32(v[6], v[7], b, true); v2u w; w.x = (unsigned)a; w.y = (unsigned)b; return w; }
__device__ __forceinline__ float bf_lo(unsigned u) { return __uint_as_float(u << 16); }
__device__ __forceinline__ float bf_hi(unsigned u) { return __uint_as_float(u & 0xffff0000u); }
__device__ __forceinline__ float sigmoidf_(float x) { return __builtin_amdgcn_rcpf(1.0f + __expf(-x)); }
__device__ __forceinline__ float shx(float v, int mask, int lane) { return __uint_as_float((unsigned)__builtin_amdgcn_ds_bpermute((lane ^ mask) << 2, (int)__float_as_uint(v))); }
__device__ __forceinline__ float wave_sum(float v, int lane) {
#pragma unroll
    for (int o = 1; o < 64; o <<= 1) v += shx(v, o, lane);
    return v;
}

#define XB_TMO      128
#define XB_XCNT(j)  (256  + 64 * (j))
#define XB_XSUB(j)  (1280 + 64 * (j))
#define XB_XGEN(j)  (2304 + 64 * (j))
#define XB_TOP      3328
#define XB_TOPGEN   3392
#define XCD_BAR_WORDS 3456
#define XB_SPIN_CAP (1u << 18)

__device__ __forceinline__ unsigned xb_ld(unsigned* p)              { return __hip_atomic_load((GAS unsigned*)p, __ATOMIC_RELAXED, __HIP_MEMORY_SCOPE_AGENT); }
__device__ __forceinline__ unsigned xb_add(unsigned* p, unsigned v) { return __hip_atomic_fetch_add((GAS unsigned*)p, v, __ATOMIC_RELAXED, __HIP_MEMORY_SCOPE_AGENT); }
__device__ __forceinline__ unsigned xb_xcc_id() { return (unsigned)__builtin_amdgcn_s_getreg((3 << 11) | 20) & 0xFu; }
#define XB_SPIN(cond, bar) do { unsigned _sp = 0; while (cond) { __builtin_amdgcn_s_sleep(1); \
    if ((++_sp & 255u) == 0u) { if (xb_ld(&(bar)[XB_TMO])) break; if (_sp > XB_SPIN_CAP) { (void)xb_add(&(bar)[XB_TMO], 1u); break; } } } } while (0)

struct XcdBarrier { unsigned* bar; unsigned x; volatile LAS unsigned* st; };

__device__ __forceinline__ XcdBarrier xcd_barrier_post(unsigned* bar, volatile LAS unsigned* st) {
    XcdBarrier b; b.bar = bar; b.x = xb_xcc_id(); b.st = st;
    if (threadIdx.x == 0) (void)xb_add(&bar[XB_XCNT(b.x)], 1u);
    return b;
}
__device__ __forceinline__ void xcd_barrier_complete(unsigned* bar, unsigned x, unsigned& nloc, unsigned& nx) {
    const unsigned G = gridDim.x * gridDim.y * gridDim.z;
    unsigned sum, cnt, mine, sp = 0u;
    for (;;) {
        sum = 0u; cnt = 0u; mine = 0u;
#pragma unroll
        for (unsigned j = 0; j < 16; ++j) { const unsigned c = xb_ld(&bar[XB_XCNT(j)]); sum += c; cnt += (c > 0u) ? 1u : 0u; mine = (j == x) ? c : mine; }
        if (sum == G) break;
        __builtin_amdgcn_s_sleep(1);
        if ((++sp & 255u) == 0u) { if (xb_ld(&bar[XB_TMO])) break; if (sp > XB_SPIN_CAP) { (void)xb_add(&bar[XB_TMO], 1u); break; } }
    }
    nloc = mine > 0u ? mine : 1u; nx = cnt > 0u ? cnt : 1u;
}
__device__ __forceinline__ void xcd_barrier(const XcdBarrier& b) {
    asm volatile("s_waitcnt vmcnt(0)" ::: "memory");
    __syncthreads();
    if (threadIdx.x == 0) {
        unsigned* bar = b.bar;
        __builtin_amdgcn_s_waitcnt(0);
        unsigned nloc = b.st[0], nx = b.st[1];
        if (nloc == 0u) { xcd_barrier_complete(bar, b.x, nloc, nx); b.st[0] = nloc; b.st[1] = nx; }
        const unsigned old = xb_add(&bar[XB_XSUB(b.x)], 1u);
        const unsigned gen = old / nloc;
        if (old + 1u == (gen + 1u) * nloc) {
            __builtin_amdgcn_fence(__ATOMIC_RELEASE, "agent");
            asm volatile("s_waitcnt vmcnt(0)" ::: "memory");
            const unsigned og = xb_add(&bar[XB_TOP], 1u);
            const unsigned tg = og / nx;
            if (og + 1u == (tg + 1u) * nx) xb_add(&bar[XB_TOPGEN], 1u);
            else XB_SPIN(xb_ld(&bar[XB_TOPGEN]) == tg, bar);
            __builtin_amdgcn_fence(__ATOMIC_ACQUIRE, "agent");
            xb_add(&bar[XB_XGEN(b.x)], 1u);
            asm volatile("s_waitcnt vmcnt(0)" ::: "memory");
        } else {
            XB_SPIN(xb_ld(&bar[XB_XGEN(b.x)]) == gen, bar);
            __builtin_amdgcn_fence(__ATOMIC_ACQUIRE, "agent");
            asm volatile("s_waitcnt vmcnt(0)" ::: "memory");
        }
    }
    __syncthreads();
}

namespace pg8 {
constexpr int BM = 256, BK = 64, HALF = 128, HTB = HALF * BK * 2, STAGE_BYTES = 8 * HTB, NXCD = 8, WGM = 8;
__host__ __device__ __forceinline__ int lds_byte(int r, int c) { const int st = (r >> 4) * 2 + (c >> 5), rr = r & 15, cc = c & 31, ob = rr * 64 + cc * 2; return st * 1024 + (ob ^ (((ob >> 9) & 1) << 5)); }
__host__ __device__ __forceinline__ void stage_rc(int b, int& R, int& C) { const int st = b / 1024, sb = b % 1024, swz = sb ^ (((sb >> 9) & 1) << 5); R = (st >> 1) * 16 + swz / 64; C = (st & 1) * 32 + (swz % 64) / 2; }
__host__ __device__ __forceinline__ int perm32(int rho) { const int n = rho >> 4, i = rho & 15; return 8 * (i >> 2) + 4 * n + (i & 3); }

struct Unit { int pm, pn, e; };
struct GemmP {
    const char* A; unsigned lda2;
    unsigned acol_pn;
    const char* Bt; size_t b_estride;
    int Kb;
    int sA, sB;
};

__device__ __forceinline__ void unit_of(int L, int nM, int nN, int& pm, int& pn) {
    const int nwg = nM * nN;
    int wgid = L; { const int q = nwg / NXCD, r = nwg % NXCD, xcd = wgid % NXCD, off = wgid / NXCD; wgid = (xcd < r ? xcd * (q + 1) : r * (q + 1) + (xcd - r) * q) + off; }
    const int nig = WGM * nN, gid = wgid / nig, fm = gid * WGM, gsz = (nM - fm) < WGM ? (nM - fm) : WGM;
    pm = fm + ((wgid % nig) % gsz); pn = (wgid % nig) / gsz;
}
__device__ __forceinline__ int build_units(LAS unsigned char* lds, const int tid, int nM, int nN, int G, int c, bool moe, const int* row_tok, const int dup = 1) {
    LAS int* UT = (LAS int*)(lds + UT_OFF); LAS const int* TS = (LAS const int*)(lds + TS_OFF); LAS int* TOK = (LAS int*)(lds + TOK_OFF);
    const int nwg = nM * nN;
    int n_my = (nwg > c) ? (nwg - c + G - 1) / G : 0; if (n_my > MAXU) n_my = MAXU;
    if (tid < n_my) {
        int pm, pn; unit_of(tid * G + c, nM, nN, pm, pn);
        int e = 0; if (moe) { while (e < NE - 1 && TS[e + 1] <= pm) ++e; }
        UT[4 * tid + 0] = pm; UT[4 * tid + 1] = pn; UT[4 * tid + 2] = e; UT[4 * tid + 3] = 0;
    }
    __syncthreads();
    if (row_tok) {
        for (int idx = tid; idx < n_my * 256; idx += NTHR) { const int i = idx >> 8, r = idx & 255; TOK[idx] = gld<int>(row_tok + UT[4 * i] * 256 + r); }
    }
    __syncthreads();
    if (dup > 1) { if (tid < n_my) { UT[4 * (tid + n_my) + 0] = UT[4 * tid]; UT[4 * (tid + n_my) + 1] = UT[4 * tid + 1]; UT[4 * (tid + n_my) + 2] = UT[4 * tid + 2]; UT[4 * (tid + n_my) + 3] = 0; } __syncthreads(); return 2 * n_my; }
    return n_my;
}
__device__ __forceinline__ Unit read_unit(LAS const int* UT, int i) {
    Unit u; u.pm = __builtin_amdgcn_readfirstlane(UT[4 * i]); u.pn = __builtin_amdgcn_readfirstlane(UT[4 * i + 1]); u.e = __builtin_amdgcn_readfirstlane(UT[4 * i + 2]); return u;
}
template <bool GATHER>
__device__ __forceinline__ void a_offsets(unsigned (&v)[2][2], const GemmP& g, const Unit& u, int ui, const int (&Rr)[2], const int (&Cc2)[2], LAS const int* TOK, const int tokn) {
#pragma unroll
    for (int h = 0; h < 2; ++h)
#pragma unroll
        for (int i = 0; i < 2; ++i) {
            const int row = GATHER ? TOK[(ui >= tokn ? ui - tokn : ui) * 256 + h * HALF + Rr[i]] : (u.pm * BM + h * HALF + Rr[i]);
            v[h][i] = (unsigned)row * g.lda2 + (unsigned)Cc2[i] + (unsigned)u.pn * g.acol_pn;
        }
}

template <bool GATHER, bool FP8, class Epi>
__device__ __forceinline__ void gemm_phase(LAS unsigned char* lds, const int tid, const GemmP g, const int n_my, const Epi& E, const int tokn = 1 << 20) {
    const int wid = __builtin_amdgcn_readfirstlane(tid >> 6), lane = tid & 63, wr = wid >> 2, wc = wid & 3, fr = lane & 15, fq = lane >> 4;
    const int Kb = g.Kb, nt = Kb / (BK * 2);
    if (n_my <= 0) return;
    int Rr[2], Cc2[2]; unsigned voffB[2];
#pragma unroll
    for (int i = 0; i < 2; ++i) { int R, C; stage_rc(tid * 16 + i * 8192, R, C); const int Rb = Epi::PERM ? ((R & ~31) + perm32(R & 31)) : R;
        Rr[i] = R; Cc2[i] = C * 2; voffB[i] = (unsigned)(Rb * Kb + C * 2); }
    const size_t kstep = (size_t)(BK * 2);
    const size_t hstep = (size_t)HALF * Kb;
    const size_t tstepB = 2 * hstep;
    const unsigned ldsw = (unsigned)wid * 1024u;
    const int aoff = lds_byte(wr * 64 + fr, fq * 8), boff = lds_byte(wc * 32 + fr, fq * 8);
    LAS const int* UT = (LAS const int*)(lds + UT_OFF); LAS const int* TOK = (LAS const int*)(lds + TOK_OFF);
#define PG8_SA(b, h) (((b) * 2 + (h)) * HTB)
#define PG8_SB(b, h) ((4 + (b) * 2 + (h)) * HTB)
#define PG8_STAGE(bufoff, gbase, voff) do { _Pragma("unroll") for (int _i = 0; _i < 2; ++_i) \
        __builtin_amdgcn_global_load_lds((const unsigned*)((const char*)(gbase) + (voff)[_i]), (LAS unsigned*)(lds + (bufoff) + ldsw + _i * 8192), 16, 0, 0); } while (0)
#define PG8_LDA(dst, b, h) do { _Pragma("unroll") for (int m = 0; m < 4; ++m) _Pragma("unroll") for (int k = 0; k < 2; ++k) dst[m][k] = *(const LAS bf16x8*)(lds + PG8_SA(b, h) + aoff + m * 2048 + k * 1024); } while (0)
#define PG8_LDB(dst, b, h) do { _Pragma("unroll") for (int n = 0; n < 2; ++n) _Pragma("unroll") for (int k = 0; k < 2; ++k) dst[n][k] = *(const LAS bf16x8*)(lds + PG8_SB(b, h) + boff + n * 2048 + k * 1024); } while (0)
#define PG8_CAT(x) __builtin_shufflevector(__builtin_bit_cast(v4i, (x)[0]), __builtin_bit_cast(v4i, (x)[1]), 0, 1, 2, 3, 4, 5, 6, 7)
#define PG8_MMA(ai, bj, At, Bt) do { __builtin_amdgcn_s_setprio(1); _Pragma("unroll") for (int m = 0; m < 4; ++m) _Pragma("unroll") for (int n = 0; n < 2; ++n) { \
        if constexpr (FP8) { const v8i b8_ = PG8_CAT(Bt[n]), a8_ = PG8_CAT(At[m]); asm volatile("v_mfma_scale_f32_16x16x128_f8f6f4 %0, %1, %2, %0, %3, %4 op_sel_hi:[0,0,0]" : "+v"(acc[ai][bj][m][n]) : "v"(b8_), "v"(a8_), "v"(vsB), "v"(vsA)); } \
        else { _Pragma("unroll") for (int k = 0; k < 2; ++k) acc[ai][bj][m][n] = __builtin_amdgcn_mfma_f32_16x16x32_bf16(Bt[n][k], At[m][k], acc[ai][bj][m][n], 0, 0, 0); } } \
        __builtin_amdgcn_s_setprio(0); } while (0)
#define PG8_WAIT_V(n) asm volatile("s_waitcnt vmcnt(" #n ")" ::: "memory")
#define PG8_WAIT_L(n) asm volatile("s_waitcnt lgkmcnt(" #n ")" ::: "memory")
#define PG8_BAR __builtin_amdgcn_s_barrier()
#define PG8_SCHED __builtin_amdgcn_sched_barrier(0)
    Unit cur = read_unit(UT, 0), nxt; int ui = 0;
    f32x4 acc[2][2][4][2];
#pragma unroll
    for (int a = 0; a < 2; ++a)
#pragma unroll
        for (int b = 0; b < 2; ++b)
#pragma unroll
            for (int m = 0; m < 4; ++m)
#pragma unroll
                for (int n = 0; n < 2; ++n) acc[a][b][m][n] = (f32x4){0.f, 0.f, 0.f, 0.f};
#define PG8_PIN_ACC() do { if constexpr (FP8) { _Pragma("unroll") for (int a_ = 0; a_ < 2; ++a_) _Pragma("unroll") for (int b_ = 0; b_ < 2; ++b_) \
        asm volatile("" : "+v"(acc[a_][b_][0][0]), "+v"(acc[a_][b_][0][1]), "+v"(acc[a_][b_][1][0]), "+v"(acc[a_][b_][1][1]), "+v"(acc[a_][b_][2][0]), "+v"(acc[a_][b_][2][1]), "+v"(acc[a_][b_][3][0]), "+v"(acc[a_][b_][3][1])); \
        asm volatile("s_nop 1" ::: "memory"); } } while (0)
    PG8_PIN_ACC();
    bf16x8 At[4][2], B0[2][2], B1[2][2];
    int vsA = g.sA, vsB = g.sB; asm volatile("" : "+v"(vsA), "+v"(vsB));
    unsigned vAc[2][2], vAn[2][2];
    a_offsets<GATHER>(vAc, g, cur, 0, Rr, Cc2, TOK, tokn);
    const char* const Ab = g.A;
    const char* cB = g.Bt + (size_t)cur.e * g.b_estride + (size_t)cur.pn * tstepB;
    PG8_STAGE(PG8_SB(0, 0), cB, voffB); PG8_STAGE(PG8_SB(0, 1), cB + hstep, voffB); PG8_STAGE(PG8_SA(0, 0), Ab, vAc[0]); PG8_STAGE(PG8_SA(0, 1), Ab, vAc[1]);
    if (wr == 1) PG8_BAR;
    PG8_WAIT_V(2); PG8_BAR;
    PG8_STAGE(PG8_SB(1, 0), cB + kstep, voffB); PG8_STAGE(PG8_SA(1, 0), Ab + kstep, vAc[0]); PG8_STAGE(PG8_SB(1, 1), cB + hstep + kstep, voffB);
    PG8_WAIT_V(6); PG8_BAR;
    for (;;) {
        const bool has_next = (ui + 1 < n_my);
        nxt = cur; if (has_next) nxt = read_unit(UT, ui + 1);
        const char* nB = has_next ? g.Bt + (size_t)nxt.e * g.b_estride + (size_t)nxt.pn * tstepB : cB;
        for (int t = 0; t < nt; t += 2) {
            const bool last = (t == nt - 2);
            const char* a1 = Ab + (size_t)(t + 1) * kstep;
            const char* a2 = last ? Ab : Ab + (size_t)(t + 2) * kstep; const char* b2 = last ? nB : cB + (size_t)(t + 2) * kstep;
            const char* a3 = a2 + kstep; const char* b3 = b2 + kstep;
            unsigned o2[2][2];
            if (last) {
                if (has_next) a_offsets<GATHER>(vAn, g, nxt, ui + 1, Rr, Cc2, TOK, tokn);
                else { vAn[0][0] = vAc[0][0]; vAn[0][1] = vAc[0][1]; vAn[1][0] = vAc[1][0]; vAn[1][1] = vAc[1][1]; }
                o2[0][0] = vAn[0][0]; o2[0][1] = vAn[0][1]; o2[1][0] = vAn[1][0]; o2[1][1] = vAn[1][1];
            } else { o2[0][0] = vAc[0][0]; o2[0][1] = vAc[0][1]; o2[1][0] = vAc[1][0]; o2[1][1] = vAc[1][1]; }
            PG8_LDB(B0, 0, 0); PG8_LDB(B1, 0, 1); PG8_SCHED; PG8_LDA(At, 0, 0); PG8_STAGE(PG8_SA(1, 1), a1, vAc[1]);
            PG8_WAIT_V(8); PG8_WAIT_L(0); PG8_BAR; PG8_MMA(0, 0, At, B0); PG8_MMA(0, 1, At, B1); PG8_BAR; PG8_SCHED;
            PG8_LDA(At, 0, 1); PG8_STAGE(PG8_SB(0, 0), b2, voffB); PG8_STAGE(PG8_SB(0, 1), b2 + hstep, voffB); PG8_STAGE(PG8_SA(0, 0), a2, o2[0]);
            PG8_WAIT_V(8); PG8_WAIT_L(0); PG8_BAR; PG8_MMA(1, 0, At, B0); PG8_MMA(1, 1, At, B1); PG8_BAR; PG8_SCHED;
            PG8_LDB(B0, 1, 0); PG8_LDB(B1, 1, 1); PG8_SCHED; PG8_LDA(At, 1, 0); PG8_STAGE(PG8_SA(0, 1), a2, o2[1]);
            PG8_WAIT_V(8); PG8_WAIT_L(0); PG8_BAR; PG8_MMA(0, 0, At, B0); PG8_MMA(0, 1, At, B1); PG8_BAR; PG8_SCHED;
            PG8_LDA(At, 1, 1); PG8_STAGE(PG8_SB(1, 0), b3, voffB); PG8_STAGE(PG8_SB(1, 1), b3 + hstep, voffB); PG8_STAGE(PG8_SA(1, 0), a3, o2[0]);
            PG8_WAIT_V(8); PG8_WAIT_L(0); PG8_BAR; PG8_MMA(1, 0, At, B0); PG8_MMA(1, 1, At, B1); PG8_BAR; PG8_SCHED;
        }
        if (wr == 0) PG8_BAR;
        if constexpr (FP8) asm volatile("s_nop 15" ::: "memory");
        E(acc, cur, wr, wc, fr, fq);
        if (!has_next) break;
#pragma unroll
        for (int a = 0; a < 2; ++a)
#pragma unroll
            for (int b = 0; b < 2; ++b)
#pragma unroll
                for (int m = 0; m < 4; ++m)
#pragma unroll
                    for (int n = 0; n < 2; ++n) acc[a][b][m][n] = (f32x4){0.f, 0.f, 0.f, 0.f};
        PG8_PIN_ACC();
        cur = nxt; cB = nB; ++ui;
        vAc[0][0] = vAn[0][0]; vAc[0][1] = vAn[0][1]; vAc[1][0] = vAn[1][0]; vAc[1][1] = vAn[1][1];
        if (wr == 1) PG8_BAR;
    }
    PG8_WAIT_V(0);
    PG8_BAR;
#undef PG8_SA
#undef PG8_SB
#undef PG8_STAGE
#undef PG8_LDA
#undef PG8_LDB
#undef PG8_MMA
#undef PG8_PIN_ACC
#undef PG8_CAT
#undef PG8_WAIT_V
#undef PG8_WAIT_L
#undef PG8_BAR
#undef PG8_SCHED
}

struct EpiOut {
    static constexpr bool PERM = true;
    const bf16* xres; bf16* z; const float* bias; const float* scale;
    __device__ __forceinline__ void operator()(const f32x4 (&acc)[2][2][4][2], const Unit& u, int wr, int wc, int fr, int fq) const {
        const int row0 = u.pm * BM + wr * 64 + fr, c0 = u.pn * BM + wc * 32 + 8 * fq;
        f32x4 bv[2][2], sv[2][2];
#pragma unroll
        for (int bj = 0; bj < 2; ++bj)
#pragma unroll
            for (int n = 0; n < 2; ++n) {
                bv[bj][n] = bias ? gld<f32x4>(bias + c0 + bj * HALF + 4 * n) : (f32x4){0.f, 0.f, 0.f, 0.f};
                sv[bj][n] = scale ? gld<f32x4>(scale + c0 + bj * HALF + 4 * n) : (f32x4){1.f, 1.f, 1.f, 1.f};
            }
#pragma unroll
        for (int ai = 0; ai < 2; ++ai)
#pragma unroll
            for (int m = 0; m < 4; ++m) { const size_t off = (size_t)(row0 + ai * HALF + m * 16) * D + c0;
#pragma unroll
                for (int bj = 0; bj < 2; ++bj) { const v4u xr = gld<v4u>(xres + off + bj * HALF);
                    const f32x4 x0 = (f32x4){bf_lo(xr.x), bf_hi(xr.x), bf_lo(xr.y), bf_hi(xr.y)}, x1 = (f32x4){bf_lo(xr.z), bf_hi(xr.z), bf_lo(xr.w), bf_hi(xr.w)};
                    const f32x4 o0 = x0 * ALPHA + (acc[ai][bj][m][0] + bv[bj][0]) * sv[bj][0], o1 = x1 * ALPHA + (acc[ai][bj][m][1] + bv[bj][1]) * sv[bj][1];
                    v4u w; w.x = cvt_pk_bf16(o0[0], o0[1]); w.y = cvt_pk_bf16(o0[2], o0[3]); w.z = cvt_pk_bf16(o1[0], o1[1]); w.w = cvt_pk_bf16(o1[2], o1[3]);
                    gst<v4u>(z + off + bj * HALF, w); }
                asm volatile("" ::: "memory"); }
    }
};
struct EpiPair {
    static constexpr bool PERM = true;
    bf16* O1; bf16* O2; const float* bias; int mode;
    __device__ __forceinline__ void operator()(const f32x4 (&acc)[2][2][4][2], const Unit& u, int wr, int wc, int fr, int fq) const {
        const int row0 = u.pm * BM + wr * 64 + fr;
        if (u.pn < 8) {
            const int j0 = u.pn * HALF + wc * 32 + 8 * fq;
            f32x4 b1[2], b2[2];
#pragma unroll
            for (int n = 0; n < 2; ++n) { b1[n] = mode ? gld<f32x4>(bias + j0 + 4 * n) : (f32x4){0.f, 0.f, 0.f, 0.f}; b2[n] = mode ? gld<f32x4>(bias + 1024 + j0 + 4 * n) : (f32x4){0.f, 0.f, 0.f, 0.f}; }
#pragma unroll
            for (int ai = 0; ai < 2; ++ai)
#pragma unroll
                for (int m = 0; m < 4; ++m) { bf16* rowp = O1 + (size_t)(row0 + ai * HALF + m * 16) * D + j0; f32x4 r[2];
#pragma unroll
                    for (int n = 0; n < 2; ++n) { const f32x4 g1 = acc[ai][0][m][n] + b1[n], g2 = acc[ai][1][m][n] + b2[n];
                        if (mode) { r[n][0] = g1[0] * sigmoidf_(g2[0]); r[n][1] = g1[1] * sigmoidf_(g2[1]); r[n][2] = g1[2] * sigmoidf_(g2[2]); r[n][3] = g1[3] * sigmoidf_(g2[3]); }
                        else r[n] = g1 * g2; }
                    v4u w; w.x = cvt_pk_bf16(r[0][0], r[0][1]); w.y = cvt_pk_bf16(r[0][2], r[0][3]); w.z = cvt_pk_bf16(r[1][0], r[1][1]); w.w = cvt_pk_bf16(r[1][2], r[1][3]);
                    gst<v4u>(rowp, w); }
        } else {
            const int c0 = (u.pn - 8) * BM + wc * 32 + 8 * fq;
#pragma unroll
            for (int ai = 0; ai < 2; ++ai)
#pragma unroll
                for (int m = 0; m < 4; ++m) { bf16* rowp = O2 + (size_t)(row0 + ai * HALF + m * 16) * D + c0;
#pragma unroll
                    for (int bj = 0; bj < 2; ++bj) { const f32x4 v0 = acc[ai][bj][m][0], v1 = acc[ai][bj][m][1];
                        v4u w; w.x = cvt_pk_bf16(v0[0], v0[1]); w.y = cvt_pk_bf16(v0[2], v0[3]); w.z = cvt_pk_bf16(v1[0], v1[1]); w.w = cvt_pk_bf16(v1[2], v1[3]);
                        gst<v4u>(rowp + bj * HALF, w); } }
        }
    }
};
struct EpiSwiglu {
    static constexpr bool PERM = true;
    unsigned char* act; const float* bgu;
    __device__ __forceinline__ void operator()(const f32x4 (&acc)[2][2][4][2], const Unit& u, int wr, int wc, int fr, int fq) const {
        const int row0 = u.pm * BM + wr * 64 + fr, j0 = u.pn * HALF + wc * 32 + 8 * fq;
        const float* bp = bgu + (size_t)u.e * 2048 + 2 * j0;
        float gb[8], ub[8];
#pragma unroll
        for (int i = 0; i < 4; ++i) { const f32x4 b = gld<f32x4>(bp + 4 * i); gb[2 * i] = b[0]; ub[2 * i] = b[1]; gb[2 * i + 1] = b[2]; ub[2 * i + 1] = b[3]; }
#pragma unroll
        for (int ai = 0; ai < 2; ++ai)
#pragma unroll
            for (int m = 0; m < 4; ++m) { unsigned char* rowp = act + (size_t)(row0 + ai * HALF + m * 16) * D + j0; float r[8];
#pragma unroll
                for (int n = 0; n < 2; ++n)
#pragma unroll
                    for (int q = 0; q < 4; ++q) { const int j = 4 * n + q;
                        const float gg = fminf(acc[ai][0][m][n][q] + gb[j], 7.0f);
                        const float uu = fminf(fmaxf(acc[ai][1][m][n][q] + ub[j], -7.0f), 7.0f);
                        r[j] = (uu + 1.0f) * (gg * sigmoidf_(1.702f * gg)) * SACT8; }
                gst<v2u>(rowp, pack8_fp8(r)); }
    }
};
struct EpiMoe2 {
    static constexpr bool PERM = true;
    bf16* Y; const float* bdn; const int* rowdst; const float* rowgate;
    __device__ __forceinline__ void operator()(const f32x4 (&acc)[2][2][4][2], const Unit& u, int wr, int wc, int fr, int fq) const {
        const int pos0 = u.pm * BM + wr * 64 + fr, c0 = u.pn * BM + wc * 32 + 8 * fq;
        const float* bp = bdn + (size_t)u.e * D + c0;
        f32x4 bv[2][2];
#pragma unroll
        for (int bj = 0; bj < 2; ++bj)
#pragma unroll
            for (int n = 0; n < 2; ++n) bv[bj][n] = gld<f32x4>(bp + bj * HALF + 4 * n);
        int dst[2][4]; float gt[2][4];
#pragma unroll
        for (int ai = 0; ai < 2; ++ai)
#pragma unroll
            for (int m = 0; m < 4; ++m) { const int pos = pos0 + ai * HALF + m * 16; dst[ai][m] = gld<int>(rowdst + pos); gt[ai][m] = gld<float>(rowgate + pos); }
#pragma unroll
        for (int ai = 0; ai < 2; ++ai)
#pragma unroll
            for (int m = 0; m < 4; ++m) {
                if (dst[ai][m] >= 0) { bf16* rowp = Y + (size_t)dst[ai][m] * D + c0; const float s = gt[ai][m];
#pragma unroll
                    for (int bj = 0; bj < 2; ++bj) { const f32x4 v0 = (acc[ai][bj][m][0] + bv[bj][0]) * s, v1 = (acc[ai][bj][m][1] + bv[bj][1]) * s;
                        v4u w; w.x = cvt_pk_bf16(v0[0], v0[1]); w.y = cvt_pk_bf16(v0[2], v0[3]); w.z = cvt_pk_bf16(v1[0], v1[1]); w.w = cvt_pk_bf16(v1[2], v1[3]);
                        gst<v4u>(rowp + bj * HALF, w); } } }
    }
};
}

__device__ __forceinline__ int chq(int lane, int q) { return (q >> 1) * 512 + 8 * lane + (q & 1) * 4; }
__device__ __forceinline__ v4u pack8(const float* v) { v4u w; w.x = cvt_pk_bf16(v[0], v[1]); w.y = cvt_pk_bf16(v[2], v[3]); w.z = cvt_pk_bf16(v[4], v[5]); w.w = cvt_pk_bf16(v[6], v[7]); return w; }
__device__ __forceinline__ void unpack8(const v4u w, float* v) { v[0] = bf_lo(w.x); v[1] = bf_hi(w.x); v[2] = bf_lo(w.y); v[3] = bf_hi(w.y); v[4] = bf_lo(w.z); v[5] = bf_hi(w.z); v[6] = bf_lo(w.w); v[7] = bf_hi(w.w); }

__device__ __forceinline__ int drow_of(int mode, int c) {
    if (mode == 1) { const int j = c >> 1, p = c & 1; return (j >> 7) * 256 + p * 128 + (j & 127); }
    if (mode == 2) { if (c < 1024) return 2048 + c; const int j = (c - 1024) & 1023, p = (c - 1024) >> 10; return (j >> 7) * 256 + p * 128 + (j & 127); }
    if (mode == 3) { const int j = c & 1023, p = c >> 10; return (j >> 7) * 256 + p * 128 + (j & 127); }
    return c;
}
struct TItem { const float* src; unsigned char* dst; int N, Kout  , k0, n0, mode, fp8; };
__device__ __forceinline__ void titem_load(const TItem& d, int lane, float (&tmp)[32]) {
#pragma unroll
    for (int i = 0; i < 32; ++i) { const int kk = 2 * i + (lane >> 5); tmp[i] = gld<float>(d.src + (size_t)(d.k0 + kk) * d.N + d.n0 + (lane & 31)); }
}
__device__ __forceinline__ void titem_store(const TItem& d, int lane, LAS float* scr, const float (&tmp)[32]) {
#pragma unroll
    for (int i = 0; i < 32; ++i) { const int kk = 2 * i + (lane >> 5); scr[kk * 33 + (lane & 31)] = tmp[i]; }
    LDS_WAIT(); asm volatile("" ::: "memory");
    const int c = lane & 7;
#pragma unroll
    for (int j = 0; j < 4; ++j) { const int n = (lane >> 3) + 8 * j; const LAS float* s = scr + (8 * c) * 33 + n;
        float v[8];
#pragma unroll
        for (int i = 0; i < 8; ++i) v[i] = s[i * 33];
        const size_t e = (size_t)drow_of(d.mode, d.n0 + n) * d.Kout + d.k0 + 8 * c;
        if (d.fp8) {
#pragma unroll
            for (int i = 0; i < 8; ++i) v[i] *= SW8;
            gst<v2u>(d.dst + e, pack8_fp8(v));
        } else gst<v4u>(d.dst + 2 * e, pack8(v)); }
    LDS_WAIT(); asm volatile("" ::: "memory");
}

struct Args { const float* in[24]; float* out; unsigned char* ws; };
#define CAS __attribute__((address_space(4)))
__device__ __forceinline__ const void* karg_ptr(int off) {
    const CAS char* kp = (const CAS char*)__builtin_amdgcn_kernarg_segment_ptr();
    asm volatile("" : "+s"(off));
    return *(const void* const CAS*)(kp + off);
}
#define ARG_IN(i) ((const float*)karg_ptr(8 * (i)))
#define ARG_OUT() ((float*)karg_ptr(8 * 24))
#define ARG_WS() ((unsigned char*)karg_ptr(8 * 25))

#define PHASE_BEGIN() \
    int tid = threadIdx.x; asm volatile("" : "+v"(tid)); \
    const int lane = tid & 63, wave = __builtin_amdgcn_readfirstlane(tid >> 6); \
    unsigned char* ws_ = ARG_WS(); asm volatile("" : "+s"(ws_)); unsigned char* ws = (unsigned char*)(GAS unsigned char*)ws_; \
    unsigned* ctl = (unsigned*)(ws + WS_CTL); \
    const int gw = vcu * NWAVES + wave, NGW = G * NWAVES; (void)gw; (void)NGW; (void)lane; (void)ctl;

__device__ __forceinline__ float butterfly32(float (&p)[32], int lane) {
#pragma unroll
    for (int i = 0; i < 16; ++i) { const bool hi = (lane & 32) != 0; const float snd = hi ? p[i] : p[i + 16]; const float keep = hi ? p[i + 16] : p[i]; p[i] = keep + shx(snd, 32, lane); }
#pragma unroll
    for (int i = 0; i < 8; ++i) { const bool hi = (lane & 16) != 0; const float snd = hi ? p[i] : p[i + 8]; const float keep = hi ? p[i + 8] : p[i]; p[i] = keep + shx(snd, 16, lane); }
#pragma unroll
    for (int i = 0; i < 4; ++i) { const bool hi = (lane & 8) != 0; const float snd = hi ? p[i] : p[i + 4]; const float keep = hi ? p[i + 4] : p[i]; p[i] = keep + shx(snd, 8, lane); }
#pragma unroll
    for (int i = 0; i < 2; ++i) { const bool hi = (lane & 4) != 0; const float snd = hi ? p[i] : p[i + 2]; const float keep = hi ? p[i + 2] : p[i]; p[i] = keep + shx(snd, 4, lane); }
    { const bool hi = (lane & 2) != 0; const float snd = hi ? p[0] : p[1]; const float keep = hi ? p[1] : p[0]; p[0] = keep + shx(snd, 2, lane); }
    return p[0] + shx(p[0], 1, lane);
}
__device__ __forceinline__ void ln16(float (&v)[16], const float (&lg)[16], const float (&lb)[16], int lane) {
    float sm = 0.f;
#pragma unroll
    for (int i = 0; i < 16; ++i) sm += v[i];
    const float mean = wave_sum(sm, lane) * (1.0f / D);
    float sq = 0.f;
#pragma unroll
    for (int i = 0; i < 16; ++i) { v[i] -= mean; sq += v[i] * v[i]; }
    const float rstd = 1.0f / sqrtf(wave_sum(sq, lane) * (1.0f / D) + LN_EPS);
#pragma unroll
    for (int i = 0; i < 16; ++i) v[i] = v[i] * rstd * lg[i] + lb[i];
}
template <bool F32IN>
__device__ __forceinline__ void pool_diff_run(const float* xf, const bf16* xb, bf16* M3, int t0, int lane) {
    const int s0 = t0 & (SEQ - 1);
#pragma unroll
    for (int g = 0; g < 4; ++g) {
        const int w = 2 << g, c = 256 * g + 4 * lane;
        f32x4 r[31];
#pragma unroll
        for (int j = 0; j < w + 15; ++j) {
            const int dt = j - (w - 1);
            if (dt >= 0 || s0 != 0) {
                const size_t o = (size_t)(t0 + dt) * D + c;
                if (F32IN) r[j] = gld<f32x4>(xf + o);
                else { const v2u q = gld<v2u>(xb + o); r[j] = (f32x4){bf_lo(q.x), bf_hi(q.x), bf_lo(q.y), bf_hi(q.y)}; }
            } else r[j] = (f32x4){0.f, 0.f, 0.f, 0.f};
        }
#pragma unroll
        for (int i = 0; i < 16; ++i) {
            f32x4 sum = r[i];
#pragma unroll
            for (int j = 1; j < w; ++j) sum += r[i + j];
            const int nv = (s0 + i + 1 < w) ? s0 + i + 1 : w;
            const f32x4 df = sum * (1.0f / (float)nv) - r[i + w - 1];
            v2u o; o.x = cvt_pk_bf16(df[0], df[1]); o.y = cvt_pk_bf16(df[2], df[3]);
            gst<v2u>(M3 + (size_t)(t0 + i) * D + c, o);
        }
    }
}

__global__ void __launch_bounds__(NTHR, 2) mega_fwd(Args args) {
    extern __shared__ __attribute__((aligned(16))) unsigned char lds_raw[];
    LAS unsigned char* lds = (LAS unsigned char*)lds_raw;
    volatile LAS unsigned* MISC = (volatile LAS unsigned*)(lds + MISC_OFF);
    const int G = gridDim.x, bx = blockIdx.x;
    const int vcu = (G % 8 == 0) ? (bx % 8) * (G / 8) + bx / 8 : bx;
    if (threadIdx.x < 128) MISC[threadIdx.x] = 0u;
    __syncthreads();
    (void)xcd_barrier_post((unsigned*)(ARG_WS() + WS_CTL) + CW_BAR, MISC + 0);
#define GRID_BAR() do { XcdBarrier b_; unsigned* bp_ = (unsigned*)(ARG_WS() + WS_CTL) + CW_BAR; asm volatile("" : "+s"(bp_)); b_.bar = (unsigned*)(GAS unsigned*)bp_; b_.x = xb_xcc_id(); b_.st = MISC; xcd_barrier(b_); } while (0)

    {
        PHASE_BEGIN();
        LAS float* scr = (LAS float*)(lds + RING_OFF + wave * 16384);
        constexpr int I_GU = 16 * 64, I_DN = 16 * 32, I_POOL = 4 * 8, I_SCIN = 16 * 96, I_SQ = 16 * 32, I_CFIN = 16 * 64;
        constexpr int N_GU = 128 * I_GU, N_DN = 128 * I_DN, N_POOL = 8 * I_POOL;
        constexpr int NITEMS = N_GU + N_DN + N_POOL + I_SCIN + I_SQ + I_CFIN + I_SQ;
#define TITEM_SET(d_, src_, K_, N_, dst_, mode_, fp8_, item_) do { const int nb_ = (N_) / 32; (d_).src = (src_); (d_).dst = (unsigned char*)(dst_); (d_).N = (N_); (d_).Kout = (K_); \
        (d_).k0 = 64 * ((item_) / nb_); (d_).n0 = 32 * ((item_) % nb_); (d_).mode = (mode_); (d_).fp8 = (fp8_); } while (0)
#define TITEM_DECODE(it_, d_) do { int r_ = (it_); \
        if (r_ < N_GU) { const int mt_ = r_ / I_GU; TITEM_SET(d_, ARG_IN(18) + (size_t)mt_ * 1024 * 2048, 1024, 2048, ws + WS_WGU + (size_t)mt_ * 2048 * 1024, 1, 1, r_ % I_GU); break; } r_ -= N_GU; \
        if (r_ < N_DN) { const int mt_ = r_ / I_DN; TITEM_SET(d_, ARG_IN(20) + (size_t)mt_ * 1024 * 1024, 1024, 1024, ws + WS_WDN + (size_t)mt_ * 1024 * 1024, 0, 1, r_ % I_DN); break; } r_ -= N_DN; \
        if (r_ < N_POOL) { const int mt_ = r_ / I_POOL; TITEM_SET(d_, ARG_IN(1) + (size_t)mt_ * 256 * 256, 256, 256, ws + WS_WPOOL + (size_t)mt_ * 256 * 256 * 2, 0, 0, r_ % I_POOL); break; } r_ -= N_POOL; \
        if (r_ < I_SCIN) { TITEM_SET(d_, ARG_IN(3), 1024, 3072, ws + WS_WSCIN, 2, 0, r_); break; } r_ -= I_SCIN; \
        if (r_ < I_SQ) { TITEM_SET(d_, ARG_IN(5), 1024, 1024, ws + WS_WSCOUT, 0, 0, r_); break; } r_ -= I_SQ; \
        if (r_ < I_CFIN) { TITEM_SET(d_, ARG_IN(6), 1024, 2048, ws + WS_WCFIN, 3, 0, r_); break; } r_ -= I_CFIN; \
        TITEM_SET(d_, ARG_IN(12), 1024, 1024, ws + WS_WCFOUT, 0, 0, r_); } while (0)
        for (int rep = 0; rep < REP_P0; ++rep) {
            int it = gw; TItem cur; float ta[32];
            if (it < NITEMS) { TITEM_DECODE(it, cur); titem_load(cur, lane, ta); }
            while (it < NITEMS) {
                const int itn = it + NGW; TItem nx = cur; float tb[32];
                if (itn < NITEMS) { TITEM_DECODE(itn, nx); titem_load(nx, lane, tb); }
                else {
#pragma unroll
                    for (int i = 0; i < 32; ++i) tb[i] = 0.f; }
                titem_store(cur, lane, scr, ta);
                cur = nx; it = itn;
#pragma unroll
                for (int i = 0; i < 32; ++i) ta[i] = tb[i];
            }
        }
#undef TITEM_SET
#undef TITEM_DECODE
        const float* x0 = ARG_IN(0); bf16* XAb = (bf16*)(ws + WS_XAB);
        for (int t = gw; t < T; t += NGW) {
            float v[16];
#pragma unroll
            for (int q = 0; q < 4; ++q) { const f32x4 z = gld<f32x4>(x0 + (size_t)t * D + chq(lane, q)); v[4 * q] = z[0]; v[4 * q + 1] = z[1]; v[4 * q + 2] = z[2]; v[4 * q + 3] = z[3]; }
            gst<v4u>(XAb + (size_t)t * D + 8 * lane, pack8(v));
            gst<v4u>(XAb + (size_t)t * D + 512 + 8 * lane, pack8(v + 8));
        }
    }
    GRID_BAR();

    for (int layer = 0; layer < DEPTH; ++layer) {
        const int kind = layer % 3;

        if (kind == 0) {
            PHASE_BEGIN();
            bf16* M3 = (bf16*)(ws + WS_M3); const bf16* xb = (const bf16*)(ws + WS_XAB);
            for (int rep = 0; rep < REP_THIN; ++rep)
            for (int tb = vcu; tb < T / 128; tb += G) {
                const int t0 = tb * 128 + wave * 16;
                if (layer == 0) pool_diff_run<true>(ARG_IN(0), xb, M3, t0, lane);
                else pool_diff_run<false>(ARG_IN(0), xb, M3, t0, lane);
            }
        } else {
            {
                PHASE_BEGIN();
                bf16* M1 = (bf16*)(ws + WS_M1); bf16* M2 = (bf16*)(ws + WS_M2);
                const int nN = (kind == 1) ? 12 : 8;
                const int n_my = pg8::build_units(lds, tid, T / 256, nN, G, bx, false, nullptr, REP_MIXG);
                pg8::GemmP gp; gp.A = (const char*)(ws + WS_XAB); gp.lda2 = D * 2; gp.acol_pn = 0; gp.Bt = (const char*)(ws + ((kind == 1) ? WS_WSCIN : WS_WCFIN)); gp.b_estride = 0; gp.Kb = 2048; gp.sA = 0; gp.sB = 0;
                pg8::EpiPair E; E.O1 = (kind == 1) ? M2 : M1; E.O2 = M1; E.bias = ARG_IN(7); E.mode = (kind == 1) ? 0 : 1;
                pg8::gemm_phase<false, false, pg8::EpiPair>(lds, tid, gp, n_my, E);
            }
            GRID_BAR();
            if (kind == 1) {
                PHASE_BEGIN();
                const bf16* M1 = (const bf16*)(ws + WS_M1); const bf16* M2 = (const bf16*)(ws + WS_M2); bf16* M3 = (bf16*)(ws + WS_M3);
                const float* cw = ARG_IN(4);
                float wk[3][16];
#pragma unroll
                for (int k = 0; k < 3; ++k)
#pragma unroll
                    for (int q = 0; q < 4; ++q) { const f32x4 v = gld<f32x4>(cw + k * D + chq(lane, q)); wk[k][4 * q] = v[0]; wk[k][4 * q + 1] = v[1]; wk[k][4 * q + 2] = v[2]; wk[k][4 * q + 3] = v[3]; }
                for (int rep = 0; rep < REP_THIN; ++rep)
                for (int tb = vcu; tb < T / 128; tb += G) {
                    const int t0 = tb * 128 + wave * 16, s0 = t0 & (SEQ - 1);
                    float p2[16], p1[16];
                    if (s0 != 0) { unpack8(gld<v4u>(M2 + (size_t)(t0 - 2) * D + 8 * lane), p2); unpack8(gld<v4u>(M2 + (size_t)(t0 - 2) * D + 512 + 8 * lane), p2 + 8);
                                   unpack8(gld<v4u>(M2 + (size_t)(t0 - 1) * D + 8 * lane), p1); unpack8(gld<v4u>(M2 + (size_t)(t0 - 1) * D + 512 + 8 * lane), p1 + 8); }
                    else {
#pragma unroll
                        for (int i = 0; i < 16; ++i) { p2[i] = 0.f; p1[i] = 0.f; } }
                    for (int i0 = 0; i0 < 16; i0 += 4) {
                        v4u cv[4][2], gv[4][2];
#pragma unroll
                        for (int u = 0; u < 4; ++u)
#pragma unroll
                            for (int j = 0; j < 2; ++j) { const size_t o = (size_t)(t0 + i0 + u) * D + j * 512 + 8 * lane; cv[u][j] = gld<v4u>(M2 + o); gv[u][j] = gld<v4u>(M1 + o); }
#pragma unroll
                        for (int u = 0; u < 4; ++u) {
                            float c[16], gb[16], o[16];
                            unpack8(cv[u][0], c); unpack8(cv[u][1], c + 8); unpack8(gv[u][0], gb); unpack8(gv[u][1], gb + 8);
#pragma unroll
                            for (int i = 0; i < 16; ++i) { o[i] = gb[i] * (wk[0][i] * p2[i] + wk[1][i] * p1[i] + wk[2][i] * c[i]); p2[i] = p1[i]; p1[i] = c[i]; }
                            gst<v4u>(M3 + (size_t)(t0 + i0 + u) * D + 8 * lane, pack8(o));
                            gst<v4u>(M3 + (size_t)(t0 + i0 + u) * D + 512 + 8 * lane, pack8(o + 8));
                        }
                    }
                }
            } else {
                PHASE_BEGIN();
                const bf16* U = (const bf16*)(ws + WS_M1); bf16* M3 = (bf16*)(ws + WS_M3);
                const int c = 128 * wave + 2 * lane;
                float wk0[31], wk1[31];
#pragma unroll
                for (int k = 0; k < 31; ++k) { const v2u q = gld<v2u>(ARG_IN(8) + k * D + c); wk0[k] = __uint_as_float(q.x); wk1[k] = __uint_as_float(q.y); }
                const v2u qb = gld<v2u>(ARG_IN(9) + c), qg = gld<v2u>(ARG_IN(10) + c), ql = gld<v2u>(ARG_IN(11) + c);
                const float db0 = __uint_as_float(qb.x), db1 = __uint_as_float(qb.y), lg0 = __uint_as_float(qg.x), lg1 = __uint_as_float(qg.y), lb0 = __uint_as_float(ql.x), lb1 = __uint_as_float(ql.y);
                LAS float* part = (LAS float*)(lds + RING_OFF);
                LAS float* stat = part + 256;
                for (int rep = 0; rep < REP_THIN; ++rep)
                for (int run = vcu; run < T / 16; run += G) {
                    const int t0 = run * 16, s0 = t0 & (SEQ - 1);
                    unsigned r[46];
#pragma unroll
                    for (int j = 0; j < 46; ++j) r[j] = (s0 + j - 30 >= 0) ? gld<unsigned>(U + (size_t)(t0 + j - 30) * D + c) : 0u;
                    float a0[16], a1[16];
#pragma unroll
                    for (int i = 0; i < 16; ++i) { a0[i] = db0; a1[i] = db1; }
#pragma unroll
                    for (int j = 0; j < 46; ++j) { const float x0 = bf_lo(r[j]), x1 = bf_hi(r[j]);
#pragma unroll
                        for (int i = 0; i < 16; ++i) { const int k = j - i; if (k >= 0 && k <= 30) { a0[i] += wk0[k] * x0; a1[i] += wk1[k] * x1; } } }
                    float st[32];
#pragma unroll
                    for (int i = 0; i < 16; ++i) { st[2 * i] = a0[i] + a1[i]; st[2 * i + 1] = a0[i] * a0[i] + a1[i] * a1[i]; }
                    const float tot = butterfly32(st, lane);
                    if ((lane & 1) == 0) part[wave * 32 + (lane >> 1)] = tot;
                    __syncthreads();
                    if (tid < 16) { float S = 0.f, Q = 0.f;
#pragma unroll
                        for (int w8 = 0; w8 < 8; ++w8) { S += part[w8 * 32 + 2 * tid]; Q += part[w8 * 32 + 2 * tid + 1]; }
                        const float mean = S * (1.0f / D); const float var = fmaxf(Q * (1.0f / D) - mean * mean, 0.f);
                        stat[2 * tid] = mean; stat[2 * tid + 1] = 1.0f / sqrtf(var + LN_EPS); }
                    __syncthreads();
#pragma unroll
                    for (int i = 0; i < 16; ++i) { const float mean = stat[2 * i], rstd = stat[2 * i + 1];
                        const float y0 = (a0[i] - mean) * rstd * lg0 + lb0, y1 = (a1[i] - mean) * rstd * lg1 + lb1;
                        gst<unsigned>(M3 + (size_t)(t0 + i) * D + c, cvt_pk_bf16(y0 * sigmoidf_(y0), y1 * sigmoidf_(y1))); }
                }
                __syncthreads();
            }
        }
        GRID_BAR();

        {
            PHASE_BEGIN();
            const int n_my = pg8::build_units(lds, tid, T / 256, 4, G, bx, false, nullptr, REP_MIXG);
            pg8::GemmP gp; gp.A = (const char*)(ws + WS_M3); gp.lda2 = D * 2; gp.b_estride = 0; gp.sA = 0; gp.sB = 0;
            pg8::EpiOut E; E.xres = (const bf16*)(ws + WS_XAB); E.z = (bf16*)(ws + WS_ZB); E.bias = nullptr; E.scale = nullptr;
            if (kind == 0) { gp.acol_pn = 512; gp.Bt = (const char*)(ws + WS_WPOOL + (size_t)(layer / 3) * 1024 * 256 * 2); gp.Kb = 512; E.scale = ARG_IN(2) + (layer / 3) * D; }
            else if (kind == 1) { gp.acol_pn = 0; gp.Bt = (const char*)(ws + WS_WSCOUT); gp.Kb = 2048; }
            else { gp.acol_pn = 0; gp.Bt = (const char*)(ws + WS_WCFOUT); gp.Kb = 2048; E.bias = ARG_IN(13); }
            pg8::gemm_phase<false, false, pg8::EpiOut>(lds, tid, gp, n_my, E);
        }
        GRID_BAR();

        {
            PHASE_BEGIN();
            const bf16* Zb = (const bf16*)(ws + WS_ZB); bf16* X1b = (bf16*)(ws + WS_X1B); unsigned char* X18 = (unsigned char*)(ws + WS_X18);
            int* TIDX = (int*)(ws + WS_IDX); float* TGATE = (float*)(ws + WS_GATE);
            unsigned* CNT = ctl + CW_CNT + layer * NE;
            LAS float* rwl = (LAS float*)(lds + RING_OFF);
            const float* rw = ARG_IN(16) + (size_t)layer * D * NE;
            for (int idx = tid; idx < D * 8; idx += NTHR) { const int c = idx >> 3, eg = idx & 7; const int j = c >> 9, r = c & 511, l = r >> 3, ci = j * 8 + (r & 7);
                *(LAS f32x4*)(rwl + ((ci * 8 + eg) * 64 + l) * 4) = gld<f32x4>(rw + c * NE + eg * 4); }
            if (tid < NE) MISC[32 + tid] = 0u;
            __syncthreads();
            LAS f32x4* lnp = (LAS f32x4*)(lds + TOK_OFF);
            if (tid < 256) { const int q = tid >> 6, l = tid & 63; lnp[q * 64 + l] = gld<f32x4>(ARG_IN(14) + layer * D + chq(l, q)); lnp[(4 + q) * 64 + l] = gld<f32x4>(ARG_IN(15) + layer * D + chq(l, q)); }
            __syncthreads();
            const int myexp = (lane >> 1) & 31;
            const float rbias = gld<float>(ARG_IN(17) + layer * NE + myexp);
            for (int tb = vcu; tb < T / 128; tb += G) {
                const int t0 = tb * 128 + wave * 16;
                v4u zn0 = gld<v4u>(Zb + (size_t)t0 * D + 8 * lane), zn1 = gld<v4u>(Zb + (size_t)t0 * D + 512 + 8 * lane);
                for (int ti = 0; ti < 16; ++ti) {
                    const int t = t0 + ti;
                    float v[16]; unpack8(zn0, v); unpack8(zn1, v + 8);
                    if (ti + 1 < 16) { zn0 = gld<v4u>(Zb + (size_t)(t + 1) * D + 8 * lane); zn1 = gld<v4u>(Zb + (size_t)(t + 1) * D + 512 + 8 * lane); }
                    { float sm = 0.f;
#pragma unroll
                      for (int i = 0; i < 16; ++i) sm += v[i];
                      const float mean = wave_sum(sm, lane) * (1.0f / D);
                      float sq = 0.f;
#pragma unroll
                      for (int i = 0; i < 16; ++i) { v[i] -= mean; sq += v[i] * v[i]; }
                      const float rstd = 1.0f / sqrtf(wave_sum(sq, lane) * (1.0f / D) + LN_EPS);
#pragma unroll
                      for (int q = 0; q < 4; ++q) { const f32x4 g4 = lnp[q * 64 + lane], b4 = lnp[(4 + q) * 64 + lane];
#pragma unroll
                          for (int i = 0; i < 4; ++i) v[4 * q + i] = v[4 * q + i] * rstd * g4[i] + b4[i]; } }
                    gst<v4u>(X1b + (size_t)t * D + 8 * lane, pack8(v));
                    gst<v4u>(X1b + (size_t)t * D + 512 + 8 * lane, pack8(v + 8));
                    { float s8[16];
#pragma unroll
                      for (int i = 0; i < 16; ++i) s8[i] = v[i] * SX8;
                      gst<v2u>(X18 + (size_t)t * D + 8 * lane, pack8_fp8(s8)); gst<v2u>(X18 + (size_t)t * D + 512 + 8 * lane, pack8_fp8(s8 + 8)); }
                    float p[32];
#pragma unroll
                    for (int e = 0; e < 32; ++e) p[e] = 0.f;
#pragma unroll
                    for (int ci = 0; ci < 16; ++ci)
#pragma unroll
                        for (int eg = 0; eg < 8; ++eg) { const f32x4 w4 = *(const LAS f32x4*)(rwl + ((ci * 8 + eg) * 64 + lane) * 4);
#pragma unroll
                            for (int i = 0; i < 4; ++i) p[4 * eg + i] += v[ci] * w4[i]; }
                    const float logit = butterfly32(p, lane) + rbias;
                    int rank = 0;
#pragma unroll
                    for (int e = 0; e < 32; ++e) { const float se = __uint_as_float((unsigned)__builtin_amdgcn_readlane((int)__float_as_uint(logit), 2 * e)); rank += (se > logit || (se == logit && e < myexp)) ? 1 : 0; }
                    float tv[4]; int tix[4];
#pragma unroll
                    for (int r = 0; r < 4; ++r) { const unsigned long long mk = __ballot(rank == r); const int src = (int)__builtin_ctzll(mk | (1ull << 63));
                        tv[r] = __uint_as_float((unsigned)__builtin_amdgcn_readlane((int)__float_as_uint(logit), src)); tix[r] = src >> 1; }
                    const float e1 = __expf(tv[1] - tv[0]), e2 = __expf(tv[2] - tv[0]), e3 = __expf(tv[3] - tv[0]);
                    const float inv = 1.0f / (1.0f + e1 + e2 + e3);
                    if (lane < 4) {
                        const int ix = lane == 0 ? tix[0] : lane == 1 ? tix[1] : lane == 2 ? tix[2] : tix[3];
                        const float gv = (lane == 0 ? 1.0f : lane == 1 ? e1 : lane == 2 ? e2 : e3) * inv;
                        gst<int>(TIDX + t * 4 + lane, ix); gst<float>(TGATE + t * 4 + lane, gv);
                        __hip_atomic_fetch_add((LAS unsigned*)(lds + MISC_OFF) + 32 + ix, 1u, __ATOMIC_RELAXED, __HIP_MEMORY_SCOPE_WORKGROUP);
                    }
                }
            }
            __syncthreads();
            if (tid < NE) { const unsigned c = MISC[32 + tid]; if (c) (void)xb_add(CNT + tid, c); }
        }
        GRID_BAR();

        {
            PHASE_BEGIN();
            const int* TIDX = (const int*)(ws + WS_IDX); const float* TGATE = (const float*)(ws + WS_GATE);
            int* RTOK = (int*)(ws + WS_RTOK); int* RDST = (int*)(ws + WS_RDST); float* RGATE = (float*)(ws + WS_RGATE);
            unsigned* CNT = ctl + CW_CNT + layer * NE; unsigned* CUR = ctl + CW_CUR + layer * NE;
            LAS int* TS = (LAS int*)(lds + TS_OFF);
            if (tid == 0) { int a = 0; for (int e = 0; e < NE; ++e) { TS[e] = a; a += (int)((xb_ld(CNT + e) + 255u) >> 8); } TS[NE] = a; }
            for (int tb = vcu; tb < T / 128; tb += G) {
                __syncthreads();
                if (tid < NE) MISC[32 + tid] = 0u;
                __syncthreads();
                const int t = tb * 128 + (tid >> 2), k = tid & 3;
                const int e = gld<int>(TIDX + t * 4 + k); const float gv = gld<float>(TGATE + t * 4 + k);
                const unsigned rank = __hip_atomic_fetch_add((LAS unsigned*)(lds + MISC_OFF) + 32 + e, 1u, __ATOMIC_RELAXED, __HIP_MEMORY_SCOPE_WORKGROUP);
                __syncthreads();
                if (tid < NE) { const unsigned c = MISC[32 + tid]; MISC[64 + tid] = c ? xb_add(CUR + tid, c) : 0u; }
                __syncthreads();
                const int pos = TS[e] * 256 + (int)MISC[64 + e] + (int)rank;
                gst<int>(RTOK + pos, t); gst<int>(RDST + pos, t * 4 + k); gst<float>(RGATE + pos, gv);
            }
            __syncthreads();
            for (int e = vcu; e < NE; e += G) {
                const int beg = TS[e] * 256 + (int)xb_ld(CNT + e), end = TS[e + 1] * 256;
                for (int p = beg + tid; p < end; p += NTHR) { gst<int>(RTOK + p, 0); gst<int>(RDST + p, -1); gst<float>(RGATE + p, 0.f); }
            }
        }
        GRID_BAR();

        {
            PHASE_BEGIN();
            unsigned* CNT = ctl + CW_CNT + layer * NE;
            LAS int* TS = (LAS int*)(lds + TS_OFF);
            __syncthreads();
            if (tid == 0) { int a = 0; for (int e = 0; e < NE; ++e) { TS[e] = a; a += (int)((xb_ld(CNT + e) + 255u) >> 8); } TS[NE] = a; }
            __syncthreads();
            const int nM = TS[NE];
            const int n_my = pg8::build_units(lds, tid, nM, 8, G, bx, true, (const int*)(ws + WS_RTOK), REP_MOE1);
            pg8::GemmP gp; gp.A = (const char*)(ws + WS_X18); gp.lda2 = D; gp.acol_pn = 0; gp.Bt = (const char*)(ws + WS_WGU + (size_t)layer * NE * 2048 * 1024); gp.b_estride = (size_t)2048 * 1024; gp.Kb = 1024; gp.sA = E8_X; gp.sB = E8_W;
            pg8::EpiSwiglu E; E.act = (unsigned char*)(ws + WS_ACT); E.bgu = ARG_IN(19) + (size_t)layer * NE * 2048;
            pg8::gemm_phase<true, true, pg8::EpiSwiglu>(lds, tid, gp, n_my, E, REP_MOE1 > 1 ? n_my / 2 : (1 << 20));
        }
        GRID_BAR();

        {
            PHASE_BEGIN();
            LAS int* TS = (LAS int*)(lds + TS_OFF);
            const int nM = TS[NE];
            const int n_my = pg8::build_units(lds, tid, nM, 4, G, bx, true, nullptr, REP_MOE2);
            pg8::GemmP gp; gp.A = (const char*)(ws + WS_ACT); gp.lda2 = D; gp.acol_pn = 0; gp.Bt = (const char*)(ws + WS_WDN + (size_t)layer * NE * 1024 * 1024); gp.b_estride = (size_t)1024 * 1024; gp.Kb = 1024; gp.sA = E8_ACT; gp.sB = E8_W;
            pg8::EpiMoe2 E; E.Y = (bf16*)(ws + WS_Y); E.bdn = ARG_IN(21) + (size_t)layer * NE * D; E.rowdst = (const int*)(ws + WS_RDST); E.rowgate = (const float*)(ws + WS_RGATE);
            pg8::gemm_phase<false, true, pg8::EpiMoe2>(lds, tid, gp, n_my, E);
        }
        GRID_BAR();

        {
            PHASE_BEGIN();
            const bf16* X1b = (const bf16*)(ws + WS_X1B); const bf16* Y = (const bf16*)(ws + WS_Y); float* OUT = ARG_OUT(); bf16* XAb = (bf16*)(ws + WS_XAB);
            float lg[16], lb[16];
#pragma unroll
            for (int q = 0; q < 4; ++q) { const f32x4 b = gld<f32x4>(ARG_IN(22) + layer * D + chq(lane, q)), c = gld<f32x4>(ARG_IN(23) + layer * D + chq(lane, q));
#pragma unroll
                for (int i = 0; i < 4; ++i) { lg[4 * q + i] = b[i]; lb[4 * q + i] = c[i]; } }
            for (int rep = 0; rep < REP_THIN; ++rep)
            for (int tb = vcu; tb < T / 128; tb += G) {
                const int t0 = tb * 128 + wave * 16;
                v4u nx[2], ny[4][2];
#pragma unroll
                for (int j = 0; j < 2; ++j) { nx[j] = gld<v4u>(X1b + (size_t)t0 * D + j * 512 + 8 * lane);
#pragma unroll
                    for (int k = 0; k < 4; ++k) ny[k][j] = gld<v4u>(Y + (size_t)(t0 * 4 + k) * D + j * 512 + 8 * lane); }
                for (int ti = 0; ti < 16; ++ti) {
                    const int t = t0 + ti;
                    float v[16], h[16];
                    unpack8(nx[0], v); unpack8(nx[1], v + 8);
#pragma unroll
                    for (int i = 0; i < 16; ++i) { v[i] *= ALPHA; h[i] = 0.f; }
#pragma unroll
                    for (int k = 0; k < 4; ++k) { float y[16]; unpack8(ny[k][0], y); unpack8(ny[k][1], y + 8);
#pragma unroll
                        for (int i = 0; i < 16; ++i) h[i] += y[i]; }
                    if (ti + 1 < 16) {
#pragma unroll
                        for (int j = 0; j < 2; ++j) { nx[j] = gld<v4u>(X1b + (size_t)(t + 1) * D + j * 512 + 8 * lane);
#pragma unroll
                            for (int k = 0; k < 4; ++k) ny[k][j] = gld<v4u>(Y + (size_t)((t + 1) * 4 + k) * D + j * 512 + 8 * lane); } }
#pragma unroll
                    for (int i = 0; i < 16; ++i) v[i] += h[i];
                    ln16(v, lg, lb, lane);
                    if (layer == DEPTH - 1) {
#pragma unroll
                        for (int q = 0; q < 4; ++q) gst<f32x4>(OUT + (size_t)t * D + chq(lane, q), (f32x4){v[4 * q], v[4 * q + 1], v[4 * q + 2], v[4 * q + 3]});
                    } else {
                        gst<v4u>(XAb + (size_t)t * D + 8 * lane, pack8(v));
                        gst<v4u>(XAb + (size_t)t * D + 512 + 8 * lane, pack8(v + 8));
                    }
                }
            }
        }
        if (layer + 1 < DEPTH) GRID_BAR();
    }
}

extern "C" void kernel_launch(void* const* d_in, const int* in_sizes, int n_in, void* d_out, int out_size, void* d_ws, size_t ws_size, hipStream_t stream) {
    static int grid = 0;
    if (grid == 0) {
        if (n_in != 24 || out_size != T * D || ws_size < WS_END) { fprintf(stderr, "kernel_launch: unexpected shapes (n_in %d out %d ws %zu)\n", n_in, out_size, ws_size); grid = -1; return; }
        if (hipFuncSetAttribute((const void*)mega_fwd, hipFuncAttributeMaxDynamicSharedMemorySize, LDS_BYTES) != hipSuccess) { fprintf(stderr, "kernel_launch: hipFuncSetAttribute failed\n"); grid = -1; return; }
        int dev = 0, cus = 0, per_cu = 0;
        (void)hipGetDevice(&dev); (void)hipDeviceGetAttribute(&cus, hipDeviceAttributeMultiprocessorCount, dev);
        if (hipOccupancyMaxActiveBlocksPerMultiprocessor(&per_cu, (const void*)mega_fwd, NTHR, LDS_BYTES) != hipSuccess || per_cu < 1) fprintf(stderr, "kernel_launch: occupancy query reports %d blocks per CU\n", per_cu);
        (void)hipGetLastError();
        grid = 256; if (cus > 0 && cus < grid) grid = cus;
    }
    if (grid < 0) return;
    (void)hipMemsetAsync((char*)d_ws + WS_CTL, 0, CTL_ZERO_BYTES, stream);
    Args a{};
    for (int i = 0; i < 24; ++i) a.in[i] = (const float*)d_in[i];
    a.out = (float*)d_out; a.ws = (unsigned char*)d_ws;
    hipLaunchKernelGGL(mega_fwd, dim3(grid), dim3(NTHR), LDS_BYTES, stream, a);
    const hipError_t le = hipPeekAtLastError();
    if (le != hipSuccess) fprintf(stderr, "kernel_launch: launch failed: %s\n", hipGetErrorName(le));
}
```

```cpp
#include <hip/hip_runtime.h>
#include <cstdio>
#include <cstdint>

#define GAS __attribute__((address_space(1)))
#define LAS __attribute__((address_space(3)))
typedef unsigned short bf16;
typedef unsigned v4u __attribute__((ext_vector_type(4)));
typedef unsigned v2u __attribute__((ext_vector_type(2)));
typedef float f32x4 __attribute__((ext_vector_type(4)));
typedef float f32x2 __attribute__((ext_vector_type(2)));
typedef short bf16x8 __attribute__((ext_vector_type(8)));
typedef int v4i __attribute__((ext_vector_type(4)));
typedef int v8i __attribute__((ext_vector_type(8)));

template <class V> __device__ __forceinline__ V gld(const void* p) { return *(const GAS V*)p; }
template <class V> __device__ __forceinline__ void gst(void* p, V v) { *(GAS V*)p = v; }

#ifndef REP_P0
#define REP_P0 1
#endif
#ifndef REP_MOE1
#define REP_MOE1 1
#endif
#ifndef REP_MOE2
#define REP_MOE2 1
#endif
#ifndef REP_THIN
#define REP_THIN 1
#endif
#ifndef REP_MIXG
#define REP_MIXG 1
#endif
#ifndef REP_LNR
#define REP_LNR 1
#endif
constexpr int T = 32768, D = 1024, SEQ = 4096, NE = 32, TOPK = 4, NA = T * TOPK, DEPTH = 4;
constexpr int MAXTILES = NA / 256 + NE;
constexpr int NPAD = MAXTILES * 256;
constexpr float LN_EPS = 1e-5f;
constexpr float ALPHA = 1.681792830507429f;
constexpr int NWAVES = 8, NTHR = 512;
constexpr int MAXU = 17;
constexpr float SX8 = 16.0f, SACT8 = 4.0f, SW8 = 256.0f;
constexpr int E8_X = 0x7B7B7B7B  , E8_ACT = 0x7D7D7D7D  , E8_W = 0x77777777  ;

constexpr size_t MiB = 1u << 20;
constexpr size_t WS_CTL = 0, CTL_ZERO_BYTES = 1 * MiB;
constexpr size_t WS_IDX = 1 * MiB;
constexpr size_t WS_GATE = 1 * MiB + 512 * 1024;
constexpr size_t WS_RTOK = 2 * MiB;
constexpr size_t WS_RDST = 3 * MiB;
constexpr size_t WS_RGATE = 4 * MiB;
constexpr size_t WS_WPOOL = 5 * MiB;
constexpr size_t WS_WSCIN = 6 * MiB;
constexpr size_t WS_WSCOUT = 12 * MiB;
constexpr size_t WS_WCFIN = 14 * MiB;
constexpr size_t WS_WCFOUT = 18 * MiB;
constexpr size_t WS_WGU = 32 * MiB;
constexpr size_t WS_WDN = 544 * MiB;
constexpr size_t WS_X18 = 704 * MiB;
constexpr size_t WS_ZB = 800 * MiB;
constexpr size_t WS_XAB = 864 * MiB;
constexpr size_t WS_X1B = 928 * MiB;
constexpr size_t WS_M1 = 992 * MiB;
constexpr size_t WS_M2 = 1056 * MiB;
constexpr size_t WS_M3 = 1120 * MiB;
constexpr size_t WS_ACT = 1184 * MiB;
constexpr size_t WS_Y = 1456 * MiB;
constexpr size_t WS_END = 1712 * MiB;
constexpr int CW_BAR = 4096;
constexpr int CW_CNT = 8192;
constexpr int CW_CUR = 8192 + 256;

constexpr int RING_OFF = 0, RING_BYTES = 131072;
constexpr int TOK_OFF = RING_BYTES;
constexpr int UT_OFF = TOK_OFF + MAXU * 1024;
constexpr int TS_OFF = UT_OFF + (2 * MAXU + 2) * 16;
constexpr int MISC_OFF = TS_OFF + 36 * 4;
constexpr int LDS_BYTES = MISC_OFF + 128 * 4;
static_assert(LDS_BYTES <= 160 * 1024 && (MISC_OFF % 16) == 0, "LDS map");

#define LDS_WAIT() asm volatile("s_waitcnt lgkmcnt(0)" ::: "memory")
#define VM_WAIT() asm volatile("s_waitcnt vmcnt(0)" ::: "memory")

__device__ __forceinline__ unsigned cvt_pk_bf16(float lo, float hi) { unsigned r; asm volatile("v_cvt_pk_bf16_f32 %0, %1, %2" : "=v"(r) : "v"(lo), "v"(hi)); return r; }
__device__ __forceinline__ v2u pack8_fp8(const float* v) { int a = __builtin_amdgcn_cvt_pk_fp8_f32(v[0], v[1], 0, false); a = __builtin_amdgcn_cvt_pk_fp8_f32(v[2], v[3], a, true);
    int b = __builtin_amdgcn_cvt_pk_fp8_f32(v[4], v[5], 0, false); b = __builtin_amdgcn_cvt_pk_fp8_f32(v[6], v[7], b, true); v2u w; w.x = (unsigned)a; w.y = (unsigned)b; return w; }
__device__ __forceinline__ float bf_lo(unsigned u) { return __uint_as_float(u << 16); }
__device__ __forceinline__ float bf_hi(unsigned u) { return __uint_as_float(u & 0xffff0000u); }
__device__ __forceinline__ float sigmoidf_(float x) { return __builtin_amdgcn_rcpf(1.0f + __expf(-x)); }
__device__ __forceinline__ float shx(float v, int mask, int lane) { return __uint_as_float((unsigned)__builtin_amdgcn_ds_bpermute((lane ^ mask) << 2, (int)__float_as_uint(v))); }
__device__ __forceinline__ float wave_sum(float v, int lane) {
#pragma unroll
    for (int o = 1; o < 64; o <<= 1) v += shx(v, o, lane);
    return v;
}

#define XB_TMO      128
#define XB_XCNT(j)  (256  + 64 * (j))
#define XB_XSUB(j)  (1280 + 64 * (j))
#define XB_XGEN(j)  (2304 + 64 * (j))
#define XB_TOP      3328
#define XB_TOPGEN   3392
#define XCD_BAR_WORDS 3456
#define XB_SPIN_CAP (1u << 18)

__device__ __forceinline__ unsigned xb_ld(unsigned* p)              { return __hip_atomic_load((GAS unsigned*)p, __ATOMIC_RELAXED, __HIP_MEMORY_SCOPE_AGENT); }
__device__ __forceinline__ unsigned xb_add(unsigned* p, unsigned v) { return __hip_atomic_fetch_add((GAS unsigned*)p, v, __ATOMIC_RELAXED, __HIP_MEMORY_SCOPE_AGENT); }
__device__ __forceinline__ unsigned xb_xcc_id() { return (unsigned)__builtin_amdgcn_s_getreg((3 << 11) | 20) & 0xFu; }
#define XB_SPIN(cond, bar) do { unsigned _sp = 0; while (cond) { __builtin_amdgcn_s_sleep(1); \
    if ((++_sp & 255u) == 0u) { if (xb_ld(&(bar)[XB_TMO])) break; if (_sp > XB_SPIN_CAP) { (void)xb_add(&(bar)[XB_TMO], 1u); break; } } } } while (0)

struct XcdBarrier { unsigned* bar; unsigned x; volatile LAS unsigned* st; };

__device__ __forceinline__ XcdBarrier xcd_barrier_post(unsigned* bar, volatile LAS unsigned* st) {
    XcdBarrier b; b.bar = bar; b.x = xb_xcc_id(); b.st = st;
    if (threadIdx.x == 0) (void)xb_add(&bar[XB_XCNT(b.x)], 1u);
    return b;
}
__device__ __forceinline__ void xcd_barrier_complete(unsigned* bar, unsigned x, unsigned& nloc, unsigned& nx) {
    const unsigned G = gridDim.x * gridDim.y * gridDim.z;
    unsigned sum, cnt, mine, sp = 0u;
    for (;;) {
        sum = 0u; cnt = 0u; mine = 0u;
#pragma unroll
        for (unsigned j = 0; j < 16; ++j) { const unsigned c = xb_ld(&bar[XB_XCNT(j)]); sum += c; cnt += (c > 0u) ? 1u : 0u; mine = (j == x) ? c : mine; }
        if (sum == G) break;
        __builtin_amdgcn_s_sleep(1);
        if ((++sp & 255u) == 0u) { if (xb_ld(&bar[XB_TMO])) break; if (sp > XB_SPIN_CAP) { (void)xb_add(&bar[XB_TMO], 1u); break; } }
    }
    nloc = mine > 0u ? mine : 1u; nx = cnt > 0u ? cnt : 1u;
}
__device__ __forceinline__ void xcd_barrier(const XcdBarrier& b) {
    asm volatile("s_waitcnt vmcnt(0)" ::: "memory");
    __syncthreads();
    if (threadIdx.x == 0) {
        unsigned* bar = b.bar;
        __builtin_amdgcn_s_waitcnt(0);
        unsigned nloc = b.st[0], nx = b.st[1];
        if (nloc == 0u) { xcd_barrier_complete(bar, b.x, nloc, nx); b.st[0] = nloc; b.st[1] = nx; }
        const unsigned old = xb_add(&bar[XB_XSUB(b.x)], 1u);
        const unsigned gen = old / nloc;
        if (old + 1u == (gen + 1u) * nloc) {
            __builtin_amdgcn_fence(__ATOMIC_RELEASE, "agent");
            asm volatile("s_waitcnt vmcnt(0)" ::: "memory");
            const unsigned og = xb_add(&bar[XB_TOP], 1u);
            const unsigned tg = og / nx;
            if (og + 1u == (tg + 1u) * nx) xb_add(&bar[XB_TOPGEN], 1u);
            else XB_SPIN(xb_ld(&bar[XB_TOPGEN]) == tg, bar);
            __builtin_amdgcn_fence(__ATOMIC_ACQUIRE, "agent");
            xb_add(&bar[XB_XGEN(b.x)], 1u);
            asm volatile("s_waitcnt vmcnt(0)" ::: "memory");
        } else {
            XB_SPIN(xb_ld(&bar[XB_XGEN(b.x)]) == gen, bar);
            __builtin_amdgcn_fence(__ATOMIC_ACQUIRE, "agent");
            asm volatile("s_waitcnt vmcnt(0)" ::: "memory");
        }
    }
    __syncthreads();
}

namespace pg8 {
constexpr int BM = 256, BK = 64, HALF = 128, HTB = HALF * BK * 2, STAGE_BYTES = 8 * HTB, NXCD = 8, WGM = 8;
__host__ __device__ __forceinline__ int lds_byte(int r, int c) { const int st = (r >> 4) * 2 + (c >> 5), rr = r & 15, cc = c & 31, ob = rr * 64 + cc * 2; return st * 1024 + (ob ^ (((ob >> 9) & 1) << 5)); }
__host__ __device__ __forceinline__ void stage_rc(int b, int& R, int& C) { const int st = b / 1024, sb = b % 1024, swz = sb ^ (((sb >> 9) & 1) << 5); R = (st >> 1) * 16 + swz / 64; C = (st & 1) * 32 + (swz % 64) / 2; }
__host__ __device__ __forceinline__ int perm32(int rho) { const int n = rho >> 4, i = rho & 15; return 8 * (i >> 2) + 4 * n + (i & 3); }

struct Unit { int pm, pn, e; };
struct GemmP {
    const char* A; unsigned lda2;
    unsigned acol_pn;
    const char* Bt; size_t b_estride;
    int Kb;
    int sA, sB;
};

__device__ __forceinline__ void unit_of(int L, int nM, int nN, int& pm, int& pn) {
    const int nwg = nM * nN;
    int wgid = L; { const int q = nwg / NXCD, r = nwg % NXCD, xcd = wgid % NXCD, off = wgid / NXCD; wgid = (xcd < r ? xcd * (q + 1) : r * (q + 1) + (xcd - r) * q) + off; }
    const int nig = WGM * nN, gid = wgid / nig, fm = gid * WGM, gsz = (nM - fm) < WGM ? (nM - fm) : WGM;
    pm = fm + ((wgid % nig) % gsz); pn = (wgid % nig) / gsz;
}
__device__ __forceinline__ int build_units(LAS unsigned char* lds, const int tid, int nM, int nN, int G, int c, bool moe, const int* row_tok, const int dup = 1) {
    LAS int* UT = (LAS int*)(lds + UT_OFF); LAS const int* TS = (LAS const int*)(lds + TS_OFF); LAS int* TOK = (LAS int*)(lds + TOK_OFF);
    const int nwg = nM * nN;
    int n_my = (nwg > c) ? (nwg - c + G - 1) / G : 0; if (n_my > MAXU) n_my = MAXU;
    if (tid < n_my) {
        int pm, pn; unit_of(tid * G + c, nM, nN, pm, pn);
        int e = 0; if (moe) { while (e < NE - 1 && TS[e + 1] <= pm) ++e; }
        UT[4 * tid + 0] = pm; UT[4 * tid + 1] = pn; UT[4 * tid + 2] = e; UT[4 * tid + 3] = 0;
    }
    __syncthreads();
    if (row_tok) {
        for (int idx = tid; idx < n_my * 256; idx += NTHR) { const int i = idx >> 8, r = idx & 255; TOK[idx] = gld<int>(row_tok + UT[4 * i] * 256 + r); }
    }
    __syncthreads();
    if (dup > 1) { if (tid < n_my) { UT[4 * (tid + n_my) + 0] = UT[4 * tid]; UT[4 * (tid + n_my) + 1] = UT[4 * tid + 1]; UT[4 * (tid + n_my) + 2] = UT[4 * tid + 2]; UT[4 * (tid + n_my) + 3] = 0; } __syncthreads(); return 2 * n_my; }
    return n_my;
}
__device__ __forceinline__ Unit read_unit(LAS const int* UT, int i) {
    Unit u; u.pm = __builtin_amdgcn_readfirstlane(UT[4 * i]); u.pn = __builtin_amdgcn_readfirstlane(UT[4 * i + 1]); u.e = __builtin_amdgcn_readfirstlane(UT[4 * i + 2]); return u;
}
template <bool GATHER>
__device__ __forceinline__ void a_offsets(unsigned (&v)[2][2], const GemmP& g, const Unit& u, int ui, const int (&Rr)[2], const int (&Cc2)[2], LAS const int* TOK, const int tokn) {
#pragma unroll
    for (int h = 0; h < 2; ++h)
#pragma unroll
        for (int i = 0; i < 2; ++i) {
            const int row = GATHER ? TOK[(ui >= tokn ? ui - tokn : ui) * 256 + h * HALF + Rr[i]] : (u.pm * BM + h * HALF + Rr[i]);
            v[h][i] = (unsigned)row * g.lda2 + (unsigned)Cc2[i] + (unsigned)u.pn * g.acol_pn;
        }
}

template <bool GATHER, bool FP8, class Epi>
__device__ __forceinline__ void gemm_phase(LAS unsigned char* lds, const int tid, const GemmP g, const int n_my, const Epi& E, const int tokn = 1 << 20) {
    const int wid = __builtin_amdgcn_readfirstlane(tid >> 6), lane = tid & 63, wr = wid >> 2, wc = wid & 3, fr = lane & 15, fq = lane >> 4;
    const int Kb = g.Kb, nt = Kb / (BK * 2);
    if (n_my <= 0) return;
    int Rr[2], Cc2[2]; unsigned voffB[2];
#pragma unroll
    for (int i = 0; i < 2; ++i) { int R, C; stage_rc(tid * 16 + i * 8192, R, C); const int Rb = Epi::PERM ? ((R & ~31) + perm32(R & 31)) : R;
        Rr[i] = R; Cc2[i] = C * 2; voffB[i] = (unsigned)(Rb * Kb + C * 2); }
    const size_t kstep = (size_t)(BK * 2);
    const size_t hstep = (size_t)HALF * Kb;
    const size_t tstepB = 2 * hstep;
    const unsigned ldsw = (unsigned)wid * 1024u;
    const int aoff = lds_byte(wr * 64 + fr, fq * 8), boff = lds_byte(wc * 32 + fr, fq * 8);
    LAS const int* UT = (LAS const int*)(lds + UT_OFF); LAS const int* TOK = (LAS const int*)(lds + TOK_OFF);
#define PG8_SA(b, h) (((b) * 2 + (h)) * HTB)
#define PG8_SB(b, h) ((4 + (b) * 2 + (h)) * HTB)
#define PG8_STAGE(bufoff, gbase, voff) do { _Pragma("unroll") for (int _i = 0; _i < 2; ++_i) \
        __builtin_amdgcn_global_load_lds((const unsigned*)((const char*)(gbase) + (voff)[_i]), (LAS unsigned*)(lds + (bufoff) + ldsw + _i * 8192), 16, 0, 0); } while (0)
#define PG8_LDA(dst, b, h) do { _Pragma("unroll") for (int m = 0; m < 4; ++m) _Pragma("unroll") for (int k = 0; k < 2; ++k) dst[m][k] = *(const LAS bf16x8*)(lds + PG8_SA(b, h) + aoff + m * 2048 + k * 1024); } while (0)
#define PG8_LDB(dst, b, h) do { _Pragma("unroll") for (int n = 0; n < 2; ++n) _Pragma("unroll") for (int k = 0; k < 2; ++k) dst[n][k] = *(const LAS bf16x8*)(lds + PG8_SB(b, h) + boff + n * 2048 + k * 1024); } while (0)
#define PG8_CAT(x) __builtin_shufflevector(__builtin_bit_cast(v4i, (x)[0]), __builtin_bit_cast(v4i, (x)[1]), 0, 1, 2, 3, 4, 5, 6, 7)
#define PG8_MMA(ai, bj, At, Bt) do { __builtin_amdgcn_s_setprio(1); _Pragma("unroll") for (int m = 0; m < 4; ++m) _Pragma("unroll") for (int n = 0; n < 2; ++n) { \
        if constexpr (FP8) { const v8i b8_ = PG8_CAT(Bt[n]), a8_ = PG8_CAT(At[m]); asm volatile("v_mfma_scale_f32_16x16x128_f8f6f4 %0, %1, %2, %0, %3, %4 op_sel_hi:[0,0,0]" : "+v"(acc[ai][bj][m][n]) : "v"(b8_), "v"(a8_), "v"(vsB), "v"(vsA)); } \
        else { _Pragma("unroll") for (int k = 0; k < 2; ++k) acc[ai][bj][m][n] = __builtin_amdgcn_mfma_f32_16x16x32_bf16(Bt[n][k], At[m][k], acc[ai][bj][m][n], 0, 0, 0); } } \
        __builtin_amdgcn_s_setprio(0); } while (0)
#define PG8_WAIT_V(n) asm volatile("s_waitcnt vmcnt(" #n ")" ::: "memory")
#define PG8_WAIT_L(n) asm volatile("s_waitcnt lgkmcnt(" #n ")" ::: "memory")
#define PG8_BAR __builtin_amdgcn_s_barrier()
#define PG8_SCHED __builtin_amdgcn_sched_barrier(0)
    Unit cur = read_unit(UT, 0), nxt; int ui = 0;
    f32x4 acc[2][2][4][2];
#pragma unroll
    for (int a = 0; a < 2; ++a)
#pragma unroll
        for (int b = 0; b < 2; ++b)
#pragma unroll
            for (int m = 0; m < 4; ++m)
#pragma unroll
                for (int n = 0; n < 2; ++n) acc[a][b][m][n] = (f32x4){0.f, 0.f, 0.f, 0.f};
#define PG8_PIN_ACC() do { if constexpr (FP8) { _Pragma("unroll") for (int a_ = 0; a_ < 2; ++a_) _Pragma("unroll") for (int b_ = 0; b_ < 2; ++b_) \
        asm volatile("" : "+v"(acc[a_][b_][0][0]), "+v"(acc[a_][b_][0][1]), "+v"(acc[a_][b_][1][0]), "+v"(acc[a_][b_][1][1]), "+v"(acc[a_][b_][2][0]), "+v"(acc[a_][b_][2][1]), "+v"(acc[a_][b_][3][0]), "+v"(acc[a_][b_][3][1])); \
        asm volatile("s_nop 1" ::: "memory"); } } while (0)
    PG8_PIN_ACC();
    bf16x8 At[4][2], B0[2][2], B1[2][2];
    int vsA = g.sA, vsB = g.sB; asm volatile("" : "+v"(vsA), "+v"(vsB));
    unsigned vAc[2][2], vAn[2][2];
    a_offsets<GATHER>(vAc, g, cur, 0, Rr, Cc2, TOK, tokn);
    const char* const Ab = g.A;
    const char* cB = g.Bt + (size_t)cur.e * g.b_estride + (size_t)cur.pn * tstepB;
    PG8_STAGE(PG8_SB(0, 0), cB, voffB); PG8_STAGE(PG8_SB(0, 1), cB + hstep, voffB); PG8_STAGE(PG8_SA(0, 0), Ab, vAc[0]); PG8_STAGE(PG8_SA(0, 1), Ab, vAc[1]);
    if (wr == 1) PG8_BAR;
    PG8_WAIT_V(2); PG8_BAR;
    PG8_STAGE(PG8_SB(1, 0), cB + kstep, voffB); PG8_STAGE(PG8_SA(1, 0), Ab + kstep, vAc[0]); PG8_STAGE(PG8_SB(1, 1), cB + hstep + kstep, voffB);
    PG8_WAIT_V(6); PG8_BAR;
    for (;;) {
        const bool has_next = (ui + 1 < n_my);
        nxt = cur; if (has_next) nxt = read_unit(UT, ui + 1);
        const char* nB = has_next ? g.Bt + (size_t)nxt.e * g.b_estride + (size_t)nxt.pn * tstepB : cB;
        for (int t = 0; t < nt; t += 2) {
            const bool last = (t == nt - 2);
            const char* a1 = Ab + (size_t)(t + 1) * kstep;
            const char* a2 = last ? Ab : Ab + (size_t)(t + 2) * kstep; const char* b2 = last ? nB : cB + (size_t)(t + 2) * kstep;
            const char* a3 = a2 + kstep; const char* b3 = b2 + kstep;
            unsigned o2[2][2];
            if (last) {
                if (has_next) a_offsets<GATHER>(vAn, g, nxt, ui + 1, Rr, Cc2, TOK, tokn);
                else { vAn[0][0] = vAc[0][0]; vAn[0][1] = vAc[0][1]; vAn[1][0] = vAc[1][0]; vAn[1][1] = vAc[1][1]; }
                o2[0][0] = vAn[0][0]; o2[0][1] = vAn[0][1]; o2[1][0] = vAn[1][0]; o2[1][1] = vAn[1][1];
            } else { o2[0][0] = vAc[0][0]; o2[0][1] = vAc[0][1]; o2[1][0] = vAc[1][0]; o2[1][1] = vAc[1][1]; }
            PG8_LDB(B0, 0, 0); PG8_LDB(B1, 0, 1); PG8_SCHED; PG8_LDA(At, 0, 0); PG8_STAGE(PG8_SA(1, 1), a1, vAc[1]);
            PG8_WAIT_V(8); PG8_WAIT_L(0); PG8_BAR; PG8_MMA(0, 0, At, B0); PG8_MMA(0, 1, At, B1); PG8_BAR; PG8_SCHED;
            PG8_LDA(At, 0, 1); PG8_STAGE(PG8_SB(0, 0), b2, voffB); PG8_STAGE(PG8_SB(0, 1), b2 + hstep, voffB); PG8_STAGE(PG8_SA(0, 0), a2, o2[0]);
            PG8_WAIT_V(8); PG8_WAIT_L(0); PG8_BAR; PG8_MMA(1, 0, At, B0); PG8_MMA(1, 1, At, B1); PG8_BAR; PG8_SCHED;
            PG8_LDB(B0, 1, 0); PG8_LDB(B1, 1, 1); PG8_SCHED; PG8_LDA(At, 1, 0); PG8_STAGE(PG8_SA(0, 1), a2, o2[1]);
            PG8_WAIT_V(8); PG8_WAIT_L(0); PG8_BAR; PG8_MMA(0, 0, At, B0); PG8_MMA(0, 1, At, B1); PG8_BAR; PG8_SCHED;
            PG8_LDA(At, 1, 1); PG8_STAGE(PG8_SB(1, 0), b3, voffB); PG8_STAGE(PG8_SB(1, 1), b3 + hstep, voffB); PG8_STAGE(PG8_SA(1, 0), a3, o2[0]);
            PG8_WAIT_V(8); PG8_WAIT_L(0); PG8_BAR; PG8_MMA(1, 0, At, B0); PG8_MMA(1, 1, At, B1); PG8_BAR; PG8_SCHED;
        }
        if (wr == 0) PG8_BAR;
        if constexpr (FP8) asm volatile("s_nop 15" ::: "memory");
        E(acc, cur, wr, wc, fr, fq);
        if (!has_next) break;
#pragma unroll
        for (int a = 0; a < 2; ++a)
#pragma unroll
            for (int b = 0; b < 2; ++b)
#pragma unroll
                for (int m = 0; m < 4; ++m)
#pragma unroll
                    for (int n = 0; n < 2; ++n) acc[a][b][m][n] = (f32x4){0.f, 0.f, 0.f, 0.f};
        PG8_PIN_ACC();
        cur = nxt; cB = nB; ++ui;
        vAc[0][0] = vAn[0][0]; vAc[0][1] = vAn[0][1]; vAc[1][0] = vAn[1][0]; vAc[1][1] = vAn[1][1];
        if (wr == 1) PG8_BAR;
    }
    PG8_WAIT_V(0);
    PG8_BAR;
#undef PG8_SA
#undef PG8_SB
#undef PG8_STAGE
#undef PG8_LDA
#undef PG8_LDB
#undef PG8_MMA
#undef PG8_PIN_ACC
#undef PG8_CAT
#undef PG8_WAIT_V
#undef PG8_WAIT_L
#undef PG8_BAR
#undef PG8_SCHED
}

struct EpiOut {
    static constexpr bool PERM = true;
    const bf16* xres; bf16* z; const float* bias; const float* scale;
    __device__ __forceinline__ void operator()(const f32x4 (&acc)[2][2][4][2], const Unit& u, int wr, int wc, int fr, int fq) const {
        const int row0 = u.pm * BM + wr * 64 + fr, c0 = u.pn * BM + wc * 32 + 8 * fq;
        f32x4 bv[2][2], sv[2][2];
#pragma unroll
        for (int bj = 0; bj < 2; ++bj)
#pragma unroll
            for (int n = 0; n < 2; ++n) {
                bv[bj][n] = bias ? gld<f32x4>(bias + c0 + bj * HALF + 4 * n) : (f32x4){0.f, 0.f, 0.f, 0.f};
                sv[bj][n] = scale ? gld<f32x4>(scale + c0 + bj * HALF + 4 * n) : (f32x4){1.f, 1.f, 1.f, 1.f};
            }
#pragma unroll
        for (int ai = 0; ai < 2; ++ai)
#pragma unroll
            for (int m = 0; m < 4; ++m) { const size_t off = (size_t)(row0 + ai * HALF + m * 16) * D + c0;
#pragma unroll
                for (int bj = 0; bj < 2; ++bj) { const v4u xr = gld<v4u>(xres + off + bj * HALF);
                    const f32x4 x0 = (f32x4){bf_lo(xr.x), bf_hi(xr.x), bf_lo(xr.y), bf_hi(xr.y)}, x1 = (f32x4){bf_lo(xr.z), bf_hi(xr.z), bf_lo(xr.w), bf_hi(xr.w)};
                    const f32x4 o0 = x0 * ALPHA + (acc[ai][bj][m][0] + bv[bj][0]) * sv[bj][0], o1 = x1 * ALPHA + (acc[ai][bj][m][1] + bv[bj][1]) * sv[bj][1];
                    v4u w; w.x = cvt_pk_bf16(o0[0], o0[1]); w.y = cvt_pk_bf16(o0[2], o0[3]); w.z = cvt_pk_bf16(o1[0], o1[1]); w.w = cvt_pk_bf16(o1[2], o1[3]);
                    gst<v4u>(z + off + bj * HALF, w); }
                asm volatile("" ::: "memory"); }
    }
};
struct EpiPair {
    static constexpr bool PERM = true;
    bf16* O1; bf16* O2; const float* bias; int mode;
    __device__ __forceinline__ void operator()(const f32x4 (&acc)[2][2][4][2], const Unit& u, int wr, int wc, int fr, int fq) const {
        const int row0 = u.pm * BM + wr * 64 + fr;
        if (u.pn < 8) {
            const int j0 = u.pn * HALF + wc * 32 + 8 * fq;
            f32x4 b1[2], b2[2];
#pragma unroll
            for (int n = 0; n < 2; ++n) { b1[n] = mode ? gld<f32x4>(bias + j0 + 4 * n) : (f32x4){0.f, 0.f, 0.f, 0.f}; b2[n] = mode ? gld<f32x4>(bias + 1024 + j0 + 4 * n) : (f32x4){0.f, 0.f, 0.f, 0.f}; }
#pragma unroll
            for (int ai = 0; ai < 2; ++ai)
#pragma unroll
                for (int m = 0; m < 4; ++m) { bf16* rowp = O1 + (size_t)(row0 + ai * HALF + m * 16) * D + j0; f32x4 r[2];
#pragma unroll
                    for (int n = 0; n < 2; ++n) { const f32x4 g1 = acc[ai][0][m][n] + b1[n], g2 = acc[ai][1][m][n] + b2[n];
                        if (mode) { r[n][0] = g1[0] * sigmoidf_(g2[0]); r[n][1] = g1[1] * sigmoidf_(g2[1]); r[n][2] = g1[2] * sigmoidf_(g2[2]); r[n][3] = g1[3] * sigmoidf_(g2[3]); }
                        else r[n] = g1 * g2; }
                    v4u w; w.x = cvt_pk_bf16(r[0][0], r[0][1]); w.y = cvt_pk_bf16(r[0][2], r[0][3]); w.z = cvt_pk_bf16(r[1][0], r[1][1]); w.w = cvt_pk_bf16(r[1][2], r[1][3]);
                    gst<v4u>(rowp, w); }
        } else {
            const int c0 = (u.pn - 8) * BM + wc * 32 + 8 * fq;
#pragma unroll
            for (int ai = 0; ai < 2; ++ai)
#pragma unroll
                for (int m = 0; m < 4; ++m) { bf16* rowp = O2 + (size_t)(row0 + ai * HALF + m * 16) * D + c0;
#pragma unroll
                    for (int bj = 0; bj < 2; ++bj) { const f32x4 v0 = acc[ai][bj][m][0], v1 = acc[ai][bj][m][1];
                        v4u w; w.x = cvt_pk_bf16(v0[0], v0[1]); w.y = cvt_pk_bf16(v0[2], v0[3]); w.z = cvt_pk_bf16(v1[0], v1[1]); w.w = cvt_pk_bf16(v1[2], v1[3]);
                        gst<v4u>(rowp + bj * HALF, w); } }
        }
    }
};
struct EpiSwiglu {
    static constexpr bool PERM = true;
    unsigned char* act; const float* bgu;
    __device__ __forceinline__ void operator()(const f32x4 (&acc)[2][2][4][2], const Unit& u, int wr, int wc, int fr, int fq) const {
        const int row0 = u.pm * BM + wr * 64 + fr, j0 = u.pn * HALF + wc * 32 + 8 * fq;
        const float* bp = bgu + (size_t)u.e * 2048 + 2 * j0;
        float gb[8], ub[8];
#pragma unroll
        for (int i = 0; i < 4; ++i) { const f32x4 b = gld<f32x4>(bp + 4 * i); gb[2 * i] = b[0]; ub[2 * i] = b[1]; gb[2 * i + 1] = b[2]; ub[2 * i + 1] = b[3]; }
#pragma unroll
        for (int ai = 0; ai < 2; ++ai)
#pragma unroll
            for (int m = 0; m < 4; ++m) { unsigned char* rowp = act + (size_t)(row0 + ai * HALF + m * 16) * D + j0; float r[8];
#pragma unroll
                for (int n = 0; n < 2; ++n)
#pragma unroll
                    for (int q = 0; q < 4; ++q) { const int j = 4 * n + q;
                        const float gg = fminf(acc[ai][0][m][n][q] + gb[j], 7.0f);
                        const float uu = fminf(fmaxf(acc[ai][1][m][n][q] + ub[j], -7.0f), 7.0f);
                        r[j] = (uu + 1.0f) * (gg * sigmoidf_(1.702f * gg)) * SACT8; }
                gst<v2u>(rowp, pack8_fp8(r)); }
    }
};
struct EpiMoe2 {
    static constexpr bool PERM = true;
    bf16* Y; const float* bdn; const int* rowdst; const float* rowgate;
    __device__ __forceinline__ void operator()(const f32x4 (&acc)[2][2][4][2], const Unit& u, int wr, int wc, int fr, int fq) const {
        const int pos0 = u.pm * BM + wr * 64 + fr, c0 = u.pn * BM + wc * 32 + 8 * fq;
        const float* bp = bdn + (size_t)u.e * D + c0;
        f32x4 bv[2][2];
#pragma unroll
        for (int bj = 0; bj < 2; ++bj)
#pragma unroll
            for (int n = 0; n < 2; ++n) bv[bj][n] = gld<f32x4>(bp + bj * HALF + 4 * n);
        int dst[2][4]; float gt[2][4];
#pragma unroll
        for (int ai = 0; ai < 2; ++ai)
#pragma unroll
            for (int m = 0; m < 4; ++m) { const int pos = pos0 + ai * HALF + m * 16; dst[ai][m] = gld<int>(rowdst + pos); gt[ai][m] = gld<float>(rowgate + pos); }
#pragma unroll
        for (int ai = 0; ai < 2; ++ai)
#pragma unroll
            for (int m = 0; m < 4; ++m) {
                if (dst[ai][m] >= 0) { bf16* rowp = Y + (size_t)dst[ai][m] * D + c0; const float s = gt[ai][m];
#pragma unroll
                    for (int bj = 0; bj < 2; ++bj) { const f32x4 v0 = (acc[ai][bj][m][0] + bv[bj][0]) * s, v1 = (acc[ai][bj][m][1] + bv[bj][1]) * s;
                        v4u w; w.x = cvt_pk_bf16(v0[0], v0[1]); w.y = cvt_pk_bf16(v0[2], v0[3]); w.z = cvt_pk_bf16(v1[0], v1[1]); w.w = cvt_pk_bf16(v1[2], v1[3]);
                        gst<v4u>(rowp + bj * HALF, w); } } }
    }
};
}

__device__ __forceinline__ int chq(int lane, int q) { return (q >> 1) * 512 + 8 * lane + (q & 1) * 4; }
__device__ __forceinline__ v4u pack8(const float* v) { v4u w; w.x = cvt_pk_bf16(v[0], v[1]); w.y = cvt_pk_bf16(v[2], v[3]); w.z = cvt_pk_bf16(v[4], v[5]); w.w = cvt_pk_bf16(v[6], v[7]); return w; }
__device__ __forceinline__ void unpack8(const v4u w, float* v) { v[0] = bf_lo(w.x); v[1] = bf_hi(w.x); v[2] = bf_lo(w.y); v[3] = bf_hi(w.y); v[4] = bf_lo(w.z); v[5] = bf_hi(w.z); v[6] = bf_lo(w.w); v[7] = bf_hi(w.w); }

__device__ __forceinline__ int drow_of(int mode, int c) {
    if (mode == 1) { const int j = c >> 1, p = c & 1; return (j >> 7) * 256 + p * 128 + (j & 127); }
    if (mode == 2) { if (c < 1024) return 2048 + c; const int j = (c - 1024) & 1023, p = (c - 1024) >> 10; return (j >> 7) * 256 + p * 128 + (j & 127); }
    if (mode == 3) { const int j = c & 1023, p = c >> 10; return (j >> 7) * 256 + p * 128 + (j & 127); }
    return c;
}
struct TItem { const float* src; unsigned char* dst; int N, Kout  , k0, n0, mode, fp8; };
__device__ __forceinline__ void titem_load(const TItem& d, int lane, float (&tmp)[32]) {
#pragma unroll
    for (int i = 0; i < 32; ++i) { const int kk = 2 * i + (lane >> 5); tmp[i] = gld<float>(d.src + (size_t)(d.k0 + kk) * d.N + d.n0 + (lane & 31)); }
}
__device__ __forceinline__ void titem_store(const TItem& d, int lane, LAS float* scr, const float (&tmp)[32]) {
#pragma unroll
    for (int i = 0; i < 32; ++i) { const int kk = 2 * i + (lane >> 5); scr[kk * 33 + (lane & 31)] = tmp[i]; }
    LDS_WAIT(); asm volatile("" ::: "memory");
    const int c = lane & 7;
#pragma unroll
    for (int j = 0; j < 4; ++j) { const int n = (lane >> 3) + 8 * j; const LAS float* s = scr + (8 * c) * 33 + n;
        float v[8];
#pragma unroll
        for (int i = 0; i < 8; ++i) v[i] = s[i * 33];
        const size_t e = (size_t)drow_of(d.mode, d.n0 + n) * d.Kout + d.k0 + 8 * c;
        if (d.fp8) {
#pragma unroll
            for (int i = 0; i < 8; ++i) v[i] *= SW8;
            gst<v2u>(d.dst + e, pack8_fp8(v));
        } else gst<v4u>(d.dst + 2 * e, pack8(v)); }
    LDS_WAIT(); asm volatile("" ::: "memory");
}

struct Args { const float* in[24]; float* out; unsigned char* ws; };
#define CAS __attribute__((address_space(4)))
__device__ __forceinline__ const void* karg_ptr(int off) {
    const CAS char* kp = (const CAS char*)__builtin_amdgcn_kernarg_segment_ptr();
    asm volatile("" : "+s"(off));
    return *(const void* const CAS*)(kp + off);
}
#define ARG_IN(i) ((const float*)karg_ptr(8 * (i)))
#define ARG_OUT() ((float*)karg_ptr(8 * 24))
#define ARG_WS() ((unsigned char*)karg_ptr(8 * 25))

#define PHASE_BEGIN() \
    int tid = threadIdx.x; asm volatile("" : "+v"(tid)); \
    const int lane = tid & 63, wave = __builtin_amdgcn_readfirstlane(tid >> 6); \
    unsigned char* ws_ = ARG_WS(); asm volatile("" : "+s"(ws_)); unsigned char* ws = (unsigned char*)(GAS unsigned char*)ws_; \
    unsigned* ctl = (unsigned*)(ws + WS_CTL); \
    const int gw = vcu * NWAVES + wave, NGW = G * NWAVES; (void)gw; (void)NGW; (void)lane; (void)ctl;

__device__ __forceinline__ float butterfly32(float (&p)[32], int lane) {
#pragma unroll
    for (int i = 0; i < 16; ++i) { const bool hi = (lane & 32) != 0; const float snd = hi ? p[i] : p[i + 16]; const float keep = hi ? p[i + 16] : p[i]; p[i] = keep + shx(snd, 32, lane); }
#pragma unroll
    for (int i = 0; i < 8; ++i) { const bool hi = (lane & 16) != 0; const float snd = hi ? p[i] : p[i + 8]; const float keep = hi ? p[i + 8] : p[i]; p[i] = keep + shx(snd, 16, lane); }
#pragma unroll
    for (int i = 0; i < 4; ++i) { const bool hi = (lane & 8) != 0; const float snd = hi ? p[i] : p[i + 4]; const float keep = hi ? p[i + 4] : p[i]; p[i] = keep + shx(snd, 8, lane); }
#pragma unroll
    for (int i = 0; i < 2; ++i) { const bool hi = (lane & 4) != 0; const float snd = hi ? p[i] : p[i + 2]; const float keep = hi ? p[i + 2] : p[i]; p[i] = keep + shx(snd, 4, lane); }
    { const bool hi = (lane & 2) != 0; const float snd = hi ? p[0] : p[1]; const float keep = hi ? p[1] : p[0]; p[0] = keep + shx(snd, 2, lane); }
    return p[0] + shx(p[0], 1, lane);
}
__device__ __forceinline__ void ln16(float (&v)[16], const float (&lg)[16], const float (&lb)[16], int lane) {
    float sm = 0.f;
#pragma unroll
    for (int i = 0; i < 16; ++i) sm += v[i];
    const float mean = wave_sum(sm, lane) * (1.0f / D);
    float sq = 0.f;
#pragma unroll
    for (int i = 0; i < 16; ++i) { v[i] -= mean; sq += v[i] * v[i]; }
    const float rstd = 1.0f / sqrtf(wave_sum(sq, lane) * (1.0f / D) + LN_EPS);
#pragma unroll
    for (int i = 0; i < 16; ++i) v[i] = v[i] * rstd * lg[i] + lb[i];
}
__device__ __forceinline__ void route_token(const float logit, const int myexp, const int lane, const int t, int* TIDX, float* TGATE, LAS unsigned* hist, const bool count) {
    int rank = 0;
#pragma unroll
    for (int e = 0; e < 32; ++e) { const float se = __uint_as_float((unsigned)__builtin_amdgcn_readlane((int)__float_as_uint(logit), 2 * e)); rank += (se > logit || (se == logit && e < myexp)) ? 1 : 0; }
    float tv[4]; int tix[4];
#pragma unroll
    for (int r = 0; r < 4; ++r) { const unsigned long long mk = __ballot(rank == r); const int src = (int)__builtin_ctzll(mk | (1ull << 63));
        tv[r] = __uint_as_float((unsigned)__builtin_amdgcn_readlane((int)__float_as_uint(logit), src)); tix[r] = src >> 1; }
    const float e1 = __expf(tv[1] - tv[0]), e2 = __expf(tv[2] - tv[0]), e3 = __expf(tv[3] - tv[0]);
    const float inv = 1.0f / (1.0f + e1 + e2 + e3);
    if (lane < 4) {
        const int ix = lane == 0 ? tix[0] : lane == 1 ? tix[1] : lane == 2 ? tix[2] : tix[3];
        const float gv = (lane == 0 ? 1.0f : lane == 1 ? e1 : lane == 2 ? e2 : e3) * inv;
        gst<int>(TIDX + t * 4 + lane, ix); gst<float>(TGATE + t * 4 + lane, gv);
        if (count) __hip_atomic_fetch_add(hist + ix, 1u, __ATOMIC_RELAXED, __HIP_MEMORY_SCOPE_WORKGROUP);
    }
}
__device__ __forceinline__ void ln16_lds(float (&v)[16], const LAS f32x4* lnp, int lane) {
    float sm = 0.f;
#pragma unroll
    for (int i = 0; i < 16; ++i) sm += v[i];
    const float mean = wave_sum(sm, lane) * (1.0f / D);
    float sq = 0.f;
#pragma unroll
    for (int i = 0; i < 16; ++i) { v[i] -= mean; sq += v[i] * v[i]; }
    const float rstd = 1.0f / sqrtf(wave_sum(sq, lane) * (1.0f / D) + LN_EPS);
#pragma unroll
    for (int q = 0; q < 4; ++q) { const f32x4 g4 = lnp[q * 64 + lane], b4 = lnp[(4 + q) * 64 + lane];
#pragma unroll
        for (int i = 0; i < 4; ++i) v[4 * q + i] = v[4 * q + i] * rstd * g4[i] + b4[i]; }
}
template <bool F32IN>
__device__ __forceinline__ void pool_diff_run(const float* xf, const bf16* xb, bf16* M3, int t0, int lane) {
    const int s0 = t0 & (SEQ - 1);
#pragma unroll
    for (int g = 0; g < 4; ++g) {
        const int w = 2 << g, c = 256 * g + 4 * lane;
        f32x4 r[31];
#pragma unroll
        for (int j = 0; j < w + 15; ++j) {
            const int dt = j - (w - 1);
            if (dt >= 0 || s0 != 0) {
                const size_t o = (size_t)(t0 + dt) * D + c;
                if (F32IN) r[j] = gld<f32x4>(xf + o);
                else { const v2u q = gld<v2u>(xb + o); r[j] = (f32x4){bf_lo(q.x), bf_hi(q.x), bf_lo(q.y), bf_hi(q.y)}; }
            } else r[j] = (f32x4){0.f, 0.f, 0.f, 0.f};
        }
#pragma unroll
        for (int i = 0; i < 16; ++i) {
            f32x4 sum = r[i];
#pragma unroll
            for (int j = 1; j < w; ++j) sum += r[i + j];
            const int nv = (s0 + i + 1 < w) ? s0 + i + 1 : w;
            const f32x4 df = sum * (1.0f / (float)nv) - r[i + w - 1];
            v2u o; o.x = cvt_pk_bf16(df[0], df[1]); o.y = cvt_pk_bf16(df[2], df[3]);
            gst<v2u>(M3 + (size_t)(t0 + i) * D + c, o);
        }
    }
}

__global__ void __launch_bounds__(NTHR, 2) mega_fwd(Args args) {
    extern __shared__ __attribute__((aligned(16))) unsigned char lds_raw[];
    LAS unsigned char* lds = (LAS unsigned char*)lds_raw;
    volatile LAS unsigned* MISC = (volatile LAS unsigned*)(lds + MISC_OFF);
    const int G = gridDim.x, bx = blockIdx.x;
    const int vcu = (G % 8 == 0) ? (bx % 8) * (G / 8) + bx / 8 : bx;
    if (threadIdx.x < 128) MISC[threadIdx.x] = 0u;
    __syncthreads();
    (void)xcd_barrier_post((unsigned*)(ARG_WS() + WS_CTL) + CW_BAR, MISC + 0);
#define GRID_BAR() do { XcdBarrier b_; unsigned* bp_ = (unsigned*)(ARG_WS() + WS_CTL) + CW_BAR; asm volatile("" : "+s"(bp_)); b_.bar = (unsigned*)(GAS unsigned*)bp_; b_.x = xb_xcc_id(); b_.st = MISC; xcd_barrier(b_); } while (0)

    {
        PHASE_BEGIN();
        LAS float* scr = (LAS float*)(lds + RING_OFF + wave * 16384);
        constexpr int I_GU = 16 * 64, I_DN = 16 * 32, I_POOL = 4 * 8, I_SCIN = 16 * 96, I_SQ = 16 * 32, I_CFIN = 16 * 64;
        constexpr int N_GU = 128 * I_GU, N_DN = 128 * I_DN, N_POOL = 8 * I_POOL;
        constexpr int NITEMS = N_GU + N_DN + N_POOL + I_SCIN + I_SQ + I_CFIN + I_SQ;
#define TITEM_SET(d_, src_, K_, N_, dst_, mode_, fp8_, item_) do { const int nb_ = (N_) / 32; (d_).src = (src_); (d_).dst = (unsigned char*)(dst_); (d_).N = (N_); (d_).Kout = (K_); \
        (d_).k0 = 64 * ((item_) / nb_); (d_).n0 = 32 * ((item_) % nb_); (d_).mode = (mode_); (d_).fp8 = (fp8_); } while (0)
#define TITEM_DECODE(it_, d_) do { int r_ = (it_); \
        if (r_ < N_GU) { const int mt_ = r_ / I_GU; TITEM_SET(d_, ARG_IN(18) + (size_t)mt_ * 1024 * 2048, 1024, 2048, ws + WS_WGU + (size_t)mt_ * 2048 * 1024, 1, 1, r_ % I_GU); break; } r_ -= N_GU; \
        if (r_ < N_DN) { const int mt_ = r_ / I_DN; TITEM_SET(d_, ARG_IN(20) + (size_t)mt_ * 1024 * 1024, 1024, 1024, ws + WS_WDN + (size_t)mt_ * 1024 * 1024, 0, 1, r_ % I_DN); break; } r_ -= N_DN; \
        if (r_ < N_POOL) { const int mt_ = r_ / I_POOL; TITEM_SET(d_, ARG_IN(1) + (size_t)mt_ * 256 * 256, 256, 256, ws + WS_WPOOL + (size_t)mt_ * 256 * 256 * 2, 0, 0, r_ % I_POOL); break; } r_ -= N_POOL; \
        if (r_ < I_SCIN) { TITEM_SET(d_, ARG_IN(3), 1024, 3072, ws + WS_WSCIN, 2, 0, r_); break; } r_ -= I_SCIN; \
        if (r_ < I_SQ) { TITEM_SET(d_, ARG_IN(5), 1024, 1024, ws + WS_WSCOUT, 0, 0, r_); break; } r_ -= I_SQ; \
        if (r_ < I_CFIN) { TITEM_SET(d_, ARG_IN(6), 1024, 2048, ws + WS_WCFIN, 3, 0, r_); break; } r_ -= I_CFIN; \
        TITEM_SET(d_, ARG_IN(12), 1024, 1024, ws + WS_WCFOUT, 0, 0, r_); } while (0)
        for (int rep = 0; rep < REP_P0; ++rep) {
            int it = gw; TItem cur; float ta[32];
            if (it < NITEMS) { TITEM_DECODE(it, cur); titem_load(cur, lane, ta); }
            while (it < NITEMS) {
                const int itn = it + NGW; TItem nx = cur; float tb[32];
                if (itn < NITEMS) { TITEM_DECODE(itn, nx); titem_load(nx, lane, tb); }
                else {
#pragma unroll
                    for (int i = 0; i < 32; ++i) tb[i] = 0.f; }
                titem_store(cur, lane, scr, ta);
                cur = nx; it = itn;
#pragma unroll
                for (int i = 0; i < 32; ++i) ta[i] = tb[i];
            }
        }
#undef TITEM_SET
#undef TITEM_DECODE
        const float* x0 = ARG_IN(0); bf16* XAb = (bf16*)(ws + WS_XAB);
        for (int t = gw; t < T; t += NGW) {
            float v[16];
#pragma unroll
            for (int q = 0; q < 4; ++q) { const f32x4 z = gld<f32x4>(x0 + (size_t)t * D + chq(lane, q)); v[4 * q] = z[0]; v[4 * q + 1] = z[1]; v[4 * q + 2] = z[2]; v[4 * q + 3] = z[3]; }
            gst<v4u>(XAb + (size_t)t * D + 8 * lane, pack8(v));
            gst<v4u>(XAb + (size_t)t * D + 512 + 8 * lane, pack8(v + 8));
        }
    }
    GRID_BAR();

    for (int layer = 0; layer < DEPTH; ++layer) {
        const int kind = layer % 3;

        if (kind == 0) {
            PHASE_BEGIN();
            bf16* M3 = (bf16*)(ws + WS_M3); const bf16* xb = (const bf16*)(ws + WS_XAB);
            for (int rep = 0; rep < REP_THIN; ++rep)
            for (int tb = vcu; tb < T / 128; tb += G) {
                const int t0 = tb * 128 + wave * 16;
                if (layer == 0) pool_diff_run<true>(ARG_IN(0), xb, M3, t0, lane);
                else pool_diff_run<false>(ARG_IN(0), xb, M3, t0, lane);
            }
        } else {
            {
                PHASE_BEGIN();
                bf16* M1 = (bf16*)(ws + WS_M1); bf16* M2 = (bf16*)(ws + WS_M2);
                const int nN = (kind == 1) ? 12 : 8;
                const int n_my = pg8::build_units(lds, tid, T / 256, nN, G, bx, false, nullptr, REP_MIXG);
                pg8::GemmP gp; gp.A = (const char*)(ws + WS_XAB); gp.lda2 = D * 2; gp.acol_pn = 0; gp.Bt = (const char*)(ws + ((kind == 1) ? WS_WSCIN : WS_WCFIN)); gp.b_estride = 0; gp.Kb = 2048; gp.sA = 0; gp.sB = 0;
                pg8::EpiPair E; E.O1 = (kind == 1) ? M2 : M1; E.O2 = M1; E.bias = ARG_IN(7); E.mode = (kind == 1) ? 0 : 1;
                pg8::gemm_phase<false, false, pg8::EpiPair>(lds, tid, gp, n_my, E);
            }
            GRID_BAR();
            if (kind == 1) {
                PHASE_BEGIN();
                const bf16* M1 = (const bf16*)(ws + WS_M1); const bf16* M2 = (const bf16*)(ws + WS_M2); bf16* M3 = (bf16*)(ws + WS_M3);
                const float* cw = ARG_IN(4);
                float wk[3][16];
#pragma unroll
                for (int k = 0; k < 3; ++k)
#pragma unroll
                    for (int q = 0; q < 4; ++q) { const f32x4 v = gld<f32x4>(cw + k * D + chq(lane, q)); wk[k][4 * q] = v[0]; wk[k][4 * q + 1] = v[1]; wk[k][4 * q + 2] = v[2]; wk[k][4 * q + 3] = v[3]; }
                for (int rep = 0; rep < REP_THIN; ++rep)
                for (int tb = vcu; tb < T / 128; tb += G) {
                    const int t0 = tb * 128 + wave * 16, s0 = t0 & (SEQ - 1);
                    float p2[16], p1[16];
                    if (s0 != 0) { unpack8(gld<v4u>(M2 + (size_t)(t0 - 2) * D + 8 * lane), p2); unpack8(gld<v4u>(M2 + (size_t)(t0 - 2) * D + 512 + 8 * lane), p2 + 8);
                                   unpack8(gld<v4u>(M2 + (size_t)(t0 - 1) * D + 8 * lane), p1); unpack8(gld<v4u>(M2 + (size_t)(t0 - 1) * D + 512 + 8 * lane), p1 + 8); }
                    else {
#pragma unroll
                        for (int i = 0; i < 16; ++i) { p2[i] = 0.f; p1[i] = 0.f; } }
                    for (int i0 = 0; i0 < 16; i0 += 4) {
                        v4u cv[4][2], gv[4][2];
#pragma unroll
                        for (int u = 0; u < 4; ++u)
#pragma unroll
                            for (int j = 0; j < 2; ++j) { const size_t o = (size_t)(t0 + i0 + u) * D + j * 512 + 8 * lane; cv[u][j] = gld<v4u>(M2 + o); gv[u][j] = gld<v4u>(M1 + o); }
#pragma unroll
                        for (int u = 0; u < 4; ++u) {
                            float c[16], gb[16], o[16];
                            unpack8(cv[u][0], c); unpack8(cv[u][1], c + 8); unpack8(gv[u][0], gb); unpack8(gv[u][1], gb + 8);
#pragma unroll
                            for (int i = 0; i < 16; ++i) { o[i] = gb[i] * (wk[0][i] * p2[i] + wk[1][i] * p1[i] + wk[2][i] * c[i]); p2[i] = p1[i]; p1[i] = c[i]; }
                            gst<v4u>(M3 + (size_t)(t0 + i0 + u) * D + 8 * lane, pack8(o));
                            gst<v4u>(M3 + (size_t)(t0 + i0 + u) * D + 512 + 8 * lane, pack8(o + 8));
                        }
                    }
                }
            } else {
                PHASE_BEGIN();
                const bf16* U = (const bf16*)(ws + WS_M1); bf16* M3 = (bf16*)(ws + WS_M3);
                const int c = 128 * wave + 2 * lane;
                float wk0[31], wk1[31];
#pragma unroll
                for (int k = 0; k < 31; ++k) { const v2u q = gld<v2u>(ARG_IN(8) + k * D + c); wk0[k] = __uint_as_float(q.x); wk1[k] = __uint_as_float(q.y); }
                const v2u qb = gld<v2u>(ARG_IN(9) + c), qg = gld<v2u>(ARG_IN(10) + c), ql = gld<v2u>(ARG_IN(11) + c);
                const float db0 = __uint_as_float(qb.x), db1 = __uint_as_float(qb.y), lg0 = __uint_as_float(qg.x), lg1 = __uint_as_float(qg.y), lb0 = __uint_as_float(ql.x), lb1 = __uint_as_float(ql.y);
                LAS float* part = (LAS float*)(lds + RING_OFF);
                LAS float* stat = part + 256;
                for (int rep = 0; rep < REP_THIN; ++rep)
                for (int run = vcu; run < T / 16; run += G) {
                    const int t0 = run * 16, s0 = t0 & (SEQ - 1);
                    unsigned r[46];
#pragma unroll
                    for (int j = 0; j < 46; ++j) r[j] = (s0 + j - 30 >= 0) ? gld<unsigned>(U + (size_t)(t0 + j - 30) * D + c) : 0u;
                    float a0[16], a1[16];
#pragma unroll
                    for (int i = 0; i < 16; ++i) { a0[i] = db0; a1[i] = db1; }
#pragma unroll
                    for (int j = 0; j < 46; ++j) { const float x0 = bf_lo(r[j]), x1 = bf_hi(r[j]);
#pragma unroll
                        for (int i = 0; i < 16; ++i) { const int k = j - i; if (k >= 0 && k <= 30) { a0[i] += wk0[k] * x0; a1[i] += wk1[k] * x1; } } }
                    float st[32];
#pragma unroll
                    for (int i = 0; i < 16; ++i) { st[2 * i] = a0[i] + a1[i]; st[2 * i + 1] = a0[i] * a0[i] + a1[i] * a1[i]; }
                    const float tot = butterfly32(st, lane);
                    if ((lane & 1) == 0) part[wave * 32 + (lane >> 1)] = tot;
                    __syncthreads();
                    if (tid < 16) { float S = 0.f, Q = 0.f;
#pragma unroll
                        for (int w8 = 0; w8 < 8; ++w8) { S += part[w8 * 32 + 2 * tid]; Q += part[w8 * 32 + 2 * tid + 1]; }
                        const float mean = S * (1.0f / D); const float var = fmaxf(Q * (1.0f / D) - mean * mean, 0.f);
                        stat[2 * tid] = mean; stat[2 * tid + 1] = 1.0f / sqrtf(var + LN_EPS); }
                    __syncthreads();
#pragma unroll
                    for (int i = 0; i < 16; ++i) { const float mean = stat[2 * i], rstd = stat[2 * i + 1];
                        const float y0 = (a0[i] - mean) * rstd * lg0 + lb0, y1 = (a1[i] - mean) * rstd * lg1 + lb1;
                        gst<unsigned>(M3 + (size_t)(t0 + i) * D + c, cvt_pk_bf16(y0 * sigmoidf_(y0), y1 * sigmoidf_(y1))); }
                }
                __syncthreads();
            }
        }
        GRID_BAR();

        {
            PHASE_BEGIN();
            const int n_my = pg8::build_units(lds, tid, T / 256, 4, G, bx, false, nullptr, REP_MIXG);
            pg8::GemmP gp; gp.A = (const char*)(ws + WS_M3); gp.lda2 = D * 2; gp.b_estride = 0; gp.sA = 0; gp.sB = 0;
            pg8::EpiOut E; E.xres = (const bf16*)(ws + WS_XAB); E.z = (bf16*)(ws + WS_ZB); E.bias = nullptr; E.scale = nullptr;
            if (kind == 0) { gp.acol_pn = 512; gp.Bt = (const char*)(ws + WS_WPOOL + (size_t)(layer / 3) * 1024 * 256 * 2); gp.Kb = 512; E.scale = ARG_IN(2) + (layer / 3) * D; }
            else if (kind == 1) { gp.acol_pn = 0; gp.Bt = (const char*)(ws + WS_WSCOUT); gp.Kb = 2048; }
            else { gp.acol_pn = 0; gp.Bt = (const char*)(ws + WS_WCFOUT); gp.Kb = 2048; E.bias = ARG_IN(13); }
            pg8::gemm_phase<false, false, pg8::EpiOut>(lds, tid, gp, n_my, E);
        }
        GRID_BAR();

        {
            PHASE_BEGIN();
            const bf16* Zb = (const bf16*)(ws + WS_ZB); bf16* X1b = (bf16*)(ws + WS_X1B); unsigned char* X18 = (unsigned char*)(ws + WS_X18);
            int* TIDX = (int*)(ws + WS_IDX); float* TGATE = (float*)(ws + WS_GATE);
            unsigned* CNT = ctl + CW_CNT + layer * NE;
            LAS float* rwl = (LAS float*)(lds + RING_OFF);
            const float* rw = ARG_IN(16) + (size_t)layer * D * NE;
            for (int idx = tid; idx < D * 8; idx += NTHR) { const int c = idx >> 3, eg = idx & 7; const int j = c >> 9, r = c & 511, l = r >> 3, ci = j * 8 + (r & 7);
                *(LAS f32x4*)(rwl + ((ci * 8 + eg) * 64 + l) * 4) = gld<f32x4>(rw + c * NE + eg * 4); }
            if (tid < NE) MISC[32 + tid] = 0u;
            __syncthreads();
            LAS f32x4* lnp = (LAS f32x4*)(lds + TOK_OFF);
            if (tid < 256) { const int q = tid >> 6, l = tid & 63; lnp[q * 64 + l] = gld<f32x4>(ARG_IN(14) + layer * D + chq(l, q)); lnp[(4 + q) * 64 + l] = gld<f32x4>(ARG_IN(15) + layer * D + chq(l, q)); }
            __syncthreads();
            const int myexp = (lane >> 1) & 31;
            const float rbias = gld<float>(ARG_IN(17) + layer * NE + myexp);
            LAS unsigned* hist = (LAS unsigned*)(lds + MISC_OFF) + 32;
            for (int rep = 0; rep < REP_LNR; ++rep)
            for (int tb = vcu; tb < T / 128; tb += G) {
                const int t0 = tb * 128 + wave * 16;
                v4u zn[2][2];
#pragma unroll
                for (int u = 0; u < 2; ++u)
#pragma unroll
                    for (int j = 0; j < 2; ++j) zn[u][j] = gld<v4u>(Zb + (size_t)(t0 + u) * D + j * 512 + 8 * lane);
                for (int ti = 0; ti < 16; ti += 2) {
                    const int t = t0 + ti;
                    float va[16], vb[16];
                    unpack8(zn[0][0], va); unpack8(zn[0][1], va + 8); unpack8(zn[1][0], vb); unpack8(zn[1][1], vb + 8);
                    if (ti + 2 < 16) {
#pragma unroll
                        for (int u = 0; u < 2; ++u)
#pragma unroll
                            for (int j = 0; j < 2; ++j) zn[u][j] = gld<v4u>(Zb + (size_t)(t + 2 + u) * D + j * 512 + 8 * lane); }
                    ln16_lds(va, lnp, lane); ln16_lds(vb, lnp, lane);
                    gst<v4u>(X1b + (size_t)t * D + 8 * lane, pack8(va)); gst<v4u>(X1b + (size_t)t * D + 512 + 8 * lane, pack8(va + 8));
                    gst<v4u>(X1b + (size_t)(t + 1) * D + 8 * lane, pack8(vb)); gst<v4u>(X1b + (size_t)(t + 1) * D + 512 + 8 * lane, pack8(vb + 8));
                    { float s8[16];
#pragma unroll
                      for (int i = 0; i < 16; ++i) s8[i] = va[i] * SX8;
                      gst<v2u>(X18 + (size_t)t * D + 8 * lane, pack8_fp8(s8)); gst<v2u>(X18 + (size_t)t * D + 512 + 8 * lane, pack8_fp8(s8 + 8));
#pragma unroll
                      for (int i = 0; i < 16; ++i) s8[i] = vb[i] * SX8;
                      gst<v2u>(X18 + (size_t)(t + 1) * D + 8 * lane, pack8_fp8(s8)); gst<v2u>(X18 + (size_t)(t + 1) * D + 512 + 8 * lane, pack8_fp8(s8 + 8)); }
                    f32x2 pa[16], pb[16];
#pragma unroll
                    for (int e = 0; e < 16; ++e) { pa[e] = (f32x2){0.f, 0.f}; pb[e] = (f32x2){0.f, 0.f}; }
                    f32x4 w0[8], w1[8];
#define RW_LOAD(dst, ci) do { _Pragma("unroll") for (int eg = 0; eg < 8; ++eg) dst[eg] = *(const LAS f32x4*)(rwl + (((ci) * 8 + eg) * 64 + lane) * 4); asm volatile("" ::: "memory"); } while (0)
#define RW_FMA(wsrc, ci) do { const f32x2 sa = (f32x2){va[ci], va[ci]}, sb = (f32x2){vb[ci], vb[ci]}; _Pragma("unroll") for (int eg = 0; eg < 8; ++eg) { \
                        const f32x2 lo = (f32x2){wsrc[eg][0], wsrc[eg][1]}, hi = (f32x2){wsrc[eg][2], wsrc[eg][3]}; \
                        pa[2 * eg] = __builtin_elementwise_fma(lo, sa, pa[2 * eg]); pa[2 * eg + 1] = __builtin_elementwise_fma(hi, sa, pa[2 * eg + 1]); \
                        pb[2 * eg] = __builtin_elementwise_fma(lo, sb, pb[2 * eg]); pb[2 * eg + 1] = __builtin_elementwise_fma(hi, sb, pb[2 * eg + 1]); } } while (0)
                    RW_LOAD(w0, 0);
#pragma unroll
                    for (int ci = 0; ci < 16; ci += 2) {
                        RW_LOAD(w1, ci + 1);
                        RW_FMA(w0, ci);
                        if (ci + 2 < 16) RW_LOAD(w0, ci + 2);
                        RW_FMA(w1, ci + 1);
                    }
#undef RW_LOAD
#undef RW_FMA
                    float qa[32], qb[32];
#pragma unroll
                    for (int e = 0; e < 16; ++e) { qa[2 * e] = pa[e][0]; qa[2 * e + 1] = pa[e][1]; qb[2 * e] = pb[e][0]; qb[2 * e + 1] = pb[e][1]; }
                    const float logitA = butterfly32(qa, lane) + rbias, logitB = butterfly32(qb, lane) + rbias;
                    route_token(logitA, myexp, lane, t, TIDX, TGATE, hist, rep == 0);
                    route_token(logitB, myexp, lane, t + 1, TIDX, TGATE, hist, rep == 0);
                }
            }
            __syncthreads();
            if (tid < NE) { const unsigned c = MISC[32 + tid]; if (c) (void)xb_add(CNT + tid, c); }
        }
        GRID_BAR();

        {
            PHASE_BEGIN();
            const int* TIDX = (const int*)(ws + WS_IDX); const float* TGATE = (const float*)(ws + WS_GATE);
            int* RTOK = (int*)(ws + WS_RTOK); int* RDST = (int*)(ws + WS_RDST); float* RGATE = (float*)(ws + WS_RGATE);
            unsigned* CNT = ctl + CW_CNT + layer * NE; unsigned* CUR = ctl + CW_CUR + layer * NE;
            LAS int* TS = (LAS int*)(lds + TS_OFF);
            if (tid == 0) { int a = 0; for (int e = 0; e < NE; ++e) { TS[e] = a; a += (int)((xb_ld(CNT + e) + 255u) >> 8); } TS[NE] = a; }
            for (int tb = vcu; tb < T / 128; tb += G) {
                __syncthreads();
                if (tid < NE) MISC[32 + tid] = 0u;
                __syncthreads();
                const int t = tb * 128 + (tid >> 2), k = tid & 3;
                const int e = gld<int>(TIDX + t * 4 + k); const float gv = gld<float>(TGATE + t * 4 + k);
                const unsigned rank = __hip_atomic_fetch_add((LAS unsigned*)(lds + MISC_OFF) + 32 + e, 1u, __ATOMIC_RELAXED, __HIP_MEMORY_SCOPE_WORKGROUP);
                __syncthreads();
                if (tid < NE) { const unsigned c = MISC[32 + tid]; MISC[64 + tid] = c ? xb_add(CUR + tid, c) : 0u; }
                __syncthreads();
                const int pos = TS[e] * 256 + (int)MISC[64 + e] + (int)rank;
                gst<int>(RTOK + pos, t); gst<int>(RDST + pos, t * 4 + k); gst<float>(RGATE + pos, gv);
            }
            __syncthreads();
            for (int e = vcu; e < NE; e += G) {
                const int beg = TS[e] * 256 + (int)xb_ld(CNT + e), end = TS[e + 1] * 256;
                for (int p = beg + tid; p < end; p += NTHR) { gst<int>(RTOK + p, 0); gst<int>(RDST + p, -1); gst<float>(RGATE + p, 0.f); }
            }
        }
        GRID_BAR();

        {
            PHASE_BEGIN();
            unsigned* CNT = ctl + CW_CNT + layer * NE;
            LAS int* TS = (LAS int*)(lds + TS_OFF);
            __syncthreads();
            if (tid == 0) { int a = 0; for (int e = 0; e < NE; ++e) { TS[e] = a; a += (int)((xb_ld(CNT + e) + 255u) >> 8); } TS[NE] = a; }
            __syncthreads();
            const int nM = TS[NE];
            const int n_my = pg8::build_units(lds, tid, nM, 8, G, bx, true, (const int*)(ws + WS_RTOK), REP_MOE1);
            pg8::GemmP gp; gp.A = (const char*)(ws + WS_X18); gp.lda2 = D; gp.acol_pn = 0; gp.Bt = (const char*)(ws + WS_WGU + (size_t)layer * NE * 2048 * 1024); gp.b_estride = (size_t)2048 * 1024; gp.Kb = 1024; gp.sA = E8_X; gp.sB = E8_W;
            pg8::EpiSwiglu E; E.act = (unsigned char*)(ws + WS_ACT); E.bgu = ARG_IN(19) + (size_t)layer * NE * 2048;
            pg8::gemm_phase<true, true, pg8::EpiSwiglu>(lds, tid, gp, n_my, E, REP_MOE1 > 1 ? n_my / 2 : (1 << 20));
        }
        GRID_BAR();

        {
            PHASE_BEGIN();
            LAS int* TS = (LAS int*)(lds + TS_OFF);
            const int nM = TS[NE];
            const int n_my = pg8::build_units(lds, tid, nM, 4, G, bx, true, nullptr, REP_MOE2);
            pg8::GemmP gp; gp.A = (const char*)(ws + WS_ACT); gp.lda2 = D; gp.acol_pn = 0; gp.Bt = (const char*)(ws + WS_WDN + (size_t)layer * NE * 1024 * 1024); gp.b_estride = (size_t)1024 * 1024; gp.Kb = 1024; gp.sA = E8_ACT; gp.sB = E8_W;
            pg8::EpiMoe2 E; E.Y = (bf16*)(ws + WS_Y); E.bdn = ARG_IN(21) + (size_t)layer * NE * D; E.rowdst = (const int*)(ws + WS_RDST); E.rowgate = (const float*)(ws + WS_RGATE);
            pg8::gemm_phase<false, true, pg8::EpiMoe2>(lds, tid, gp, n_my, E);
        }
        GRID_BAR();

        {
            PHASE_BEGIN();
            const bf16* X1b = (const bf16*)(ws + WS_X1B); const bf16* Y = (const bf16*)(ws + WS_Y); float* OUT = ARG_OUT(); bf16* XAb = (bf16*)(ws + WS_XAB);
            float lg[16], lb[16];
#pragma unroll
            for (int q = 0; q < 4; ++q) { const f32x4 b = gld<f32x4>(ARG_IN(22) + layer * D + chq(lane, q)), c = gld<f32x4>(ARG_IN(23) + layer * D + chq(lane, q));
#pragma unroll
                for (int i = 0; i < 4; ++i) { lg[4 * q + i] = b[i]; lb[4 * q + i] = c[i]; } }
            for (int rep = 0; rep < REP_THIN; ++rep)
            for (int tb = vcu; tb < T / 128; tb += G) {
                const int t0 = tb * 128 + wave * 16;
                v4u nx[2], ny[4][2];
#pragma unroll
                for (int j = 0; j < 2; ++j) { nx[j] = gld<v4u>(X1b + (size_t)t0 * D + j * 512 + 8 * lane);
#pragma unroll
                    for (int k = 0; k < 4; ++k) ny[k][j] = gld<v4u>(Y + (size_t)(t0 * 4 + k) * D + j * 512 + 8 * lane); }
                for (int ti = 0; ti < 16; ++ti) {
                    const int t = t0 + ti;
                    float v[16], h[16];
                    unpack8(nx[0], v); unpack8(nx[1], v + 8);
#pragma unroll
                    for (int i = 0; i < 16; ++i) { v[i] *= ALPHA; h[i] = 0.f; }
#pragma unroll
                    for (int k = 0; k < 4; ++k) { float y[16]; unpack8(ny[k][0], y); unpack8(ny[k][1], y + 8);
#pragma unroll
                        for (int i = 0; i < 16; ++i) h[i] += y[i]; }
                    if (ti + 1 < 16) {
#pragma unroll
                        for (int j = 0; j < 2; ++j) { nx[j] = gld<v4u>(X1b + (size_t)(t + 1) * D + j * 512 + 8 * lane);
#pragma unroll
                            for (int k = 0; k < 4; ++k) ny[k][j] = gld<v4u>(Y + (size_t)((t + 1) * 4 + k) * D + j * 512 + 8 * lane); } }
#pragma unroll
                    for (int i = 0; i < 16; ++i) v[i] += h[i];
                    ln16(v, lg, lb, lane);
                    if (layer == DEPTH - 1) {
#pragma unroll
                        for (int q = 0; q < 4; ++q) gst<f32x4>(OUT + (size_t)t * D + chq(lane, q), (f32x4){v[4 * q], v[4 * q + 1], v[4 * q + 2], v[4 * q + 3]});
                    } else {
                        gst<v4u>(XAb + (size_t)t * D + 8 * lane, pack8(v));
                        gst<v4u>(XAb + (size_t)t * D + 512 + 8 * lane, pack8(v + 8));
                    }
                }
            }
        }
        if (layer + 1 < DEPTH) GRID_BAR();
    }
}

extern "C" void kernel_launch(void* const* d_in, const int* in_sizes, int n_in, void* d_out, int out_size, void* d_ws, size_t ws_size, hipStream_t stream) {
    static int grid = 0;
    if (grid == 0) {
        if (n_in != 24 || out_size != T * D || ws_size < WS_END) { fprintf(stderr, "kernel_launch: unexpected shapes (n_in %d out %d ws %zu)\n", n_in, out_size, ws_size); grid = -1; return; }
        if (hipFuncSetAttribute((const void*)mega_fwd, hipFuncAttributeMaxDynamicSharedMemorySize, LDS_BYTES) != hipSuccess) { fprintf(stderr, "kernel_launch: hipFuncSetAttribute failed\n"); grid = -1; return; }
        int dev = 0, cus = 0, per_cu = 0;
        (void)hipGetDevice(&dev); (void)hipDeviceGetAttribute(&cus, hipDeviceAttributeMultiprocessorCount, dev);
        if (hipOccupancyMaxActiveBlocksPerMultiprocessor(&per_cu, (const void*)mega_fwd, NTHR, LDS_BYTES) != hipSuccess || per_cu < 1) fprintf(stderr, "kernel_launch: occupancy query reports %d blocks per CU\n", per_cu);
        (void)hipGetLastError();
        grid = 256; if (cus > 0 && cus < grid) grid = cus;
    }
    if (grid < 0) return;
    (void)hipMemsetAsync((char*)d_ws + WS_CTL, 0, CTL_ZERO_BYTES, stream);
    Args a{};
    for (int i = 0; i < 24; ++i) a.in[i] = (const float*)d_in[i];
    a.out = (float*)d_out; a.ws = (unsigned char*)d_ws;
    hipLaunchKernelGGL(mega_fwd, dim3(grid), dim3(NTHR), LDS_BYTES, stream, a);
    const hipError_t le = hipPeekAtLastError();
    if (le != hipSuccess) fprintf(stderr, "kernel_launch: launch failed: %s\n", hipGetErrorName(le));
}
```

```cpp
#include <hip/hip_runtime.h>
#include <cstdio>
#include <cstdint>

#define GAS __attribute__((address_space(1)))
#define LAS __attribute__((address_space(3)))
typedef unsigned short bf16;
typedef unsigned v4u __attribute__((ext_vector_type(4)));
typedef unsigned v2u __attribute__((ext_vector_type(2)));
typedef float f32x4 __attribute__((ext_vector_type(4)));
typedef float f32x2 __attribute__((ext_vector_type(2)));
typedef short bf16x8 __attribute__((ext_vector_type(8)));
typedef int v4i __attribute__((ext_vector_type(4)));
typedef int v8i __attribute__((ext_vector_type(8)));

template <class V> __device__ __forceinline__ V gld(const void* p) { return *(const GAS V*)p; }
template <class V> __device__ __forceinline__ void gst(void* p, V v) { *(GAS V*)p = v; }

#ifndef REP_P0
#define REP_P0 1
#endif
#ifndef REP_MOE1
#define REP_MOE1 1
#endif
#ifndef REP_MOE2
#define REP_MOE2 1
#endif
#ifndef REP_THIN
#define REP_THIN 1
#endif
#ifndef REP_MIXG
#define REP_MIXG 1
#endif
#ifndef REP_LNR
#define REP_LNR 1
#endif
constexpr int T = 32768, D = 1024, SEQ = 4096, NE = 32, TOPK = 4, NA = T * TOPK, DEPTH = 4;
constexpr int MAXTILES = NA / 256 + NE;
constexpr int NPAD = MAXTILES * 256;
constexpr float LN_EPS = 1e-5f;
constexpr float ALPHA = 1.681792830507429f;
constexpr int NWAVES = 8, NTHR = 512;
constexpr int MAXU = 17;
constexpr float SX8 = 16.0f, SACT8 = 4.0f, SW8 = 256.0f, SY8 = 64.0f;
constexpr int E8_X = 0x7B7B7B7B  , E8_ACT = 0x7D7D7D7D  , E8_W = 0x77777777  ;

constexpr size_t MiB = 1u << 20;
constexpr size_t WS_CTL = 0, CTL_ZERO_BYTES = 1 * MiB;
constexpr size_t WS_IDX = 1 * MiB;
constexpr size_t WS_GATE = 1 * MiB + 512 * 1024;
constexpr size_t WS_RTOK = 2 * MiB;
constexpr size_t WS_RDST = 3 * MiB;
constexpr size_t WS_RGATE = 4 * MiB;
constexpr size_t WS_WPOOL = 5 * MiB;
constexpr size_t WS_WSCIN = 6 * MiB;
constexpr size_t WS_WSCOUT = 12 * MiB;
constexpr size_t WS_WCFIN = 14 * MiB;
constexpr size_t WS_WCFOUT = 18 * MiB;
constexpr size_t WS_WGU = 32 * MiB;
constexpr size_t WS_WDN = 544 * MiB;
constexpr size_t WS_X18 = 704 * MiB;
constexpr size_t WS_ZB = 800 * MiB;
constexpr size_t WS_XAB = 864 * MiB;
constexpr size_t WS_X1B = 928 * MiB;
constexpr size_t WS_M1 = 992 * MiB;
constexpr size_t WS_M2 = 1056 * MiB;
constexpr size_t WS_M3 = 1120 * MiB;
constexpr size_t WS_ACT = 1184 * MiB;
constexpr size_t WS_Y = 1456 * MiB;
constexpr size_t WS_END = 1712 * MiB;
constexpr int CW_BAR = 4096;
constexpr int CW_CNT = 8192;
constexpr int CW_CUR = 8192 + 256;

constexpr int RING_OFF = 0, RING_BYTES = 131072;
constexpr int TOK_OFF = RING_BYTES;
constexpr int UT_OFF = TOK_OFF + MAXU * 1024;
constexpr int TS_OFF = UT_OFF + (2 * MAXU + 2) * 16;
constexpr int MISC_OFF = TS_OFF + 36 * 4;
constexpr int LDS_BYTES = MISC_OFF + 128 * 4;
static_assert(LDS_BYTES <= 160 * 1024 && (MISC_OFF % 16) == 0, "LDS map");

#define LDS_WAIT() asm volatile("s_waitcnt lgkmcnt(0)" ::: "memory")
#define VM_WAIT() asm volatile("s_waitcnt vmcnt(0)" ::: "memory")

__device__ __forceinline__ unsigned cvt_pk_bf16(float lo, float hi) { unsigned r; asm volatile("v_cvt_pk_bf16_f32 %0, %1, %2" : "=v"(r) : "v"(lo), "v"(hi)); return r; }
__device__ __forceinline__ v2u pack8_fp8(const float* v) { int a = __builtin_amdgcn_cvt_pk_fp8_f32(v[0], v[1], 0, false); a = __builtin_amdgcn_cvt_pk_fp8_f32(v[2], v[3], a, true);
    int b = __builtin_amdgcn_cvt_pk_fp8_f32(v[4], v[5], 0, false); b = __builtin_amdgcn_cvt_pk_fp8_f32(v[6], v[7], b, true); v2u w; w.x = (unsigned)a; w.y = (unsigned)b; return w; }
__device__ __forceinline__ float bf_lo(unsigned u) { return __uint_as_float(u << 16); }
__device__ __forceinline__ float bf_hi(unsigned u) { return __uint_as_float(u & 0xffff0000u); }
__device__ __forceinline__ float sigmoidf_(float x) { return __builtin_amdgcn_rcpf(1.0f + __expf(-x)); }
__device__ __forceinline__ float shx(float v, int mask, int lane) { return __uint_as_float((unsigned)__builtin_amdgcn_ds_bpermute((lane ^ mask) << 2, (int)__float_as_uint(v))); }
__device__ __forceinline__ float wave_sum(float v, int lane) {
#pragma unroll
    for (int o = 1; o < 64; o <<= 1) v += shx(v, o, lane);
    return v;
}

#define XB_TMO      128
#define XB_XCNT(j)  (256  + 64 * (j))
#define XB_XSUB(j)  (1280 + 64 * (j))
#define XB_XGEN(j)  (2304 + 64 * (j))
#define XB_TOP      3328
#define XB_TOPGEN   3392
#define XCD_BAR_WORDS 3456
#define XB_SPIN_CAP (1u << 18)

__device__ __forceinline__ unsigned xb_ld(unsigned* p)              { return __hip_atomic_load((GAS unsigned*)p, __ATOMIC_RELAXED, __HIP_MEMORY_SCOPE_AGENT); }
__device__ __forceinline__ unsigned xb_add(unsigned* p, unsigned v) { return __hip_atomic_fetch_add((GAS unsigned*)p, v, __ATOMIC_RELAXED, __HIP_MEMORY_SCOPE_AGENT); }
__device__ __forceinline__ unsigned xb_xcc_id() { return (unsigned)__builtin_amdgcn_s_getreg((3 << 11) | 20) & 0xFu; }
#define XB_SPIN(cond, bar) do { unsigned _sp = 0; while (cond) { __builtin_amdgcn_s_sleep(1); \
    if ((++_sp & 255u) == 0u) { if (xb_ld(&(bar)[XB_TMO])) break; if (_sp > XB_SPIN_CAP) { (void)xb_add(&(bar)[XB_TMO], 1u); break; } } } } while (0)

struct XcdBarrier { unsigned* bar; unsigned x; volatile LAS unsigned* st; };

__device__ __forceinline__ XcdBarrier xcd_barrier_post(unsigned* bar, volatile LAS unsigned* st) {
    XcdBarrier b; b.bar = bar; b.x = xb_xcc_id(); b.st = st;
    if (threadIdx.x == 0) (void)xb_add(&bar[XB_XCNT(b.x)], 1u);
    return b;
}
__device__ __forceinline__ void xcd_barrier_complete(unsigned* bar, unsigned x, unsigned& nloc, unsigned& nx) {
    const unsigned G = gridDim.x * gridDim.y * gridDim.z;
    unsigned sum, cnt, mine, sp = 0u;
    for (;;) {
        sum = 0u; cnt = 0u; mine = 0u;
#pragma unroll
        for (unsigned j = 0; j < 16; ++j) { const unsigned c = xb_ld(&bar[XB_XCNT(j)]); sum += c; cnt += (c > 0u) ? 1u : 0u; mine = (j == x) ? c : mine; }
        if (sum == G) break;
        __builtin_amdgcn_s_sleep(1);
        if ((++sp & 255u) == 0u) { if (xb_ld(&bar[XB_TMO])) break; if (sp > XB_SPIN_CAP) { (void)xb_add(&bar[XB_TMO], 1u); break; } }
    }
    nloc = mine > 0u ? mine : 1u; nx = cnt > 0u ? cnt : 1u;
}
__device__ __forceinline__ void xcd_barrier(const XcdBarrier& b) {
    asm volatile("s_waitcnt vmcnt(0)" ::: "memory");
    __syncthreads();
    if (threadIdx.x == 0) {
        unsigned* bar = b.bar;
        __builtin_amdgcn_s_waitcnt(0);
        unsigned nloc = b.st[0], nx = b.st[1];
        if (nloc == 0u) { xcd_barrier_complete(bar, b.x, nloc, nx); b.st[0] = nloc; b.st[1] = nx; }
        const unsigned old = xb_add(&bar[XB_XSUB(b.x)], 1u);
        const unsigned gen = old / nloc;
        if (old + 1u == (gen + 1u) * nloc) {
            __builtin_amdgcn_fence(__ATOMIC_RELEASE, "agent");
            asm volatile("s_waitcnt vmcnt(0)" ::: "memory");
            const unsigned og = xb_add(&bar[XB_TOP], 1u);
            const unsigned tg = og / nx;
            if (og + 1u == (tg + 1u) * nx) xb_add(&bar[XB_TOPGEN], 1u);
            else XB_SPIN(xb_ld(&bar[XB_TOPGEN]) == tg, bar);
            __builtin_amdgcn_fence(__ATOMIC_ACQUIRE, "agent");
            xb_add(&bar[XB_XGEN(b.x)], 1u);
            asm volatile("s_waitcnt vmcnt(0)" ::: "memory");
        } else {
            XB_SPIN(xb_ld(&bar[XB_XGEN(b.x)]) == gen, bar);
            __builtin_amdgcn_fence(__ATOMIC_ACQUIRE, "agent");
            asm volatile("s_waitcnt vmcnt(0)" ::: "memory");
        }
    }
    __syncthreads();
}

namespace pg8 {
constexpr int BM = 256, BK = 64, HALF = 128, HTB = HALF * BK * 2, STAGE_BYTES = 8 * HTB, NXCD = 8, WGM = 8;
__host__ __device__ __forceinline__ int lds_byte(int r, int c) { const int st = (r >> 4) * 2 + (c >> 5), rr = r & 15, cc = c & 31, ob = rr * 64 + cc * 2; return st * 1024 + (ob ^ (((ob >> 9) & 1) << 5)); }
__host__ __device__ __forceinline__ void stage_rc(int b, int& R, int& C) { const int st = b / 1024, sb = b % 1024, swz = sb ^ (((sb >> 9) & 1) << 5); R = (st >> 1) * 16 + swz / 64; C = (st & 1) * 32 + (swz % 64) / 2; }
__host__ __device__ __forceinline__ int perm32(int rho) { const int n = rho >> 4, i = rho & 15; return 8 * (i >> 2) + 4 * n + (i & 3); }

struct Unit { int pm, pn, e; };
struct GemmP {
    const char* A; unsigned lda2;
    unsigned acol_pn;
    const char* Bt; size_t b_estride;
    int Kb;
    int sA, sB;
};

__device__ __forceinline__ void unit_of(int L, int nM, int nN, int& pm, int& pn) {
    const int nwg = nM * nN;
    int wgid = L; { const int q = nwg / NXCD, r = nwg % NXCD, xcd = wgid % NXCD, off = wgid / NXCD; wgid = (xcd < r ? xcd * (q + 1) : r * (q + 1) + (xcd - r) * q) + off; }
    const int nig = WGM * nN, gid = wgid / nig, fm = gid * WGM, gsz = (nM - fm) < WGM ? (nM - fm) : WGM;
    pm = fm + ((wgid % nig) % gsz); pn = (wgid % nig) / gsz;
}
__device__ __forceinline__ int build_units(LAS unsigned char* lds, const int tid, int nM, int nN, int G, int c, bool moe, const int* row_tok, const int dup = 1) {
    LAS int* UT = (LAS int*)(lds + UT_OFF); LAS const int* TS = (LAS const int*)(lds + TS_OFF); LAS int* TOK = (LAS int*)(lds + TOK_OFF);
    const int nwg = nM * nN;
    int n_my = (nwg > c) ? (nwg - c + G - 1) / G : 0; if (n_my > MAXU) n_my = MAXU;
    if (tid < n_my) {
        int pm, pn; unit_of(tid * G + c, nM, nN, pm, pn);
        int e = 0; if (moe) { while (e < NE - 1 && TS[e + 1] <= pm) ++e; }
        UT[4 * tid + 0] = pm; UT[4 * tid + 1] = pn; UT[4 * tid + 2] = e; UT[4 * tid + 3] = 0;
    }
    __syncthreads();
    if (row_tok) {
        for (int idx = tid; idx < n_my * 256; idx += NTHR) { const int i = idx >> 8, r = idx & 255; TOK[idx] = gld<int>(row_tok + UT[4 * i] * 256 + r); }
    }
    __syncthreads();
    if (dup > 1) { if (tid < n_my) { UT[4 * (tid + n_my) + 0] = UT[4 * tid]; UT[4 * (tid + n_my) + 1] = UT[4 * tid + 1]; UT[4 * (tid + n_my) + 2] = UT[4 * tid + 2]; UT[4 * (tid + n_my) + 3] = 0; } __syncthreads(); return 2 * n_my; }
    return n_my;
}
__device__ __forceinline__ Unit read_unit(LAS const int* UT, int i) {
    Unit u; u.pm = __builtin_amdgcn_readfirstlane(UT[4 * i]); u.pn = __builtin_amdgcn_readfirstlane(UT[4 * i + 1]); u.e = __builtin_amdgcn_readfirstlane(UT[4 * i + 2]); return u;
}
template <bool GATHER>
__device__ __forceinline__ void a_offsets(unsigned (&v)[2][2], const GemmP& g, const Unit& u, int ui, const int (&Rr)[2], const int (&Cc2)[2], LAS const int* TOK, const int tokn) {
#pragma unroll
    for (int h = 0; h < 2; ++h)
#pragma unroll
        for (int i = 0; i < 2; ++i) {
            const int row = GATHER ? TOK[(ui >= tokn ? ui - tokn : ui) * 256 + h * HALF + Rr[i]] : (u.pm * BM + h * HALF + Rr[i]);
            v[h][i] = (unsigned)row * g.lda2 + (unsigned)Cc2[i] + (unsigned)u.pn * g.acol_pn;
        }
}

template <bool GATHER, bool FP8, class Epi>
__device__ __forceinline__ void gemm_phase(LAS unsigned char* lds, const int tid, const GemmP g, const int n_my, const Epi& E, const int tokn = 1 << 20) {
    const int wid = __builtin_amdgcn_readfirstlane(tid >> 6), lane = tid & 63, wr = wid >> 2, wc = wid & 3, fr = lane & 15, fq = lane >> 4;
    const int Kb = g.Kb, nt = Kb / (BK * 2);
    if (n_my <= 0) return;
    int Rr[2], Cc2[2]; unsigned voffB[2];
#pragma unroll
    for (int i = 0; i < 2; ++i) { int R, C; stage_rc(tid * 16 + i * 8192, R, C); const int Rb = Epi::PERM ? ((R & ~31) + perm32(R & 31)) : R;
        Rr[i] = R; Cc2[i] = C * 2; voffB[i] = (unsigned)(Rb * Kb + C * 2); }
    const size_t kstep = (size_t)(BK * 2);
    const size_t hstep = (size_t)HALF * Kb;
    const size_t tstepB = 2 * hstep;
    const unsigned ldsw = (unsigned)wid * 1024u;
    const int aoff = lds_byte(wr * 64 + fr, fq * 8), boff = lds_byte(wc * 32 + fr, fq * 8);
    LAS const int* UT = (LAS const int*)(lds + UT_OFF); LAS const int* TOK = (LAS const int*)(lds + TOK_OFF);
#define PG8_SA(b, h) (((b) * 2 + (h)) * HTB)
#define PG8_SB(b, h) ((4 + (b) * 2 + (h)) * HTB)
#define PG8_STAGE(bufoff, gbase, voff) do { _Pragma("unroll") for (int _i = 0; _i < 2; ++_i) \
        __builtin_amdgcn_global_load_lds((const unsigned*)((const char*)(gbase) + (voff)[_i]), (LAS unsigned*)(lds + (bufoff) + ldsw + _i * 8192), 16, 0, 0); } while (0)
#define PG8_LDA(dst, b, h) do { _Pragma("unroll") for (int m = 0; m < 4; ++m) _Pragma("unroll") for (int k = 0; k < 2; ++k) dst[m][k] = *(const LAS bf16x8*)(lds + PG8_SA(b, h) + aoff + m * 2048 + k * 1024); } while (0)
#define PG8_LDB(dst, b, h) do { _Pragma("unroll") for (int n = 0; n < 2; ++n) _Pragma("unroll") for (int k = 0; k < 2; ++k) dst[n][k] = *(const LAS bf16x8*)(lds + PG8_SB(b, h) + boff + n * 2048 + k * 1024); } while (0)
#define PG8_CAT(x) __builtin_shufflevector(__builtin_bit_cast(v4i, (x)[0]), __builtin_bit_cast(v4i, (x)[1]), 0, 1, 2, 3, 4, 5, 6, 7)
#define PG8_MMA(ai, bj, At, Bt) do { __builtin_amdgcn_s_setprio(1); _Pragma("unroll") for (int m = 0; m < 4; ++m) _Pragma("unroll") for (int n = 0; n < 2; ++n) { \
        if constexpr (FP8) { const v8i b8_ = PG8_CAT(Bt[n]), a8_ = PG8_CAT(At[m]); asm volatile("v_mfma_scale_f32_16x16x128_f8f6f4 %0, %1, %2, %0, %3, %4 op_sel_hi:[0,0,0]" : "+v"(acc[ai][bj][m][n]) : "v"(b8_), "v"(a8_), "v"(vsB), "v"(vsA)); } \
        else { _Pragma("unroll") for (int k = 0; k < 2; ++k) acc[ai][bj][m][n] = __builtin_amdgcn_mfma_f32_16x16x32_bf16(Bt[n][k], At[m][k], acc[ai][bj][m][n], 0, 0, 0); } } \
        __builtin_amdgcn_s_setprio(0); } while (0)
#define PG8_WAIT_V(n) asm volatile("s_waitcnt vmcnt(" #n ")" ::: "memory")
#define PG8_WAIT_L(n) asm volatile("s_waitcnt lgkmcnt(" #n ")" ::: "memory")
#define PG8_BAR __builtin_amdgcn_s_barrier()
#define PG8_SCHED __builtin_amdgcn_sched_barrier(0)
    Unit cur = read_unit(UT, 0), nxt; int ui = 0;
    f32x4 acc[2][2][4][2];
#pragma unroll
    for (int a = 0; a < 2; ++a)
#pragma unroll
        for (int b = 0; b < 2; ++b)
#pragma unroll
            for (int m = 0; m < 4; ++m)
#pragma unroll
                for (int n = 0; n < 2; ++n) acc[a][b][m][n] = (f32x4){0.f, 0.f, 0.f, 0.f};
#define PG8_PIN_ACC() do { if constexpr (FP8) { _Pragma("unroll") for (int a_ = 0; a_ < 2; ++a_) _Pragma("unroll") for (int b_ = 0; b_ < 2; ++b_) \
        asm volatile("" : "+v"(acc[a_][b_][0][0]), "+v"(acc[a_][b_][0][1]), "+v"(acc[a_][b_][1][0]), "+v"(acc[a_][b_][1][1]), "+v"(acc[a_][b_][2][0]), "+v"(acc[a_][b_][2][1]), "+v"(acc[a_][b_][3][0]), "+v"(acc[a_][b_][3][1])); \
        asm volatile("s_nop 1" ::: "memory"); } } while (0)
    PG8_PIN_ACC();
    bf16x8 At[4][2], B0[2][2], B1[2][2];
    int vsA = g.sA, vsB = g.sB; asm volatile("" : "+v"(vsA), "+v"(vsB));
    unsigned vAc[2][2], vAn[2][2];
    a_offsets<GATHER>(vAc, g, cur, 0, Rr, Cc2, TOK, tokn);
    const char* const Ab = g.A;
    const char* cB = g.Bt + (size_t)cur.e * g.b_estride + (size_t)cur.pn * tstepB;
    PG8_STAGE(PG8_SB(0, 0), cB, voffB); PG8_STAGE(PG8_SB(0, 1), cB + hstep, voffB); PG8_STAGE(PG8_SA(0, 0), Ab, vAc[0]); PG8_STAGE(PG8_SA(0, 1), Ab, vAc[1]);
    if (wr == 1) PG8_BAR;
    PG8_WAIT_V(2); PG8_BAR;
    PG8_STAGE(PG8_SB(1, 0), cB + kstep, voffB); PG8_STAGE(PG8_SA(1, 0), Ab + kstep, vAc[0]); PG8_STAGE(PG8_SB(1, 1), cB + hstep + kstep, voffB);
    PG8_WAIT_V(6); PG8_BAR;
    for (;;) {
        const bool has_next = (ui + 1 < n_my);
        nxt = cur; if (has_next) nxt = read_unit(UT, ui + 1);
        const char* nB = has_next ? g.Bt + (size_t)nxt.e * g.b_estride + (size_t)nxt.pn * tstepB : cB;
        for (int t = 0; t < nt; t += 2) {
            const bool last = (t == nt - 2);
            const char* a1 = Ab + (size_t)(t + 1) * kstep;
            const char* a2 = last ? Ab : Ab + (size_t)(t + 2) * kstep; const char* b2 = last ? nB : cB + (size_t)(t + 2) * kstep;
            const char* a3 = a2 + kstep; const char* b3 = b2 + kstep;
            unsigned o2[2][2];
            if (last) {
                if (has_next) a_offsets<GATHER>(vAn, g, nxt, ui + 1, Rr, Cc2, TOK, tokn);
                else { vAn[0][0] = vAc[0][0]; vAn[0][1] = vAc[0][1]; vAn[1][0] = vAc[1][0]; vAn[1][1] = vAc[1][1]; }
                o2[0][0] = vAn[0][0]; o2[0][1] = vAn[0][1]; o2[1][0] = vAn[1][0]; o2[1][1] = vAn[1][1];
            } else { o2[0][0] = vAc[0][0]; o2[0][1] = vAc[0][1]; o2[1][0] = vAc[1][0]; o2[1][1] = vAc[1][1]; }
            PG8_LDB(B0, 0, 0); PG8_LDB(B1, 0, 1); PG8_SCHED; PG8_LDA(At, 0, 0); PG8_STAGE(PG8_SA(1, 1), a1, vAc[1]);
            PG8_WAIT_V(8); PG8_WAIT_L(0); PG8_BAR; PG8_MMA(0, 0, At, B0); PG8_MMA(0, 1, At, B1); PG8_BAR; PG8_SCHED;
            PG8_LDA(At, 0, 1); PG8_STAGE(PG8_SB(0, 0), b2, voffB); PG8_STAGE(PG8_SB(0, 1), b2 + hstep, voffB); PG8_STAGE(PG8_SA(0, 0), a2, o2[0]);
            PG8_WAIT_V(8); PG8_WAIT_L(0); PG8_BAR; PG8_MMA(1, 0, At, B0); PG8_MMA(1, 1, At, B1); PG8_BAR; PG8_SCHED;
            PG8_LDB(B0, 1, 0); PG8_LDB(B1, 1, 1); PG8_SCHED; PG8_LDA(At, 1, 0); PG8_STAGE(PG8_SA(0, 1), a2, o2[1]);
            PG8_WAIT_V(8); PG8_WAIT_L(0); PG8_BAR; PG8_MMA(0, 0, At, B0); PG8_MMA(0, 1, At, B1); PG8_BAR; PG8_SCHED;
            PG8_LDA(At, 1, 1); PG8_STAGE(PG8_SB(1, 0), b3, voffB); PG8_STAGE(PG8_SB(1, 1), b3 + hstep, voffB); PG8_STAGE(PG8_SA(1, 0), a3, o2[0]);
            PG8_WAIT_V(8); PG8_WAIT_L(0); PG8_BAR; PG8_MMA(1, 0, At, B0); PG8_MMA(1, 1, At, B1); PG8_BAR; PG8_SCHED;
        }
        if (wr == 0) PG8_BAR;
        if constexpr (FP8) asm volatile("s_nop 15" ::: "memory");
        E(acc, cur, wr, wc, fr, fq);
        if (!has_next) break;
#pragma unroll
        for (int a = 0; a < 2; ++a)
#pragma unroll
            for (int b = 0; b < 2; ++b)
#pragma unroll
                for (int m = 0; m < 4; ++m)
#pragma unroll
                    for (int n = 0; n < 2; ++n) acc[a][b][m][n] = (f32x4){0.f, 0.f, 0.f, 0.f};
        PG8_PIN_ACC();
        cur = nxt; cB = nB; ++ui;
        vAc[0][0] = vAn[0][0]; vAc[0][1] = vAn[0][1]; vAc[1][0] = vAn[1][0]; vAc[1][1] = vAn[1][1];
        if (wr == 1) PG8_BAR;
    }
    PG8_WAIT_V(0);
    PG8_BAR;
#undef PG8_SA
#undef PG8_SB
#undef PG8_STAGE
#undef PG8_LDA
#undef PG8_LDB
#undef PG8_MMA
#undef PG8_PIN_ACC
#undef PG8_CAT
#undef PG8_WAIT_V
#undef PG8_WAIT_L
#undef PG8_BAR
#undef PG8_SCHED
}

struct EpiOut {
    static constexpr bool PERM = true;
    const bf16* xres; bf16* z; const float* bias; const float* scale;
    __device__ __forceinline__ void operator()(const f32x4 (&acc)[2][2][4][2], const Unit& u, int wr, int wc, int fr, int fq) const {
        const int row0 = u.pm * BM + wr * 64 + fr, c0 = u.pn * BM + wc * 32 + 8 * fq;
        f32x4 bv[2][2], sv[2][2];
#pragma unroll
        for (int bj = 0; bj < 2; ++bj)
#pragma unroll
            for (int n = 0; n < 2; ++n) {
                bv[bj][n] = bias ? gld<f32x4>(bias + c0 + bj * HALF + 4 * n) : (f32x4){0.f, 0.f, 0.f, 0.f};
                sv[bj][n] = scale ? gld<f32x4>(scale + c0 + bj * HALF + 4 * n) : (f32x4){1.f, 1.f, 1.f, 1.f};
            }
#pragma unroll
        for (int ai = 0; ai < 2; ++ai)
#pragma unroll
            for (int m = 0; m < 4; ++m) { const size_t off = (size_t)(row0 + ai * HALF + m * 16) * D + c0;
#pragma unroll
                for (int bj = 0; bj < 2; ++bj) { const v4u xr = gld<v4u>(xres + off + bj * HALF);
                    const f32x4 x0 = (f32x4){bf_lo(xr.x), bf_hi(xr.x), bf_lo(xr.y), bf_hi(xr.y)}, x1 = (f32x4){bf_lo(xr.z), bf_hi(xr.z), bf_lo(xr.w), bf_hi(xr.w)};
                    const f32x4 o0 = x0 * ALPHA + (acc[ai][bj][m][0] + bv[bj][0]) * sv[bj][0], o1 = x1 * ALPHA + (acc[ai][bj][m][1] + bv[bj][1]) * sv[bj][1];
                    v4u w; w.x = cvt_pk_bf16(o0[0], o0[1]); w.y = cvt_pk_bf16(o0[2], o0[3]); w.z = cvt_pk_bf16(o1[0], o1[1]); w.w = cvt_pk_bf16(o1[2], o1[3]);
                    gst<v4u>(z + off + bj * HALF, w); }
                asm volatile("" ::: "memory"); }
    }
};
struct EpiPair {
    static constexpr bool PERM = true;
    bf16* O1; bf16* O2; const float* bias; int mode;
    __device__ __forceinline__ void operator()(const f32x4 (&acc)[2][2][4][2], const Unit& u, int wr, int wc, int fr, int fq) const {
        const int row0 = u.pm * BM + wr * 64 + fr;
        if (u.pn < 8) {
            const int j0 = u.pn * HALF + wc * 32 + 8 * fq;
            f32x4 b1[2], b2[2];
#pragma unroll
            for (int n = 0; n < 2; ++n) { b1[n] = mode ? gld<f32x4>(bias + j0 + 4 * n) : (f32x4){0.f, 0.f, 0.f, 0.f}; b2[n] = mode ? gld<f32x4>(bias + 1024 + j0 + 4 * n) : (f32x4){0.f, 0.f, 0.f, 0.f}; }
#pragma unroll
            for (int ai = 0; ai < 2; ++ai)
#pragma unroll
                for (int m = 0; m < 4; ++m) { bf16* rowp = O1 + (size_t)(row0 + ai * HALF + m * 16) * D + j0; f32x4 r[2];
#pragma unroll
                    for (int n = 0; n < 2; ++n) { const f32x4 g1 = acc[ai][0][m][n] + b1[n], g2 = acc[ai][1][m][n] + b2[n];
                        if (mode) { r[n][0] = g1[0] * sigmoidf_(g2[0]); r[n][1] = g1[1] * sigmoidf_(g2[1]); r[n][2] = g1[2] * sigmoidf_(g2[2]); r[n][3] = g1[3] * sigmoidf_(g2[3]); }
                        else r[n] = g1 * g2; }
                    v4u w; w.x = cvt_pk_bf16(r[0][0], r[0][1]); w.y = cvt_pk_bf16(r[0][2], r[0][3]); w.z = cvt_pk_bf16(r[1][0], r[1][1]); w.w = cvt_pk_bf16(r[1][2], r[1][3]);
                    gst<v4u>(rowp, w); }
        } else {
            const int c0 = (u.pn - 8) * BM + wc * 32 + 8 * fq;
#pragma unroll
            for (int ai = 0; ai < 2; ++ai)
#pragma unroll
                for (int m = 0; m < 4; ++m) { bf16* rowp = O2 + (size_t)(row0 + ai * HALF + m * 16) * D + c0;
#pragma unroll
                    for (int bj = 0; bj < 2; ++bj) { const f32x4 v0 = acc[ai][bj][m][0], v1 = acc[ai][bj][m][1];
                        v4u w; w.x = cvt_pk_bf16(v0[0], v0[1]); w.y = cvt_pk_bf16(v0[2], v0[3]); w.z = cvt_pk_bf16(v1[0], v1[1]); w.w = cvt_pk_bf16(v1[2], v1[3]);
                        gst<v4u>(rowp + bj * HALF, w); } }
        }
    }
};
struct EpiSwiglu {
    static constexpr bool PERM = true;
    unsigned char* act; const float* bgu;
    __device__ __forceinline__ void operator()(const f32x4 (&acc)[2][2][4][2], const Unit& u, int wr, int wc, int fr, int fq) const {
        const int row0 = u.pm * BM + wr * 64 + fr, j0 = u.pn * HALF + wc * 32 + 8 * fq;
        const float* bp = bgu + (size_t)u.e * 2048 + 2 * j0;
        float gb[8], ub[8];
#pragma unroll
        for (int i = 0; i < 4; ++i) { const f32x4 b = gld<f32x4>(bp + 4 * i); gb[2 * i] = b[0]; ub[2 * i] = b[1]; gb[2 * i + 1] = b[2]; ub[2 * i + 1] = b[3]; }
#pragma unroll
        for (int ai = 0; ai < 2; ++ai)
#pragma unroll
            for (int m = 0; m < 4; ++m) { unsigned char* rowp = act + (size_t)(row0 + ai * HALF + m * 16) * D + j0; float r[8];
#pragma unroll
                for (int n = 0; n < 2; ++n)
#pragma unroll
                    for (int q = 0; q < 4; ++q) { const int j = 4 * n + q;
                        const float gg = fminf(acc[ai][0][m][n][q] + gb[j], 7.0f);
                        const float uu = fminf(fmaxf(acc[ai][1][m][n][q] + ub[j], -7.0f), 7.0f);
                        r[j] = (uu + 1.0f) * (gg * sigmoidf_(1.702f * gg)) * SACT8; }
                gst<v2u>(rowp, pack8_fp8(r)); }
    }
};
struct EpiMoe2 {
    static constexpr bool PERM = true;
    unsigned char* Y; const float* bdn; const int* rowdst; const float* rowgate;
    __device__ __forceinline__ void operator()(const f32x4 (&acc)[2][2][4][2], const Unit& u, int wr, int wc, int fr, int fq) const {
        const int pos0 = u.pm * BM + wr * 64 + fr, c0 = u.pn * BM + wc * 32 + 8 * fq;
        const float* bp = bdn + (size_t)u.e * D + c0;
        f32x4 bv[2][2];
#pragma unroll
        for (int bj = 0; bj < 2; ++bj)
#pragma unroll
            for (int n = 0; n < 2; ++n) bv[bj][n] = gld<f32x4>(bp + bj * HALF + 4 * n);
        int dst[2][4]; float gt[2][4];
#pragma unroll
        for (int ai = 0; ai < 2; ++ai)
#pragma unroll
            for (int m = 0; m < 4; ++m) { const int pos = pos0 + ai * HALF + m * 16; dst[ai][m] = gld<int>(rowdst + pos); gt[ai][m] = gld<float>(rowgate + pos) * SY8; }
#pragma unroll
        for (int ai = 0; ai < 2; ++ai)
#pragma unroll
            for (int m = 0; m < 4; ++m) {
                if (dst[ai][m] >= 0) { unsigned char* rowp = Y + (size_t)dst[ai][m] * D + c0; const float s = gt[ai][m];
#pragma unroll
                    for (int bj = 0; bj < 2; ++bj) { const f32x4 v0 = (acc[ai][bj][m][0] + bv[bj][0]) * s, v1 = (acc[ai][bj][m][1] + bv[bj][1]) * s;
                        const float r[8] = {v0[0], v0[1], v0[2], v0[3], v1[0], v1[1], v1[2], v1[3]};
                        gst<v2u>(rowp + bj * HALF, pack8_fp8(r)); } } }
    }
};
}

__device__ __forceinline__ int chq(int lane, int q) { return (q >> 1) * 512 + 8 * lane + (q & 1) * 4; }
__device__ __forceinline__ v4u pack8(const float* v) { v4u w; w.x = cvt_pk_bf16(v[0], v[1]); w.y = cvt_pk_bf16(v[2], v[3]); w.z = cvt_pk_bf16(v[4], v[5]); w.w = cvt_pk_bf16(v[6], v[7]); return w; }
__device__ __forceinline__ void unpack8(const v4u w, float* v) { v[0] = bf_lo(w.x); v[1] = bf_hi(w.x); v[2] = bf_lo(w.y); v[3] = bf_hi(w.y); v[4] = bf_lo(w.z); v[5] = bf_hi(w.z); v[6] = bf_lo(w.w); v[7] = bf_hi(w.w); }

__device__ __forceinline__ int drow_of(int mode, int c) {
    if (mode == 1) { const int j = c >> 1, p = c & 1; return (j >> 7) * 256 + p * 128 + (j & 127); }
    if (mode == 2) { if (c < 1024) return 2048 + c; const int j = (c - 1024) & 1023, p = (c - 1024) >> 10; return (j >> 7) * 256 + p * 128 + (j & 127); }
    if (mode == 3) { const int j = c & 1023, p = c >> 10; return (j >> 7) * 256 + p * 128 + (j & 127); }
    return c;
}
struct TItem { const float* src; unsigned char* dst; int N, Kout  , k0, n0, mode, fp8; };
__device__ __forceinline__ void titem_load(const TItem& d, int lane, float (&tmp)[32]) {
#pragma unroll
    for (int i = 0; i < 32; ++i) { const int kk = 2 * i + (lane >> 5); tmp[i] = gld<float>(d.src + (size_t)(d.k0 + kk) * d.N + d.n0 + (lane & 31)); }
}
__device__ __forceinline__ void titem_store(const TItem& d, int lane, LAS float* scr, const float (&tmp)[32]) {
#pragma unroll
    for (int i = 0; i < 32; ++i) { const int kk = 2 * i + (lane >> 5); scr[kk * 33 + (lane & 31)] = tmp[i]; }
    LDS_WAIT(); asm volatile("" ::: "memory");
    const int c = lane & 7;
#pragma unroll
    for (int j = 0; j < 4; ++j) { const int n = (lane >> 3) + 8 * j; const LAS float* s = scr + (8 * c) * 33 + n;
        float v[8];
#pragma unroll
        for (int i = 0; i < 8; ++i) v[i] = s[i * 33];
        const size_t e = (size_t)drow_of(d.mode, d.n0 + n) * d.Kout + d.k0 + 8 * c;
        if (d.fp8) {
#pragma unroll
            for (int i = 0; i < 8; ++i) v[i] *= SW8;
            gst<v2u>(d.dst + e, pack8_fp8(v));
        } else gst<v4u>(d.dst + 2 * e, pack8(v)); }
    LDS_WAIT(); asm volatile("" ::: "memory");
}

struct Args { const float* in[24]; float* out; unsigned char* ws; };
#define CAS __attribute__((address_space(4)))
__device__ __forceinline__ const void* karg_ptr(int off) {
    const CAS char* kp = (const CAS char*)__builtin_amdgcn_kernarg_segment_ptr();
    asm volatile("" : "+s"(off));
    return *(const void* const CAS*)(kp + off);
}
#define ARG_IN(i) ((const float*)karg_ptr(8 * (i)))
#define ARG_OUT() ((float*)karg_ptr(8 * 24))
#define ARG_WS() ((unsigned char*)karg_ptr(8 * 25))

#define PHASE_BEGIN() \
    int tid = threadIdx.x; asm volatile("" : "+v"(tid)); \
    const int lane = tid & 63, wave = __builtin_amdgcn_readfirstlane(tid >> 6); \
    unsigned char* ws_ = ARG_WS(); asm volatile("" : "+s"(ws_)); unsigned char* ws = (unsigned char*)(GAS unsigned char*)ws_; \
    unsigned* ctl = (unsigned*)(ws + WS_CTL); \
    const int gw = vcu * NWAVES + wave, NGW = G * NWAVES; (void)gw; (void)NGW; (void)lane; (void)ctl;

__device__ __forceinline__ float butterfly32(float (&p)[32], int lane) {
#pragma unroll
    for (int i = 0; i < 16; ++i) { const bool hi = (lane & 32) != 0; const float snd = hi ? p[i] : p[i + 16]; const float keep = hi ? p[i + 16] : p[i]; p[i] = keep + shx(snd, 32, lane); }
#pragma unroll
    for (int i = 0; i < 8; ++i) { const bool hi = (lane & 16) != 0; const float snd = hi ? p[i] : p[i + 8]; const float keep = hi ? p[i + 8] : p[i]; p[i] = keep + shx(snd, 16, lane); }
#pragma unroll
    for (int i = 0; i < 4; ++i) { const bool hi = (lane & 8) != 0; const float snd = hi ? p[i] : p[i + 4]; const float keep = hi ? p[i + 4] : p[i]; p[i] = keep + shx(snd, 8, lane); }
#pragma unroll
    for (int i = 0; i < 2; ++i) { const bool hi = (lane & 4) != 0; const float snd = hi ? p[i] : p[i + 2]; const float keep = hi ? p[i + 2] : p[i]; p[i] = keep + shx(snd, 4, lane); }
    { const bool hi = (lane & 2) != 0; const float snd = hi ? p[0] : p[1]; const float keep = hi ? p[1] : p[0]; p[0] = keep + shx(snd, 2, lane); }
    return p[0] + shx(p[0], 1, lane);
}
__device__ __forceinline__ void ln16(float (&v)[16], const float (&lg)[16], const float (&lb)[16], int lane) {
    float sm = 0.f;
#pragma unroll
    for (int i = 0; i < 16; ++i) sm += v[i];
    const float mean = wave_sum(sm, lane) * (1.0f / D);
    float sq = 0.f;
#pragma unroll
    for (int i = 0; i < 16; ++i) { v[i] -= mean; sq += v[i] * v[i]; }
    const float rstd = 1.0f / sqrtf(wave_sum(sq, lane) * (1.0f / D) + LN_EPS);
#pragma unroll
    for (int i = 0; i < 16; ++i) v[i] = v[i] * rstd * lg[i] + lb[i];
}
__device__ __forceinline__ void route_token(const float logit, const int myexp, const int lane, const int t, int* TIDX, float* TGATE, LAS unsigned* hist, const bool count) {
    int rank = 0;
#pragma unroll
    for (int e = 0; e < 32; ++e) { const float se = __uint_as_float((unsigned)__builtin_amdgcn_readlane((int)__float_as_uint(logit), 2 * e)); rank += (se > logit || (se == logit && e < myexp)) ? 1 : 0; }
    float tv[4]; int tix[4];
#pragma unroll
    for (int r = 0; r < 4; ++r) { const unsigned long long mk = __ballot(rank == r); const int src = (int)__builtin_ctzll(mk | (1ull << 63));
        tv[r] = __uint_as_float((unsigned)__builtin_amdgcn_readlane((int)__float_as_uint(logit), src)); tix[r] = src >> 1; }
    const float e1 = __expf(tv[1] - tv[0]), e2 = __expf(tv[2] - tv[0]), e3 = __expf(tv[3] - tv[0]);
    const float inv = 1.0f / (1.0f + e1 + e2 + e3);
    if (lane < 4) {
        const int ix = lane == 0 ? tix[0] : lane == 1 ? tix[1] : lane == 2 ? tix[2] : tix[3];
        const float gv = (lane == 0 ? 1.0f : lane == 1 ? e1 : lane == 2 ? e2 : e3) * inv;
        gst<int>(TIDX + t * 4 + lane, ix); gst<float>(TGATE + t * 4 + lane, gv);
        if (count) __hip_atomic_fetch_add(hist + ix, 1u, __ATOMIC_RELAXED, __HIP_MEMORY_SCOPE_WORKGROUP);
    }
}
__device__ __forceinline__ void ln16_lds(float (&v)[16], const LAS f32x4* lnp, int lane) {
    float sm = 0.f;
#pragma unroll
    for (int i = 0; i < 16; ++i) sm += v[i];
    const float mean = wave_sum(sm, lane) * (1.0f / D);
    float sq = 0.f;
#pragma unroll
    for (int i = 0; i < 16; ++i) { v[i] -= mean; sq += v[i] * v[i]; }
    const float rstd = 1.0f / sqrtf(wave_sum(sq, lane) * (1.0f / D) + LN_EPS);
#pragma unroll
    for (int q = 0; q < 4; ++q) { const f32x4 g4 = lnp[q * 64 + lane], b4 = lnp[(4 + q) * 64 + lane];
#pragma unroll
        for (int i = 0; i < 4; ++i) v[4 * q + i] = v[4 * q + i] * rstd * g4[i] + b4[i]; }
}
template <bool F32IN>
__device__ __forceinline__ void pool_diff_run(const float* xf, const bf16* xb, bf16* M3, int t0, int lane) {
    const int s0 = t0 & (SEQ - 1);
#pragma unroll
    for (int g = 0; g < 4; ++g) {
        const int w = 2 << g, c = 256 * g + 4 * lane;
        f32x4 r[31];
#pragma unroll
        for (int j = 0; j < w + 15; ++j) {
            const int dt = j - (w - 1);
            if (dt >= 0 || s0 != 0) {
                const size_t o = (size_t)(t0 + dt) * D + c;
                if (F32IN) r[j] = gld<f32x4>(xf + o);
                else { const v2u q = gld<v2u>(xb + o); r[j] = (f32x4){bf_lo(q.x), bf_hi(q.x), bf_lo(q.y), bf_hi(q.y)}; }
            } else r[j] = (f32x4){0.f, 0.f, 0.f, 0.f};
        }
#pragma unroll
        for (int i = 0; i < 16; ++i) {
            f32x4 sum = r[i];
#pragma unroll
            for (int j = 1; j < w; ++j) sum += r[i + j];
            const int nv = (s0 + i + 1 < w) ? s0 + i + 1 : w;
            const f32x4 df = sum * (1.0f / (float)nv) - r[i + w - 1];
            v2u o; o.x = cvt_pk_bf16(df[0], df[1]); o.y = cvt_pk_bf16(df[2], df[3]);
            gst<v2u>(M3 + (size_t)(t0 + i) * D + c, o);
        }
    }
}

__global__ void __launch_bounds__(NTHR, 2) mega_fwd(Args args) {
    extern __shared__ __attribute__((aligned(16))) unsigned char lds_raw[];
    LAS unsigned char* lds = (LAS unsigned char*)lds_raw;
    volatile LAS unsigned* MISC = (volatile LAS unsigned*)(lds + MISC_OFF);
    const int G = gridDim.x, bx = blockIdx.x;
    const int vcu = (G % 8 == 0) ? (bx % 8) * (G / 8) + bx / 8 : bx;
    if (threadIdx.x < 128) MISC[threadIdx.x] = 0u;
    __syncthreads();
    (void)xcd_barrier_post((unsigned*)(ARG_WS() + WS_CTL) + CW_BAR, MISC + 0);
#define GRID_BAR() do { XcdBarrier b_; unsigned* bp_ = (unsigned*)(ARG_WS() + WS_CTL) + CW_BAR; asm volatile("" : "+s"(bp_)); b_.bar = (unsigned*)(GAS unsigned*)bp_; b_.x = xb_xcc_id(); b_.st = MISC; xcd_barrier(b_); } while (0)

    {
        PHASE_BEGIN();
        LAS float* scr = (LAS float*)(lds + RING_OFF + wave * 16384);
        constexpr int I_GU = 16 * 64, I_DN = 16 * 32, I_POOL = 4 * 8, I_SCIN = 16 * 96, I_SQ = 16 * 32, I_CFIN = 16 * 64;
        constexpr int N_GU = 128 * I_GU, N_DN = 128 * I_DN, N_POOL = 8 * I_POOL;
        constexpr int NITEMS = N_GU + N_DN + N_POOL + I_SCIN + I_SQ + I_CFIN + I_SQ;
#define TITEM_SET(d_, src_, K_, N_, dst_, mode_, fp8_, item_) do { const int nb_ = (N_) / 32; (d_).src = (src_); (d_).dst = (unsigned char*)(dst_); (d_).N = (N_); (d_).Kout = (K_); \
        (d_).k0 = 64 * ((item_) / nb_); (d_).n0 = 32 * ((item_) % nb_); (d_).mode = (mode_); (d_).fp8 = (fp8_); } while (0)
#define TITEM_DECODE(it_, d_) do { int r_ = (it_); \
        if (r_ < N_GU) { const int mt_ = r_ / I_GU; TITEM_SET(d_, ARG_IN(18) + (size_t)mt_ * 1024 * 2048, 1024, 2048, ws + WS_WGU + (size_t)mt_ * 2048 * 1024, 1, 1, r_ % I_GU); break; } r_ -= N_GU; \
        if (r_ < N_DN) { const int mt_ = r_ / I_DN; TITEM_SET(d_, ARG_IN(20) + (size_t)mt_ * 1024 * 1024, 1024, 1024, ws + WS_WDN + (size_t)mt_ * 1024 * 1024, 0, 1, r_ % I_DN); break; } r_ -= N_DN; \
        if (r_ < N_POOL) { const int mt_ = r_ / I_POOL; TITEM_SET(d_, ARG_IN(1) + (size_t)mt_ * 256 * 256, 256, 256, ws + WS_WPOOL + (size_t)mt_ * 256 * 256 * 2, 0, 0, r_ % I_POOL); break; } r_ -= N_POOL; \
        if (r_ < I_SCIN) { TITEM_SET(d_, ARG_IN(3), 1024, 3072, ws + WS_WSCIN, 2, 0, r_); break; } r_ -= I_SCIN; \
        if (r_ < I_SQ) { TITEM_SET(d_, ARG_IN(5), 1024, 1024, ws + WS_WSCOUT, 0, 0, r_); break; } r_ -= I_SQ; \
        if (r_ < I_CFIN) { TITEM_SET(d_, ARG_IN(6), 1024, 2048, ws + WS_WCFIN, 3, 0, r_); break; } r_ -= I_CFIN; \
        TITEM_SET(d_, ARG_IN(12), 1024, 1024, ws + WS_WCFOUT, 0, 0, r_); } while (0)
        for (int rep = 0; rep < REP_P0; ++rep) {
            int it = gw; TItem cur; float ta[32];
            if (it < NITEMS) { TITEM_DECODE(it, cur); titem_load(cur, lane, ta); }
            while (it < NITEMS) {
                const int itn = it + NGW; TItem nx = cur; float tb[32];
                if (itn < NITEMS) { TITEM_DECODE(itn, nx); titem_load(nx, lane, tb); }
                else {
#pragma unroll
                    for (int i = 0; i < 32; ++i) tb[i] = 0.f; }
                titem_store(cur, lane, scr, ta);
                cur = nx; it = itn;
#pragma unroll
                for (int i = 0; i < 32; ++i) ta[i] = tb[i];
            }
        }
#undef TITEM_SET
#undef TITEM_DECODE
        const float* x0 = ARG_IN(0); bf16* XAb = (bf16*)(ws + WS_XAB);
        for (int t = gw; t < T; t += NGW) {
            float v[16];
#pragma unroll
            for (int q = 0; q < 4; ++q) { const f32x4 z = gld<f32x4>(x0 + (size_t)t * D + chq(lane, q)); v[4 * q] = z[0]; v[4 * q + 1] = z[1]; v[4 * q + 2] = z[2]; v[4 * q + 3] = z[3]; }
            gst<v4u>(XAb + (size_t)t * D + 8 * lane, pack8(v));
            gst<v4u>(XAb + (size_t)t * D + 512 + 8 * lane, pack8(v + 8));
        }
    }
    GRID_BAR();

    for (int layer = 0; layer < DEPTH; ++layer) {
        const int kind = layer % 3;

        if (kind == 0) {
            PHASE_BEGIN();
            bf16* M3 = (bf16*)(ws + WS_M3); const bf16* xb = (const bf16*)(ws + WS_XAB);
            for (int rep = 0; rep < REP_THIN; ++rep)
            for (int tb = vcu; tb < T / 128; tb += G) {
                const int t0 = tb * 128 + wave * 16;
                if (layer == 0) pool_diff_run<true>(ARG_IN(0), xb, M3, t0, lane);
                else pool_diff_run<false>(ARG_IN(0), xb, M3, t0, lane);
            }
        } else {
            {
                PHASE_BEGIN();
                bf16* M1 = (bf16*)(ws + WS_M1); bf16* M2 = (bf16*)(ws + WS_M2);
                const int nN = (kind == 1) ? 12 : 8;
                const int n_my = pg8::build_units(lds, tid, T / 256, nN, G, bx, false, nullptr, REP_MIXG);
                pg8::GemmP gp; gp.A = (const char*)(ws + WS_XAB); gp.lda2 = D * 2; gp.acol_pn = 0; gp.Bt = (const char*)(ws + ((kind == 1) ? WS_WSCIN : WS_WCFIN)); gp.b_estride = 0; gp.Kb = 2048; gp.sA = 0; gp.sB = 0;
                pg8::EpiPair E; E.O1 = (kind == 1) ? M2 : M1; E.O2 = M1; E.bias = ARG_IN(7); E.mode = (kind == 1) ? 0 : 1;
                pg8::gemm_phase<false, false, pg8::EpiPair>(lds, tid, gp, n_my, E);
            }
            GRID_BAR();
            if (kind == 1) {
                PHASE_BEGIN();
                const bf16* M1 = (const bf16*)(ws + WS_M1); const bf16* M2 = (const bf16*)(ws + WS_M2); bf16* M3 = (bf16*)(ws + WS_M3);
                const float* cw = ARG_IN(4);
                float wk[3][16];
#pragma unroll
                for (int k = 0; k < 3; ++k)
#pragma unroll
                    for (int q = 0; q < 4; ++q) { const f32x4 v = gld<f32x4>(cw + k * D + chq(lane, q)); wk[k][4 * q] = v[0]; wk[k][4 * q + 1] = v[1]; wk[k][4 * q + 2] = v[2]; wk[k][4 * q + 3] = v[3]; }
                for (int rep = 0; rep < REP_THIN; ++rep)
                for (int tb = vcu; tb < T / 128; tb += G) {
                    const int t0 = tb * 128 + wave * 16, s0 = t0 & (SEQ - 1);
                    float p2[16], p1[16];
                    if (s0 != 0) { unpack8(gld<v4u>(M2 + (size_t)(t0 - 2) * D + 8 * lane), p2); unpack8(gld<v4u>(M2 + (size_t)(t0 - 2) * D + 512 + 8 * lane), p2 + 8);
                                   unpack8(gld<v4u>(M2 + (size_t)(t0 - 1) * D + 8 * lane), p1); unpack8(gld<v4u>(M2 + (size_t)(t0 - 1) * D + 512 + 8 * lane), p1 + 8); }
                    else {
#pragma unroll
                        for (int i = 0; i < 16; ++i) { p2[i] = 0.f; p1[i] = 0.f; } }
                    for (int i0 = 0; i0 < 16; i0 += 4) {
                        v4u cv[4][2], gv[4][2];
#pragma unroll
                        for (int u = 0; u < 4; ++u)
#pragma unroll
                            for (int j = 0; j < 2; ++j) { const size_t o = (size_t)(t0 + i0 + u) * D + j * 512 + 8 * lane; cv[u][j] = gld<v4u>(M2 + o); gv[u][j] = gld<v4u>(M1 + o); }
#pragma unroll
                        for (int u = 0; u < 4; ++u) {
                            float c[16], gb[16], o[16];
                            unpack8(cv[u][0], c); unpack8(cv[u][1], c + 8); unpack8(gv[u][0], gb); unpack8(gv[u][1], gb + 8);
#pragma unroll
                            for (int i = 0; i < 16; ++i) { o[i] = gb[i] * (wk[0][i] * p2[i] + wk[1][i] * p1[i] + wk[2][i] * c[i]); p2[i] = p1[i]; p1[i] = c[i]; }
                            gst<v4u>(M3 + (size_t)(t0 + i0 + u) * D + 8 * lane, pack8(o));
                            gst<v4u>(M3 + (size_t)(t0 + i0 + u) * D + 512 + 8 * lane, pack8(o + 8));
                        }
                    }
                }
            } else {
                PHASE_BEGIN();
                const bf16* U = (const bf16*)(ws + WS_M1); bf16* M3 = (bf16*)(ws + WS_M3);
                const int c = 128 * wave + 2 * lane;
                float wk0[31], wk1[31];
#pragma unroll
                for (int k = 0; k < 31; ++k) { const v2u q = gld<v2u>(ARG_IN(8) + k * D + c); wk0[k] = __uint_as_float(q.x); wk1[k] = __uint_as_float(q.y); }
                const v2u qb = gld<v2u>(ARG_IN(9) + c), qg = gld<v2u>(ARG_IN(10) + c), ql = gld<v2u>(ARG_IN(11) + c);
                const float db0 = __uint_as_float(qb.x), db1 = __uint_as_float(qb.y), lg0 = __uint_as_float(qg.x), lg1 = __uint_as_float(qg.y), lb0 = __uint_as_float(ql.x), lb1 = __uint_as_float(ql.y);
                LAS float* part = (LAS float*)(lds + RING_OFF);
                LAS float* stat = part + 256;
                for (int rep = 0; rep < REP_THIN; ++rep)
                for (int run = vcu; run < T / 16; run += G) {
                    const int t0 = run * 16, s0 = t0 & (SEQ - 1);
                    unsigned r[46];
#pragma unroll
                    for (int j = 0; j < 46; ++j) r[j] = (s0 + j - 30 >= 0) ? gld<unsigned>(U + (size_t)(t0 + j - 30) * D + c) : 0u;
                    float a0[16], a1[16];
#pragma unroll
                    for (int i = 0; i < 16; ++i) { a0[i] = db0; a1[i] = db1; }
#pragma unroll
                    for (int j = 0; j < 46; ++j) { const float x0 = bf_lo(r[j]), x1 = bf_hi(r[j]);
#pragma unroll
                        for (int i = 0; i < 16; ++i) { const int k = j - i; if (k >= 0 && k <= 30) { a0[i] += wk0[k] * x0; a1[i] += wk1[k] * x1; } } }
                    float st[32];
#pragma unroll
                    for (int i = 0; i < 16; ++i) { st[2 * i] = a0[i] + a1[i]; st[2 * i + 1] = a0[i] * a0[i] + a1[i] * a1[i]; }
                    const float tot = butterfly32(st, lane);
                    if ((lane & 1) == 0) part[wave * 32 + (lane >> 1)] = tot;
                    __syncthreads();
                    if (tid < 16) { float S = 0.f, Q = 0.f;
#pragma unroll
                        for (int w8 = 0; w8 < 8; ++w8) { S += part[w8 * 32 + 2 * tid]; Q += part[w8 * 32 + 2 * tid + 1]; }
                        const float mean = S * (1.0f / D); const float var = fmaxf(Q * (1.0f / D) - mean * mean, 0.f);
                        stat[2 * tid] = mean; stat[2 * tid + 1] = 1.0f / sqrtf(var + LN_EPS); }
                    __syncthreads();
#pragma unroll
                    for (int i = 0; i < 16; ++i) { const float mean = stat[2 * i], rstd = stat[2 * i + 1];
                        const float y0 = (a0[i] - mean) * rstd * lg0 + lb0, y1 = (a1[i] - mean) * rstd * lg1 + lb1;
                        gst<unsigned>(M3 + (size_t)(t0 + i) * D + c, cvt_pk_bf16(y0 * sigmoidf_(y0), y1 * sigmoidf_(y1))); }
                }
                __syncthreads();
            }
        }
        GRID_BAR();

        {
            PHASE_BEGIN();
            const int n_my = pg8::build_units(lds, tid, T / 256, 4, G, bx, false, nullptr, REP_MIXG);
            pg8::GemmP gp; gp.A = (const char*)(ws + WS_M3); gp.lda2 = D * 2; gp.b_estride = 0; gp.sA = 0; gp.sB = 0;
            pg8::EpiOut E; E.xres = (const bf16*)(ws + WS_XAB); E.z = (bf16*)(ws + WS_ZB); E.bias = nullptr; E.scale = nullptr;
            if (kind == 0) { gp.acol_pn = 512; gp.Bt = (const char*)(ws + WS_WPOOL + (size_t)(layer / 3) * 1024 * 256 * 2); gp.Kb = 512; E.scale = ARG_IN(2) + (layer / 3) * D; }
            else if (kind == 1) { gp.acol_pn = 0; gp.Bt = (const char*)(ws + WS_WSCOUT); gp.Kb = 2048; }
            else { gp.acol_pn = 0; gp.Bt = (const char*)(ws + WS_WCFOUT); gp.Kb = 2048; E.bias = ARG_IN(13); }
            pg8::gemm_phase<false, false, pg8::EpiOut>(lds, tid, gp, n_my, E);
        }
        GRID_BAR();

        {
            PHASE_BEGIN();
            const bf16* Zb = (const bf16*)(ws + WS_ZB); bf16* X1b = (bf16*)(ws + WS_X1B); unsigned char* X18 = (unsigned char*)(ws + WS_X18);
            int* TIDX = (int*)(ws + WS_IDX); float* TGATE = (float*)(ws + WS_GATE);
            unsigned* CNT = ctl + CW_CNT + layer * NE;
            LAS float* rwl = (LAS float*)(lds + RING_OFF);
            const float* rw = ARG_IN(16) + (size_t)layer * D * NE;
            for (int idx = tid; idx < D * 8; idx += NTHR) { const int c = idx >> 3, eg = idx & 7; const int j = c >> 9, r = c & 511, l = r >> 3, ci = j * 8 + (r & 7);
                *(LAS f32x4*)(rwl + ((ci * 8 + eg) * 64 + l) * 4) = gld<f32x4>(rw + c * NE + eg * 4); }
            if (tid < NE) MISC[32 + tid] = 0u;
            __syncthreads();
            LAS f32x4* lnp = (LAS f32x4*)(lds + TOK_OFF);
            if (tid < 256) { const int q = tid >> 6, l = tid & 63; lnp[q * 64 + l] = gld<f32x4>(ARG_IN(14) + layer * D + chq(l, q)); lnp[(4 + q) * 64 + l] = gld<f32x4>(ARG_IN(15) + layer * D + chq(l, q)); }
            __syncthreads();
            const int myexp = (lane >> 1) & 31;
            const float rbias = gld<float>(ARG_IN(17) + layer * NE + myexp);
            LAS unsigned* hist = (LAS unsigned*)(lds + MISC_OFF) + 32;
            for (int rep = 0; rep < REP_LNR; ++rep)
            for (int tb = vcu; tb < T / 128; tb += G) {
                const int t0 = tb * 128 + wave * 16;
                v4u zn[2][2];
#pragma unroll
                for (int u = 0; u < 2; ++u)
#pragma unroll
                    for (int j = 0; j < 2; ++j) zn[u][j] = gld<v4u>(Zb + (size_t)(t0 + u) * D + j * 512 + 8 * lane);
                for (int ti = 0; ti < 16; ti += 2) {
                    const int t = t0 + ti;
                    float va[16], vb[16];
                    unpack8(zn[0][0], va); unpack8(zn[0][1], va + 8); unpack8(zn[1][0], vb); unpack8(zn[1][1], vb + 8);
                    if (ti + 2 < 16) {
#pragma unroll
                        for (int u = 0; u < 2; ++u)
#pragma unroll
                            for (int j = 0; j < 2; ++j) zn[u][j] = gld<v4u>(Zb + (size_t)(t + 2 + u) * D + j * 512 + 8 * lane); }
                    ln16_lds(va, lnp, lane); ln16_lds(vb, lnp, lane);
                    gst<v4u>(X1b + (size_t)t * D + 8 * lane, pack8(va)); gst<v4u>(X1b + (size_t)t * D + 512 + 8 * lane, pack8(va + 8));
                    gst<v4u>(X1b + (size_t)(t + 1) * D + 8 * lane, pack8(vb)); gst<v4u>(X1b + (size_t)(t + 1) * D + 512 + 8 * lane, pack8(vb + 8));
                    { float s8[16];
#pragma unroll
                      for (int i = 0; i < 16; ++i) s8[i] = va[i] * SX8;
                      gst<v2u>(X18 + (size_t)t * D + 8 * lane, pack8_fp8(s8)); gst<v2u>(X18 + (size_t)t * D + 512 + 8 * lane, pack8_fp8(s8 + 8));
#pragma unroll
                      for (int i = 0; i < 16; ++i) s8[i] = vb[i] * SX8;
                      gst<v2u>(X18 + (size_t)(t + 1) * D + 8 * lane, pack8_fp8(s8)); gst<v2u>(X18 + (size_t)(t + 1) * D + 512 + 8 * lane, pack8_fp8(s8 + 8)); }
                    f32x2 pa[16], pb[16];
#pragma unroll
                    for (int e = 0; e < 16; ++e) { pa[e] = (f32x2){0.f, 0.f}; pb[e] = (f32x2){0.f, 0.f}; }
                    f32x4 w0[8], w1[8];
#define RW_LOAD(dst, ci) do { _Pragma("unroll") for (int eg = 0; eg < 8; ++eg) dst[eg] = *(const LAS f32x4*)(rwl + (((ci) * 8 + eg) * 64 + lane) * 4); asm volatile("" ::: "memory"); } while (0)
#define RW_FMA(wsrc, ci) do { const f32x2 sa = (f32x2){va[ci], va[ci]}, sb = (f32x2){vb[ci], vb[ci]}; _Pragma("unroll") for (int eg = 0; eg < 8; ++eg) { \
                        const f32x2 lo = (f32x2){wsrc[eg][0], wsrc[eg][1]}, hi = (f32x2){wsrc[eg][2], wsrc[eg][3]}; \
                        pa[2 * eg] = __builtin_elementwise_fma(lo, sa, pa[2 * eg]); pa[2 * eg + 1] = __builtin_elementwise_fma(hi, sa, pa[2 * eg + 1]); \
                        pb[2 * eg] = __builtin_elementwise_fma(lo, sb, pb[2 * eg]); pb[2 * eg + 1] = __builtin_elementwise_fma(hi, sb, pb[2 * eg + 1]); } } while (0)
                    RW_LOAD(w0, 0);
#pragma unroll
                    for (int ci = 0; ci < 16; ci += 2) {
                        RW_LOAD(w1, ci + 1);
                        RW_FMA(w0, ci);
                        if (ci + 2 < 16) RW_LOAD(w0, ci + 2);
                        RW_FMA(w1, ci + 1);
                    }
#undef RW_LOAD
#undef RW_FMA
                    float qa[32], qb[32];
#pragma unroll
                    for (int e = 0; e < 16; ++e) { qa[2 * e] = pa[e][0]; qa[2 * e + 1] = pa[e][1]; qb[2 * e] = pb[e][0]; qb[2 * e + 1] = pb[e][1]; }
                    const float logitA = butterfly32(qa, lane) + rbias, logitB = butterfly32(qb, lane) + rbias;
                    route_token(logitA, myexp, lane, t, TIDX, TGATE, hist, rep == 0);
                    route_token(logitB, myexp, lane, t + 1, TIDX, TGATE, hist, rep == 0);
                }
            }
            __syncthreads();
            if (tid < NE) { const unsigned c = MISC[32 + tid]; if (c) (void)xb_add(CNT + tid, c); }
        }
        GRID_BAR();

        {
            PHASE_BEGIN();
            const int* TIDX = (const int*)(ws + WS_IDX); const float* TGATE = (const float*)(ws + WS_GATE);
            int* RTOK = (int*)(ws + WS_RTOK); int* RDST = (int*)(ws + WS_RDST); float* RGATE = (float*)(ws + WS_RGATE);
            unsigned* CNT = ctl + CW_CNT + layer * NE; unsigned* CUR = ctl + CW_CUR + layer * NE;
            LAS int* TS = (LAS int*)(lds + TS_OFF);
            if (tid == 0) { int a = 0; for (int e = 0; e < NE; ++e) { TS[e] = a; a += (int)((xb_ld(CNT + e) + 255u) >> 8); } TS[NE] = a; }
            for (int tb = vcu; tb < T / 128; tb += G) {
                __syncthreads();
                if (tid < NE) MISC[32 + tid] = 0u;
                __syncthreads();
                const int t = tb * 128 + (tid >> 2), k = tid & 3;
                const int e = gld<int>(TIDX + t * 4 + k); const float gv = gld<float>(TGATE + t * 4 + k);
                const unsigned rank = __hip_atomic_fetch_add((LAS unsigned*)(lds + MISC_OFF) + 32 + e, 1u, __ATOMIC_RELAXED, __HIP_MEMORY_SCOPE_WORKGROUP);
                __syncthreads();
                if (tid < NE) { const unsigned c = MISC[32 + tid]; MISC[64 + tid] = c ? xb_add(CUR + tid, c) : 0u; }
                __syncthreads();
                const int pos = TS[e] * 256 + (int)MISC[64 + e] + (int)rank;
                gst<int>(RTOK + pos, t); gst<int>(RDST + pos, t * 4 + k); gst<float>(RGATE + pos, gv);
            }
            __syncthreads();
            for (int e = vcu; e < NE; e += G) {
                const int beg = TS[e] * 256 + (int)xb_ld(CNT + e), end = TS[e + 1] * 256;
                for (int p = beg + tid; p < end; p += NTHR) { gst<int>(RTOK + p, 0); gst<int>(RDST + p, -1); gst<float>(RGATE + p, 0.f); }
            }
        }
        GRID_BAR();

        {
            PHASE_BEGIN();
            unsigned* CNT = ctl + CW_CNT + layer * NE;
            LAS int* TS = (LAS int*)(lds + TS_OFF);
            __syncthreads();
            if (tid == 0) { int a = 0; for (int e = 0; e < NE; ++e) { TS[e] = a; a += (int)((xb_ld(CNT + e) + 255u) >> 8); } TS[NE] = a; }
            __syncthreads();
            const int nM = TS[NE];
            const int n_my = pg8::build_units(lds, tid, nM, 8, G, bx, true, (const int*)(ws + WS_RTOK), REP_MOE1);
            pg8::GemmP gp; gp.A = (const char*)(ws + WS_X18); gp.lda2 = D; gp.acol_pn = 0; gp.Bt = (const char*)(ws + WS_WGU + (size_t)layer * NE * 2048 * 1024); gp.b_estride = (size_t)2048 * 1024; gp.Kb = 1024; gp.sA = E8_X; gp.sB = E8_W;
            pg8::EpiSwiglu E; E.act = (unsigned char*)(ws + WS_ACT); E.bgu = ARG_IN(19) + (size_t)layer * NE * 2048;
            pg8::gemm_phase<true, true, pg8::EpiSwiglu>(lds, tid, gp, n_my, E, REP_MOE1 > 1 ? n_my / 2 : (1 << 20));
        }
        GRID_BAR();

        {
            PHASE_BEGIN();
            LAS int* TS = (LAS int*)(lds + TS_OFF);
            const int nM = TS[NE];
            const int n_my = pg8::build_units(lds, tid, nM, 4, G, bx, true, nullptr, REP_MOE2);
            pg8::GemmP gp; gp.A = (const char*)(ws + WS_ACT); gp.lda2 = D; gp.acol_pn = 0; gp.Bt = (const char*)(ws + WS_WDN + (size_t)layer * NE * 1024 * 1024); gp.b_estride = (size_t)1024 * 1024; gp.Kb = 1024; gp.sA = E8_ACT; gp.sB = E8_W;
            pg8::EpiMoe2 E; E.Y = (unsigned char*)(ws + WS_Y); E.bdn = ARG_IN(21) + (size_t)layer * NE * D; E.rowdst = (const int*)(ws + WS_RDST); E.rowgate = (const float*)(ws + WS_RGATE);
            pg8::gemm_phase<false, true, pg8::EpiMoe2>(lds, tid, gp, n_my, E);
        }
        GRID_BAR();

        {
            PHASE_BEGIN();
            const bf16* X1b = (const bf16*)(ws + WS_X1B); const unsigned char* Y = (const unsigned char*)(ws + WS_Y); float* OUT = ARG_OUT(); bf16* XAb = (bf16*)(ws + WS_XAB);
            float lg[16], lb[16];
#pragma unroll
            for (int q = 0; q < 4; ++q) { const f32x4 b = gld<f32x4>(ARG_IN(22) + layer * D + 16 * lane + 4 * q), c = gld<f32x4>(ARG_IN(23) + layer * D + 16 * lane + 4 * q);
#pragma unroll
                for (int i = 0; i < 4; ++i) { lg[4 * q + i] = b[i]; lb[4 * q + i] = c[i]; } }
            for (int rep = 0; rep < REP_THIN; ++rep)
            for (int tb = vcu; tb < T / 128; tb += G) {
                const int t0 = tb * 128 + wave * 16;
                v4u nx[2], ny[4];
#pragma unroll
                for (int j = 0; j < 2; ++j) nx[j] = gld<v4u>(X1b + (size_t)t0 * D + 16 * lane + 8 * j);
#pragma unroll
                for (int k = 0; k < 4; ++k) ny[k] = gld<v4u>(Y + (size_t)(t0 * 4 + k) * D + 16 * lane);
                for (int ti = 0; ti < 16; ++ti) {
                    const int t = t0 + ti;
                    float v[16], h[16];
                    unpack8(nx[0], v); unpack8(nx[1], v + 8);
#pragma unroll
                    for (int i = 0; i < 16; ++i) h[i] = 0.f;
#pragma unroll
                    for (int k = 0; k < 4; ++k) { const unsigned wd[4] = {ny[k].x, ny[k].y, ny[k].z, ny[k].w};
#pragma unroll
                        for (int d = 0; d < 4; ++d) { const f32x2 lo = __builtin_amdgcn_cvt_pk_f32_fp8((int)wd[d], false), hi = __builtin_amdgcn_cvt_pk_f32_fp8((int)wd[d], true);
                            h[4 * d] += lo[0]; h[4 * d + 1] += lo[1]; h[4 * d + 2] += hi[0]; h[4 * d + 3] += hi[1]; } }
                    if (ti + 1 < 16) {
#pragma unroll
                        for (int j = 0; j < 2; ++j) nx[j] = gld<v4u>(X1b + (size_t)(t + 1) * D + 16 * lane + 8 * j);
#pragma unroll
                        for (int k = 0; k < 4; ++k) ny[k] = gld<v4u>(Y + (size_t)((t + 1) * 4 + k) * D + 16 * lane); }
#pragma unroll
                    for (int i = 0; i < 16; ++i) v[i] = v[i] * ALPHA + h[i] * (1.0f / SY8);
                    ln16(v, lg, lb, lane);
                    if (layer == DEPTH - 1) {
#pragma unroll
                        for (int q = 0; q < 4; ++q) gst<f32x4>(OUT + (size_t)t * D + 16 * lane + 4 * q, (f32x4){v[4 * q], v[4 * q + 1], v[4 * q + 2], v[4 * q + 3]});
                    } else {
                        gst<v4u>(XAb + (size_t)t * D + 16 * lane, pack8(v));
                        gst<v4u>(XAb + (size_t)t * D + 16 * lane + 8, pack8(v + 8));
                    }
                }
            }
        }
        if (layer + 1 < DEPTH) GRID_BAR();
    }
}

extern "C" void kernel_launch(void* const* d_in, const int* in_sizes, int n_in, void* d_out, int out_size, void* d_ws, size_t ws_size, hipStream_t stream) {
    static int grid = 0;
    if (grid == 0) {
        if (n_in != 24 || out_size != T * D || ws_size < WS_END) { fprintf(stderr, "kernel_launch: unexpected shapes (n_in %d out %d ws %zu)\n", n_in, out_size, ws_size); grid = -1; return; }
        if (hipFuncSetAttribute((const void*)mega_fwd, hipFuncAttributeMaxDynamicSharedMemorySize, LDS_BYTES) != hipSuccess) { fprintf(stderr, "kernel_launch: hipFuncSetAttribute failed\n"); grid = -1; return; }
        int dev = 0, cus = 0, per_cu = 0;
        (void)hipGetDevice(&dev); (void)hipDeviceGetAttribute(&cus, hipDeviceAttributeMultiprocessorCount, dev);
        if (hipOccupancyMaxActiveBlocksPerMultiprocessor(&per_cu, (const void*)mega_fwd, NTHR, LDS_BYTES) != hipSuccess || per_cu < 1) fprintf(stderr, "kernel_launch: occupancy query reports %d blocks per CU\n", per_cu);
        (void)hipGetLastError();
        grid = 256; if (cus > 0 && cus < grid) grid = cus;
    }
    if (grid < 0) return;
    (void)hipMemsetAsync((char*)d_ws + WS_CTL, 0, CTL_ZERO_BYTES, stream);
    Args a{};
    for (int i = 0; i < 24; ++i) a.in[i] = (const float*)d_in[i];
    a.out = (float*)d_out; a.ws = (unsigned char*)d_ws;
    hipLaunchKernelGGL(mega_fwd, dim3(grid), dim3(NTHR), LDS_BYTES, stream, a);
    const hipError_t le = hipPeekAtLastError();
    if (le != hipSuccess) fprintf(stderr, "kernel_launch: launch failed: %s\n", hipGetErrorName(le));
}
```

```cpp
#include <hip/hip_runtime.h>
#include <cstdio>
#include <cstdint>

#define GAS __attribute__((address_space(1)))
#define LAS __attribute__((address_space(3)))
typedef unsigned short bf16;
typedef unsigned v4u __attribute__((ext_vector_type(4)));
typedef unsigned v2u __attribute__((ext_vector_type(2)));
typedef float f32x4 __attribute__((ext_vector_type(4)));
typedef float f32x2 __attribute__((ext_vector_type(2)));
typedef short bf16x8 __attribute__((ext_vector_type(8)));
typedef int v4i __attribute__((ext_vector_type(4)));
typedef int v8i __attribute__((ext_vector_type(8)));

template <class V> __device__ __forceinline__ V gld(const void* p) { return *(const GAS V*)p; }
template <class V> __device__ __forceinline__ void gst(void* p, V v) { *(GAS V*)p = v; }

#ifndef REP_P0
#define REP_P0 1
#endif
#ifndef REP_MOE1
#define REP_MOE1 1
#endif
#ifndef REP_MOE2
#define REP_MOE2 1
#endif
#ifndef REP_THIN
#define REP_THIN 1
#endif
#ifndef REP_MIXG
#define REP_MIXG 1
#endif
#ifndef REP_LNR
#define REP_LNR 1
#endif
constexpr int T = 32768, D = 1024, SEQ = 4096, NE = 32, TOPK = 4, NA = T * TOPK, DEPTH = 4;
constexpr int MAXTILES = NA / 256 + NE;
constexpr int NPAD = MAXTILES * 256;
constexpr float LN_EPS = 1e-5f;
constexpr float ALPHA = 1.681792830507429f;
constexpr int NWAVES = 8, NTHR = 512;
constexpr int MAXU = 17;
constexpr float SX8 = 16.0f, SACT8 = 4.0f, SW8 = 256.0f, SY8 = 64.0f;
constexpr int E8_X = 0x7B7B7B7B  , E8_ACT = 0x7D7D7D7D  , E8_W = 0x77777777  ;

constexpr size_t MiB = 1u << 20;
constexpr size_t WS_CTL = 0, CTL_ZERO_BYTES = 1 * MiB;
constexpr size_t WS_IDX = 1 * MiB;
constexpr size_t WS_GATE = 1 * MiB + 512 * 1024;
constexpr size_t WS_RTOK = 2 * MiB;
constexpr size_t WS_RDST = 3 * MiB;
constexpr size_t WS_RGATE = 4 * MiB;
constexpr size_t WS_WPOOL = 5 * MiB;
constexpr size_t WS_WSCIN = 6 * MiB;
constexpr size_t WS_WSCOUT = 12 * MiB;
constexpr size_t WS_WCFIN = 14 * MiB;
constexpr size_t WS_WCFOUT = 18 * MiB;
constexpr size_t WS_WGU = 32 * MiB;
constexpr size_t WS_WDN = 544 * MiB;
constexpr size_t WS_X18 = 704 * MiB;
constexpr size_t WS_ZB = 800 * MiB;
constexpr size_t WS_XAB = 864 * MiB;
constexpr size_t WS_X1B = 928 * MiB;
constexpr size_t WS_M1 = 992 * MiB;
constexpr size_t WS_M2 = 1056 * MiB;
constexpr size_t WS_M3 = 1120 * MiB;
constexpr size_t WS_ACT = 1184 * MiB;
constexpr size_t WS_Y = 1456 * MiB;
constexpr size_t WS_END = 1712 * MiB;
constexpr int CW_BAR = 4096;
constexpr int CW_CNT = 8192;
constexpr int CW_CUR = 8192 + 256;

constexpr int RING_OFF = 0, RING_BYTES = 131072;
constexpr int TOK_OFF = RING_BYTES;
constexpr int UT_OFF = TOK_OFF + MAXU * 1024;
constexpr int TS_OFF = UT_OFF + (2 * MAXU + 2) * 16;
constexpr int MISC_OFF = TS_OFF + 36 * 4;
constexpr int LDS_BYTES = MISC_OFF + 128 * 4;
static_assert(LDS_BYTES <= 160 * 1024 && (MISC_OFF % 16) == 0, "LDS map");

#define LDS_WAIT() asm volatile("s_waitcnt lgkmcnt(0)" ::: "memory")
#define VM_WAIT() asm volatile("s_waitcnt vmcnt(0)" ::: "memory")

__device__ __forceinline__ unsigned cvt_pk_bf16(float lo, float hi) { unsigned r; asm volatile("v_cvt_pk_bf16_f32 %0, %1, %2" : "=v"(r) : "v"(lo), "v"(hi)); return r; }
__device__ __forceinline__ v2u pack8_fp8(const float* v) { int a = __builtin_amdgcn_cvt_pk_fp8_f32(v[0], v[1], 0, false); a = __builtin_amdgcn_cvt_pk_fp8_f32(v[2], v[3], a, true);
    int b = __builtin_amdgcn_cvt_pk_fp8_f32(v[4], v[5], 0, false); b = __builtin_amdgcn_cvt_pk_fp8_f32(v[6], v[7], b, true); v2u w; w.x = (unsigned)a; w.y = (unsigned)b; return w; }
__device__ __forceinline__ float bf_lo(unsigned u) { return __uint_as_float(u << 16); }
__device__ __forceinline__ float bf_hi(unsigned u) { return __uint_as_float(u & 0xffff0000u); }
__device__ __forceinline__ float sigmoidf_(float x) { return __builtin_amdgcn_rcpf(1.0f + __expf(-x)); }
__device__ __forceinline__ float shx(float v, int mask, int lane) { return __uint_as_float((unsigned)__builtin_amdgcn_ds_bpermute((lane ^ mask) << 2, (int)__float_as_uint(v))); }
__device__ __forceinline__ float wave_sum(float v, int lane) {
#pragma unroll
    for (int o = 1; o < 64; o <<= 1) v += shx(v, o, lane);
    return v;
}

#define XB_TMO      128
#define XB_XCNT(j)  (256  + 64 * (j))
#define XB_XSUB(j)  (1280 + 64 * (j))
#define XB_XGEN(j)  (2304 + 64 * (j))
#define XB_TOP      3328
#define XB_TOPGEN   3392
#define XCD_BAR_WORDS 3456
#define XB_SPIN_CAP (1u << 18)

__device__ __forceinline__ unsigned xb_ld(unsigned* p)              { return __hip_atomic_load((GAS unsigned*)p, __ATOMIC_RELAXED, __HIP_MEMORY_SCOPE_AGENT); }
__device__ __forceinline__ unsigned xb_add(unsigned* p, unsigned v) { return __hip_atomic_fetch_add((GAS unsigned*)p, v, __ATOMIC_RELAXED, __HIP_MEMORY_SCOPE_AGENT); }
__device__ __forceinline__ unsigned xb_xcc_id() { return (unsigned)__builtin_amdgcn_s_getreg((3 << 11) | 20) & 0xFu; }
#define XB_SPIN(cond, bar) do { unsigned _sp = 0; while (cond) { __builtin_amdgcn_s_sleep(1); \
    if ((++_sp & 255u) == 0u) { if (xb_ld(&(bar)[XB_TMO])) break; if (_sp > XB_SPIN_CAP) { (void)xb_add(&(bar)[XB_TMO], 1u); break; } } } } while (0)

struct XcdBarrier { unsigned* bar; unsigned x; volatile LAS unsigned* st; };

__device__ __forceinline__ XcdBarrier xcd_barrier_post(unsigned* bar, volatile LAS unsigned* st) {
    XcdBarrier b; b.bar = bar; b.x = xb_xcc_id(); b.st = st;
    if (threadIdx.x == 0) (void)xb_add(&bar[XB_XCNT(b.x)], 1u);
    return b;
}
__device__ __forceinline__ void xcd_barrier_complete(unsigned* bar, unsigned x, unsigned& nloc, unsigned& nx) {
    const unsigned G = gridDim.x * gridDim.y * gridDim.z;
    unsigned sum, cnt, mine, sp = 0u;
    for (;;) {
        sum = 0u; cnt = 0u; mine = 0u;
#pragma unroll
        for (unsigned j = 0; j < 16; ++j) { const unsigned c = xb_ld(&bar[XB_XCNT(j)]); sum += c; cnt += (c > 0u) ? 1u : 0u; mine = (j == x) ? c : mine; }
        if (sum == G) break;
        __builtin_amdgcn_s_sleep(1);
        if ((++sp & 255u) == 0u) { if (xb_ld(&bar[XB_TMO])) break; if (sp > XB_SPIN_CAP) { (void)xb_add(&bar[XB_TMO], 1u); break; } }
    }
    nloc = mine > 0u ? mine : 1u; nx = cnt > 0u ? cnt : 1u;
}
__device__ __forceinline__ void xcd_barrier(const XcdBarrier& b) {
    asm volatile("s_waitcnt vmcnt(0)" ::: "memory");
    __syncthreads();
    if (threadIdx.x == 0) {
        unsigned* bar = b.bar;
        __builtin_amdgcn_s_waitcnt(0);
        unsigned nloc = b.st[0], nx = b.st[1];
        if (nloc == 0u) { xcd_barrier_complete(bar, b.x, nloc, nx); b.st[0] = nloc; b.st[1] = nx; }
        const unsigned old = xb_add(&bar[XB_XSUB(b.x)], 1u);
        const unsigned gen = old / nloc;
        if (old + 1u == (gen + 1u) * nloc) {
            __builtin_amdgcn_fence(__ATOMIC_RELEASE, "agent");
            asm volatile("s_waitcnt vmcnt(0)" ::: "memory");
            const unsigned og = xb_add(&bar[XB_TOP], 1u);
            const unsigned tg = og / nx;
            if (og + 1u == (tg + 1u) * nx) xb_add(&bar[XB_TOPGEN], 1u);
            else XB_SPIN(xb_ld(&bar[XB_TOPGEN]) == tg, bar);
            __builtin_amdgcn_fence(__ATOMIC_ACQUIRE, "agent");
            xb_add(&bar[XB_XGEN(b.x)], 1u);
            asm volatile("s_waitcnt vmcnt(0)" ::: "memory");
        } else {
            XB_SPIN(xb_ld(&bar[XB_XGEN(b.x)]) == gen, bar);
            __builtin_amdgcn_fence(__ATOMIC_ACQUIRE, "agent");
            asm volatile("s_waitcnt vmcnt(0)" ::: "memory");
        }
    }
    __syncthreads();
}

namespace pg8 {
constexpr int BM = 256, BK = 64, HALF = 128, HTB = HALF * BK * 2, STAGE_BYTES = 8 * HTB, NXCD = 8, WGM = 8;
__host__ __device__ __forceinline__ int lds_byte(int r, int c) { const int st = (r >> 4) * 2 + (c >> 5), rr = r & 15, cc = c & 31, ob = rr * 64 + cc * 2; return st * 1024 + (ob ^ (((ob >> 9) & 1) << 5)); }
__host__ __device__ __forceinline__ void stage_rc(int b, int& R, int& C) { const int st = b / 1024, sb = b % 1024, swz = sb ^ (((sb >> 9) & 1) << 5); R = (st >> 1) * 16 + swz / 64; C = (st & 1) * 32 + (swz % 64) / 2; }
__host__ __device__ __forceinline__ int perm32(int rho) { const int n = rho >> 4, i = rho & 15; return 8 * (i >> 2) + 4 * n + (i & 3); }

struct Unit { int pm, pn, e; };
struct GemmP {
    const char* A; unsigned lda2;
    unsigned acol_pn;
    const char* Bt; size_t b_estride;
    int Kb;
    int sA, sB;
};

__device__ __forceinline__ void unit_of(int L, int nM, int nN, int& pm, int& pn) {
    const int nwg = nM * nN;
    int wgid = L; { const int q = nwg / NXCD, r = nwg % NXCD, xcd = wgid % NXCD, off = wgid / NXCD; wgid = (xcd < r ? xcd * (q + 1) : r * (q + 1) + (xcd - r) * q) + off; }
    const int nig = WGM * nN, gid = wgid / nig, fm = gid * WGM, gsz = (nM - fm) < WGM ? (nM - fm) : WGM;
    pm = fm + ((wgid % nig) % gsz); pn = (wgid % nig) / gsz;
}
__device__ __forceinline__ int build_units(LAS unsigned char* lds, const int tid, int nM, int nN, int G, int c, bool moe, const int* row_tok, const int dup = 1) {
    LAS int* UT = (LAS int*)(lds + UT_OFF); LAS const int* TS = (LAS const int*)(lds + TS_OFF); LAS int* TOK = (LAS int*)(lds + TOK_OFF);
    const int nwg = nM * nN;
    int n_my = (nwg > c) ? (nwg - c + G - 1) / G : 0; if (n_my > MAXU) n_my = MAXU;
    if (tid < n_my) {
        int pm, pn; unit_of(tid * G + c, nM, nN, pm, pn);
        int e = 0; if (moe) { while (e < NE - 1 && TS[e + 1] <= pm) ++e; }
        UT[4 * tid + 0] = pm; UT[4 * tid + 1] = pn; UT[4 * tid + 2] = e; UT[4 * tid + 3] = 0;
    }
    __syncthreads();
    if (row_tok) {
        for (int idx = tid; idx < n_my * 256; idx += NTHR) { const int i = idx >> 8, r = idx & 255; TOK[idx] = gld<int>(row_tok + UT[4 * i] * 256 + r); }
    }
    __syncthreads();
    if (dup > 1) { if (tid < n_my) { UT[4 * (tid + n_my) + 0] = UT[4 * tid]; UT[4 * (tid + n_my) + 1] = UT[4 * tid + 1]; UT[4 * (tid + n_my) + 2] = UT[4 * tid + 2]; UT[4 * (tid + n_my) + 3] = 0; } __syncthreads(); return 2 * n_my; }
    return n_my;
}
__device__ __forceinline__ Unit read_unit(LAS const int* UT, int i) {
    Unit u; u.pm = __builtin_amdgcn_readfirstlane(UT[4 * i]); u.pn = __builtin_amdgcn_readfirstlane(UT[4 * i + 1]); u.e = __builtin_amdgcn_readfirstlane(UT[4 * i + 2]); return u;
}
template <bool GATHER>
__device__ __forceinline__ void a_offsets(unsigned (&v)[2][2], const GemmP& g, const Unit& u, int ui, const int (&Rr)[2], const int (&Cc2)[2], LAS const int* TOK, const int tokn) {
#pragma unroll
    for (int h = 0; h < 2; ++h)
#pragma unroll
        for (int i = 0; i < 2; ++i) {
            const int row = GATHER ? TOK[(ui >= tokn ? ui - tokn : ui) * 256 + h * HALF + Rr[i]] : (u.pm * BM + h * HALF + Rr[i]);
            v[h][i] = (unsigned)row * g.lda2 + (unsigned)Cc2[i] + (unsigned)u.pn * g.acol_pn;
        }
}

template <bool GATHER, bool FP8, class Epi>
__device__ __forceinline__ void gemm_phase(LAS unsigned char* lds, const int tid, const GemmP g, const int n_my, const Epi& E, const int tokn = 1 << 20) {
    const int wid = __builtin_amdgcn_readfirstlane(tid >> 6), lane = tid & 63, wr = wid >> 2, wc = wid & 3, fr = lane & 15, fq = lane >> 4;
    const int Kb = g.Kb, nt = Kb / (BK * 2);
    if (n_my <= 0) return;
    int Rr[2], Cc2[2]; unsigned voffB[2];
#pragma unroll
    for (int i = 0; i < 2; ++i) { int R, C; stage_rc(tid * 16 + i * 8192, R, C); const int Rb = Epi::PERM ? ((R & ~31) + perm32(R & 31)) : R;
        Rr[i] = R; Cc2[i] = C * 2; voffB[i] = (unsigned)(Rb * Kb + C * 2); }
    const size_t kstep = (size_t)(BK * 2);
    const size_t hstep = (size_t)HALF * Kb;
    const size_t tstepB = 2 * hstep;
    const unsigned ldsw = (unsigned)wid * 1024u;
    const int aoff = lds_byte(wr * 64 + fr, fq * 8), boff = lds_byte(wc * 32 + fr, fq * 8);
    LAS const int* UT = (LAS const int*)(lds + UT_OFF); LAS const int* TOK = (LAS const int*)(lds + TOK_OFF);
#define PG8_SA(b, h) (((b) * 2 + (h)) * HTB)
#define PG8_SB(b, h) ((4 + (b) * 2 + (h)) * HTB)
#define PG8_STAGE(bufoff, gbase, voff) do { _Pragma("unroll") for (int _i = 0; _i < 2; ++_i) \
        __builtin_amdgcn_global_load_lds((const unsigned*)((const char*)(gbase) + (voff)[_i]), (LAS unsigned*)(lds + (bufoff) + ldsw + _i * 8192), 16, 0, 0); } while (0)
#define PG8_LDA(dst, b, h) do { _Pragma("unroll") for (int m = 0; m < 4; ++m) _Pragma("unroll") for (int k = 0; k < 2; ++k) dst[m][k] = *(const LAS bf16x8*)(lds + PG8_SA(b, h) + aoff + m * 2048 + k * 1024); } while (0)
#define PG8_LDB(dst, b, h) do { _Pragma("unroll") for (int n = 0; n < 2; ++n) _Pragma("unroll") for (int k = 0; k < 2; ++k) dst[n][k] = *(const LAS bf16x8*)(lds + PG8_SB(b, h) + boff + n * 2048 + k * 1024); } while (0)
#define PG8_CAT(x) __builtin_shufflevector(__builtin_bit_cast(v4i, (x)[0]), __builtin_bit_cast(v4i, (x)[1]), 0, 1, 2, 3, 4, 5, 6, 7)
#define PG8_MMA(ai, bj, At, Bt) do { __builtin_amdgcn_s_setprio(1); _Pragma("unroll") for (int m = 0; m < 4; ++m) _Pragma("unroll") for (int n = 0; n < 2; ++n) { \
        if constexpr (FP8) { const v8i b8_ = PG8_CAT(Bt[n]), a8_ = PG8_CAT(At[m]); asm volatile("v_mfma_scale_f32_16x16x128_f8f6f4 %0, %1, %2, %0, %3, %4 op_sel_hi:[0,0,0]" : "+v"(acc[ai][bj][m][n]) : "v"(b8_), "v"(a8_), "v"(vsB), "v"(vsA)); } \
        else { _Pragma("unroll") for (int k = 0; k < 2; ++k) acc[ai][bj][m][n] = __builtin_amdgcn_mfma_f32_16x16x32_bf16(Bt[n][k], At[m][k], acc[ai][bj][m][n], 0, 0, 0); } } \
        __builtin_amdgcn_s_setprio(0); } while (0)
#define PG8_WAIT_V(n) asm volatile("s_waitcnt vmcnt(" #n ")" ::: "memory")
#define PG8_WAIT_L(n) asm volatile("s_waitcnt lgkmcnt(" #n ")" ::: "memory")
#define PG8_BAR __builtin_amdgcn_s_barrier()
#define PG8_SCHED __builtin_amdgcn_sched_barrier(0)
    Unit cur = read_unit(UT, 0), nxt; int ui = 0;
    f32x4 acc[2][2][4][2];
#pragma unroll
    for (int a = 0; a < 2; ++a)
#pragma unroll
        for (int b = 0; b < 2; ++b)
#pragma unroll
            for (int m = 0; m < 4; ++m)
#pragma unroll
                for (int n = 0; n < 2; ++n) acc[a][b][m][n] = (f32x4){0.f, 0.f, 0.f, 0.f};
#define PG8_PIN_ACC() do { if constexpr (FP8) { _Pragma("unroll") for (int a_ = 0; a_ < 2; ++a_) _Pragma("unroll") for (int b_ = 0; b_ < 2; ++b_) \
        asm volatile("" : "+v"(acc[a_][b_][0][0]), "+v"(acc[a_][b_][0][1]), "+v"(acc[a_][b_][1][0]), "+v"(acc[a_][b_][1][1]), "+v"(acc[a_][b_][2][0]), "+v"(acc[a_][b_][2][1]), "+v"(acc[a_][b_][3][0]), "+v"(acc[a_][b_][3][1])); \
        asm volatile("s_nop 1" ::: "memory"); } } while (0)
    PG8_PIN_ACC();
    bf16x8 At[4][2], B0[2][2], B1[2][2];
    int vsA = g.sA, vsB = g.sB; asm volatile("" : "+v"(vsA), "+v"(vsB));
    unsigned vAc[2][2], vAn[2][2];
    a_offsets<GATHER>(vAc, g, cur, 0, Rr, Cc2, TOK, tokn);
    const char* const Ab = g.A;
    const char* cB = g.Bt + (size_t)cur.e * g.b_estride + (size_t)cur.pn * tstepB;
    PG8_STAGE(PG8_SB(0, 0), cB, voffB); PG8_STAGE(PG8_SB(0, 1), cB + hstep, voffB); PG8_STAGE(PG8_SA(0, 0), Ab, vAc[0]); PG8_STAGE(PG8_SA(0, 1), Ab, vAc[1]);
    if (wr == 1) PG8_BAR;
    PG8_WAIT_V(2); PG8_BAR;
    PG8_STAGE(PG8_SB(1, 0), cB + kstep, voffB); PG8_STAGE(PG8_SA(1, 0), Ab + kstep, vAc[0]); PG8_STAGE(PG8_SB(1, 1), cB + hstep + kstep, voffB);
    PG8_WAIT_V(6); PG8_BAR;
    for (;;) {
        const bool has_next = (ui + 1 < n_my);
        nxt = cur; if (has_next) nxt = read_unit(UT, ui + 1);
        const char* nB = has_next ? g.Bt + (size_t)nxt.e * g.b_estride + (size_t)nxt.pn * tstepB : cB;
        for (int t = 0; t < nt; t += 2) {
            const bool last = (t == nt - 2);
            const char* a1 = Ab + (size_t)(t + 1) * kstep;
            const char* a2 = last ? Ab : Ab + (size_t)(t + 2) * kstep; const char* b2 = last ? nB : cB + (size_t)(t + 2) * kstep;
            const char* a3 = a2 + kstep; const char* b3 = b2 + kstep;
            unsigned o2[2][2];
            if (last) {
                if (has_next) a_offsets<GATHER>(vAn, g, nxt, ui + 1, Rr, Cc2, TOK, tokn);
                else { vAn[0][0] = vAc[0][0]; vAn[0][1] = vAc[0][1]; vAn[1][0] = vAc[1][0]; vAn[1][1] = vAc[1][1]; }
                o2[0][0] = vAn[0][0]; o2[0][1] = vAn[0][1]; o2[1][0] = vAn[1][0]; o2[1][1] = vAn[1][1];
            } else { o2[0][0] = vAc[0][0]; o2[0][1] = vAc[0][1]; o2[1][0] = vAc[1][0]; o2[1][1] = vAc[1][1]; }
            PG8_LDB(B0, 0, 0); PG8_LDB(B1, 0, 1); PG8_SCHED; PG8_LDA(At, 0, 0); PG8_STAGE(PG8_SA(1, 1), a1, vAc[1]);
            PG8_WAIT_V(8); PG8_WAIT_L(0); PG8_BAR; PG8_MMA(0, 0, At, B0); PG8_MMA(0, 1, At, B1); PG8_BAR; PG8_SCHED;
            PG8_LDA(At, 0, 1); PG8_STAGE(PG8_SB(0, 0), b2, voffB); PG8_STAGE(PG8_SB(0, 1), b2 + hstep, voffB); PG8_STAGE(PG8_SA(0, 0), a2, o2[0]);
            PG8_WAIT_V(8); PG8_WAIT_L(0); PG8_BAR; PG8_MMA(1, 0, At, B0); PG8_MMA(1, 1, At, B1); PG8_BAR; PG8_SCHED;
            PG8_LDB(B0, 1, 0); PG8_LDB(B1, 1, 1); PG8_SCHED; PG8_LDA(At, 1, 0); PG8_STAGE(PG8_SA(0, 1), a2, o2[1]);
            PG8_WAIT_V(8); PG8_WAIT_L(0); PG8_BAR; PG8_MMA(0, 0, At, B0); PG8_MMA(0, 1, At, B1); PG8_BAR; PG8_SCHED;
            PG8_LDA(At, 1, 1); PG8_STAGE(PG8_SB(1, 0), b3, voffB); PG8_STAGE(PG8_SB(1, 1), b3 + hstep, voffB); PG8_STAGE(PG8_SA(1, 0), a3, o2[0]);
            PG8_WAIT_V(8); PG8_WAIT_L(0); PG8_BAR; PG8_MMA(1, 0, At, B0); PG8_MMA(1, 1, At, B1); PG8_BAR; PG8_SCHED;
        }
        if (wr == 0) PG8_BAR;
        if constexpr (FP8) asm volatile("s_nop 15" ::: "memory");
        E(acc, cur, wr, wc, fr, fq);
        if (!has_next) break;
#pragma unroll
        for (int a = 0; a < 2; ++a)
#pragma unroll
            for (int b = 0; b < 2; ++b)
#pragma unroll
                for (int m = 0; m < 4; ++m)
#pragma unroll
                    for (int n = 0; n < 2; ++n) acc[a][b][m][n] = (f32x4){0.f, 0.f, 0.f, 0.f};
        PG8_PIN_ACC();
        cur = nxt; cB = nB; ++ui;
        vAc[0][0] = vAn[0][0]; vAc[0][1] = vAn[0][1]; vAc[1][0] = vAn[1][0]; vAc[1][1] = vAn[1][1];
        if (wr == 1) PG8_BAR;
    }
    PG8_WAIT_V(0);
    PG8_BAR;
#undef PG8_SA
#undef PG8_SB
#undef PG8_STAGE
#undef PG8_LDA
#undef PG8_LDB
#undef PG8_MMA
#undef PG8_PIN_ACC
#undef PG8_CAT
#undef PG8_WAIT_V
#undef PG8_WAIT_L
#undef PG8_BAR
#undef PG8_SCHED
}

struct EpiOut {
    static constexpr bool PERM = true;
    const bf16* xres; bf16* z; const float* bias; const float* scale;
    __device__ __forceinline__ void operator()(const f32x4 (&acc)[2][2][4][2], const Unit& u, int wr, int wc, int fr, int fq) const {
        const int row0 = u.pm * BM + wr * 64 + fr, c0 = u.pn * BM + wc * 32 + 8 * fq;
        f32x4 bv[2][2], sv[2][2];
#pragma unroll
        for (int bj = 0; bj < 2; ++bj)
#pragma unroll
            for (int n = 0; n < 2; ++n) {
                bv[bj][n] = bias ? gld<f32x4>(bias + c0 + bj * HALF + 4 * n) : (f32x4){0.f, 0.f, 0.f, 0.f};
                sv[bj][n] = scale ? gld<f32x4>(scale + c0 + bj * HALF + 4 * n) : (f32x4){1.f, 1.f, 1.f, 1.f};
            }
#pragma unroll
        for (int ai = 0; ai < 2; ++ai)
#pragma unroll
            for (int m = 0; m < 4; ++m) { const size_t off = (size_t)(row0 + ai * HALF + m * 16) * D + c0;
#pragma unroll
                for (int bj = 0; bj < 2; ++bj) { const v4u xr = gld<v4u>(xres + off + bj * HALF);
                    const f32x4 x0 = (f32x4){bf_lo(xr.x), bf_hi(xr.x), bf_lo(xr.y), bf_hi(xr.y)}, x1 = (f32x4){bf_lo(xr.z), bf_hi(xr.z), bf_lo(xr.w), bf_hi(xr.w)};
                    const f32x4 o0 = x0 * ALPHA + (acc[ai][bj][m][0] + bv[bj][0]) * sv[bj][0], o1 = x1 * ALPHA + (acc[ai][bj][m][1] + bv[bj][1]) * sv[bj][1];
                    v4u w; w.x = cvt_pk_bf16(o0[0], o0[1]); w.y = cvt_pk_bf16(o0[2], o0[3]); w.z = cvt_pk_bf16(o1[0], o1[1]); w.w = cvt_pk_bf16(o1[2], o1[3]);
                    gst<v4u>(z + off + bj * HALF, w); }
                asm volatile("" ::: "memory"); }
    }
};
struct EpiPair {
    static constexpr bool PERM = true;
    bf16* O1; bf16* O2; const float* bias; int mode;
    __device__ __forceinline__ void operator()(const f32x4 (&acc)[2][2][4][2], const Unit& u, int wr, int wc, int fr, int fq) const {
        const int row0 = u.pm * BM + wr * 64 + fr;
        if (u.pn < 8) {
            const int j0 = u.pn * HALF + wc * 32 + 8 * fq;
            f32x4 b1[2], b2[2];
#pragma unroll
            for (int n = 0; n < 2; ++n) { b1[n] = mode ? gld<f32x4>(bias + j0 + 4 * n) : (f32x4){0.f, 0.f, 0.f, 0.f}; b2[n] = mode ? gld<f32x4>(bias + 1024 + j0 + 4 * n) : (f32x4){0.f, 0.f, 0.f, 0.f}; }
#pragma unroll
            for (int ai = 0; ai < 2; ++ai)
#pragma unroll
                for (int m = 0; m < 4; ++m) { bf16* rowp = O1 + (size_t)(row0 + ai * HALF + m * 16) * D + j0; f32x4 r[2];
#pragma unroll
                    for (int n = 0; n < 2; ++n) { const f32x4 g1 = acc[ai][0][m][n] + b1[n], g2 = acc[ai][1][m][n] + b2[n];
                        if (mode) { r[n][0] = g1[0] * sigmoidf_(g2[0]); r[n][1] = g1[1] * sigmoidf_(g2[1]); r[n][2] = g1[2] * sigmoidf_(g2[2]); r[n][3] = g1[3] * sigmoidf_(g2[3]); }
                        else r[n] = g1 * g2; }
                    v4u w; w.x = cvt_pk_bf16(r[0][0], r[0][1]); w.y = cvt_pk_bf16(r[0][2], r[0][3]); w.z = cvt_pk_bf16(r[1][0], r[1][1]); w.w = cvt_pk_bf16(r[1][2], r[1][3]);
                    gst<v4u>(rowp, w); }
        } else {
            const int c0 = (u.pn - 8) * BM + wc * 32 + 8 * fq;
#pragma unroll
            for (int ai = 0; ai < 2; ++ai)
#pragma unroll
                for (int m = 0; m < 4; ++m) { bf16* rowp = O2 + (size_t)(row0 + ai * HALF + m * 16) * D + c0;
#pragma unroll
                    for (int bj = 0; bj < 2; ++bj) { const f32x4 v0 = acc[ai][bj][m][0], v1 = acc[ai][bj][m][1];
                        v4u w; w.x = cvt_pk_bf16(v0[0], v0[1]); w.y = cvt_pk_bf16(v0[2], v0[3]); w.z = cvt_pk_bf16(v1[0], v1[1]); w.w = cvt_pk_bf16(v1[2], v1[3]);
                        gst<v4u>(rowp + bj * HALF, w); } }
        }
    }
};
struct EpiSwiglu {
    static constexpr bool PERM = true;
    unsigned char* act; const float* bgu;
    __device__ __forceinline__ void operator()(const f32x4 (&acc)[2][2][4][2], const Unit& u, int wr, int wc, int fr, int fq) const {
        const int row0 = u.pm * BM + wr * 64 + fr, j0 = u.pn * HALF + wc * 32 + 8 * fq;
        const float* bp = bgu + (size_t)u.e * 2048 + 2 * j0;
        float gb[8], ub[8];
#pragma unroll
        for (int i = 0; i < 4; ++i) { const f32x4 b = gld<f32x4>(bp + 4 * i); gb[2 * i] = b[0]; ub[2 * i] = b[1]; gb[2 * i + 1] = b[2]; ub[2 * i + 1] = b[3]; }
#pragma unroll
        for (int ai = 0; ai < 2; ++ai)
#pragma unroll
            for (int m = 0; m < 4; ++m) { unsigned char* rowp = act + (size_t)(row0 + ai * HALF + m * 16) * D + j0; float r[8];
#pragma unroll
                for (int n = 0; n < 2; ++n)
#pragma unroll
                    for (int q = 0; q < 4; ++q) { const int j = 4 * n + q;
                        const float gg = fminf(acc[ai][0][m][n][q] + gb[j], 7.0f);
                        const float uu = fminf(fmaxf(acc[ai][1][m][n][q] + ub[j], -7.0f), 7.0f);
                        r[j] = (uu + 1.0f) * (gg * sigmoidf_(1.702f * gg)) * SACT8; }
                gst<v2u>(rowp, pack8_fp8(r)); }
    }
};
struct EpiMoe2 {
    static constexpr bool PERM = true;
    unsigned char* Y; const float* bdn; const int* rowdst; const float* rowgate;
    __device__ __forceinline__ void operator()(const f32x4 (&acc)[2][2][4][2], const Unit& u, int wr, int wc, int fr, int fq) const {
        const int pos0 = u.pm * BM + wr * 64 + fr, c0 = u.pn * BM + wc * 32 + 8 * fq;
        const float* bp = bdn + (size_t)u.e * D + c0;
        f32x4 bv[2][2];
#pragma unroll
        for (int bj = 0; bj < 2; ++bj)
#pragma unroll
            for (int n = 0; n < 2; ++n) bv[bj][n] = gld<f32x4>(bp + bj * HALF + 4 * n);
        int dst[2][4]; float gt[2][4];
#pragma unroll
        for (int ai = 0; ai < 2; ++ai)
#pragma unroll
            for (int m = 0; m < 4; ++m) { const int pos = pos0 + ai * HALF + m * 16; dst[ai][m] = gld<int>(rowdst + pos); gt[ai][m] = gld<float>(rowgate + pos) * SY8; }
#pragma unroll
        for (int ai = 0; ai < 2; ++ai)
#pragma unroll
            for (int m = 0; m < 4; ++m) {
                if (dst[ai][m] >= 0) { unsigned char* rowp = Y + (size_t)dst[ai][m] * D + c0; const float s = gt[ai][m];
#pragma unroll
                    for (int bj = 0; bj < 2; ++bj) { const f32x4 v0 = (acc[ai][bj][m][0] + bv[bj][0]) * s, v1 = (acc[ai][bj][m][1] + bv[bj][1]) * s;
                        const float r[8] = {v0[0], v0[1], v0[2], v0[3], v1[0], v1[1], v1[2], v1[3]};
                        gst<v2u>(rowp + bj * HALF, pack8_fp8(r)); } } }
    }
};
}

__device__ __forceinline__ int chq(int lane, int q) { return (q >> 1) * 512 + 8 * lane + (q & 1) * 4; }
__device__ __forceinline__ v4u pack8(const float* v) { v4u w; w.x = cvt_pk_bf16(v[0], v[1]); w.y = cvt_pk_bf16(v[2], v[3]); w.z = cvt_pk_bf16(v[4], v[5]); w.w = cvt_pk_bf16(v[6], v[7]); return w; }
__device__ __forceinline__ void unpack8(const v4u w, float* v) { v[0] = bf_lo(w.x); v[1] = bf_hi(w.x); v[2] = bf_lo(w.y); v[3] = bf_hi(w.y); v[4] = bf_lo(w.z); v[5] = bf_hi(w.z); v[6] = bf_lo(w.w); v[7] = bf_hi(w.w); }

__device__ __forceinline__ int drow_of(int mode, int c) {
    if (mode == 1) { const int j = c >> 1, p = c & 1; return (j >> 7) * 256 + p * 128 + (j & 127); }
    if (mode == 2) { if (c < 1024) return 2048 + c; const int j = (c - 1024) & 1023, p = (c - 1024) >> 10; return (j >> 7) * 256 + p * 128 + (j & 127); }
    if (mode == 3) { const int j = c & 1023, p = c >> 10; return (j >> 7) * 256 + p * 128 + (j & 127); }
    return c;
}
struct TItem { const float* src; unsigned char* dst; int N, Kout  , k0, n0, mode, fp8; };
__device__ __forceinline__ void titem_load(const TItem& d, int lane, float (&tmp)[32]) {
#pragma unroll
    for (int i = 0; i < 32; ++i) { const int kk = 2 * i + (lane >> 5); tmp[i] = gld<float>(d.src + (size_t)(d.k0 + kk) * d.N + d.n0 + (lane & 31)); }
}
__device__ __forceinline__ void titem_store(const TItem& d, int lane, LAS float* scr, const float (&tmp)[32]) {
#pragma unroll
    for (int i = 0; i < 32; ++i) { const int kk = 2 * i + (lane >> 5); scr[kk * 33 + (lane & 31)] = tmp[i]; }
    LDS_WAIT(); asm volatile("" ::: "memory");
    const int c = lane & 7;
#pragma unroll
    for (int j = 0; j < 4; ++j) { const int n = (lane >> 3) + 8 * j; const LAS float* s = scr + (8 * c) * 33 + n;
        float v[8];
#pragma unroll
        for (int i = 0; i < 8; ++i) v[i] = s[i * 33];
        const size_t e = (size_t)drow_of(d.mode, d.n0 + n) * d.Kout + d.k0 + 8 * c;
        if (d.fp8) {
#pragma unroll
            for (int i = 0; i < 8; ++i) v[i] *= SW8;
            gst<v2u>(d.dst + e, pack8_fp8(v));
        } else gst<v4u>(d.dst + 2 * e, pack8(v)); }
    LDS_WAIT(); asm volatile("" ::: "memory");
}

struct Args { const float* in[24]; float* out; unsigned char* ws; };
#define CAS __attribute__((address_space(4)))
__device__ __forceinline__ const void* karg_ptr(int off) {
    const CAS char* kp = (const CAS char*)__builtin_amdgcn_kernarg_segment_ptr();
    asm volatile("" : "+s"(off));
    return *(const void* const CAS*)(kp + off);
}
#define ARG_IN(i) ((const float*)karg_ptr(8 * (i)))
#define ARG_OUT() ((float*)karg_ptr(8 * 24))
#define ARG_WS() ((unsigned char*)karg_ptr(8 * 25))

#define PHASE_BEGIN() \
    int tid = threadIdx.x; asm volatile("" : "+v"(tid)); \
    const int lane = tid & 63, wave = __builtin_amdgcn_readfirstlane(tid >> 6); \
    unsigned char* ws_ = ARG_WS(); asm volatile("" : "+s"(ws_)); unsigned char* ws = (unsigned char*)(GAS unsigned char*)ws_; \
    unsigned* ctl = (unsigned*)(ws + WS_CTL); \
    const int gw = vcu * NWAVES + wave, NGW = G * NWAVES; (void)gw; (void)NGW; (void)lane; (void)ctl;

__device__ __forceinline__ float butterfly32(float (&p)[32], int lane) {
#pragma unroll
    for (int i = 0; i < 16; ++i) { const bool hi = (lane & 32) != 0; const float snd = hi ? p[i] : p[i + 16]; const float keep = hi ? p[i + 16] : p[i]; p[i] = keep + shx(snd, 32, lane); }
#pragma unroll
    for (int i = 0; i < 8; ++i) { const bool hi = (lane & 16) != 0; const float snd = hi ? p[i] : p[i + 8]; const float keep = hi ? p[i + 8] : p[i]; p[i] = keep + shx(snd, 16, lane); }
#pragma unroll
    for (int i = 0; i < 4; ++i) { const bool hi = (lane & 8) != 0; const float snd = hi ? p[i] : p[i + 4]; const float keep = hi ? p[i + 4] : p[i]; p[i] = keep + shx(snd, 8, lane); }
#pragma unroll
    for (int i = 0; i < 2; ++i) { const bool hi = (lane & 4) != 0; const float snd = hi ? p[i] : p[i + 2]; const float keep = hi ? p[i + 2] : p[i]; p[i] = keep + shx(snd, 4, lane); }
    { const bool hi = (lane & 2) != 0; const float snd = hi ? p[0] : p[1]; const float keep = hi ? p[1] : p[0]; p[0] = keep + shx(snd, 2, lane); }
    return p[0] + shx(p[0], 1, lane);
}
__device__ __forceinline__ void ln16(float (&v)[16], const float (&lg)[16], const float (&lb)[16], int lane) {
    float sm = 0.f;
#pragma unroll
    for (int i = 0; i < 16; ++i) sm += v[i];
    const float mean = wave_sum(sm, lane) * (1.0f / D);
    float sq = 0.f;
#pragma unroll
    for (int i = 0; i < 16; ++i) { v[i] -= mean; sq += v[i] * v[i]; }
    const float rstd = 1.0f / sqrtf(wave_sum(sq, lane) * (1.0f / D) + LN_EPS);
#pragma unroll
    for (int i = 0; i < 16; ++i) v[i] = v[i] * rstd * lg[i] + lb[i];
}
__device__ __forceinline__ void route_token(const float logit, const int myexp, const int lane, const int t, int* TIDX, float* TGATE, LAS unsigned* hist, const bool count) {
    int rank = 0;
#pragma unroll
    for (int e = 0; e < 32; ++e) { const float se = __uint_as_float((unsigned)__builtin_amdgcn_readlane((int)__float_as_uint(logit), 2 * e)); rank += (se > logit || (se == logit && e < myexp)) ? 1 : 0; }
    float tv[4]; int tix[4];
#pragma unroll
    for (int r = 0; r < 4; ++r) { const unsigned long long mk = __ballot(rank == r); const int src = (int)__builtin_ctzll(mk | (1ull << 63));
        tv[r] = __uint_as_float((unsigned)__builtin_amdgcn_readlane((int)__float_as_uint(logit), src)); tix[r] = src >> 1; }
    const float e1 = __expf(tv[1] - tv[0]), e2 = __expf(tv[2] - tv[0]), e3 = __expf(tv[3] - tv[0]);
    const float inv = 1.0f / (1.0f + e1 + e2 + e3);
    if (lane < 4) {
        const int ix = lane == 0 ? tix[0] : lane == 1 ? tix[1] : lane == 2 ? tix[2] : tix[3];
        const float gv = (lane == 0 ? 1.0f : lane == 1 ? e1 : lane == 2 ? e2 : e3) * inv;
        gst<int>(TIDX + t * 4 + lane, ix); gst<float>(TGATE + t * 4 + lane, gv);
        if (count) __hip_atomic_fetch_add(hist + ix, 1u, __ATOMIC_RELAXED, __HIP_MEMORY_SCOPE_WORKGROUP);
    }
}
__device__ __forceinline__ void ln16_lds(float (&v)[16], const LAS f32x4* lnp, int lane) {
    float sm = 0.f;
#pragma unroll
    for (int i = 0; i < 16; ++i) sm += v[i];
    const float mean = wave_sum(sm, lane) * (1.0f / D);
    float sq = 0.f;
#pragma unroll
    for (int i = 0; i < 16; ++i) { v[i] -= mean; sq += v[i] * v[i]; }
    const float rstd = 1.0f / sqrtf(wave_sum(sq, lane) * (1.0f / D) + LN_EPS);
#pragma unroll
    for (int q = 0; q < 4; ++q) { const f32x4 g4 = lnp[q * 64 + lane], b4 = lnp[(4 + q) * 64 + lane];
#pragma unroll
        for (int i = 0; i < 4; ++i) v[4 * q + i] = v[4 * q + i] * rstd * g4[i] + b4[i]; }
}
template <bool F32IN>
__device__ __forceinline__ void pool_diff_run(const float* xf, const bf16* xb, bf16* M3, int t0, int lane) {
    const int s0 = t0 & (SEQ - 1);
#pragma unroll
    for (int g = 0; g < 4; ++g) {
        const int w = 2 << g, c = 256 * g + 4 * lane;
        f32x4 r[31];
#pragma unroll
        for (int j = 0; j < w + 15; ++j) {
            const int dt = j - (w - 1);
            if (dt >= 0 || s0 != 0) {
                const size_t o = (size_t)(t0 + dt) * D + c;
                if (F32IN) r[j] = gld<f32x4>(xf + o);
                else { const v2u q = gld<v2u>(xb + o); r[j] = (f32x4){bf_lo(q.x), bf_hi(q.x), bf_lo(q.y), bf_hi(q.y)}; }
            } else r[j] = (f32x4){0.f, 0.f, 0.f, 0.f};
        }
#pragma unroll
        for (int i = 0; i < 16; ++i) {
            f32x4 sum = r[i];
#pragma unroll
            for (int j = 1; j < w; ++j) sum += r[i + j];
            const int nv = (s0 + i + 1 < w) ? s0 + i + 1 : w;
            const f32x4 df = sum * (1.0f / (float)nv) - r[i + w - 1];
            v2u o; o.x = cvt_pk_bf16(df[0], df[1]); o.y = cvt_pk_bf16(df[2], df[3]);
            gst<v2u>(M3 + (size_t)(t0 + i) * D + c, o);
        }
    }
}

__global__ void __launch_bounds__(NTHR, 2) mega_fwd(Args args) {
    extern __shared__ __attribute__((aligned(16))) unsigned char lds_raw[];
    LAS unsigned char* lds = (LAS unsigned char*)lds_raw;
    volatile LAS unsigned* MISC = (volatile LAS unsigned*)(lds + MISC_OFF);
    const int G = gridDim.x, bx = blockIdx.x;
    const int vcu = (G % 8 == 0) ? (bx % 8) * (G / 8) + bx / 8 : bx;
    if (threadIdx.x < 128) MISC[threadIdx.x] = 0u;
    __syncthreads();
    (void)xcd_barrier_post((unsigned*)(ARG_WS() + WS_CTL) + CW_BAR, MISC + 0);
#define GRID_BAR() do { XcdBarrier b_; unsigned* bp_ = (unsigned*)(ARG_WS() + WS_CTL) + CW_BAR; asm volatile("" : "+s"(bp_)); b_.bar = (unsigned*)(GAS unsigned*)bp_; b_.x = xb_xcc_id(); b_.st = MISC; xcd_barrier(b_); } while (0)

    {
        PHASE_BEGIN();
        {
            constexpr int TPITCH = 129, TBUF = 128 * TPITCH;
            LAS float* tl = (LAS float*)(lds + RING_OFF);
            constexpr int NT_GU = 128 * 8 * 16, NT_DN = 128 * 8 * 8, NT = NT_GU + NT_DN;
            struct WTile { const float* src; unsigned char* dst; int N, nb, kb, mode; };
#define WT_DECODE(ti_, d_) do { int r_ = (ti_); if (r_ < NT_GU) { const int mt_ = r_ >> 7; r_ &= 127; (d_).kb = r_ >> 4; (d_).nb = r_ & 15; (d_).N = 2048; (d_).mode = 1; \
                (d_).src = ARG_IN(18) + (size_t)mt_ * 1024 * 2048; (d_).dst = ws + WS_WGU + (size_t)mt_ * 2048 * 1024; } \
            else { r_ -= NT_GU; const int mt_ = r_ >> 6; r_ &= 63; (d_).kb = r_ >> 3; (d_).nb = r_ & 7; (d_).N = 1024; (d_).mode = 0; \
                (d_).src = ARG_IN(20) + (size_t)mt_ * 1024 * 1024; (d_).dst = ws + WS_WDN + (size_t)mt_ * 1024 * 1024; } } while (0)
#define WT_LOAD(R_, d_) do { _Pragma("unroll") for (int i = 0; i < 16; ++i) R_[i] = gld<v2u>((d_).src + (size_t)((d_).kb * 128 + wave * 16 + i) * (d_).N + (d_).nb * 128 + 2 * lane); } while (0)
#define WT_TOLDS(R_, buf_) do { const int col_ = (2 * lane + 4 * wave) & 127; _Pragma("unroll") for (int i = 0; i < 16; ++i) { LAS float* p_ = tl + (buf_) * TBUF + (wave * 16 + i) * TPITCH + col_; \
                p_[0] = __uint_as_float(R_[i].x); p_[1] = __uint_as_float(R_[i].y); } } while (0)
#define WT_OUT(d_, buf_) do { const int kc_ = tid & 7; _Pragma("unroll") for (int p = 0; p < 2; ++p) { const int n_ = (tid >> 3) + 64 * p; const LAS float* s_ = tl + (buf_) * TBUF + (16 * kc_) * TPITCH + ((n_ + 4 * kc_) & 127); \
                float v_[16]; _Pragma("unroll") for (int i = 0; i < 16; ++i) v_[i] = s_[i * TPITCH] * SW8; \
                const v2u a_ = pack8_fp8(v_), b_ = pack8_fp8(v_ + 8); v4u o_; o_.x = a_.x; o_.y = a_.y; o_.z = b_.x; o_.w = b_.y; \
                gst<v4u>((d_).dst + (size_t)drow_of((d_).mode, (d_).nb * 128 + n_) * 1024 + (d_).kb * 128 + 16 * kc_, o_); } } while (0)
#define WT_BAR() do { LDS_WAIT(); __builtin_amdgcn_s_barrier(); asm volatile("" ::: "memory"); } while (0)
            for (int rep = 0; rep < REP_P0; ++rep) {
                v2u R0[16], R1[16]; WTile d0, d1, dn;
                int ti = vcu;
                d0.src = nullptr; d1.src = nullptr;
                if (ti < NT) { WT_DECODE(ti, d0); WT_LOAD(R0, d0); }
                if (ti + G < NT) { WT_DECODE(ti + G, d1); WT_LOAD(R1, d1); }
                for (; ti < NT; ti += 2 * G) {
                    WT_TOLDS(R0, 0);
                    const bool h2 = (ti + 2 * G < NT);
                    if (h2) { WT_DECODE(ti + 2 * G, dn); WT_LOAD(R0, dn); }
                    WT_BAR();
                    WT_OUT(d0, 0);
                    if (h2) d0 = dn;
                    if (ti + G < NT) {
                        WT_TOLDS(R1, 1);
                        const bool h3 = (ti + 3 * G < NT);
                        if (h3) { WT_DECODE(ti + 3 * G, dn); WT_LOAD(R1, dn); }
                        WT_BAR();
                        WT_OUT(d1, 1);
                        if (h3) d1 = dn;
                    }
                }
                WT_BAR();
            }
#undef WT_DECODE
#undef WT_LOAD
#undef WT_TOLDS
#undef WT_OUT
#undef WT_BAR
        }
        LAS float* scr = (LAS float*)(lds + RING_OFF + wave * 16384);
        constexpr int I_POOL = 4 * 8, I_SCIN = 16 * 96, I_SQ = 16 * 32, I_CFIN = 16 * 64;
        constexpr int N_POOL = 8 * I_POOL;
        constexpr int NITEMS = N_POOL + I_SCIN + I_SQ + I_CFIN + I_SQ;
#define TITEM_SET(d_, src_, K_, N_, dst_, mode_, fp8_, item_) do { const int nb_ = (N_) / 32; (d_).src = (src_); (d_).dst = (unsigned char*)(dst_); (d_).N = (N_); (d_).Kout = (K_); \
        (d_).k0 = 64 * ((item_) / nb_); (d_).n0 = 32 * ((item_) % nb_); (d_).mode = (mode_); (d_).fp8 = (fp8_); } while (0)
#define TITEM_DECODE(it_, d_) do { int r_ = (it_); \
        if (r_ < N_POOL) { const int mt_ = r_ / I_POOL; TITEM_SET(d_, ARG_IN(1) + (size_t)mt_ * 256 * 256, 256, 256, ws + WS_WPOOL + (size_t)mt_ * 256 * 256 * 2, 0, 0, r_ % I_POOL); break; } r_ -= N_POOL; \
        if (r_ < I_SCIN) { TITEM_SET(d_, ARG_IN(3), 1024, 3072, ws + WS_WSCIN, 2, 0, r_); break; } r_ -= I_SCIN; \
        if (r_ < I_SQ) { TITEM_SET(d_, ARG_IN(5), 1024, 1024, ws + WS_WSCOUT, 0, 0, r_); break; } r_ -= I_SQ; \
        if (r_ < I_CFIN) { TITEM_SET(d_, ARG_IN(6), 1024, 2048, ws + WS_WCFIN, 3, 0, r_); break; } r_ -= I_CFIN; \
        TITEM_SET(d_, ARG_IN(12), 1024, 1024, ws + WS_WCFOUT, 0, 0, r_); } while (0)
        for (int it = gw; it < NITEMS; it += NGW) { TItem cur; float ta[32]; TITEM_DECODE(it, cur); titem_load(cur, lane, ta); titem_store(cur, lane, scr, ta); }
#undef TITEM_SET
#undef TITEM_DECODE
        const float* x0 = ARG_IN(0); bf16* XAb = (bf16*)(ws + WS_XAB);
        for (int t = gw; t < T; t += NGW) {
            float v[16];
#pragma unroll
            for (int q = 0; q < 4; ++q) { const f32x4 z = gld<f32x4>(x0 + (size_t)t * D + chq(lane, q)); v[4 * q] = z[0]; v[4 * q + 1] = z[1]; v[4 * q + 2] = z[2]; v[4 * q + 3] = z[3]; }
            gst<v4u>(XAb + (size_t)t * D + 8 * lane, pack8(v));
            gst<v4u>(XAb + (size_t)t * D + 512 + 8 * lane, pack8(v + 8));
        }
    }
    GRID_BAR();

    for (int layer = 0; layer < DEPTH; ++layer) {
        const int kind = layer % 3;

        if (kind == 0) {
            PHASE_BEGIN();
            bf16* M3 = (bf16*)(ws + WS_M3); const bf16* xb = (const bf16*)(ws + WS_XAB);
            for (int rep = 0; rep < REP_THIN; ++rep)
            for (int tb = vcu; tb < T / 128; tb += G) {
                const int t0 = tb * 128 + wave * 16;
                if (layer == 0) pool_diff_run<true>(ARG_IN(0), xb, M3, t0, lane);
                else pool_diff_run<false>(ARG_IN(0), xb, M3, t0, lane);
            }
        } else {
            {
                PHASE_BEGIN();
                bf16* M1 = (bf16*)(ws + WS_M1); bf16* M2 = (bf16*)(ws + WS_M2);
                const int nN = (kind == 1) ? 12 : 8;
                const int n_my = pg8::build_units(lds, tid, T / 256, nN, G, bx, false, nullptr, REP_MIXG);
                pg8::GemmP gp; gp.A = (const char*)(ws + WS_XAB); gp.lda2 = D * 2; gp.acol_pn = 0; gp.Bt = (const char*)(ws + ((kind == 1) ? WS_WSCIN : WS_WCFIN)); gp.b_estride = 0; gp.Kb = 2048; gp.sA = 0; gp.sB = 0;
                pg8::EpiPair E; E.O1 = (kind == 1) ? M2 : M1; E.O2 = M1; E.bias = ARG_IN(7); E.mode = (kind == 1) ? 0 : 1;
                pg8::gemm_phase<false, false, pg8::EpiPair>(lds, tid, gp, n_my, E);
            }
            GRID_BAR();
            if (kind == 1) {
                PHASE_BEGIN();
                const bf16* M1 = (const bf16*)(ws + WS_M1); const bf16* M2 = (const bf16*)(ws + WS_M2); bf16* M3 = (bf16*)(ws + WS_M3);
                const float* cw = ARG_IN(4);
                float wk[3][16];
#pragma unroll
                for (int k = 0; k < 3; ++k)
#pragma unroll
                    for (int q = 0; q < 4; ++q) { const f32x4 v = gld<f32x4>(cw + k * D + chq(lane, q)); wk[k][4 * q] = v[0]; wk[k][4 * q + 1] = v[1]; wk[k][4 * q + 2] = v[2]; wk[k][4 * q + 3] = v[3]; }
                for (int rep = 0; rep < REP_THIN; ++rep)
                for (int tb = vcu; tb < T / 128; tb += G) {
                    const int t0 = tb * 128 + wave * 16, s0 = t0 & (SEQ - 1);
                    float p2[16], p1[16];
                    if (s0 != 0) { unpack8(gld<v4u>(M2 + (size_t)(t0 - 2) * D + 8 * lane), p2); unpack8(gld<v4u>(M2 + (size_t)(t0 - 2) * D + 512 + 8 * lane), p2 + 8);
                                   unpack8(gld<v4u>(M2 + (size_t)(t0 - 1) * D + 8 * lane), p1); unpack8(gld<v4u>(M2 + (size_t)(t0 - 1) * D + 512 + 8 * lane), p1 + 8); }
                    else {
#pragma unroll
                        for (int i = 0; i < 16; ++i) { p2[i] = 0.f; p1[i] = 0.f; } }
                    for (int i0 = 0; i0 < 16; i0 += 4) {
                        v4u cv[4][2], gv[4][2];
#pragma unroll
                        for (int u = 0; u < 4; ++u)
#pragma unroll
                            for (int j = 0; j < 2; ++j) { const size_t o = (size_t)(t0 + i0 + u) * D + j * 512 + 8 * lane; cv[u][j] = gld<v4u>(M2 + o); gv[u][j] = gld<v4u>(M1 + o); }
#pragma unroll
                        for (int u = 0; u < 4; ++u) {
                            float c[16], gb[16], o[16];
                            unpack8(cv[u][0], c); unpack8(cv[u][1], c + 8); unpack8(gv[u][0], gb); unpack8(gv[u][1], gb + 8);
#pragma unroll
                            for (int i = 0; i < 16; ++i) { o[i] = gb[i] * (wk[0][i] * p2[i] + wk[1][i] * p1[i] + wk[2][i] * c[i]); p2[i] = p1[i]; p1[i] = c[i]; }
                            gst<v4u>(M3 + (size_t)(t0 + i0 + u) * D + 8 * lane, pack8(o));
                            gst<v4u>(M3 + (size_t)(t0 + i0 + u) * D + 512 + 8 * lane, pack8(o + 8));
                        }
                    }
                }
            } else {
                PHASE_BEGIN();
                const bf16* U = (const bf16*)(ws + WS_M1); bf16* M3 = (bf16*)(ws + WS_M3);
                const int c = 128 * wave + 2 * lane;
                float wk0[31], wk1[31];
#pragma unroll
                for (int k = 0; k < 31; ++k) { const v2u q = gld<v2u>(ARG_IN(8) + k * D + c); wk0[k] = __uint_as_float(q.x); wk1[k] = __uint_as_float(q.y); }
                const v2u qb = gld<v2u>(ARG_IN(9) + c), qg = gld<v2u>(ARG_IN(10) + c), ql = gld<v2u>(ARG_IN(11) + c);
                const float db0 = __uint_as_float(qb.x), db1 = __uint_as_float(qb.y), lg0 = __uint_as_float(qg.x), lg1 = __uint_as_float(qg.y), lb0 = __uint_as_float(ql.x), lb1 = __uint_as_float(ql.y);
                LAS float* part = (LAS float*)(lds + RING_OFF);
                LAS float* stat = part + 256;
                for (int rep = 0; rep < REP_THIN; ++rep)
                for (int run = vcu; run < T / 16; run += G) {
                    const int t0 = run * 16, s0 = t0 & (SEQ - 1);
                    unsigned r[46];
#pragma unroll
                    for (int j = 0; j < 46; ++j) r[j] = (s0 + j - 30 >= 0) ? gld<unsigned>(U + (size_t)(t0 + j - 30) * D + c) : 0u;
                    float a0[16], a1[16];
#pragma unroll
                    for (int i = 0; i < 16; ++i) { a0[i] = db0; a1[i] = db1; }
#pragma unroll
                    for (int j = 0; j < 46; ++j) { const float x0 = bf_lo(r[j]), x1 = bf_hi(r[j]);
#pragma unroll
                        for (int i = 0; i < 16; ++i) { const int k = j - i; if (k >= 0 && k <= 30) { a0[i] += wk0[k] * x0; a1[i] += wk1[k] * x1; } } }
                    float st[32];
#pragma unroll
                    for (int i = 0; i < 16; ++i) { st[2 * i] = a0[i] + a1[i]; st[2 * i + 1] = a0[i] * a0[i] + a1[i] * a1[i]; }
                    const float tot = butterfly32(st, lane);
                    if ((lane & 1) == 0) part[wave * 32 + (lane >> 1)] = tot;
                    __syncthreads();
                    if (tid < 16) { float S = 0.f, Q = 0.f;
#pragma unroll
                        for (int w8 = 0; w8 < 8; ++w8) { S += part[w8 * 32 + 2 * tid]; Q += part[w8 * 32 + 2 * tid + 1]; }
                        const float mean = S * (1.0f / D); const float var = fmaxf(Q * (1.0f / D) - mean * mean, 0.f);
                        stat[2 * tid] = mean; stat[2 * tid + 1] = 1.0f / sqrtf(var + LN_EPS); }
                    __syncthreads();
#pragma unroll
                    for (int i = 0; i < 16; ++i) { const float mean = stat[2 * i], rstd = stat[2 * i + 1];
                        const float y0 = (a0[i] - mean) * rstd * lg0 + lb0, y1 = (a1[i] - mean) * rstd * lg1 + lb1;
                        gst<unsigned>(M3 + (size_t)(t0 + i) * D + c, cvt_pk_bf16(y0 * sigmoidf_(y0), y1 * sigmoidf_(y1))); }
                }
                __syncthreads();
            }
        }
        GRID_BAR();

        {
            PHASE_BEGIN();
            const int n_my = pg8::build_units(lds, tid, T / 256, 4, G, bx, false, nullptr, REP_MIXG);
            pg8::GemmP gp; gp.A = (const char*)(ws + WS_M3); gp.lda2 = D * 2; gp.b_estride = 0; gp.sA = 0; gp.sB = 0;
            pg8::EpiOut E; E.xres = (const bf16*)(ws + WS_XAB); E.z = (bf16*)(ws + WS_ZB); E.bias = nullptr; E.scale = nullptr;
            if (kind == 0) { gp.acol_pn = 512; gp.Bt = (const char*)(ws + WS_WPOOL + (size_t)(layer / 3) * 1024 * 256 * 2); gp.Kb = 512; E.scale = ARG_IN(2) + (layer / 3) * D; }
            else if (kind == 1) { gp.acol_pn = 0; gp.Bt = (const char*)(ws + WS_WSCOUT); gp.Kb = 2048; }
            else { gp.acol_pn = 0; gp.Bt = (const char*)(ws + WS_WCFOUT); gp.Kb = 2048; E.bias = ARG_IN(13); }
            pg8::gemm_phase<false, false, pg8::EpiOut>(lds, tid, gp, n_my, E);
        }
        GRID_BAR();

        {
            PHASE_BEGIN();
            const bf16* Zb = (const bf16*)(ws + WS_ZB); bf16* X1b = (bf16*)(ws + WS_X1B); unsigned char* X18 = (unsigned char*)(ws + WS_X18);
            int* TIDX = (int*)(ws + WS_IDX); float* TGATE = (float*)(ws + WS_GATE);
            unsigned* CNT = ctl + CW_CNT + layer * NE;
            LAS float* rwl = (LAS float*)(lds + RING_OFF);
            const float* rw = ARG_IN(16) + (size_t)layer * D * NE;
            for (int idx = tid; idx < D * 8; idx += NTHR) { const int c = idx >> 3, eg = idx & 7; const int j = c >> 9, r = c & 511, l = r >> 3, ci = j * 8 + (r & 7);
                *(LAS f32x4*)(rwl + ((ci * 8 + eg) * 64 + l) * 4) = gld<f32x4>(rw + c * NE + eg * 4); }
            if (tid < NE) MISC[32 + tid] = 0u;
            __syncthreads();
            LAS f32x4* lnp = (LAS f32x4*)(lds + TOK_OFF);
            if (tid < 256) { const int q = tid >> 6, l = tid & 63; lnp[q * 64 + l] = gld<f32x4>(ARG_IN(14) + layer * D + chq(l, q)); lnp[(4 + q) * 64 + l] = gld<f32x4>(ARG_IN(15) + layer * D + chq(l, q)); }
            __syncthreads();
            const int myexp = (lane >> 1) & 31;
            const float rbias = gld<float>(ARG_IN(17) + layer * NE + myexp);
            LAS unsigned* hist = (LAS unsigned*)(lds + MISC_OFF) + 32;
            for (int rep = 0; rep < REP_LNR; ++rep)
            for (int tb = vcu; tb < T / 128; tb += G) {
                const int t0 = tb * 128 + wave * 16;
                v4u zn[2][2];
#pragma unroll
                for (int u = 0; u < 2; ++u)
#pragma unroll
                    for (int j = 0; j < 2; ++j) zn[u][j] = gld<v4u>(Zb + (size_t)(t0 + u) * D + j * 512 + 8 * lane);
                for (int ti = 0; ti < 16; ti += 2) {
                    const int t = t0 + ti;
                    float va[16], vb[16];
                    unpack8(zn[0][0], va); unpack8(zn[0][1], va + 8); unpack8(zn[1][0], vb); unpack8(zn[1][1], vb + 8);
                    if (ti + 2 < 16) {
#pragma unroll
                        for (int u = 0; u < 2; ++u)
#pragma unroll
                            for (int j = 0; j < 2; ++j) zn[u][j] = gld<v4u>(Zb + (size_t)(t + 2 + u) * D + j * 512 + 8 * lane); }
                    ln16_lds(va, lnp, lane); ln16_lds(vb, lnp, lane);
                    gst<v4u>(X1b + (size_t)t * D + 8 * lane, pack8(va)); gst<v4u>(X1b + (size_t)t * D + 512 + 8 * lane, pack8(va + 8));
                    gst<v4u>(X1b + (size_t)(t + 1) * D + 8 * lane, pack8(vb)); gst<v4u>(X1b + (size_t)(t + 1) * D + 512 + 8 * lane, pack8(vb + 8));
                    { float s8[16];
#pragma unroll
                      for (int i = 0; i < 16; ++i) s8[i] = va[i] * SX8;
                      gst<v2u>(X18 + (size_t)t * D + 8 * lane, pack8_fp8(s8)); gst<v2u>(X18 + (size_t)t * D + 512 + 8 * lane, pack8_fp8(s8 + 8));
#pragma unroll
                      for (int i = 0; i < 16; ++i) s8[i] = vb[i] * SX8;
                      gst<v2u>(X18 + (size_t)(t + 1) * D + 8 * lane, pack8_fp8(s8)); gst<v2u>(X18 + (size_t)(t + 1) * D + 512 + 8 * lane, pack8_fp8(s8 + 8)); }
                    f32x2 pa[16], pb[16];
#pragma unroll
                    for (int e = 0; e < 16; ++e) { pa[e] = (f32x2){0.f, 0.f}; pb[e] = (f32x2){0.f, 0.f}; }
                    f32x4 w0[8], w1[8];
#define RW_LOAD(dst, ci) do { _Pragma("unroll") for (int eg = 0; eg < 8; ++eg) dst[eg] = *(const LAS f32x4*)(rwl + (((ci) * 8 + eg) * 64 + lane) * 4); asm volatile("" ::: "memory"); } while (0)
#define RW_FMA(wsrc, ci) do { const f32x2 sa = (f32x2){va[ci], va[ci]}, sb = (f32x2){vb[ci], vb[ci]}; _Pragma("unroll") for (int eg = 0; eg < 8; ++eg) { \
                        const f32x2 lo = (f32x2){wsrc[eg][0], wsrc[eg][1]}, hi = (f32x2){wsrc[eg][2], wsrc[eg][3]}; \
                        pa[2 * eg] = __builtin_elementwise_fma(lo, sa, pa[2 * eg]); pa[2 * eg + 1] = __builtin_elementwise_fma(hi, sa, pa[2 * eg + 1]); \
                        pb[2 * eg] = __builtin_elementwise_fma(lo, sb, pb[2 * eg]); pb[2 * eg + 1] = __builtin_elementwise_fma(hi, sb, pb[2 * eg + 1]); } } while (0)
                    RW_LOAD(w0, 0);
#pragma unroll
                    for (int ci = 0; ci < 16; ci += 2) {
                        RW_LOAD(w1, ci + 1);
                        RW_FMA(w0, ci);
                        if (ci + 2 < 16) RW_LOAD(w0, ci + 2);
                        RW_FMA(w1, ci + 1);
                    }
#undef RW_LOAD
#undef RW_FMA
                    float qa[32], qb[32];
#pragma unroll
                    for (int e = 0; e < 16; ++e) { qa[2 * e] = pa[e][0]; qa[2 * e + 1] = pa[e][1]; qb[2 * e] = pb[e][0]; qb[2 * e + 1] = pb[e][1]; }
                    const float logitA = butterfly32(qa, lane) + rbias, logitB = butterfly32(qb, lane) + rbias;
                    route_token(logitA, myexp, lane, t, TIDX, TGATE, hist, rep == 0);
                    route_token(logitB, myexp, lane, t + 1, TIDX, TGATE, hist, rep == 0);
                }
            }
            __syncthreads();
            if (tid < NE) { const unsigned c = MISC[32 + tid]; if (c) (void)xb_add(CNT + tid, c); }
        }
        GRID_BAR();

        {
            PHASE_BEGIN();
            const int* TIDX = (const int*)(ws + WS_IDX); const float* TGATE = (const float*)(ws + WS_GATE);
            int* RTOK = (int*)(ws + WS_RTOK); int* RDST = (int*)(ws + WS_RDST); float* RGATE = (float*)(ws + WS_RGATE);
            unsigned* CNT = ctl + CW_CNT + layer * NE; unsigned* CUR = ctl + CW_CUR + layer * NE;
            LAS int* TS = (LAS int*)(lds + TS_OFF);
            if (tid == 0) { int a = 0; for (int e = 0; e < NE; ++e) { TS[e] = a; a += (int)((xb_ld(CNT + e) + 255u) >> 8); } TS[NE] = a; }
            for (int tb = vcu; tb < T / 128; tb += G) {
                __syncthreads();
                if (tid < NE) MISC[32 + tid] = 0u;
                __syncthreads();
                const int t = tb * 128 + (tid >> 2), k = tid & 3;
                const int e = gld<int>(TIDX + t * 4 + k); const float gv = gld<float>(TGATE + t * 4 + k);
                const unsigned rank = __hip_atomic_fetch_add((LAS unsigned*)(lds + MISC_OFF) + 32 + e, 1u, __ATOMIC_RELAXED, __HIP_MEMORY_SCOPE_WORKGROUP);
                __syncthreads();
                if (tid < NE) { const unsigned c = MISC[32 + tid]; MISC[64 + tid] = c ? xb_add(CUR + tid, c) : 0u; }
                __syncthreads();
                const int pos = TS[e] * 256 + (int)MISC[64 + e] + (int)rank;
                gst<int>(RTOK + pos, t); gst<int>(RDST + pos, t * 4 + k); gst<float>(RGATE + pos, gv);
            }
            __syncthreads();
            for (int e = vcu; e < NE; e += G) {
                const int beg = TS[e] * 256 + (int)xb_ld(CNT + e), end = TS[e + 1] * 256;
                for (int p = beg + tid; p < end; p += NTHR) { gst<int>(RTOK + p, 0); gst<int>(RDST + p, -1); gst<float>(RGATE + p, 0.f); }
            }
        }
        GRID_BAR();

        {
            PHASE_BEGIN();
            unsigned* CNT = ctl + CW_CNT + layer * NE;
            LAS int* TS = (LAS int*)(lds + TS_OFF);
            __syncthreads();
            if (tid == 0) { int a = 0; for (int e = 0; e < NE; ++e) { TS[e] = a; a += (int)((xb_ld(CNT + e) + 255u) >> 8); } TS[NE] = a; }
            __syncthreads();
            const int nM = TS[NE];
            const int n_my = pg8::build_units(lds, tid, nM, 8, G, bx, true, (const int*)(ws + WS_RTOK), REP_MOE1);
            pg8::GemmP gp; gp.A = (const char*)(ws + WS_X18); gp.lda2 = D; gp.acol_pn = 0; gp.Bt = (const char*)(ws + WS_WGU + (size_t)layer * NE * 2048 * 1024); gp.b_estride = (size_t)2048 * 1024; gp.Kb = 1024; gp.sA = E8_X; gp.sB = E8_W;
            pg8::EpiSwiglu E; E.act = (unsigned char*)(ws + WS_ACT); E.bgu = ARG_IN(19) + (size_t)layer * NE * 2048;
            pg8::gemm_phase<true, true, pg8::EpiSwiglu>(lds, tid, gp, n_my, E, REP_MOE1 > 1 ? n_my / 2 : (1 << 20));
        }
        GRID_BAR();

        {
            PHASE_BEGIN();
            LAS int* TS = (LAS int*)(lds + TS_OFF);
            const int nM = TS[NE];
            const int n_my = pg8::build_units(lds, tid, nM, 4, G, bx, true, nullptr, REP_MOE2);
            pg8::GemmP gp; gp.A = (const char*)(ws + WS_ACT); gp.lda2 = D; gp.acol_pn = 0; gp.Bt = (const char*)(ws + WS_WDN + (size_t)layer * NE * 1024 * 1024); gp.b_estride = (size_t)1024 * 1024; gp.Kb = 1024; gp.sA = E8_ACT; gp.sB = E8_W;
            pg8::EpiMoe2 E; E.Y = (unsigned char*)(ws + WS_Y); E.bdn = ARG_IN(21) + (size_t)layer * NE * D; E.rowdst = (const int*)(ws + WS_RDST); E.rowgate = (const float*)(ws + WS_RGATE);
            pg8::gemm_phase<false, true, pg8::EpiMoe2>(lds, tid, gp, n_my, E);
        }
        GRID_BAR();

        {
            PHASE_BEGIN();
            const bf16* X1b = (const bf16*)(ws + WS_X1B); const unsigned char* Y = (const unsigned char*)(ws + WS_Y); float* OUT = ARG_OUT(); bf16* XAb = (bf16*)(ws + WS_XAB);
            float lg[16], lb[16];
#pragma unroll
            for (int q = 0; q < 4; ++q) { const f32x4 b = gld<f32x4>(ARG_IN(22) + layer * D + 16 * lane + 4 * q), c = gld<f32x4>(ARG_IN(23) + layer * D + 16 * lane + 4 * q);
#pragma unroll
                for (int i = 0; i < 4; ++i) { lg[4 * q + i] = b[i]; lb[4 * q + i] = c[i]; } }
            for (int rep = 0; rep < REP_THIN; ++rep)
            for (int tb = vcu; tb < T / 128; tb += G) {
                const int t0 = tb * 128 + wave * 16;
                v4u nx[2], ny[4];
#pragma unroll
                for (int j = 0; j < 2; ++j) nx[j] = gld<v4u>(X1b + (size_t)t0 * D + 16 * lane + 8 * j);
#pragma unroll
                for (int k = 0; k < 4; ++k) ny[k] = gld<v4u>(Y + (size_t)(t0 * 4 + k) * D + 16 * lane);
                for (int ti = 0; ti < 16; ++ti) {
                    const int t = t0 + ti;
                    float v[16], h[16];
                    unpack8(nx[0], v); unpack8(nx[1], v + 8);
#pragma unroll
                    for (int i = 0; i < 16; ++i) h[i] = 0.f;
#pragma unroll
                    for (int k = 0; k < 4; ++k) { const unsigned wd[4] = {ny[k].x, ny[k].y, ny[k].z, ny[k].w};
#pragma unroll
                        for (int d = 0; d < 4; ++d) { const f32x2 lo = __builtin_amdgcn_cvt_pk_f32_fp8((int)wd[d], false), hi = __builtin_amdgcn_cvt_pk_f32_fp8((int)wd[d], true);
                            h[4 * d] += lo[0]; h[4 * d + 1] += lo[1]; h[4 * d + 2] += hi[0]; h[4 * d + 3] += hi[1]; } }
                    if (ti + 1 < 16) {
#pragma unroll
                        for (int j = 0; j < 2; ++j) nx[j] = gld<v4u>(X1b + (size_t)(t + 1) * D + 16 * lane + 8 * j);
#pragma unroll
                        for (int k = 0; k < 4; ++k) ny[k] = gld<v4u>(Y + (size_t)((t + 1) * 4 + k) * D + 16 * lane); }
#pragma unroll
                    for (int i = 0; i < 16; ++i) v[i] = v[i] * ALPHA + h[i] * (1.0f / SY8);
                    ln16(v, lg, lb, lane);
                    if (layer == DEPTH - 1) {
#pragma unroll
                        for (int q = 0; q < 4; ++q) gst<f32x4>(OUT + (size_t)t * D + 16 * lane + 4 * q, (f32x4){v[4 * q], v[4 * q + 1], v[4 * q + 2], v[4 * q + 3]});
                    } else {
                        gst<v4u>(XAb + (size_t)t * D + 16 * lane, pack8(v));
                        gst<v4u>(XAb + (size_t)t * D + 16 * lane + 8, pack8(v + 8));
                    }
                }
            }
        }
        if (layer + 1 < DEPTH) GRID_BAR();
    }
}

extern "C" void kernel_launch(void* const* d_in, const int* in_sizes, int n_in, void* d_out, int out_size, void* d_ws, size_t ws_size, hipStream_t stream) {
    static int grid = 0;
    if (grid == 0) {
        if (n_in != 24 || out_size != T * D || ws_size < WS_END) { fprintf(stderr, "kernel_launch: unexpected shapes (n_in %d out %d ws %zu)\n", n_in, out_size, ws_size); grid = -1; return; }
        if (hipFuncSetAttribute((const void*)mega_fwd, hipFuncAttributeMaxDynamicSharedMemorySize, LDS_BYTES) != hipSuccess) { fprintf(stderr, "kernel_launch: hipFuncSetAttribute failed\n"); grid = -1; return; }
        int dev = 0, cus = 0, per_cu = 0;
        (void)hipGetDevice(&dev); (void)hipDeviceGetAttribute(&cus, hipDeviceAttributeMultiprocessorCount, dev);
        if (hipOccupancyMaxActiveBlocksPerMultiprocessor(&per_cu, (const void*)mega_fwd, NTHR, LDS_BYTES) != hipSuccess || per_cu < 1) fprintf(stderr, "kernel_launch: occupancy query reports %d blocks per CU\n", per_cu);
        (void)hipGetLastError();
        grid = 256; if (cus > 0 && cus < grid) grid = cus;
    }
    if (grid < 0) return;
    (void)hipMemsetAsync((char*)d_ws + WS_CTL, 0, CTL_ZERO_BYTES, stream);
    Args a{};
    for (int i = 0; i < 24; ++i) a.in[i] = (const float*)d_in[i];
    a.out = (float*)d_out; a.ws = (unsigned char*)d_ws;
    hipLaunchKernelGGL(mega_fwd, dim3(grid), dim3(NTHR), LDS_BYTES, stream, a);
    const hipError_t le = hipPeekAtLastError();
    if (le != hipSuccess) fprintf(stderr, "kernel_launch: launch failed: %s\n", hipGetErrorName(le));
}
```

```cpp
#include <hip/hip_runtime.h>
#include <cstdio>
#include <cstdint>

#define GAS __attribute__((address_space(1)))
#define LAS __attribute__((address_space(3)))
typedef unsigned short bf16;
typedef unsigned v4u __attribute__((ext_vector_type(4)));
typedef unsigned v2u __attribute__((ext_vector_type(2)));
typedef float f32x4 __attribute__((ext_vector_type(4)));
typedef float f32x2 __attribute__((ext_vector_type(2)));
typedef short bf16x8 __attribute__((ext_vector_type(8)));
typedef int v4i __attribute__((ext_vector_type(4)));
typedef int v8i __attribute__((ext_vector_type(8)));

template <class V> __device__ __forceinline__ V gld(const void* p) { return *(const GAS V*)p; }
template <class V> __device__ __forceinline__ void gst(void* p, V v) { *(GAS V*)p = v; }

#ifndef REP_P0
#define REP_P0 1
#endif
#ifndef REP_MOE1
#define REP_MOE1 1
#endif
#ifndef REP_MOE2
#define REP_MOE2 1
#endif
#ifndef REP_THIN
#define REP_THIN 1
#endif
#ifndef REP_MIXG
#define REP_MIXG 1
#endif
#ifndef REP_LNR
#define REP_LNR 1
#endif
constexpr int T = 32768, D = 1024, SEQ = 4096, NE = 32, TOPK = 4, NA = T * TOPK, DEPTH = 4;
constexpr int MAXTILES = NA / 256 + NE;
constexpr int NPAD = MAXTILES * 256;
constexpr float LN_EPS = 1e-5f;
constexpr float ALPHA = 1.681792830507429f;
constexpr int NWAVES = 8, NTHR = 512;
constexpr int MAXU = 17;
constexpr float SX8 = 16.0f, SACT8 = 4.0f, SW8 = 256.0f, SY8 = 64.0f;
constexpr int E8_X = 0x7B7B7B7B  , E8_ACT = 0x7D7D7D7D  , E8_W = 0x77777777  ;

constexpr size_t MiB = 1u << 20;
constexpr size_t WS_CTL = 0, CTL_ZERO_BYTES = 1 * MiB;
constexpr size_t WS_IDX = 1 * MiB;
constexpr size_t WS_GATE = 1 * MiB + 512 * 1024;
constexpr size_t WS_RTOK = 2 * MiB;
constexpr size_t WS_RDST = 3 * MiB;
constexpr size_t WS_RGATE = 4 * MiB;
constexpr size_t WS_WPOOL = 5 * MiB;
constexpr size_t WS_WSCIN = 6 * MiB;
constexpr size_t WS_WSCOUT = 12 * MiB;
constexpr size_t WS_WCFIN = 14 * MiB;
constexpr size_t WS_WCFOUT = 18 * MiB;
constexpr size_t WS_WGU = 32 * MiB;
constexpr size_t WS_WDN = 544 * MiB;
constexpr size_t WS_X18 = 704 * MiB;
constexpr size_t WS_ZB = 800 * MiB;
constexpr size_t WS_XAB = 864 * MiB;
constexpr size_t WS_X1B = 928 * MiB;
constexpr size_t WS_M1 = 992 * MiB;
constexpr size_t WS_M2 = 1056 * MiB;
constexpr size_t WS_M3 = 1120 * MiB;
constexpr size_t WS_ACT = 1184 * MiB;
constexpr size_t WS_Y = 1456 * MiB;
constexpr size_t WS_END = 1712 * MiB;
constexpr int CW_BAR = 4096;
constexpr int CW_CNT = 8192;
constexpr int CW_CUR = 8192 + 256;

constexpr int RING_OFF = 0, RING_BYTES = 131072;
constexpr int TOK_OFF = RING_BYTES;
constexpr int UT_OFF = TOK_OFF + MAXU * 1024;
constexpr int TS_OFF = UT_OFF + (2 * MAXU + 2) * 16;
constexpr int MISC_OFF = TS_OFF + 36 * 4;
constexpr int LDS_BYTES = MISC_OFF + 128 * 4;
static_assert(LDS_BYTES <= 160 * 1024 && (MISC_OFF % 16) == 0, "LDS map");

#define LDS_WAIT() asm volatile("s_waitcnt lgkmcnt(0)" ::: "memory")
#define VM_WAIT() asm volatile("s_waitcnt vmcnt(0)" ::: "memory")

__device__ __forceinline__ unsigned cvt_pk_bf16(float lo, float hi) { unsigned r; asm volatile("v_cvt_pk_bf16_f32 %0, %1, %2" : "=v"(r) : "v"(lo), "v"(hi)); return r; }
__device__ __forceinline__ v2u pack8_fp8(const float* v) { int a = __builtin_amdgcn_cvt_pk_fp8_f32(v[0], v[1], 0, false); a = __builtin_amdgcn_cvt_pk_fp8_f32(v[2], v[3], a, true);
    int b = __builtin_amdgcn_cvt_pk_fp8_f32(v[4], v[5], 0, false); b = __builtin_amdgcn_cvt_pk_fp8_f32(v[6], v[7], b, true); v2u w; w.x = (unsigned)a; w.y = (unsigned)b; return w; }
__device__ __forceinline__ float bf_lo(unsigned u) { return __uint_as_float(u << 16); }
__device__ __forceinline__ float bf_hi(unsigned u) { return __uint_as_float(u & 0xffff0000u); }
__device__ __forceinline__ float sigmoidf_(float x) { return __builtin_amdgcn_rcpf(1.0f + __expf(-x)); }
#define DPP_F(v, ctrl) __int_as_float(__builtin_amdgcn_update_dpp(0, __float_as_int(v), (ctrl), 0xf, 0xf, true))
#define DPP_XOR1 0xB1
#define DPP_XOR2 0x4E
#define DPP_QREV 0x1B
#define DPP_HMIR 0x141
#define DPP_RMIR 0x140
#define DPP_ROR8 0x128
__device__ __forceinline__ float rdlane(float v, int l) { return __uint_as_float((unsigned)__builtin_amdgcn_readlane((int)__float_as_uint(v), l)); }
__device__ __forceinline__ float wave_sum(float v, int lane) {
    (void)lane;
    v += DPP_F(v, DPP_XOR1); v += DPP_F(v, DPP_XOR2); v += DPP_F(v, DPP_HMIR); v += DPP_F(v, DPP_RMIR);
    return (rdlane(v, 0) + rdlane(v, 16)) + (rdlane(v, 32) + rdlane(v, 48));
}

#define XB_TMO      128
#define XB_XCNT(j)  (256  + 64 * (j))
#define XB_XSUB(j)  (1280 + 64 * (j))
#define XB_XGEN(j)  (2304 + 64 * (j))
#define XB_TOP      3328
#define XB_TOPGEN   3392
#define XCD_BAR_WORDS 3456
#define XB_SPIN_CAP (1u << 18)

__device__ __forceinline__ unsigned xb_ld(unsigned* p)              { return __hip_atomic_load((GAS unsigned*)p, __ATOMIC_RELAXED, __HIP_MEMORY_SCOPE_AGENT); }
__device__ __forceinline__ unsigned xb_add(unsigned* p, unsigned v) { return __hip_atomic_fetch_add((GAS unsigned*)p, v, __ATOMIC_RELAXED, __HIP_MEMORY_SCOPE_AGENT); }
__device__ __forceinline__ unsigned xb_xcc_id() { return (unsigned)__builtin_amdgcn_s_getreg((3 << 11) | 20) & 0xFu; }
#define XB_SPIN(cond, bar) do { unsigned _sp = 0; while (cond) { __builtin_amdgcn_s_sleep(1); \
    if ((++_sp & 255u) == 0u) { if (xb_ld(&(bar)[XB_TMO])) break; if (_sp > XB_SPIN_CAP) { (void)xb_add(&(bar)[XB_TMO], 1u); break; } } } } while (0)

struct XcdBarrier { unsigned* bar; unsigned x; volatile LAS unsigned* st; };

__device__ __forceinline__ XcdBarrier xcd_barrier_post(unsigned* bar, volatile LAS unsigned* st) {
    XcdBarrier b; b.bar = bar; b.x = xb_xcc_id(); b.st = st;
    if (threadIdx.x == 0) (void)xb_add(&bar[XB_XCNT(b.x)], 1u);
    return b;
}
__device__ __forceinline__ void xcd_barrier_complete(unsigned* bar, unsigned x, unsigned& nloc, unsigned& nx) {
    const unsigned G = gridDim.x * gridDim.y * gridDim.z;
    unsigned sum, cnt, mine, sp = 0u;
    for (;;) {
        sum = 0u; cnt = 0u; mine = 0u;
#pragma unroll
        for (unsigned j = 0; j < 16; ++j) { const unsigned c = xb_ld(&bar[XB_XCNT(j)]); sum += c; cnt += (c > 0u) ? 1u : 0u; mine = (j == x) ? c : mine; }
        if (sum == G) break;
        __builtin_amdgcn_s_sleep(1);
        if ((++sp & 255u) == 0u) { if (xb_ld(&bar[XB_TMO])) break; if (sp > XB_SPIN_CAP) { (void)xb_add(&bar[XB_TMO], 1u); break; } }
    }
    nloc = mine > 0u ? mine : 1u; nx = cnt > 0u ? cnt : 1u;
}
__device__ __forceinline__ void xcd_barrier(const XcdBarrier& b) {
    asm volatile("s_waitcnt vmcnt(0)" ::: "memory");
    __syncthreads();
    if (threadIdx.x == 0) {
        unsigned* bar = b.bar;
        __builtin_amdgcn_s_waitcnt(0);
        unsigned nloc = b.st[0], nx = b.st[1];
        if (nloc == 0u) { xcd_barrier_complete(bar, b.x, nloc, nx); b.st[0] = nloc; b.st[1] = nx; }
        const unsigned old = xb_add(&bar[XB_XSUB(b.x)], 1u);
        const unsigned gen = old / nloc;
        if (old + 1u == (gen + 1u) * nloc) {
            __builtin_amdgcn_fence(__ATOMIC_RELEASE, "agent");
            asm volatile("s_waitcnt vmcnt(0)" ::: "memory");
            const unsigned og = xb_add(&bar[XB_TOP], 1u);
            const unsigned tg = og / nx;
            if (og + 1u == (tg + 1u) * nx) xb_add(&bar[XB_TOPGEN], 1u);
            else XB_SPIN(xb_ld(&bar[XB_TOPGEN]) == tg, bar);
            __builtin_amdgcn_fence(__ATOMIC_ACQUIRE, "agent");
            xb_add(&bar[XB_XGEN(b.x)], 1u);
            asm volatile("s_waitcnt vmcnt(0)" ::: "memory");
        } else {
            XB_SPIN(xb_ld(&bar[XB_XGEN(b.x)]) == gen, bar);
            __builtin_amdgcn_fence(__ATOMIC_ACQUIRE, "agent");
            asm volatile("s_waitcnt vmcnt(0)" ::: "memory");
        }
    }
    __syncthreads();
}

namespace pg8 {
constexpr int BM = 256, BK = 64, HALF = 128, HTB = HALF * BK * 2, STAGE_BYTES = 8 * HTB, NXCD = 8, WGM = 8;
__host__ __device__ __forceinline__ int lds_byte(int r, int c) { const int st = (r >> 4) * 2 + (c >> 5), rr = r & 15, cc = c & 31, ob = rr * 64 + cc * 2; return st * 1024 + (ob ^ (((ob >> 9) & 1) << 5)); }
__host__ __device__ __forceinline__ void stage_rc(int b, int& R, int& C) { const int st = b / 1024, sb = b % 1024, swz = sb ^ (((sb >> 9) & 1) << 5); R = (st >> 1) * 16 + swz / 64; C = (st & 1) * 32 + (swz % 64) / 2; }
__host__ __device__ __forceinline__ int perm32(int rho) { const int n = rho >> 4, i = rho & 15; return 8 * (i >> 2) + 4 * n + (i & 3); }

struct Unit { int pm, pn, e; };
struct GemmP {
    const char* A; unsigned lda2;
    unsigned acol_pn;
    const char* Bt; size_t b_estride;
    int Kb;
    int sA, sB;
};

__device__ __forceinline__ void unit_of(int L, int nM, int nN, int& pm, int& pn) {
    const int nwg = nM * nN;
    int wgid = L; { const int q = nwg / NXCD, r = nwg % NXCD, xcd = wgid % NXCD, off = wgid / NXCD; wgid = (xcd < r ? xcd * (q + 1) : r * (q + 1) + (xcd - r) * q) + off; }
    const int nig = WGM * nN, gid = wgid / nig, fm = gid * WGM, gsz = (nM - fm) < WGM ? (nM - fm) : WGM;
    pm = fm + ((wgid % nig) % gsz); pn = (wgid % nig) / gsz;
}
__device__ __forceinline__ int build_units(LAS unsigned char* lds, const int tid, int nM, int nN, int G, int c, bool moe, const int* row_tok, const int dup = 1) {
    LAS int* UT = (LAS int*)(lds + UT_OFF); LAS const int* TS = (LAS const int*)(lds + TS_OFF); LAS int* TOK = (LAS int*)(lds + TOK_OFF);
    const int nwg = nM * nN;
    int n_my = (nwg > c) ? (nwg - c + G - 1) / G : 0; if (n_my > MAXU) n_my = MAXU;
    if (tid < n_my) {
        int pm, pn; unit_of(tid * G + c, nM, nN, pm, pn);
        int e = 0; if (moe) { while (e < NE - 1 && TS[e + 1] <= pm) ++e; }
        UT[4 * tid + 0] = pm; UT[4 * tid + 1] = pn; UT[4 * tid + 2] = e; UT[4 * tid + 3] = 0;
    }
    __syncthreads();
    if (row_tok) {
        for (int idx = tid; idx < n_my * 256; idx += NTHR) { const int i = idx >> 8, r = idx & 255; TOK[idx] = gld<int>(row_tok + UT[4 * i] * 256 + r); }
    }
    __syncthreads();
    if (dup > 1) { if (tid < n_my) { UT[4 * (tid + n_my) + 0] = UT[4 * tid]; UT[4 * (tid + n_my) + 1] = UT[4 * tid + 1]; UT[4 * (tid + n_my) + 2] = UT[4 * tid + 2]; UT[4 * (tid + n_my) + 3] = 0; } __syncthreads(); return 2 * n_my; }
    return n_my;
}
__device__ __forceinline__ Unit read_unit(LAS const int* UT, int i) {
    Unit u; u.pm = __builtin_amdgcn_readfirstlane(UT[4 * i]); u.pn = __builtin_amdgcn_readfirstlane(UT[4 * i + 1]); u.e = __builtin_amdgcn_readfirstlane(UT[4 * i + 2]); return u;
}
template <bool GATHER>
__device__ __forceinline__ void a_offsets(unsigned (&v)[2][2], const GemmP& g, const Unit& u, int ui, const int (&Rr)[2], const int (&Cc2)[2], LAS const int* TOK, const int tokn) {
#pragma unroll
    for (int h = 0; h < 2; ++h)
#pragma unroll
        for (int i = 0; i < 2; ++i) {
            const int row = GATHER ? TOK[(ui >= tokn ? ui - tokn : ui) * 256 + h * HALF + Rr[i]] : (u.pm * BM + h * HALF + Rr[i]);
            v[h][i] = (unsigned)row * g.lda2 + (unsigned)Cc2[i] + (unsigned)u.pn * g.acol_pn;
        }
}

template <bool GATHER, bool FP8, class Epi>
__device__ __forceinline__ void gemm_phase(LAS unsigned char* lds, const int tid, const GemmP g, const int n_my, const Epi& E, const int tokn = 1 << 20) {
    const int wid = __builtin_amdgcn_readfirstlane(tid >> 6), lane = tid & 63, wr = wid >> 2, wc = wid & 3, fr = lane & 15, fq = lane >> 4;
    const int Kb = g.Kb, nt = Kb / (BK * 2);
    if (n_my <= 0) return;
    int Rr[2], Cc2[2]; unsigned voffB[2];
#pragma unroll
    for (int i = 0; i < 2; ++i) { int R, C; stage_rc(tid * 16 + i * 8192, R, C); const int Rb = Epi::PERM ? ((R & ~31) + perm32(R & 31)) : R;
        Rr[i] = R; Cc2[i] = C * 2; voffB[i] = (unsigned)(Rb * Kb + C * 2); }
    const size_t kstep = (size_t)(BK * 2);
    const size_t hstep = (size_t)HALF * Kb;
    const size_t tstepB = 2 * hstep;
    const unsigned ldsw = (unsigned)wid * 1024u;
    const int aoff = lds_byte(wr * 64 + fr, fq * 8), boff = lds_byte(wc * 32 + fr, fq * 8);
    LAS const int* UT = (LAS const int*)(lds + UT_OFF); LAS const int* TOK = (LAS const int*)(lds + TOK_OFF);
#define PG8_SA(b, h) (((b) * 2 + (h)) * HTB)
#define PG8_SB(b, h) ((4 + (b) * 2 + (h)) * HTB)
#define PG8_STAGE(bufoff, gbase, voff) do { _Pragma("unroll") for (int _i = 0; _i < 2; ++_i) \
        __builtin_amdgcn_global_load_lds((const unsigned*)((const char*)(gbase) + (voff)[_i]), (LAS unsigned*)(lds + (bufoff) + ldsw + _i * 8192), 16, 0, 0); } while (0)
#define PG8_LDA(dst, b, h) do { _Pragma("unroll") for (int m = 0; m < 4; ++m) _Pragma("unroll") for (int k = 0; k < 2; ++k) dst[m][k] = *(const LAS bf16x8*)(lds + PG8_SA(b, h) + aoff + m * 2048 + k * 1024); } while (0)
#define PG8_LDB(dst, b, h) do { _Pragma("unroll") for (int n = 0; n < 2; ++n) _Pragma("unroll") for (int k = 0; k < 2; ++k) dst[n][k] = *(const LAS bf16x8*)(lds + PG8_SB(b, h) + boff + n * 2048 + k * 1024); } while (0)
#define PG8_CAT(x) __builtin_shufflevector(__builtin_bit_cast(v4i, (x)[0]), __builtin_bit_cast(v4i, (x)[1]), 0, 1, 2, 3, 4, 5, 6, 7)
#define PG8_MMA(ai, bj, At, Bt) do { __builtin_amdgcn_s_setprio(1); _Pragma("unroll") for (int m = 0; m < 4; ++m) _Pragma("unroll") for (int n = 0; n < 2; ++n) { \
        if constexpr (FP8) { const v8i b8_ = PG8_CAT(Bt[n]), a8_ = PG8_CAT(At[m]); asm volatile("v_mfma_scale_f32_16x16x128_f8f6f4 %0, %1, %2, %0, %3, %4 op_sel_hi:[0,0,0]" : "+v"(acc[ai][bj][m][n]) : "v"(b8_), "v"(a8_), "v"(vsB), "v"(vsA)); } \
        else { _Pragma("unroll") for (int k = 0; k < 2; ++k) acc[ai][bj][m][n] = __builtin_amdgcn_mfma_f32_16x16x32_bf16(Bt[n][k], At[m][k], acc[ai][bj][m][n], 0, 0, 0); } } \
        __builtin_amdgcn_s_setprio(0); } while (0)
#define PG8_WAIT_V(n) asm volatile("s_waitcnt vmcnt(" #n ")" ::: "memory")
#define PG8_WAIT_L(n) asm volatile("s_waitcnt lgkmcnt(" #n ")" ::: "memory")
#define PG8_BAR __builtin_amdgcn_s_barrier()
#define PG8_SCHED __builtin_amdgcn_sched_barrier(0)
    Unit cur = read_unit(UT, 0), nxt; int ui = 0;
    f32x4 acc[2][2][4][2];
#pragma unroll
    for (int a = 0; a < 2; ++a)
#pragma unroll
        for (int b = 0; b < 2; ++b)
#pragma unroll
            for (int m = 0; m < 4; ++m)
#pragma unroll
                for (int n = 0; n < 2; ++n) acc[a][b][m][n] = (f32x4){0.f, 0.f, 0.f, 0.f};
#define PG8_PIN_ACC() do { if constexpr (FP8) { _Pragma("unroll") for (int a_ = 0; a_ < 2; ++a_) _Pragma("unroll") for (int b_ = 0; b_ < 2; ++b_) \
        asm volatile("" : "+v"(acc[a_][b_][0][0]), "+v"(acc[a_][b_][0][1]), "+v"(acc[a_][b_][1][0]), "+v"(acc[a_][b_][1][1]), "+v"(acc[a_][b_][2][0]), "+v"(acc[a_][b_][2][1]), "+v"(acc[a_][b_][3][0]), "+v"(acc[a_][b_][3][1])); \
        asm volatile("s_nop 1" ::: "memory"); } } while (0)
    PG8_PIN_ACC();
    bf16x8 At[4][2], B0[2][2], B1[2][2];
    int vsA = g.sA, vsB = g.sB; asm volatile("" : "+v"(vsA), "+v"(vsB));
    unsigned vAc[2][2], vAn[2][2];
    a_offsets<GATHER>(vAc, g, cur, 0, Rr, Cc2, TOK, tokn);
    const char* const Ab = g.A;
    const char* cB = g.Bt + (size_t)cur.e * g.b_estride + (size_t)cur.pn * tstepB;
    PG8_STAGE(PG8_SB(0, 0), cB, voffB); PG8_STAGE(PG8_SB(0, 1), cB + hstep, voffB); PG8_STAGE(PG8_SA(0, 0), Ab, vAc[0]); PG8_STAGE(PG8_SA(0, 1), Ab, vAc[1]);
    if (wr == 1) PG8_BAR;
    PG8_WAIT_V(2); PG8_BAR;
    PG8_STAGE(PG8_SB(1, 0), cB + kstep, voffB); PG8_STAGE(PG8_SA(1, 0), Ab + kstep, vAc[0]); PG8_STAGE(PG8_SB(1, 1), cB + hstep + kstep, voffB);
    PG8_WAIT_V(6); PG8_BAR;
    for (;;) {
        const bool has_next = (ui + 1 < n_my);
        nxt = cur; if (has_next) nxt = read_unit(UT, ui + 1);
        const char* nB = has_next ? g.Bt + (size_t)nxt.e * g.b_estride + (size_t)nxt.pn * tstepB : cB;
        for (int t = 0; t < nt; t += 2) {
            const bool last = (t == nt - 2);
            const char* a1 = Ab + (size_t)(t + 1) * kstep;
            const char* a2 = last ? Ab : Ab + (size_t)(t + 2) * kstep; const char* b2 = last ? nB : cB + (size_t)(t + 2) * kstep;
            const char* a3 = a2 + kstep; const char* b3 = b2 + kstep;
            unsigned o2[2][2];
            if (last) {
                if (has_next) a_offsets<GATHER>(vAn, g, nxt, ui + 1, Rr, Cc2, TOK, tokn);
                else { vAn[0][0] = vAc[0][0]; vAn[0][1] = vAc[0][1]; vAn[1][0] = vAc[1][0]; vAn[1][1] = vAc[1][1]; }
                o2[0][0] = vAn[0][0]; o2[0][1] = vAn[0][1]; o2[1][0] = vAn[1][0]; o2[1][1] = vAn[1][1];
            } else { o2[0][0] = vAc[0][0]; o2[0][1] = vAc[0][1]; o2[1][0] = vAc[1][0]; o2[1][1] = vAc[1][1]; }
            PG8_LDB(B0, 0, 0); PG8_LDB(B1, 0, 1); PG8_SCHED; PG8_LDA(At, 0, 0); PG8_STAGE(PG8_SA(1, 1), a1, vAc[1]);
            PG8_WAIT_V(8); PG8_WAIT_L(0); PG8_BAR; PG8_MMA(0, 0, At, B0); PG8_MMA(0, 1, At, B1); PG8_BAR; PG8_SCHED;
            PG8_LDA(At, 0, 1); PG8_STAGE(PG8_SB(0, 0), b2, voffB); PG8_STAGE(PG8_SB(0, 1), b2 + hstep, voffB); PG8_STAGE(PG8_SA(0, 0), a2, o2[0]);
            PG8_WAIT_V(8); PG8_WAIT_L(0); PG8_BAR; PG8_MMA(1, 0, At, B0); PG8_MMA(1, 1, At, B1); PG8_BAR; PG8_SCHED;
            PG8_LDB(B0, 1, 0); PG8_LDB(B1, 1, 1); PG8_SCHED; PG8_LDA(At, 1, 0); PG8_STAGE(PG8_SA(0, 1), a2, o2[1]);
            PG8_WAIT_V(8); PG8_WAIT_L(0); PG8_BAR; PG8_MMA(0, 0, At, B0); PG8_MMA(0, 1, At, B1); PG8_BAR; PG8_SCHED;
            PG8_LDA(At, 1, 1); PG8_STAGE(PG8_SB(1, 0), b3, voffB); PG8_STAGE(PG8_SB(1, 1), b3 + hstep, voffB); PG8_STAGE(PG8_SA(1, 0), a3, o2[0]);
            PG8_WAIT_V(8); PG8_WAIT_L(0); PG8_BAR; PG8_MMA(1, 0, At, B0); PG8_MMA(1, 1, At, B1); PG8_BAR; PG8_SCHED;
        }
        if (wr == 0) PG8_BAR;
        if constexpr (FP8) asm volatile("s_nop 15" ::: "memory");
        E(acc, cur, wr, wc, fr, fq);
        if (!has_next) break;
#pragma unroll
        for (int a = 0; a < 2; ++a)
#pragma unroll
            for (int b = 0; b < 2; ++b)
#pragma unroll
                for (int m = 0; m < 4; ++m)
#pragma unroll
                    for (int n = 0; n < 2; ++n) acc[a][b][m][n] = (f32x4){0.f, 0.f, 0.f, 0.f};
        PG8_PIN_ACC();
        cur = nxt; cB = nB; ++ui;
        vAc[0][0] = vAn[0][0]; vAc[0][1] = vAn[0][1]; vAc[1][0] = vAn[1][0]; vAc[1][1] = vAn[1][1];
        if (wr == 1) PG8_BAR;
    }
    PG8_WAIT_V(0);
    PG8_BAR;
#undef PG8_SA
#undef PG8_SB
#undef PG8_STAGE
#undef PG8_LDA
#undef PG8_LDB
#undef PG8_MMA
#undef PG8_PIN_ACC
#undef PG8_CAT
#undef PG8_WAIT_V
#undef PG8_WAIT_L
#undef PG8_BAR
#undef PG8_SCHED
}

struct EpiOut {
    static constexpr bool PERM = true;
    const bf16* xres; bf16* z; const float* bias; const float* scale;
    __device__ __forceinline__ void operator()(const f32x4 (&acc)[2][2][4][2], const Unit& u, int wr, int wc, int fr, int fq) const {
        const int row0 = u.pm * BM + wr * 64 + fr, c0 = u.pn * BM + wc * 32 + 8 * fq;
        f32x4 bv[2][2], sv[2][2];
#pragma unroll
        for (int bj = 0; bj < 2; ++bj)
#pragma unroll
            for (int n = 0; n < 2; ++n) {
                bv[bj][n] = bias ? gld<f32x4>(bias + c0 + bj * HALF + 4 * n) : (f32x4){0.f, 0.f, 0.f, 0.f};
                sv[bj][n] = scale ? gld<f32x4>(scale + c0 + bj * HALF + 4 * n) : (f32x4){1.f, 1.f, 1.f, 1.f};
            }
#pragma unroll
        for (int ai = 0; ai < 2; ++ai)
#pragma unroll
            for (int m = 0; m < 4; ++m) { const size_t off = (size_t)(row0 + ai * HALF + m * 16) * D + c0;
#pragma unroll
                for (int bj = 0; bj < 2; ++bj) { const v4u xr = gld<v4u>(xres + off + bj * HALF);
                    const f32x4 x0 = (f32x4){bf_lo(xr.x), bf_hi(xr.x), bf_lo(xr.y), bf_hi(xr.y)}, x1 = (f32x4){bf_lo(xr.z), bf_hi(xr.z), bf_lo(xr.w), bf_hi(xr.w)};
                    const f32x4 o0 = x0 * ALPHA + (acc[ai][bj][m][0] + bv[bj][0]) * sv[bj][0], o1 = x1 * ALPHA + (acc[ai][bj][m][1] + bv[bj][1]) * sv[bj][1];
                    v4u w; w.x = cvt_pk_bf16(o0[0], o0[1]); w.y = cvt_pk_bf16(o0[2], o0[3]); w.z = cvt_pk_bf16(o1[0], o1[1]); w.w = cvt_pk_bf16(o1[2], o1[3]);
                    gst<v4u>(z + off + bj * HALF, w); }
                asm volatile("" ::: "memory"); }
    }
};
struct EpiPair {
    static constexpr bool PERM = true;
    bf16* O1; bf16* O2; const float* bias; int mode;
    __device__ __forceinline__ void operator()(const f32x4 (&acc)[2][2][4][2], const Unit& u, int wr, int wc, int fr, int fq) const {
        const int row0 = u.pm * BM + wr * 64 + fr;
        if (u.pn < 8) {
            const int j0 = u.pn * HALF + wc * 32 + 8 * fq;
            f32x4 b1[2], b2[2];
#pragma unroll
            for (int n = 0; n < 2; ++n) { b1[n] = mode ? gld<f32x4>(bias + j0 + 4 * n) : (f32x4){0.f, 0.f, 0.f, 0.f}; b2[n] = mode ? gld<f32x4>(bias + 1024 + j0 + 4 * n) : (f32x4){0.f, 0.f, 0.f, 0.f}; }
#pragma unroll
            for (int ai = 0; ai < 2; ++ai)
#pragma unroll
                for (int m = 0; m < 4; ++m) { bf16* rowp = O1 + (size_t)(row0 + ai * HALF + m * 16) * D + j0; f32x4 r[2];
#pragma unroll
                    for (int n = 0; n < 2; ++n) { const f32x4 g1 = acc[ai][0][m][n] + b1[n], g2 = acc[ai][1][m][n] + b2[n];
                        if (mode) { r[n][0] = g1[0] * sigmoidf_(g2[0]); r[n][1] = g1[1] * sigmoidf_(g2[1]); r[n][2] = g1[2] * sigmoidf_(g2[2]); r[n][3] = g1[3] * sigmoidf_(g2[3]); }
                        else r[n] = g1 * g2; }
                    v4u w; w.x = cvt_pk_bf16(r[0][0], r[0][1]); w.y = cvt_pk_bf16(r[0][2], r[0][3]); w.z = cvt_pk_bf16(r[1][0], r[1][1]); w.w = cvt_pk_bf16(r[1][2], r[1][3]);
                    gst<v4u>(rowp, w); }
        } else {
            const int c0 = (u.pn - 8) * BM + wc * 32 + 8 * fq;
#pragma unroll
            for (int ai = 0; ai < 2; ++ai)
#pragma unroll
                for (int m = 0; m < 4; ++m) { bf16* rowp = O2 + (size_t)(row0 + ai * HALF + m * 16) * D + c0;
#pragma unroll
                    for (int bj = 0; bj < 2; ++bj) { const f32x4 v0 = acc[ai][bj][m][0], v1 = acc[ai][bj][m][1];
                        v4u w; w.x = cvt_pk_bf16(v0[0], v0[1]); w.y = cvt_pk_bf16(v0[2], v0[3]); w.z = cvt_pk_bf16(v1[0], v1[1]); w.w = cvt_pk_bf16(v1[2], v1[3]);
                        gst<v4u>(rowp + bj * HALF, w); } }
        }
    }
};
struct EpiSwiglu {
    static constexpr bool PERM = true;
    unsigned char* act; const float* bgu;
    __device__ __forceinline__ void operator()(const f32x4 (&acc)[2][2][4][2], const Unit& u, int wr, int wc, int fr, int fq) const {
        const int row0 = u.pm * BM + wr * 64 + fr, j0 = u.pn * HALF + wc * 32 + 8 * fq;
        const float* bp = bgu + (size_t)u.e * 2048 + 2 * j0;
        f32x2 gb[4], ub[4];
#pragma unroll
        for (int i = 0; i < 4; ++i) { const f32x4 b = gld<f32x4>(bp + 4 * i); gb[i] = (f32x2){b[0], b[2]}; ub[i] = (f32x2){b[1], b[3]}; }
        const f32x2 one = {1.0f, 1.0f}, k4 = {SACT8, SACT8}, kc = {-1.702f * 1.4426950408889634f, -1.702f * 1.4426950408889634f};
#pragma unroll
        for (int ai = 0; ai < 2; ++ai)
#pragma unroll
            for (int m = 0; m < 4; ++m) { unsigned char* rowp = act + (size_t)(row0 + ai * HALF + m * 16) * D + j0; float r[8];
#pragma unroll
                for (int p = 0; p < 4; ++p) { const int n = p >> 1, q = 2 * (p & 1);
                    f32x2 g = (f32x2){acc[ai][0][m][n][q], acc[ai][0][m][n][q + 1]} + gb[p];
                    f32x2 uu = (f32x2){acc[ai][1][m][n][q], acc[ai][1][m][n][q + 1]} + ub[p];
                    g[0] = fminf(g[0], 7.0f); g[1] = fminf(g[1], 7.0f);
                    uu[0] = __builtin_amdgcn_fmed3f(uu[0], -7.0f, 7.0f); uu[1] = __builtin_amdgcn_fmed3f(uu[1], -7.0f, 7.0f);
                    f32x2 t = g * kc; t[0] = __builtin_amdgcn_exp2f(t[0]); t[1] = __builtin_amdgcn_exp2f(t[1]);
                    f32x2 d = t + one; d[0] = __builtin_amdgcn_rcpf(d[0]); d[1] = __builtin_amdgcn_rcpf(d[1]);
                    const f32x2 g4 = g * k4;
                    const f32x2 o = __builtin_elementwise_fma(uu, g4, g4) * d;
                    r[2 * p] = o[0]; r[2 * p + 1] = o[1]; }
                gst<v2u>(rowp, pack8_fp8(r)); }
    }
};
struct EpiMoe2 {
    static constexpr bool PERM = true;
    unsigned char* Y; const float* bdn; const int* rowdst; const float* rowgate;
    __device__ __forceinline__ void operator()(const f32x4 (&acc)[2][2][4][2], const Unit& u, int wr, int wc, int fr, int fq) const {
        const int pos0 = u.pm * BM + wr * 64 + fr, c0 = u.pn * BM + wc * 32 + 8 * fq;
        const float* bp = bdn + (size_t)u.e * D + c0;
        f32x4 bv[2][2];
#pragma unroll
        for (int bj = 0; bj < 2; ++bj)
#pragma unroll
            for (int n = 0; n < 2; ++n) bv[bj][n] = gld<f32x4>(bp + bj * HALF + 4 * n);
        int dst[2][4]; float gt[2][4];
#pragma unroll
        for (int ai = 0; ai < 2; ++ai)
#pragma unroll
            for (int m = 0; m < 4; ++m) { const int pos = pos0 + ai * HALF + m * 16; dst[ai][m] = gld<int>(rowdst + pos); gt[ai][m] = gld<float>(rowgate + pos) * SY8; }
#pragma unroll
        for (int ai = 0; ai < 2; ++ai)
#pragma unroll
            for (int m = 0; m < 4; ++m) {
                if (dst[ai][m] >= 0) { unsigned char* rowp = Y + (size_t)dst[ai][m] * D + c0; const float s = gt[ai][m];
#pragma unroll
                    for (int bj = 0; bj < 2; ++bj) { const f32x4 v0 = (acc[ai][bj][m][0] + bv[bj][0]) * s, v1 = (acc[ai][bj][m][1] + bv[bj][1]) * s;
                        const float r[8] = {v0[0], v0[1], v0[2], v0[3], v1[0], v1[1], v1[2], v1[3]};
                        gst<v2u>(rowp + bj * HALF, pack8_fp8(r)); } } }
    }
};
}

__device__ __forceinline__ int chq(int lane, int q) { return (q >> 1) * 512 + 8 * lane + (q & 1) * 4; }
__device__ __forceinline__ v4u pack8(const float* v) { v4u w; w.x = cvt_pk_bf16(v[0], v[1]); w.y = cvt_pk_bf16(v[2], v[3]); w.z = cvt_pk_bf16(v[4], v[5]); w.w = cvt_pk_bf16(v[6], v[7]); return w; }
__device__ __forceinline__ void unpack8(const v4u w, float* v) { v[0] = bf_lo(w.x); v[1] = bf_hi(w.x); v[2] = bf_lo(w.y); v[3] = bf_hi(w.y); v[4] = bf_lo(w.z); v[5] = bf_hi(w.z); v[6] = bf_lo(w.w); v[7] = bf_hi(w.w); }

__device__ __forceinline__ int drow_of(int mode, int c) {
    if (mode == 1) { const int j = c >> 1, p = c & 1; return (j >> 7) * 256 + p * 128 + (j & 127); }
    if (mode == 2) { if (c < 1024) return 2048 + c; const int j = (c - 1024) & 1023, p = (c - 1024) >> 10; return (j >> 7) * 256 + p * 128 + (j & 127); }
    if (mode == 3) { const int j = c & 1023, p = c >> 10; return (j >> 7) * 256 + p * 128 + (j & 127); }
    return c;
}
struct TItem { const float* src; unsigned char* dst; int N, Kout  , k0, n0, mode, fp8; };
__device__ __forceinline__ void titem_load(const TItem& d, int lane, float (&tmp)[32]) {
#pragma unroll
    for (int i = 0; i < 32; ++i) { const int kk = 2 * i + (lane >> 5); tmp[i] = gld<float>(d.src + (size_t)(d.k0 + kk) * d.N + d.n0 + (lane & 31)); }
}
__device__ __forceinline__ void titem_store(const TItem& d, int lane, LAS float* scr, const float (&tmp)[32]) {
#pragma unroll
    for (int i = 0; i < 32; ++i) { const int kk = 2 * i + (lane >> 5); scr[kk * 33 + (lane & 31)] = tmp[i]; }
    LDS_WAIT(); asm volatile("" ::: "memory");
    const int c = lane & 7;
#pragma unroll
    for (int j = 0; j < 4; ++j) { const int n = (lane >> 3) + 8 * j; const LAS float* s = scr + (8 * c) * 33 + n;
        float v[8];
#pragma unroll
        for (int i = 0; i < 8; ++i) v[i] = s[i * 33];
        const size_t e = (size_t)drow_of(d.mode, d.n0 + n) * d.Kout + d.k0 + 8 * c;
        if (d.fp8) {
#pragma unroll
            for (int i = 0; i < 8; ++i) v[i] *= SW8;
            gst<v2u>(d.dst + e, pack8_fp8(v));
        } else gst<v4u>(d.dst + 2 * e, pack8(v)); }
    LDS_WAIT(); asm volatile("" ::: "memory");
}

struct Args { const float* in[24]; float* out; unsigned char* ws; };
#define CAS __attribute__((address_space(4)))
__device__ __forceinline__ const void* karg_ptr(int off) {
    const CAS char* kp = (const CAS char*)__builtin_amdgcn_kernarg_segment_ptr();
    asm volatile("" : "+s"(off));
    return *(const void* const CAS*)(kp + off);
}
#define ARG_IN(i) ((const float*)karg_ptr(8 * (i)))
#define ARG_OUT() ((float*)karg_ptr(8 * 24))
#define ARG_WS() ((unsigned char*)karg_ptr(8 * 25))

#define PHASE_BEGIN() \
    int tid = threadIdx.x; asm volatile("" : "+v"(tid)); \
    const int lane = tid & 63, wave = __builtin_amdgcn_readfirstlane(tid >> 6); \
    unsigned char* ws_ = ARG_WS(); asm volatile("" : "+s"(ws_)); unsigned char* ws = (unsigned char*)(GAS unsigned char*)ws_; \
    unsigned* ctl = (unsigned*)(ws + WS_CTL); \
    const int gw = vcu * NWAVES + wave, NGW = G * NWAVES; (void)gw; (void)NGW; (void)lane; (void)ctl;

__device__ __forceinline__ float butterfly32(float (&p)[32], int lane) {
#pragma unroll
    for (int i = 0; i < 16; ++i) { const auto r = __builtin_amdgcn_permlane32_swap(__float_as_uint(p[i]), __float_as_uint(p[i + 16]), false, false); p[i] = __uint_as_float(r[0]) + __uint_as_float(r[1]); }
#pragma unroll
    for (int i = 0; i < 8; ++i) { const auto r = __builtin_amdgcn_permlane16_swap(__float_as_uint(p[i]), __float_as_uint(p[i + 8]), false, false); p[i] = __uint_as_float(r[0]) + __uint_as_float(r[1]); }
#pragma unroll
    for (int i = 0; i < 4; ++i) { const bool hi = (lane & 8) != 0; const float snd = hi ? p[i] : p[i + 4]; const float keep = hi ? p[i + 4] : p[i]; p[i] = keep + DPP_F(snd, DPP_ROR8); }
#pragma unroll
    for (int i = 0; i < 2; ++i) { const bool hi = (lane & 4) != 0; const float snd = hi ? p[i] : p[i + 2]; const float keep = hi ? p[i + 2] : p[i]; const float x = DPP_F(snd, DPP_HMIR); p[i] = keep + DPP_F(x, DPP_QREV); }
    { const bool hi = (lane & 2) != 0; const float snd = hi ? p[0] : p[1]; const float keep = hi ? p[1] : p[0]; p[0] = keep + DPP_F(snd, DPP_XOR2); }
    return p[0] + DPP_F(p[0], DPP_XOR1);
}
__device__ __forceinline__ void ln16(float (&v)[16], const float (&lg)[16], const float (&lb)[16], int lane) {
    float sm = 0.f;
#pragma unroll
    for (int i = 0; i < 16; ++i) sm += v[i];
    const float mean = wave_sum(sm, lane) * (1.0f / D);
    float sq = 0.f;
#pragma unroll
    for (int i = 0; i < 16; ++i) { v[i] -= mean; sq += v[i] * v[i]; }
    const float rstd = 1.0f / sqrtf(wave_sum(sq, lane) * (1.0f / D) + LN_EPS);
#pragma unroll
    for (int i = 0; i < 16; ++i) v[i] = v[i] * rstd * lg[i] + lb[i];
}
__device__ __forceinline__ void route_token(const float logit, const int myexp, const int lane, const int t, int* TIDX, float* TGATE, LAS unsigned* hist, const bool count) {
    int rank = 0;
#pragma unroll
    for (int e = 0; e < 32; ++e) rank += (rdlane(logit, 2 * e) > logit) ? 1 : 0;
    unsigned long long mk[4]; bool clean = true;
#pragma unroll
    for (int r = 0; r < 4; ++r) { mk[r] = __ballot(rank == r); clean = clean && (__builtin_popcountll(mk[r]) == 2); }
    if (!clean) {
        rank = 0;
#pragma unroll
        for (int e = 0; e < 32; ++e) { const float se = rdlane(logit, 2 * e); rank += (se > logit || (se == logit && e < myexp)) ? 1 : 0; }
#pragma unroll
        for (int r = 0; r < 4; ++r) mk[r] = __ballot(rank == r);
    }
    float tv[4]; int tix[4];
#pragma unroll
    for (int r = 0; r < 4; ++r) { const int src = (int)__builtin_ctzll(mk[r] | (1ull << 63)); tv[r] = rdlane(logit, src); tix[r] = src >> 1; }
    const float e1 = __expf(tv[1] - tv[0]), e2 = __expf(tv[2] - tv[0]), e3 = __expf(tv[3] - tv[0]);
    const float inv = 1.0f / (1.0f + e1 + e2 + e3);
    if (lane < 4) {
        const int ix = lane == 0 ? tix[0] : lane == 1 ? tix[1] : lane == 2 ? tix[2] : tix[3];
        const float gv = (lane == 0 ? 1.0f : lane == 1 ? e1 : lane == 2 ? e2 : e3) * inv;
        gst<int>(TIDX + t * 4 + lane, ix); gst<float>(TGATE + t * 4 + lane, gv);
        if (count) __hip_atomic_fetch_add(hist + ix, 1u, __ATOMIC_RELAXED, __HIP_MEMORY_SCOPE_WORKGROUP);
    }
}
__device__ __forceinline__ void ln16_lds(float (&v)[16], const LAS f32x4* lnp, int lane) {
    float sm = 0.f;
#pragma unroll
    for (int i = 0; i < 16; ++i) sm += v[i];
    const float mean = wave_sum(sm, lane) * (1.0f / D);
    float sq = 0.f;
#pragma unroll
    for (int i = 0; i < 16; ++i) { v[i] -= mean; sq += v[i] * v[i]; }
    const float rstd = 1.0f / sqrtf(wave_sum(sq, lane) * (1.0f / D) + LN_EPS);
#pragma unroll
    for (int q = 0; q < 4; ++q) { const f32x4 g4 = lnp[q * 64 + lane], b4 = lnp[(4 + q) * 64 + lane];
#pragma unroll
        for (int i = 0; i < 4; ++i) v[4 * q + i] = v[4 * q + i] * rstd * g4[i] + b4[i]; }
}
template <bool F32IN>
__device__ __forceinline__ void pool_diff_run(const float* xf, const bf16* xb, bf16* M3, int t0, int lane) {
    const int s0 = t0 & (SEQ - 1);
#pragma unroll
    for (int g = 0; g < 4; ++g) {
        const int w = 2 << g, c = 256 * g + 4 * lane;
        f32x4 r[31];
#pragma unroll
        for (int j = 0; j < w + 15; ++j) {
            const int dt = j - (w - 1);
            if (dt >= 0 || s0 != 0) {
                const size_t o = (size_t)(t0 + dt) * D + c;
                if (F32IN) r[j] = gld<f32x4>(xf + o);
                else { const v2u q = gld<v2u>(xb + o); r[j] = (f32x4){bf_lo(q.x), bf_hi(q.x), bf_lo(q.y), bf_hi(q.y)}; }
            } else r[j] = (f32x4){0.f, 0.f, 0.f, 0.f};
        }
#pragma unroll
        for (int i = 0; i < 16; ++i) {
            f32x4 sum = r[i];
#pragma unroll
            for (int j = 1; j < w; ++j) sum += r[i + j];
            const int nv = (s0 + i + 1 < w) ? s0 + i + 1 : w;
            const f32x4 df = sum * (1.0f / (float)nv) - r[i + w - 1];
            v2u o; o.x = cvt_pk_bf16(df[0], df[1]); o.y = cvt_pk_bf16(df[2], df[3]);
            gst<v2u>(M3 + (size_t)(t0 + i) * D + c, o);
        }
    }
}

__global__ void __launch_bounds__(NTHR, 2) mega_fwd(Args args) {
    extern __shared__ __attribute__((aligned(16))) unsigned char lds_raw[];
    LAS unsigned char* lds = (LAS unsigned char*)lds_raw;
    volatile LAS unsigned* MISC = (volatile LAS unsigned*)(lds + MISC_OFF);
    const int G = gridDim.x, bx = blockIdx.x;
    const int vcu = (G % 8 == 0) ? (bx % 8) * (G / 8) + bx / 8 : bx;
    if (threadIdx.x < 128) MISC[threadIdx.x] = 0u;
    __syncthreads();
    (void)xcd_barrier_post((unsigned*)(ARG_WS() + WS_CTL) + CW_BAR, MISC + 0);
#define GRID_BAR() do { XcdBarrier b_; unsigned* bp_ = (unsigned*)(ARG_WS() + WS_CTL) + CW_BAR; asm volatile("" : "+s"(bp_)); b_.bar = (unsigned*)(GAS unsigned*)bp_; b_.x = xb_xcc_id(); b_.st = MISC; xcd_barrier(b_); } while (0)

    {
        PHASE_BEGIN();
        {
            constexpr int TPITCH = 129, TBUF = 128 * TPITCH;
            LAS float* tl = (LAS float*)(lds + RING_OFF);
            constexpr int NT_GU = 128 * 8 * 16, NT_DN = 128 * 8 * 8, NT = NT_GU + NT_DN;
            struct WTile { const float* src; unsigned char* dst; int N, nb, kb, mode; };
#define WT_DECODE(ti_, d_) do { int r_ = (ti_); if (r_ < NT_GU) { const int mt_ = r_ >> 7; r_ &= 127; (d_).kb = r_ >> 4; (d_).nb = r_ & 15; (d_).N = 2048; (d_).mode = 1; \
                (d_).src = ARG_IN(18) + (size_t)mt_ * 1024 * 2048; (d_).dst = ws + WS_WGU + (size_t)mt_ * 2048 * 1024; } \
            else { r_ -= NT_GU; const int mt_ = r_ >> 6; r_ &= 63; (d_).kb = r_ >> 3; (d_).nb = r_ & 7; (d_).N = 1024; (d_).mode = 0; \
                (d_).src = ARG_IN(20) + (size_t)mt_ * 1024 * 1024; (d_).dst = ws + WS_WDN + (size_t)mt_ * 1024 * 1024; } } while (0)
#define WT_LOAD(R_, d_) do { _Pragma("unroll") for (int i = 0; i < 16; ++i) R_[i] = gld<v2u>((d_).src + (size_t)((d_).kb * 128 + wave * 16 + i) * (d_).N + (d_).nb * 128 + 2 * lane); } while (0)
#define WT_TOLDS(R_, buf_) do { const int col_ = (2 * lane + 4 * wave) & 127; _Pragma("unroll") for (int i = 0; i < 16; ++i) { LAS float* p_ = tl + (buf_) * TBUF + (wave * 16 + i) * TPITCH + col_; \
                p_[0] = __uint_as_float(R_[i].x); p_[1] = __uint_as_float(R_[i].y); } } while (0)
#define WT_OUT(d_, buf_) do { const int kc_ = tid & 7; _Pragma("unroll") for (int p = 0; p < 2; ++p) { const int n_ = (tid >> 3) + 64 * p; const LAS float* s_ = tl + (buf_) * TBUF + (16 * kc_) * TPITCH + ((n_ + 4 * kc_) & 127); \
                float v_[16]; _Pragma("unroll") for (int i = 0; i < 16; ++i) v_[i] = s_[i * TPITCH] * SW8; \
                const v2u a_ = pack8_fp8(v_), b_ = pack8_fp8(v_ + 8); v4u o_; o_.x = a_.x; o_.y = a_.y; o_.z = b_.x; o_.w = b_.y; \
                gst<v4u>((d_).dst + (size_t)drow_of((d_).mode, (d_).nb * 128 + n_) * 1024 + (d_).kb * 128 + 16 * kc_, o_); } } while (0)
#define WT_BAR() do { LDS_WAIT(); __builtin_amdgcn_s_barrier(); asm volatile("" ::: "memory"); } while (0)
            for (int rep = 0; rep < REP_P0; ++rep) {
                v2u R0[16], R1[16]; WTile d0, d1, dn;
                int ti = vcu;
                d0.src = nullptr; d1.src = nullptr;
                if (ti < NT) { WT_DECODE(ti, d0); WT_LOAD(R0, d0); }
                if (ti + G < NT) { WT_DECODE(ti + G, d1); WT_LOAD(R1, d1); }
                for (; ti < NT; ti += 2 * G) {
                    WT_TOLDS(R0, 0);
                    const bool h2 = (ti + 2 * G < NT);
                    if (h2) { WT_DECODE(ti + 2 * G, dn); WT_LOAD(R0, dn); }
                    WT_BAR();
                    WT_OUT(d0, 0);
                    if (h2) d0 = dn;
                    if (ti + G < NT) {
                        WT_TOLDS(R1, 1);
                        const bool h3 = (ti + 3 * G < NT);
                        if (h3) { WT_DECODE(ti + 3 * G, dn); WT_LOAD(R1, dn); }
                        WT_BAR();
                        WT_OUT(d1, 1);
                        if (h3) d1 = dn;
                    }
                }
                WT_BAR();
            }
#undef WT_DECODE
#undef WT_LOAD
#undef WT_TOLDS
#undef WT_OUT
#undef WT_BAR
        }
        LAS float* scr = (LAS float*)(lds + RING_OFF + wave * 16384);
        constexpr int I_POOL = 4 * 8, I_SCIN = 16 * 96, I_SQ = 16 * 32, I_CFIN = 16 * 64;
        constexpr int N_POOL = 8 * I_POOL;
        constexpr int NITEMS = N_POOL + I_SCIN + I_SQ + I_CFIN + I_SQ;
#define TITEM_SET(d_, src_, K_, N_, dst_, mode_, fp8_, item_) do { const int nb_ = (N_) / 32; (d_).src = (src_); (d_).dst = (unsigned char*)(dst_); (d_).N = (N_); (d_).Kout = (K_); \
        (d_).k0 = 64 * ((item_) / nb_); (d_).n0 = 32 * ((item_) % nb_); (d_).mode = (mode_); (d_).fp8 = (fp8_); } while (0)
#define TITEM_DECODE(it_, d_) do { int r_ = (it_); \
        if (r_ < N_POOL) { const int mt_ = r_ / I_POOL; TITEM_SET(d_, ARG_IN(1) + (size_t)mt_ * 256 * 256, 256, 256, ws + WS_WPOOL + (size_t)mt_ * 256 * 256 * 2, 0, 0, r_ % I_POOL); break; } r_ -= N_POOL; \
        if (r_ < I_SCIN) { TITEM_SET(d_, ARG_IN(3), 1024, 3072, ws + WS_WSCIN, 2, 0, r_); break; } r_ -= I_SCIN; \
        if (r_ < I_SQ) { TITEM_SET(d_, ARG_IN(5), 1024, 1024, ws + WS_WSCOUT, 0, 0, r_); break; } r_ -= I_SQ; \
        if (r_ < I_CFIN) { TITEM_SET(d_, ARG_IN(6), 1024, 2048, ws + WS_WCFIN, 3, 0, r_); break; } r_ -= I_CFIN; \
        TITEM_SET(d_, ARG_IN(12), 1024, 1024, ws + WS_WCFOUT, 0, 0, r_); } while (0)
        for (int it = gw; it < NITEMS; it += NGW) { TItem cur; float ta[32]; TITEM_DECODE(it, cur); titem_load(cur, lane, ta); titem_store(cur, lane, scr, ta); }
#undef TITEM_SET
#undef TITEM_DECODE
        const float* x0 = ARG_IN(0); bf16* XAb = (bf16*)(ws + WS_XAB);
        for (int t = gw; t < T; t += NGW) {
            float v[16];
#pragma unroll
            for (int q = 0; q < 4; ++q) { const f32x4 z = gld<f32x4>(x0 + (size_t)t * D + chq(lane, q)); v[4 * q] = z[0]; v[4 * q + 1] = z[1]; v[4 * q + 2] = z[2]; v[4 * q + 3] = z[3]; }
            gst<v4u>(XAb + (size_t)t * D + 8 * lane, pack8(v));
            gst<v4u>(XAb + (size_t)t * D + 512 + 8 * lane, pack8(v + 8));
        }
    }
    GRID_BAR();

    for (int layer = 0; layer < DEPTH; ++layer) {
        const int kind = layer % 3;

        if (kind == 0) {
            PHASE_BEGIN();
            bf16* M3 = (bf16*)(ws + WS_M3); const bf16* xb = (const bf16*)(ws + WS_XAB);
            for (int rep = 0; rep < REP_THIN; ++rep)
            for (int tb = vcu; tb < T / 128; tb += G) {
                const int t0 = tb * 128 + wave * 16;
                if (layer == 0) pool_diff_run<true>(ARG_IN(0), xb, M3, t0, lane);
                else pool_diff_run<false>(ARG_IN(0), xb, M3, t0, lane);
            }
        } else {
            {
                PHASE_BEGIN();
                bf16* M1 = (bf16*)(ws + WS_M1); bf16* M2 = (bf16*)(ws + WS_M2);
                const int nN = (kind == 1) ? 12 : 8;
                const int n_my = pg8::build_units(lds, tid, T / 256, nN, G, bx, false, nullptr, REP_MIXG);
                pg8::GemmP gp; gp.A = (const char*)(ws + WS_XAB); gp.lda2 = D * 2; gp.acol_pn = 0; gp.Bt = (const char*)(ws + ((kind == 1) ? WS_WSCIN : WS_WCFIN)); gp.b_estride = 0; gp.Kb = 2048; gp.sA = 0; gp.sB = 0;
                pg8::EpiPair E; E.O1 = (kind == 1) ? M2 : M1; E.O2 = M1; E.bias = ARG_IN(7); E.mode = (kind == 1) ? 0 : 1;
                pg8::gemm_phase<false, false, pg8::EpiPair>(lds, tid, gp, n_my, E);
            }
            GRID_BAR();
            if (kind == 1) {
                PHASE_BEGIN();
                const bf16* M1 = (const bf16*)(ws + WS_M1); const bf16* M2 = (const bf16*)(ws + WS_M2); bf16* M3 = (bf16*)(ws + WS_M3);
                const float* cw = ARG_IN(4);
                float wk[3][16];
#pragma unroll
                for (int k = 0; k < 3; ++k)
#pragma unroll
                    for (int q = 0; q < 4; ++q) { const f32x4 v = gld<f32x4>(cw + k * D + chq(lane, q)); wk[k][4 * q] = v[0]; wk[k][4 * q + 1] = v[1]; wk[k][4 * q + 2] = v[2]; wk[k][4 * q + 3] = v[3]; }
                for (int rep = 0; rep < REP_THIN; ++rep)
                for (int tb = vcu; tb < T / 128; tb += G) {
                    const int t0 = tb * 128 + wave * 16, s0 = t0 & (SEQ - 1);
                    float p2[16], p1[16];
                    if (s0 != 0) { unpack8(gld<v4u>(M2 + (size_t)(t0 - 2) * D + 8 * lane), p2); unpack8(gld<v4u>(M2 + (size_t)(t0 - 2) * D + 512 + 8 * lane), p2 + 8);
                                   unpack8(gld<v4u>(M2 + (size_t)(t0 - 1) * D + 8 * lane), p1); unpack8(gld<v4u>(M2 + (size_t)(t0 - 1) * D + 512 + 8 * lane), p1 + 8); }
                    else {
#pragma unroll
                        for (int i = 0; i < 16; ++i) { p2[i] = 0.f; p1[i] = 0.f; } }
                    for (int i0 = 0; i0 < 16; i0 += 4) {
                        v4u cv[4][2], gv[4][2];
#pragma unroll
                        for (int u = 0; u < 4; ++u)
#pragma unroll
                            for (int j = 0; j < 2; ++j) { const size_t o = (size_t)(t0 + i0 + u) * D + j * 512 + 8 * lane; cv[u][j] = gld<v4u>(M2 + o); gv[u][j] = gld<v4u>(M1 + o); }
#pragma unroll
                        for (int u = 0; u < 4; ++u) {
                            float c[16], gb[16], o[16];
                            unpack8(cv[u][0], c); unpack8(cv[u][1], c + 8); unpack8(gv[u][0], gb); unpack8(gv[u][1], gb + 8);
#pragma unroll
                            for (int i = 0; i < 16; ++i) { o[i] = gb[i] * (wk[0][i] * p2[i] + wk[1][i] * p1[i] + wk[2][i] * c[i]); p2[i] = p1[i]; p1[i] = c[i]; }
                            gst<v4u>(M3 + (size_t)(t0 + i0 + u) * D + 8 * lane, pack8(o));
                            gst<v4u>(M3 + (size_t)(t0 + i0 + u) * D + 512 + 8 * lane, pack8(o + 8));
                        }
                    }
                }
            } else {
                PHASE_BEGIN();
                const bf16* U = (const bf16*)(ws + WS_M1); bf16* M3 = (bf16*)(ws + WS_M3);
                const int c = 128 * wave + 2 * lane;
                float wk0[31], wk1[31];
#pragma unroll
                for (int k = 0; k < 31; ++k) { const v2u q = gld<v2u>(ARG_IN(8) + k * D + c); wk0[k] = __uint_as_float(q.x); wk1[k] = __uint_as_float(q.y); }
                const v2u qb = gld<v2u>(ARG_IN(9) + c), qg = gld<v2u>(ARG_IN(10) + c), ql = gld<v2u>(ARG_IN(11) + c);
                const float db0 = __uint_as_float(qb.x), db1 = __uint_as_float(qb.y), lg0 = __uint_as_float(qg.x), lg1 = __uint_as_float(qg.y), lb0 = __uint_as_float(ql.x), lb1 = __uint_as_float(ql.y);
                LAS float* part = (LAS float*)(lds + RING_OFF);
                LAS float* stat = part + 256;
                for (int rep = 0; rep < REP_THIN; ++rep)
                for (int run = vcu; run < T / 16; run += G) {
                    const int t0 = run * 16, s0 = t0 & (SEQ - 1);
                    unsigned r[46];
#pragma unroll
                    for (int j = 0; j < 46; ++j) r[j] = (s0 + j - 30 >= 0) ? gld<unsigned>(U + (size_t)(t0 + j - 30) * D + c) : 0u;
                    float a0[16], a1[16];
#pragma unroll
                    for (int i = 0; i < 16; ++i) { a0[i] = db0; a1[i] = db1; }
#pragma unroll
                    for (int j = 0; j < 46; ++j) { const float x0 = bf_lo(r[j]), x1 = bf_hi(r[j]);
#pragma unroll
                        for (int i = 0; i < 16; ++i) { const int k = j - i; if (k >= 0 && k <= 30) { a0[i] += wk0[k] * x0; a1[i] += wk1[k] * x1; } } }
                    float st[32];
#pragma unroll
                    for (int i = 0; i < 16; ++i) { st[2 * i] = a0[i] + a1[i]; st[2 * i + 1] = a0[i] * a0[i] + a1[i] * a1[i]; }
                    const float tot = butterfly32(st, lane);
                    if ((lane & 1) == 0) part[wave * 32 + (lane >> 1)] = tot;
                    __syncthreads();
                    if (tid < 16) { float S = 0.f, Q = 0.f;
#pragma unroll
                        for (int w8 = 0; w8 < 8; ++w8) { S += part[w8 * 32 + 2 * tid]; Q += part[w8 * 32 + 2 * tid + 1]; }
                        const float mean = S * (1.0f / D); const float var = fmaxf(Q * (1.0f / D) - mean * mean, 0.f);
                        stat[2 * tid] = mean; stat[2 * tid + 1] = 1.0f / sqrtf(var + LN_EPS); }
                    __syncthreads();
#pragma unroll
                    for (int i = 0; i < 16; ++i) { const float mean = stat[2 * i], rstd = stat[2 * i + 1];
                        const float y0 = (a0[i] - mean) * rstd * lg0 + lb0, y1 = (a1[i] - mean) * rstd * lg1 + lb1;
                        gst<unsigned>(M3 + (size_t)(t0 + i) * D + c, cvt_pk_bf16(y0 * sigmoidf_(y0), y1 * sigmoidf_(y1))); }
                }
                __syncthreads();
            }
        }
        GRID_BAR();

        {
            PHASE_BEGIN();
            const int n_my = pg8::build_units(lds, tid, T / 256, 4, G, bx, false, nullptr, REP_MIXG);
            pg8::GemmP gp; gp.A = (const char*)(ws + WS_M3); gp.lda2 = D * 2; gp.b_estride = 0; gp.sA = 0; gp.sB = 0;
            pg8::EpiOut E; E.xres = (const bf16*)(ws + WS_XAB); E.z = (bf16*)(ws + WS_ZB); E.bias = nullptr; E.scale = nullptr;
            if (kind == 0) { gp.acol_pn = 512; gp.Bt = (const char*)(ws + WS_WPOOL + (size_t)(layer / 3) * 1024 * 256 * 2); gp.Kb = 512; E.scale = ARG_IN(2) + (layer / 3) * D; }
            else if (kind == 1) { gp.acol_pn = 0; gp.Bt = (const char*)(ws + WS_WSCOUT); gp.Kb = 2048; }
            else { gp.acol_pn = 0; gp.Bt = (const char*)(ws + WS_WCFOUT); gp.Kb = 2048; E.bias = ARG_IN(13); }
            pg8::gemm_phase<false, false, pg8::EpiOut>(lds, tid, gp, n_my, E);
        }
        GRID_BAR();

        {
            PHASE_BEGIN();
            const bf16* Zb = (const bf16*)(ws + WS_ZB); bf16* X1b = (bf16*)(ws + WS_X1B); unsigned char* X18 = (unsigned char*)(ws + WS_X18);
            int* TIDX = (int*)(ws + WS_IDX); float* TGATE = (float*)(ws + WS_GATE);
            unsigned* CNT = ctl + CW_CNT + layer * NE;
            LAS float* rwl = (LAS float*)(lds + RING_OFF);
            const float* rw = ARG_IN(16) + (size_t)layer * D * NE;
            for (int idx = tid; idx < D * 8; idx += NTHR) { const int c = idx >> 3, eg = idx & 7; const int j = c >> 9, r = c & 511, l = r >> 3, ci = j * 8 + (r & 7);
                *(LAS f32x4*)(rwl + ((ci * 8 + eg) * 64 + l) * 4) = gld<f32x4>(rw + c * NE + eg * 4); }
            if (tid < NE) MISC[32 + tid] = 0u;
            __syncthreads();
            LAS f32x4* lnp = (LAS f32x4*)(lds + TOK_OFF);
            if (tid < 256) { const int q = tid >> 6, l = tid & 63; lnp[q * 64 + l] = gld<f32x4>(ARG_IN(14) + layer * D + chq(l, q)); lnp[(4 + q) * 64 + l] = gld<f32x4>(ARG_IN(15) + layer * D + chq(l, q)); }
            __syncthreads();
            const int myexp = (lane >> 1) & 31;
            const float rbias = gld<float>(ARG_IN(17) + layer * NE + myexp);
            LAS unsigned* hist = (LAS unsigned*)(lds + MISC_OFF) + 32;
            for (int rep = 0; rep < REP_LNR; ++rep)
            for (int tb = vcu; tb < T / 128; tb += G) {
                const int t0 = tb * 128 + wave * 16;
                v4u zn[2][2];
#pragma unroll
                for (int u = 0; u < 2; ++u)
#pragma unroll
                    for (int j = 0; j < 2; ++j) zn[u][j] = gld<v4u>(Zb + (size_t)(t0 + u) * D + j * 512 + 8 * lane);
                for (int ti = 0; ti < 16; ti += 2) {
                    const int t = t0 + ti;
                    float va[16], vb[16];
                    unpack8(zn[0][0], va); unpack8(zn[0][1], va + 8); unpack8(zn[1][0], vb); unpack8(zn[1][1], vb + 8);
                    if (ti + 2 < 16) {
#pragma unroll
                        for (int u = 0; u < 2; ++u)
#pragma unroll
                            for (int j = 0; j < 2; ++j) zn[u][j] = gld<v4u>(Zb + (size_t)(t + 2 + u) * D + j * 512 + 8 * lane); }
                    ln16_lds(va, lnp, lane); ln16_lds(vb, lnp, lane);
                    gst<v4u>(X1b + (size_t)t * D + 8 * lane, pack8(va)); gst<v4u>(X1b + (size_t)t * D + 512 + 8 * lane, pack8(va + 8));
                    gst<v4u>(X1b + (size_t)(t + 1) * D + 8 * lane, pack8(vb)); gst<v4u>(X1b + (size_t)(t + 1) * D + 512 + 8 * lane, pack8(vb + 8));
                    { float s8[16];
#pragma unroll
                      for (int i = 0; i < 16; ++i) s8[i] = va[i] * SX8;
                      gst<v2u>(X18 + (size_t)t * D + 8 * lane, pack8_fp8(s8)); gst<v2u>(X18 + (size_t)t * D + 512 + 8 * lane, pack8_fp8(s8 + 8));
#pragma unroll
                      for (int i = 0; i < 16; ++i) s8[i] = vb[i] * SX8;
                      gst<v2u>(X18 + (size_t)(t + 1) * D + 8 * lane, pack8_fp8(s8)); gst<v2u>(X18 + (size_t)(t + 1) * D + 512 + 8 * lane, pack8_fp8(s8 + 8)); }
                    f32x2 pa[16], pb[16];
#pragma unroll
                    for (int e = 0; e < 16; ++e) { pa[e] = (f32x2){0.f, 0.f}; pb[e] = (f32x2){0.f, 0.f}; }
                    f32x4 w0[8], w1[8];
#define RW_LOAD(dst, ci) do { _Pragma("unroll") for (int eg = 0; eg < 8; ++eg) dst[eg] = *(const LAS f32x4*)(rwl + (((ci) * 8 + eg) * 64 + lane) * 4); asm volatile("" ::: "memory"); } while (0)
#define RW_FMA(wsrc, ci) do { const f32x2 sa = (f32x2){va[ci], va[ci]}, sb = (f32x2){vb[ci], vb[ci]}; _Pragma("unroll") for (int eg = 0; eg < 8; ++eg) { \
                        const f32x2 lo = (f32x2){wsrc[eg][0], wsrc[eg][1]}, hi = (f32x2){wsrc[eg][2], wsrc[eg][3]}; \
                        pa[2 * eg] = __builtin_elementwise_fma(lo, sa, pa[2 * eg]); pa[2 * eg + 1] = __builtin_elementwise_fma(hi, sa, pa[2 * eg + 1]); \
                        pb[2 * eg] = __builtin_elementwise_fma(lo, sb, pb[2 * eg]); pb[2 * eg + 1] = __builtin_elementwise_fma(hi, sb, pb[2 * eg + 1]); } } while (0)
                    RW_LOAD(w0, 0);
#pragma unroll
                    for (int ci = 0; ci < 16; ci += 2) {
                        RW_LOAD(w1, ci + 1);
                        RW_FMA(w0, ci);
                        if (ci + 2 < 16) RW_LOAD(w0, ci + 2);
                        RW_FMA(w1, ci + 1);
                    }
#undef RW_LOAD
#undef RW_FMA
                    float qa[32], qb[32];
#pragma unroll
                    for (int e = 0; e < 16; ++e) { qa[2 * e] = pa[e][0]; qa[2 * e + 1] = pa[e][1]; qb[2 * e] = pb[e][0]; qb[2 * e + 1] = pb[e][1]; }
                    const float logitA = butterfly32(qa, lane) + rbias, logitB = butterfly32(qb, lane) + rbias;
                    route_token(logitA, myexp, lane, t, TIDX, TGATE, hist, rep == 0);
                    route_token(logitB, myexp, lane, t + 1, TIDX, TGATE, hist, rep == 0);
                }
            }
            __syncthreads();
            if (tid < NE) { const unsigned c = MISC[32 + tid]; if (c) (void)xb_add(CNT + tid, c); }
        }
        GRID_BAR();

        {
            PHASE_BEGIN();
            const int* TIDX = (const int*)(ws + WS_IDX); const float* TGATE = (const float*)(ws + WS_GATE);
            int* RTOK = (int*)(ws + WS_RTOK); int* RDST = (int*)(ws + WS_RDST); float* RGATE = (float*)(ws + WS_RGATE);
            unsigned* CNT = ctl + CW_CNT + layer * NE; unsigned* CUR = ctl + CW_CUR + layer * NE;
            LAS int* TS = (LAS int*)(lds + TS_OFF);
            if (tid == 0) { int a = 0; for (int e = 0; e < NE; ++e) { TS[e] = a; a += (int)((xb_ld(CNT + e) + 255u) >> 8); } TS[NE] = a; }
            for (int tb = vcu; tb < T / 128; tb += G) {
                __syncthreads();
                if (tid < NE) MISC[32 + tid] = 0u;
                __syncthreads();
                const int t = tb * 128 + (tid >> 2), k = tid & 3;
                const int e = gld<int>(TIDX + t * 4 + k); const float gv = gld<float>(TGATE + t * 4 + k);
                const unsigned rank = __hip_atomic_fetch_add((LAS unsigned*)(lds + MISC_OFF) + 32 + e, 1u, __ATOMIC_RELAXED, __HIP_MEMORY_SCOPE_WORKGROUP);
                __syncthreads();
                if (tid < NE) { const unsigned c = MISC[32 + tid]; MISC[64 + tid] = c ? xb_add(CUR + tid, c) : 0u; }
                __syncthreads();
                const int pos = TS[e] * 256 + (int)MISC[64 + e] + (int)rank;
                gst<int>(RTOK + pos, t); gst<int>(RDST + pos, t * 4 + k); gst<float>(RGATE + pos, gv);
            }
            __syncthreads();
            for (int e = vcu; e < NE; e += G) {
                const int beg = TS[e] * 256 + (int)xb_ld(CNT + e), end = TS[e + 1] * 256;
                for (int p = beg + tid; p < end; p += NTHR) { gst<int>(RTOK + p, 0); gst<int>(RDST + p, -1); gst<float>(RGATE + p, 0.f); }
            }
        }
        GRID_BAR();

        {
            PHASE_BEGIN();
            unsigned* CNT = ctl + CW_CNT + layer * NE;
            LAS int* TS = (LAS int*)(lds + TS_OFF);
            __syncthreads();
            if (tid == 0) { int a = 0; for (int e = 0; e < NE; ++e) { TS[e] = a; a += (int)((xb_ld(CNT + e) + 255u) >> 8); } TS[NE] = a; }
            __syncthreads();
            const int nM = TS[NE];
            const int n_my = pg8::build_units(lds, tid, nM, 8, G, bx, true, (const int*)(ws + WS_RTOK), REP_MOE1);
            pg8::GemmP gp; gp.A = (const char*)(ws + WS_X18); gp.lda2 = D; gp.acol_pn = 0; gp.Bt = (const char*)(ws + WS_WGU + (size_t)layer * NE * 2048 * 1024); gp.b_estride = (size_t)2048 * 1024; gp.Kb = 1024; gp.sA = E8_X; gp.sB = E8_W;
            pg8::EpiSwiglu E; E.act = (unsigned char*)(ws + WS_ACT); E.bgu = ARG_IN(19) + (size_t)layer * NE * 2048;
            pg8::gemm_phase<true, true, pg8::EpiSwiglu>(lds, tid, gp, n_my, E, REP_MOE1 > 1 ? n_my / 2 : (1 << 20));
        }
        GRID_BAR();

        {
            PHASE_BEGIN();
            LAS int* TS = (LAS int*)(lds + TS_OFF);
            const int nM = TS[NE];
            const int n_my = pg8::build_units(lds, tid, nM, 4, G, bx, true, nullptr, REP_MOE2);
            pg8::GemmP gp; gp.A = (const char*)(ws + WS_ACT); gp.lda2 = D; gp.acol_pn = 0; gp.Bt = (const char*)(ws + WS_WDN + (size_t)layer * NE * 1024 * 1024); gp.b_estride = (size_t)1024 * 1024; gp.Kb = 1024; gp.sA = E8_ACT; gp.sB = E8_W;
            pg8::EpiMoe2 E; E.Y = (unsigned char*)(ws + WS_Y); E.bdn = ARG_IN(21) + (size_t)layer * NE * D; E.rowdst = (const int*)(ws + WS_RDST); E.rowgate = (const float*)(ws + WS_RGATE);
            pg8::gemm_phase<false, true, pg8::EpiMoe2>(lds, tid, gp, n_my, E);
        }
        GRID_BAR();

        {
            PHASE_BEGIN();
            const bf16* X1b = (const bf16*)(ws + WS_X1B); const unsigned char* Y = (const unsigned char*)(ws + WS_Y); float* OUT = ARG_OUT(); bf16* XAb = (bf16*)(ws + WS_XAB);
            float lg[16], lb[16];
#pragma unroll
            for (int q = 0; q < 4; ++q) { const f32x4 b = gld<f32x4>(ARG_IN(22) + layer * D + 16 * lane + 4 * q), c = gld<f32x4>(ARG_IN(23) + layer * D + 16 * lane + 4 * q);
#pragma unroll
                for (int i = 0; i < 4; ++i) { lg[4 * q + i] = b[i]; lb[4 * q + i] = c[i]; } }
            for (int rep = 0; rep < REP_THIN; ++rep)
            for (int tb = vcu; tb < T / 128; tb += G) {
                const int t0 = tb * 128 + wave * 16;
                v4u nx[2], ny[4];
#pragma unroll
                for (int j = 0; j < 2; ++j) nx[j] = gld<v4u>(X1b + (size_t)t0 * D + 16 * lane + 8 * j);
#pragma unroll
                for (int k = 0; k < 4; ++k) ny[k] = gld<v4u>(Y + (size_t)(t0 * 4 + k) * D + 16 * lane);
                for (int ti = 0; ti < 16; ++ti) {
                    const int t = t0 + ti;
                    float v[16], h[16];
                    unpack8(nx[0], v); unpack8(nx[1], v + 8);
#pragma unroll
                    for (int i = 0; i < 16; ++i) h[i] = 0.f;
#pragma unroll
                    for (int k = 0; k < 4; ++k) { const unsigned wd[4] = {ny[k].x, ny[k].y, ny[k].z, ny[k].w};
#pragma unroll
                        for (int d = 0; d < 4; ++d) { const f32x2 lo = __builtin_amdgcn_cvt_pk_f32_fp8((int)wd[d], false), hi = __builtin_amdgcn_cvt_pk_f32_fp8((int)wd[d], true);
                            h[4 * d] += lo[0]; h[4 * d + 1] += lo[1]; h[4 * d + 2] += hi[0]; h[4 * d + 3] += hi[1]; } }
                    if (ti + 1 < 16) {
#pragma unroll
                        for (int j = 0; j < 2; ++j) nx[j] = gld<v4u>(X1b + (size_t)(t + 1) * D + 16 * lane + 8 * j);
#pragma unroll
                        for (int k = 0; k < 4; ++k) ny[k] = gld<v4u>(Y + (size_t)((t + 1) * 4 + k) * D + 16 * lane); }
#pragma unroll
                    for (int i = 0; i < 16; ++i) v[i] = v[i] * ALPHA + h[i] * (1.0f / SY8);
                    ln16(v, lg, lb, lane);
                    if (layer == DEPTH - 1) {
#pragma unroll
                        for (int q = 0; q < 4; ++q) gst<f32x4>(OUT + (size_t)t * D + 16 * lane + 4 * q, (f32x4){v[4 * q], v[4 * q + 1], v[4 * q + 2], v[4 * q + 3]});
                    } else {
                        gst<v4u>(XAb + (size_t)t * D + 16 * lane, pack8(v));
                        gst<v4u>(XAb + (size_t)t * D + 16 * lane + 8, pack8(v + 8));
                    }
                }
            }
        }
        if (layer + 1 < DEPTH) GRID_BAR();
    }
}

extern "C" void kernel_launch(void* const* d_in, const int* in_sizes, int n_in, void* d_out, int out_size, void* d_ws, size_t ws_size, hipStream_t stream) {
    static int grid = 0;
    if (grid == 0) {
        if (n_in != 24 || out_size != T * D || ws_size < WS_END) { fprintf(stderr, "kernel_launch: unexpected shapes (n_in %d out %d ws %zu)\n", n_in, out_size, ws_size); grid = -1; return; }
        if (hipFuncSetAttribute((const void*)mega_fwd, hipFuncAttributeMaxDynamicSharedMemorySize, LDS_BYTES) != hipSuccess) { fprintf(stderr, "kernel_launch: hipFuncSetAttribute failed\n"); grid = -1; return; }
        int dev = 0, cus = 0, per_cu = 0;
        (void)hipGetDevice(&dev); (void)hipDeviceGetAttribute(&cus, hipDeviceAttributeMultiprocessorCount, dev);
        if (hipOccupancyMaxActiveBlocksPerMultiprocessor(&per_cu, (const void*)mega_fwd, NTHR, LDS_BYTES) != hipSuccess || per_cu < 1) fprintf(stderr, "kernel_launch: occupancy query reports %d blocks per CU\n", per_cu);
        (void)hipGetLastError();
        grid = 256; if (cus > 0 && cus < grid) grid = cus;
    }
    if (grid < 0) return;
    (void)hipMemsetAsync((char*)d_ws + WS_CTL, 0, CTL_ZERO_BYTES, stream);
    Args a{};
    for (int i = 0; i < 24; ++i) a.in[i] = (const float*)d_in[i];
    a.out = (float*)d_out; a.ws = (unsigned char*)d_ws;
    hipLaunchKernelGGL(mega_fwd, dim3(grid), dim3(NTHR), LDS_BYTES, stream, a);
    const hipError_t le = hipPeekAtLastError();
    if (le != hipSuccess) fprintf(stderr, "kernel_launch: launch failed: %s\n", hipGetErrorName(le));
}
```

```cpp
#include <hip/hip_runtime.h>
#include <cstdio>
#include <cstdint>

#define GAS __attribute__((address_space(1)))
#define LAS __attribute__((address_space(3)))
typedef unsigned short bf16;
typedef unsigned v4u __attribute__((ext_vector_type(4)));
typedef unsigned v2u __attribute__((ext_vector_type(2)));
typedef float f32x4 __attribute__((ext_vector_type(4)));
typedef float f32x2 __attribute__((ext_vector_type(2)));
typedef short bf16x8 __attribute__((ext_vector_type(8)));
typedef int v4i __attribute__((ext_vector_type(4)));
typedef int v8i __attribute__((ext_vector_type(8)));

template <class V> __device__ __forceinline__ V gld(const void* p) { return *(const GAS V*)p; }
template <class V> __device__ __forceinline__ void gst(void* p, V v) { *(GAS V*)p = v; }

#ifndef REP_P0
#define REP_P0 1
#endif
#ifndef REP_MOE1
#define REP_MOE1 1
#endif
#ifndef REP_MOE2
#define REP_MOE2 1
#endif
#ifndef REP_THIN
#define REP_THIN 1
#endif
#ifndef REP_MIXG
#define REP_MIXG 1
#endif
#ifndef REP_LNR
#define REP_LNR 1
#endif
#ifndef REP_BAR
#define REP_BAR 1
#endif
#ifndef REP_EPI1
#define REP_EPI1 1
#endif
#ifndef REP_EPI2
#define REP_EPI2 1
#endif
constexpr int T = 32768, D = 1024, SEQ = 4096, NE = 32, TOPK = 4, NA = T * TOPK, DEPTH = 4;
constexpr int MAXTILES = NA / 256 + NE;
constexpr int NPAD = MAXTILES * 256;
constexpr float LN_EPS = 1e-5f;
constexpr float ALPHA = 1.681792830507429f;
constexpr int NWAVES = 8, NTHR = 512;
constexpr int MAXU = 17;
constexpr float SX8 = 16.0f, SACT8 = 4.0f, SW8 = 256.0f, SY8 = 64.0f;
constexpr int E8_X = 0x7B7B7B7B  , E8_ACT = 0x7D7D7D7D  , E8_W = 0x77777777  ;

constexpr size_t MiB = 1u << 20;
constexpr size_t WS_CTL = 0, CTL_ZERO_BYTES = 1 * MiB;
constexpr size_t WS_IDX = 1 * MiB;
constexpr size_t WS_GATE = 1 * MiB + 512 * 1024;
constexpr size_t WS_RTOK = 2 * MiB;
constexpr size_t WS_RDST = 3 * MiB;
constexpr size_t WS_RGATE = 4 * MiB;
constexpr size_t WS_WPOOL = 5 * MiB;
constexpr size_t WS_WSCIN = 6 * MiB;
constexpr size_t WS_WSCOUT = 12 * MiB;
constexpr size_t WS_WCFIN = 14 * MiB;
constexpr size_t WS_WCFOUT = 18 * MiB;
constexpr size_t WS_WGU = 32 * MiB;
constexpr size_t WS_WDN = 544 * MiB;
constexpr size_t WS_X18 = 704 * MiB;
constexpr size_t WS_ZB = 800 * MiB;
constexpr size_t WS_XAB = 864 * MiB;
constexpr size_t WS_X1B = 928 * MiB;
constexpr size_t WS_M1 = 992 * MiB;
constexpr size_t WS_M2 = 1056 * MiB;
constexpr size_t WS_M3 = 1120 * MiB;
constexpr size_t WS_ACT = 1184 * MiB;
constexpr size_t WS_Y = 1456 * MiB;
constexpr size_t WS_END = 1712 * MiB;
constexpr int CW_BAR = 4096;
constexpr int CW_CNT = 8192;
constexpr int CW_CUR = 8192 + 256;

constexpr int RING_OFF = 0, RING_BYTES = 131072;
constexpr int TOK_OFF = RING_BYTES;
constexpr int UT_OFF = TOK_OFF + MAXU * 1024;
constexpr int TS_OFF = UT_OFF + (2 * MAXU + 2) * 16;
constexpr int MISC_OFF = TS_OFF + 36 * 4;
constexpr int EPI_OFF = ((MISC_OFF + 128 * 4 + 255) / 256) * 256;
constexpr int LDS_BYTES = EPI_OFF + 2 * 4096;
static_assert(LDS_BYTES <= 160 * 1024 && (MISC_OFF % 16) == 0, "LDS map");

#define LDS_WAIT() asm volatile("s_waitcnt lgkmcnt(0)" ::: "memory")
#define VM_WAIT() asm volatile("s_waitcnt vmcnt(0)" ::: "memory")

__device__ __forceinline__ unsigned cvt_pk_bf16(float lo, float hi) { unsigned r; asm volatile("v_cvt_pk_bf16_f32 %0, %1, %2" : "=v"(r) : "v"(lo), "v"(hi)); return r; }
__device__ __forceinline__ v2u pack8_fp8(const float* v) { int a = __builtin_amdgcn_cvt_pk_fp8_f32(v[0], v[1], 0, false); a = __builtin_amdgcn_cvt_pk_fp8_f32(v[2], v[3], a, true);
    int b = __builtin_amdgcn_cvt_pk_fp8_f32(v[4], v[5], 0, false); b = __builtin_amdgcn_cvt_pk_fp8_f32(v[6], v[7], b, true); v2u w; w.x = (unsigned)a; w.y = (unsigned)b; return w; }
__device__ __forceinline__ float bf_lo(unsigned u) { return __uint_as_float(u << 16); }
__device__ __forceinline__ float bf_hi(unsigned u) { return __uint_as_float(u & 0xffff0000u); }
__device__ __forceinline__ float sigmoidf_(float x) { return __builtin_amdgcn_rcpf(1.0f + __expf(-x)); }
#define DPP_F(v, ctrl) __int_as_float(__builtin_amdgcn_update_dpp(0, __float_as_int(v), (ctrl), 0xf, 0xf, true))
#define DPP_XOR1 0xB1
#define DPP_XOR2 0x4E
#define DPP_QREV 0x1B
#define DPP_HMIR 0x141
#define DPP_RMIR 0x140
#define DPP_ROR8 0x128
__device__ __forceinline__ float rdlane(float v, int l) { return __uint_as_float((unsigned)__builtin_amdgcn_readlane((int)__float_as_uint(v), l)); }
__device__ __forceinline__ float wave_sum(float v, int lane) {
    (void)lane;
    v += DPP_F(v, DPP_XOR1); v += DPP_F(v, DPP_XOR2); v += DPP_F(v, DPP_HMIR); v += DPP_F(v, DPP_RMIR);
    return (rdlane(v, 0) + rdlane(v, 16)) + (rdlane(v, 32) + rdlane(v, 48));
}

#define XB_TMO      128
#define XB_XCNT(j)  (256  + 64 * (j))
#define XB_XSUB(j)  (1280 + 64 * (j))
#define XB_XGEN(j)  (2304 + 64 * (j))
#define XB_TOP      3328
#define XB_TOPGEN   3392
#define XCD_BAR_WORDS 3456
#define XB_SPIN_CAP (1u << 18)

__device__ __forceinline__ unsigned xb_ld(unsigned* p)              { return __hip_atomic_load((GAS unsigned*)p, __ATOMIC_RELAXED, __HIP_MEMORY_SCOPE_AGENT); }
__device__ __forceinline__ unsigned xb_add(unsigned* p, unsigned v) { return __hip_atomic_fetch_add((GAS unsigned*)p, v, __ATOMIC_RELAXED, __HIP_MEMORY_SCOPE_AGENT); }
__device__ __forceinline__ unsigned xb_xcc_id() { return (unsigned)__builtin_amdgcn_s_getreg((3 << 11) | 20) & 0xFu; }
#define XB_SPIN(cond, bar) do { unsigned _sp = 0; while (cond) { __builtin_amdgcn_s_sleep(1); \
    if ((++_sp & 255u) == 0u) { if (xb_ld(&(bar)[XB_TMO])) break; if (_sp > XB_SPIN_CAP) { (void)xb_add(&(bar)[XB_TMO], 1u); break; } } } } while (0)

struct XcdBarrier { unsigned* bar; unsigned x; volatile LAS unsigned* st; };

__device__ __forceinline__ XcdBarrier xcd_barrier_post(unsigned* bar, volatile LAS unsigned* st) {
    XcdBarrier b; b.bar = bar; b.x = xb_xcc_id(); b.st = st;
    if (threadIdx.x == 0) (void)xb_add(&bar[XB_XCNT(b.x)], 1u);
    return b;
}
__device__ __forceinline__ void xcd_barrier_complete(unsigned* bar, unsigned x, unsigned& nloc, unsigned& nx) {
    const unsigned G = gridDim.x * gridDim.y * gridDim.z;
    unsigned sum, cnt, mine, sp = 0u;
    for (;;) {
        sum = 0u; cnt = 0u; mine = 0u;
#pragma unroll
        for (unsigned j = 0; j < 16; ++j) { const unsigned c = xb_ld(&bar[XB_XCNT(j)]); sum += c; cnt += (c > 0u) ? 1u : 0u; mine = (j == x) ? c : mine; }
        if (sum == G) break;
        __builtin_amdgcn_s_sleep(1);
        if ((++sp & 255u) == 0u) { if (xb_ld(&bar[XB_TMO])) break; if (sp > XB_SPIN_CAP) { (void)xb_add(&bar[XB_TMO], 1u); break; } }
    }
    nloc = mine > 0u ? mine : 1u; nx = cnt > 0u ? cnt : 1u;
}
__device__ __forceinline__ void xcd_barrier(const XcdBarrier& b) {
    asm volatile("s_waitcnt vmcnt(0)" ::: "memory");
    __syncthreads();
    if (threadIdx.x == 0) {
        unsigned* bar = b.bar;
        __builtin_amdgcn_s_waitcnt(0);
        unsigned nloc = b.st[0], nx = b.st[1];
        if (nloc == 0u) { xcd_barrier_complete(bar, b.x, nloc, nx); b.st[0] = nloc; b.st[1] = nx; }
        const unsigned old = xb_add(&bar[XB_XSUB(b.x)], 1u);
        const unsigned gen = old / nloc;
        if (old + 1u == (gen + 1u) * nloc) {
            __builtin_amdgcn_fence(__ATOMIC_RELEASE, "agent");
            asm volatile("s_waitcnt vmcnt(0)" ::: "memory");
            const unsigned og = xb_add(&bar[XB_TOP], 1u);
            const unsigned tg = og / nx;
            if (og + 1u == (tg + 1u) * nx) xb_add(&bar[XB_TOPGEN], 1u);
            else XB_SPIN(xb_ld(&bar[XB_TOPGEN]) == tg, bar);
            __builtin_amdgcn_fence(__ATOMIC_ACQUIRE, "agent");
            xb_add(&bar[XB_XGEN(b.x)], 1u);
            asm volatile("s_waitcnt vmcnt(0)" ::: "memory");
        } else {
            XB_SPIN(xb_ld(&bar[XB_XGEN(b.x)]) == gen, bar);
            __builtin_amdgcn_fence(__ATOMIC_ACQUIRE, "agent");
            asm volatile("s_waitcnt vmcnt(0)" ::: "memory");
        }
    }
    __syncthreads();
}

namespace pg8 {
constexpr int BM = 256, BK = 64, HALF = 128, HTB = HALF * BK * 2, STAGE_BYTES = 8 * HTB, NXCD = 8, WGM = 8;
__host__ __device__ __forceinline__ int lds_byte(int r, int c) { const int st = (r >> 4) * 2 + (c >> 5), rr = r & 15, cc = c & 31, ob = rr * 64 + cc * 2; return st * 1024 + (ob ^ (((ob >> 9) & 1) << 5)); }
__host__ __device__ __forceinline__ void stage_rc(int b, int& R, int& C) { const int st = b / 1024, sb = b % 1024, swz = sb ^ (((sb >> 9) & 1) << 5); R = (st >> 1) * 16 + swz / 64; C = (st & 1) * 32 + (swz % 64) / 2; }
__host__ __device__ __forceinline__ int perm32(int rho) { const int n = rho >> 4, i = rho & 15; return 8 * (i >> 2) + 4 * n + (i & 3); }

struct Unit { int pm, pn, e; };
struct GemmP {
    const char* A; unsigned lda2;
    unsigned acol_pn;
    const char* Bt; size_t b_estride;
    int Kb;
    int sA, sB;
};

__device__ __forceinline__ void unit_of(int L, int nM, int nN, int& pm, int& pn) {
    const int nwg = nM * nN;
    int wgid = L; { const int q = nwg / NXCD, r = nwg % NXCD, xcd = wgid % NXCD, off = wgid / NXCD; wgid = (xcd < r ? xcd * (q + 1) : r * (q + 1) + (xcd - r) * q) + off; }
    const int nig = WGM * nN, gid = wgid / nig, fm = gid * WGM, gsz = (nM - fm) < WGM ? (nM - fm) : WGM;
    pm = fm + ((wgid % nig) % gsz); pn = (wgid % nig) / gsz;
}
__device__ __forceinline__ int build_units(LAS unsigned char* lds, const int tid, int nM, int nN, int G, int c, bool moe, const int* row_tok, const int dup = 1) {
    LAS int* UT = (LAS int*)(lds + UT_OFF); LAS const int* TS = (LAS const int*)(lds + TS_OFF); LAS int* TOK = (LAS int*)(lds + TOK_OFF);
    const int nwg = nM * nN;
    int n_my = (nwg > c) ? (nwg - c + G - 1) / G : 0; if (n_my > MAXU) n_my = MAXU;
    if (tid < n_my) {
        int pm, pn; unit_of(tid * G + c, nM, nN, pm, pn);
        int e = 0; if (moe) { while (e < NE - 1 && TS[e + 1] <= pm) ++e; }
        UT[4 * tid + 0] = pm; UT[4 * tid + 1] = pn; UT[4 * tid + 2] = e; UT[4 * tid + 3] = 0;
    }
    __syncthreads();
    if (row_tok) {
        for (int idx = tid; idx < n_my * 256; idx += NTHR) { const int i = idx >> 8, r = idx & 255; TOK[idx] = gld<int>(row_tok + UT[4 * i] * 256 + r); }
    }
    __syncthreads();
    if (dup > 1) { if (tid < n_my) { UT[4 * (tid + n_my) + 0] = UT[4 * tid]; UT[4 * (tid + n_my) + 1] = UT[4 * tid + 1]; UT[4 * (tid + n_my) + 2] = UT[4 * tid + 2]; UT[4 * (tid + n_my) + 3] = 0; } __syncthreads(); return 2 * n_my; }
    return n_my;
}
__device__ __forceinline__ Unit read_unit(LAS const int* UT, int i) {
    Unit u; u.pm = __builtin_amdgcn_readfirstlane(UT[4 * i]); u.pn = __builtin_amdgcn_readfirstlane(UT[4 * i + 1]); u.e = __builtin_amdgcn_readfirstlane(UT[4 * i + 2]); return u;
}
template <bool GATHER>
__device__ __forceinline__ void a_offsets(unsigned (&v)[2][2], const GemmP& g, const Unit& u, int ui, const int (&Rr)[2], const int (&Cc2)[2], LAS const int* TOK, const int tokn) {
#pragma unroll
    for (int h = 0; h < 2; ++h)
#pragma unroll
        for (int i = 0; i < 2; ++i) {
            const int row = GATHER ? TOK[(ui >= tokn ? ui - tokn : ui) * 256 + h * HALF + Rr[i]] : (u.pm * BM + h * HALF + Rr[i]);
            v[h][i] = (unsigned)row * g.lda2 + (unsigned)Cc2[i] + (unsigned)u.pn * g.acol_pn;
        }
}

template <bool GATHER, bool FP8, class Epi>
__device__ __forceinline__ void gemm_phase(LAS unsigned char* lds, const int tid, const GemmP g, const int n_my, const Epi& E, const int tokn = 1 << 20) {
    const int wid = __builtin_amdgcn_readfirstlane(tid >> 6), lane = tid & 63, wr = wid >> 2, wc = wid & 3, fr = lane & 15, fq = lane >> 4;
    const int Kb = g.Kb, nt = Kb / (BK * 2);
    if (n_my <= 0) return;
    int Rr[2], Cc2[2]; unsigned voffB[2];
#pragma unroll
    for (int i = 0; i < 2; ++i) { int R, C; stage_rc(tid * 16 + i * 8192, R, C); const int Rb = Epi::PERM ? ((R & ~31) + perm32(R & 31)) : R;
        Rr[i] = R; Cc2[i] = C * 2; voffB[i] = (unsigned)(Rb * Kb + C * 2); }
    const size_t kstep = (size_t)(BK * 2);
    const size_t hstep = (size_t)HALF * Kb;
    const size_t tstepB = 2 * hstep;
    const unsigned ldsw = (unsigned)wid * 1024u;
    const int aoff = lds_byte(wr * 64 + fr, fq * 8), boff = lds_byte(wc * 32 + fr, fq * 8);
    LAS const int* UT = (LAS const int*)(lds + UT_OFF); LAS const int* TOK = (LAS const int*)(lds + TOK_OFF);
#define PG8_SA(b, h) (((b) * 2 + (h)) * HTB)
#define PG8_SB(b, h) ((4 + (b) * 2 + (h)) * HTB)
#define PG8_STAGE(bufoff, gbase, voff) do { _Pragma("unroll") for (int _i = 0; _i < 2; ++_i) \
        __builtin_amdgcn_global_load_lds((const unsigned*)((const char*)(gbase) + (voff)[_i]), (LAS unsigned*)(lds + (bufoff) + ldsw + _i * 8192), 16, 0, 0); } while (0)
#define PG8_LDA(dst, b, h) do { _Pragma("unroll") for (int m = 0; m < 4; ++m) _Pragma("unroll") for (int k = 0; k < 2; ++k) dst[m][k] = *(const LAS bf16x8*)(lds + PG8_SA(b, h) + aoff + m * 2048 + k * 1024); } while (0)
#define PG8_LDB(dst, b, h) do { _Pragma("unroll") for (int n = 0; n < 2; ++n) _Pragma("unroll") for (int k = 0; k < 2; ++k) dst[n][k] = *(const LAS bf16x8*)(lds + PG8_SB(b, h) + boff + n * 2048 + k * 1024); } while (0)
#define PG8_CAT(x) __builtin_shufflevector(__builtin_bit_cast(v4i, (x)[0]), __builtin_bit_cast(v4i, (x)[1]), 0, 1, 2, 3, 4, 5, 6, 7)
#define PG8_MMA(ai, bj, At, Bt) do { __builtin_amdgcn_s_setprio(1); _Pragma("unroll") for (int m = 0; m < 4; ++m) _Pragma("unroll") for (int n = 0; n < 2; ++n) { \
        if constexpr (FP8) { const v8i b8_ = PG8_CAT(Bt[n]), a8_ = PG8_CAT(At[m]); asm volatile("v_mfma_scale_f32_16x16x128_f8f6f4 %0, %1, %2, %0, %3, %4 op_sel_hi:[0,0,0]" : "+v"(acc[ai][bj][m][n]) : "v"(b8_), "v"(a8_), "v"(vsB), "v"(vsA)); } \
        else { _Pragma("unroll") for (int k = 0; k < 2; ++k) acc[ai][bj][m][n] = __builtin_amdgcn_mfma_f32_16x16x32_bf16(Bt[n][k], At[m][k], acc[ai][bj][m][n], 0, 0, 0); } } \
        __builtin_amdgcn_s_setprio(0); } while (0)
#define PG8_WAIT_V(n) asm volatile("s_waitcnt vmcnt(" #n ")" ::: "memory")
#define PG8_WAIT_L(n) asm volatile("s_waitcnt lgkmcnt(" #n ")" ::: "memory")
#define PG8_BAR __builtin_amdgcn_s_barrier()
#define PG8_SCHED __builtin_amdgcn_sched_barrier(0)
    Unit cur = read_unit(UT, 0), nxt; int ui = 0;
    f32x4 acc[2][2][4][2];
#pragma unroll
    for (int a = 0; a < 2; ++a)
#pragma unroll
        for (int b = 0; b < 2; ++b)
#pragma unroll
            for (int m = 0; m < 4; ++m)
#pragma unroll
                for (int n = 0; n < 2; ++n) acc[a][b][m][n] = (f32x4){0.f, 0.f, 0.f, 0.f};
#define PG8_PIN_ACC() do { if constexpr (FP8) { _Pragma("unroll") for (int a_ = 0; a_ < 2; ++a_) _Pragma("unroll") for (int b_ = 0; b_ < 2; ++b_) \
        asm volatile("" : "+v"(acc[a_][b_][0][0]), "+v"(acc[a_][b_][0][1]), "+v"(acc[a_][b_][1][0]), "+v"(acc[a_][b_][1][1]), "+v"(acc[a_][b_][2][0]), "+v"(acc[a_][b_][2][1]), "+v"(acc[a_][b_][3][0]), "+v"(acc[a_][b_][3][1])); \
        asm volatile("s_nop 1" ::: "memory"); } } while (0)
    PG8_PIN_ACC();
    bf16x8 At[4][2], B0[2][2], B1[2][2];
    int vsA = g.sA, vsB = g.sB; asm volatile("" : "+v"(vsA), "+v"(vsB));
    unsigned vAc[2][2], vAn[2][2];
    a_offsets<GATHER>(vAc, g, cur, 0, Rr, Cc2, TOK, tokn);
    const char* const Ab = g.A;
    const char* cB = g.Bt + (size_t)cur.e * g.b_estride + (size_t)cur.pn * tstepB;
    PG8_STAGE(PG8_SB(0, 0), cB, voffB); PG8_STAGE(PG8_SB(0, 1), cB + hstep, voffB); PG8_STAGE(PG8_SA(0, 0), Ab, vAc[0]); PG8_STAGE(PG8_SA(0, 1), Ab, vAc[1]);
    if (wr == 1) PG8_BAR;
    PG8_WAIT_V(2); PG8_BAR;
    PG8_STAGE(PG8_SB(1, 0), cB + kstep, voffB); PG8_STAGE(PG8_SA(1, 0), Ab + kstep, vAc[0]); PG8_STAGE(PG8_SB(1, 1), cB + hstep + kstep, voffB);
    PG8_WAIT_V(6); PG8_BAR;
    for (;;) {
        const bool has_next = (ui + 1 < n_my);
        nxt = cur; if (has_next) nxt = read_unit(UT, ui + 1);
        const char* nB = has_next ? g.Bt + (size_t)nxt.e * g.b_estride + (size_t)nxt.pn * tstepB : cB;
        for (int t = 0; t < nt; t += 2) {
            const bool last = (t == nt - 2);
            if (t == 0) E.prefetch(lds + EPI_OFF + (ui & 1) * 4096, cur, wid, lane);
            const char* a1 = Ab + (size_t)(t + 1) * kstep;
            const char* a2 = last ? Ab : Ab + (size_t)(t + 2) * kstep; const char* b2 = last ? nB : cB + (size_t)(t + 2) * kstep;
            const char* a3 = a2 + kstep; const char* b3 = b2 + kstep;
            unsigned o2[2][2];
            if (last) {
                if (has_next) a_offsets<GATHER>(vAn, g, nxt, ui + 1, Rr, Cc2, TOK, tokn);
                else { vAn[0][0] = vAc[0][0]; vAn[0][1] = vAc[0][1]; vAn[1][0] = vAc[1][0]; vAn[1][1] = vAc[1][1]; }
                o2[0][0] = vAn[0][0]; o2[0][1] = vAn[0][1]; o2[1][0] = vAn[1][0]; o2[1][1] = vAn[1][1];
            } else { o2[0][0] = vAc[0][0]; o2[0][1] = vAc[0][1]; o2[1][0] = vAc[1][0]; o2[1][1] = vAc[1][1]; }
            PG8_LDB(B0, 0, 0); PG8_LDB(B1, 0, 1); PG8_SCHED; PG8_LDA(At, 0, 0); PG8_STAGE(PG8_SA(1, 1), a1, vAc[1]);
            PG8_WAIT_V(8); PG8_WAIT_L(0); PG8_BAR; PG8_MMA(0, 0, At, B0); PG8_MMA(0, 1, At, B1); PG8_BAR; PG8_SCHED;
            PG8_LDA(At, 0, 1); PG8_STAGE(PG8_SB(0, 0), b2, voffB); PG8_STAGE(PG8_SB(0, 1), b2 + hstep, voffB); PG8_STAGE(PG8_SA(0, 0), a2, o2[0]);
            PG8_WAIT_V(8); PG8_WAIT_L(0); PG8_BAR; PG8_MMA(1, 0, At, B0); PG8_MMA(1, 1, At, B1); PG8_BAR; PG8_SCHED;
            PG8_LDB(B0, 1, 0); PG8_LDB(B1, 1, 1); PG8_SCHED; PG8_LDA(At, 1, 0); PG8_STAGE(PG8_SA(0, 1), a2, o2[1]);
            PG8_WAIT_V(8); PG8_WAIT_L(0); PG8_BAR; PG8_MMA(0, 0, At, B0); PG8_MMA(0, 1, At, B1); PG8_BAR; PG8_SCHED;
            PG8_LDA(At, 1, 1); PG8_STAGE(PG8_SB(1, 0), b3, voffB); PG8_STAGE(PG8_SB(1, 1), b3 + hstep, voffB); PG8_STAGE(PG8_SA(1, 0), a3, o2[0]);
            PG8_WAIT_V(8); PG8_WAIT_L(0); PG8_BAR; PG8_MMA(1, 0, At, B0); PG8_MMA(1, 1, At, B1); PG8_BAR; PG8_SCHED;
        }
        if (wr == 0) PG8_BAR;
        if constexpr (FP8) asm volatile("s_nop 15" ::: "memory");
        for (int re_ = 0; re_ < Epi::REPS; ++re_) E(acc, cur, wr, wc, fr, fq, lds + EPI_OFF + (ui & 1) * 4096);
        if (!has_next) break;
#pragma unroll
        for (int a = 0; a < 2; ++a)
#pragma unroll
            for (int b = 0; b < 2; ++b)
#pragma unroll
                for (int m = 0; m < 4; ++m)
#pragma unroll
                    for (int n = 0; n < 2; ++n) acc[a][b][m][n] = (f32x4){0.f, 0.f, 0.f, 0.f};
        PG8_PIN_ACC();
        cur = nxt; cB = nB; ++ui;
        vAc[0][0] = vAn[0][0]; vAc[0][1] = vAn[0][1]; vAc[1][0] = vAn[1][0]; vAc[1][1] = vAn[1][1];
        if (wr == 1) PG8_BAR;
    }
    PG8_WAIT_V(0);
    PG8_BAR;
#undef PG8_SA
#undef PG8_SB
#undef PG8_STAGE
#undef PG8_LDA
#undef PG8_LDB
#undef PG8_MMA
#undef PG8_PIN_ACC
#undef PG8_CAT
#undef PG8_WAIT_V
#undef PG8_WAIT_L
#undef PG8_BAR
#undef PG8_SCHED
}

struct EpiOut {
    static constexpr bool PERM = true; static constexpr int REPS = 1;
    const bf16* xres; bf16* z; const float* bias; const float* scale;
    __device__ __forceinline__ void prefetch(LAS unsigned char*, const Unit&, int, int) const {}
    __device__ __forceinline__ void operator()(const f32x4 (&acc)[2][2][4][2], const Unit& u, int wr, int wc, int fr, int fq, const LAS unsigned char*) const {
        const int row0 = u.pm * BM + wr * 64 + fr, c0 = u.pn * BM + wc * 32 + 8 * fq;
        f32x4 bv[2][2], sv[2][2];
#pragma unroll
        for (int bj = 0; bj < 2; ++bj)
#pragma unroll
            for (int n = 0; n < 2; ++n) {
                bv[bj][n] = bias ? gld<f32x4>(bias + c0 + bj * HALF + 4 * n) : (f32x4){0.f, 0.f, 0.f, 0.f};
                sv[bj][n] = scale ? gld<f32x4>(scale + c0 + bj * HALF + 4 * n) : (f32x4){1.f, 1.f, 1.f, 1.f};
            }
#pragma unroll
        for (int ai = 0; ai < 2; ++ai)
#pragma unroll
            for (int m = 0; m < 4; ++m) { const size_t off = (size_t)(row0 + ai * HALF + m * 16) * D + c0;
#pragma unroll
                for (int bj = 0; bj < 2; ++bj) { const v4u xr = gld<v4u>(xres + off + bj * HALF);
                    const f32x4 x0 = (f32x4){bf_lo(xr.x), bf_hi(xr.x), bf_lo(xr.y), bf_hi(xr.y)}, x1 = (f32x4){bf_lo(xr.z), bf_hi(xr.z), bf_lo(xr.w), bf_hi(xr.w)};
                    const f32x4 o0 = x0 * ALPHA + (acc[ai][bj][m][0] + bv[bj][0]) * sv[bj][0], o1 = x1 * ALPHA + (acc[ai][bj][m][1] + bv[bj][1]) * sv[bj][1];
                    v4u w; w.x = cvt_pk_bf16(o0[0], o0[1]); w.y = cvt_pk_bf16(o0[2], o0[3]); w.z = cvt_pk_bf16(o1[0], o1[1]); w.w = cvt_pk_bf16(o1[2], o1[3]);
                    gst<v4u>(z + off + bj * HALF, w); }
                asm volatile("" ::: "memory"); }
    }
};
struct EpiPair {
    static constexpr bool PERM = true; static constexpr int REPS = 1;
    bf16* O1; bf16* O2; const float* bias; int mode;
    __device__ __forceinline__ void prefetch(LAS unsigned char*, const Unit&, int, int) const {}
    __device__ __forceinline__ void operator()(const f32x4 (&acc)[2][2][4][2], const Unit& u, int wr, int wc, int fr, int fq, const LAS unsigned char*) const {
        const int row0 = u.pm * BM + wr * 64 + fr;
        if (u.pn < 8) {
            const int j0 = u.pn * HALF + wc * 32 + 8 * fq;
            f32x4 b1[2], b2[2];
#pragma unroll
            for (int n = 0; n < 2; ++n) { b1[n] = mode ? gld<f32x4>(bias + j0 + 4 * n) : (f32x4){0.f, 0.f, 0.f, 0.f}; b2[n] = mode ? gld<f32x4>(bias + 1024 + j0 + 4 * n) : (f32x4){0.f, 0.f, 0.f, 0.f}; }
#pragma unroll
            for (int ai = 0; ai < 2; ++ai)
#pragma unroll
                for (int m = 0; m < 4; ++m) { bf16* rowp = O1 + (size_t)(row0 + ai * HALF + m * 16) * D + j0; f32x4 r[2];
#pragma unroll
                    for (int n = 0; n < 2; ++n) { const f32x4 g1 = acc[ai][0][m][n] + b1[n], g2 = acc[ai][1][m][n] + b2[n];
                        if (mode) { r[n][0] = g1[0] * sigmoidf_(g2[0]); r[n][1] = g1[1] * sigmoidf_(g2[1]); r[n][2] = g1[2] * sigmoidf_(g2[2]); r[n][3] = g1[3] * sigmoidf_(g2[3]); }
                        else r[n] = g1 * g2; }
                    v4u w; w.x = cvt_pk_bf16(r[0][0], r[0][1]); w.y = cvt_pk_bf16(r[0][2], r[0][3]); w.z = cvt_pk_bf16(r[1][0], r[1][1]); w.w = cvt_pk_bf16(r[1][2], r[1][3]);
                    gst<v4u>(rowp, w); }
        } else {
            const int c0 = (u.pn - 8) * BM + wc * 32 + 8 * fq;
#pragma unroll
            for (int ai = 0; ai < 2; ++ai)
#pragma unroll
                for (int m = 0; m < 4; ++m) { bf16* rowp = O2 + (size_t)(row0 + ai * HALF + m * 16) * D + c0;
#pragma unroll
                    for (int bj = 0; bj < 2; ++bj) { const f32x4 v0 = acc[ai][bj][m][0], v1 = acc[ai][bj][m][1];
                        v4u w; w.x = cvt_pk_bf16(v0[0], v0[1]); w.y = cvt_pk_bf16(v0[2], v0[3]); w.z = cvt_pk_bf16(v1[0], v1[1]); w.w = cvt_pk_bf16(v1[2], v1[3]);
                        gst<v4u>(rowp + bj * HALF, w); } }
        }
    }
};
struct EpiSwiglu {
    static constexpr bool PERM = true; static constexpr int REPS = REP_EPI1;
    unsigned char* act; const float* bgu;
    __device__ __forceinline__ void prefetch(LAS unsigned char* slot, const Unit& u, int wid, int lane) const {
        if (wid == 0) __builtin_amdgcn_global_load_lds((const unsigned*)(bgu + (size_t)u.e * 2048 + 2 * u.pn * HALF + 4 * lane), (LAS unsigned*)slot, 16, 0, 0);
    }
    __device__ __forceinline__ void operator()(const f32x4 (&acc)[2][2][4][2], const Unit& u, int wr, int wc, int fr, int fq, const LAS unsigned char* slot) const {
        const int row0 = u.pm * BM + wr * 64 + fr, j0 = u.pn * HALF + wc * 32 + 8 * fq;
        const LAS float* bp = (const LAS float*)slot + 2 * (wc * 32 + 8 * fq);
        f32x2 gb[4], ub[4];
#pragma unroll
        for (int i = 0; i < 4; ++i) { const f32x4 b = *(const LAS f32x4*)(bp + 4 * i); gb[i] = (f32x2){b[0], b[2]}; ub[i] = (f32x2){b[1], b[3]}; }
        const f32x2 one = {1.0f, 1.0f}, k4 = {SACT8, SACT8}, kc = {-1.702f * 1.4426950408889634f, -1.702f * 1.4426950408889634f};
#pragma unroll
        for (int ai = 0; ai < 2; ++ai)
#pragma unroll
            for (int m = 0; m < 4; ++m) { unsigned char* rowp = act + (size_t)(row0 + ai * HALF + m * 16) * D + j0; float r[8];
#pragma unroll
                for (int p = 0; p < 4; ++p) { const int n = p >> 1, q = 2 * (p & 1);
                    f32x2 g = (f32x2){acc[ai][0][m][n][q], acc[ai][0][m][n][q + 1]} + gb[p];
                    f32x2 uu = (f32x2){acc[ai][1][m][n][q], acc[ai][1][m][n][q + 1]} + ub[p];
                    g[0] = fminf(g[0], 7.0f); g[1] = fminf(g[1], 7.0f);
                    uu[0] = __builtin_amdgcn_fmed3f(uu[0], -7.0f, 7.0f); uu[1] = __builtin_amdgcn_fmed3f(uu[1], -7.0f, 7.0f);
                    f32x2 t = g * kc; t[0] = __builtin_amdgcn_exp2f(t[0]); t[1] = __builtin_amdgcn_exp2f(t[1]);
                    f32x2 d = t + one; d[0] = __builtin_amdgcn_rcpf(d[0]); d[1] = __builtin_amdgcn_rcpf(d[1]);
                    const f32x2 g4 = g * k4;
                    const f32x2 o = __builtin_elementwise_fma(uu, g4, g4) * d;
                    r[2 * p] = o[0]; r[2 * p + 1] = o[1]; }
                gst<v2u>(rowp, pack8_fp8(r)); }
    }
};
struct EpiMoe2 {
    static constexpr bool PERM = true; static constexpr int REPS = REP_EPI2;
    unsigned char* Y; const float* bdn; const int* rowdst; const float* rowgate;
    __device__ __forceinline__ void prefetch(LAS unsigned char* slot, const Unit& u, int wid, int lane) const {
        if (wid == 0) __builtin_amdgcn_global_load_lds((const unsigned*)(bdn + (size_t)u.e * D + u.pn * BM + 4 * lane), (LAS unsigned*)slot, 16, 0, 0);
        else if (wid == 1) __builtin_amdgcn_global_load_lds((const unsigned*)(rowdst + u.pm * BM + 4 * lane), (LAS unsigned*)(slot + 1024), 16, 0, 0);
        else if (wid == 2) __builtin_amdgcn_global_load_lds((const unsigned*)(rowgate + u.pm * BM + 4 * lane), (LAS unsigned*)(slot + 2048), 16, 0, 0);
    }
    __device__ __forceinline__ void operator()(const f32x4 (&acc)[2][2][4][2], const Unit& u, int wr, int wc, int fr, int fq, const LAS unsigned char* slot) const {
        const int pos0 = wr * 64 + fr, c0 = u.pn * BM + wc * 32 + 8 * fq;
        const LAS float* bp = (const LAS float*)slot + wc * 32 + 8 * fq;
        f32x4 bv[2][2];
#pragma unroll
        for (int bj = 0; bj < 2; ++bj)
#pragma unroll
            for (int n = 0; n < 2; ++n) bv[bj][n] = *(const LAS f32x4*)(bp + bj * HALF + 4 * n);
        int dst[2][4]; float gt[2][4];
#pragma unroll
        for (int ai = 0; ai < 2; ++ai)
#pragma unroll
            for (int m = 0; m < 4; ++m) { const int pos = pos0 + ai * HALF + m * 16; dst[ai][m] = *((const LAS int*)(slot + 1024) + pos); gt[ai][m] = *((const LAS float*)(slot + 2048) + pos) * SY8; }
#pragma unroll
        for (int ai = 0; ai < 2; ++ai)
#pragma unroll
            for (int m = 0; m < 4; ++m) {
                if (dst[ai][m] >= 0) { unsigned char* rowp = Y + (size_t)dst[ai][m] * D + c0; const float s = gt[ai][m];
#pragma unroll
                    for (int bj = 0; bj < 2; ++bj) { const f32x4 v0 = (acc[ai][bj][m][0] + bv[bj][0]) * s, v1 = (acc[ai][bj][m][1] + bv[bj][1]) * s;
                        const float r[8] = {v0[0], v0[1], v0[2], v0[3], v1[0], v1[1], v1[2], v1[3]};
                        gst<v2u>(rowp + bj * HALF, pack8_fp8(r)); } } }
    }
};
}

__device__ __forceinline__ int chq(int lane, int q) { return (q >> 1) * 512 + 8 * lane + (q & 1) * 4; }
__device__ __forceinline__ v4u pack8(const float* v) { v4u w; w.x = cvt_pk_bf16(v[0], v[1]); w.y = cvt_pk_bf16(v[2], v[3]); w.z = cvt_pk_bf16(v[4], v[5]); w.w = cvt_pk_bf16(v[6], v[7]); return w; }
__device__ __forceinline__ void unpack8(const v4u w, float* v) { v[0] = bf_lo(w.x); v[1] = bf_hi(w.x); v[2] = bf_lo(w.y); v[3] = bf_hi(w.y); v[4] = bf_lo(w.z); v[5] = bf_hi(w.z); v[6] = bf_lo(w.w); v[7] = bf_hi(w.w); }

__device__ __forceinline__ int drow_of(int mode, int c) {
    if (mode == 1) { const int j = c >> 1, p = c & 1; return (j >> 7) * 256 + p * 128 + (j & 127); }
    if (mode == 2) { if (c < 1024) return 2048 + c; const int j = (c - 1024) & 1023, p = (c - 1024) >> 10; return (j >> 7) * 256 + p * 128 + (j & 127); }
    if (mode == 3) { const int j = c & 1023, p = c >> 10; return (j >> 7) * 256 + p * 128 + (j & 127); }
    return c;
}
struct TItem { const float* src; unsigned char* dst; int N, Kout  , k0, n0, mode, fp8; };
__device__ __forceinline__ void titem_load(const TItem& d, int lane, float (&tmp)[32]) {
#pragma unroll
    for (int i = 0; i < 32; ++i) { const int kk = 2 * i + (lane >> 5); tmp[i] = gld<float>(d.src + (size_t)(d.k0 + kk) * d.N + d.n0 + (lane & 31)); }
}
__device__ __forceinline__ void titem_store(const TItem& d, int lane, LAS float* scr, const float (&tmp)[32]) {
#pragma unroll
    for (int i = 0; i < 32; ++i) { const int kk = 2 * i + (lane >> 5); scr[kk * 33 + (lane & 31)] = tmp[i]; }
    LDS_WAIT(); asm volatile("" ::: "memory");
    const int c = lane & 7;
#pragma unroll
    for (int j = 0; j < 4; ++j) { const int n = (lane >> 3) + 8 * j; const LAS float* s = scr + (8 * c) * 33 + n;
        float v[8];
#pragma unroll
        for (int i = 0; i < 8; ++i) v[i] = s[i * 33];
        const size_t e = (size_t)drow_of(d.mode, d.n0 + n) * d.Kout + d.k0 + 8 * c;
        if (d.fp8) {
#pragma unroll
            for (int i = 0; i < 8; ++i) v[i] *= SW8;
            gst<v2u>(d.dst + e, pack8_fp8(v));
        } else gst<v4u>(d.dst + 2 * e, pack8(v)); }
    LDS_WAIT(); asm volatile("" ::: "memory");
}

struct Args { const float* in[24]; float* out; unsigned char* ws; };
#define CAS __attribute__((address_space(4)))
__device__ __forceinline__ const void* karg_ptr(int off) {
    const CAS char* kp = (const CAS char*)__builtin_amdgcn_kernarg_segment_ptr();
    asm volatile("" : "+s"(off));
    return *(const void* const CAS*)(kp + off);
}
#define ARG_IN(i) ((const float*)karg_ptr(8 * (i)))
#define ARG_OUT() ((float*)karg_ptr(8 * 24))
#define ARG_WS() ((unsigned char*)karg_ptr(8 * 25))

#define PHASE_BEGIN() \
    int tid = threadIdx.x; asm volatile("" : "+v"(tid)); \
    const int lane = tid & 63, wave = __builtin_amdgcn_readfirstlane(tid >> 6); \
    unsigned char* ws_ = ARG_WS(); asm volatile("" : "+s"(ws_)); unsigned char* ws = (unsigned char*)(GAS unsigned char*)ws_; \
    unsigned* ctl = (unsigned*)(ws + WS_CTL); \
    const int gw = vcu * NWAVES + wave, NGW = G * NWAVES; (void)gw; (void)NGW; (void)lane; (void)ctl;

__device__ __forceinline__ float butterfly32(float (&p)[32], int lane) {
#pragma unroll
    for (int i = 0; i < 16; ++i) { const auto r = __builtin_amdgcn_permlane32_swap(__float_as_uint(p[i]), __float_as_uint(p[i + 16]), false, false); p[i] = __uint_as_float(r[0]) + __uint_as_float(r[1]); }
#pragma unroll
    for (int i = 0; i < 8; ++i) { const auto r = __builtin_amdgcn_permlane16_swap(__float_as_uint(p[i]), __float_as_uint(p[i + 8]), false, false); p[i] = __uint_as_float(r[0]) + __uint_as_float(r[1]); }
#pragma unroll
    for (int i = 0; i < 4; ++i) { const bool hi = (lane & 8) != 0; const float snd = hi ? p[i] : p[i + 4]; const float keep = hi ? p[i + 4] : p[i]; p[i] = keep + DPP_F(snd, DPP_ROR8); }
#pragma unroll
    for (int i = 0; i < 2; ++i) { const bool hi = (lane & 4) != 0; const float snd = hi ? p[i] : p[i + 2]; const float keep = hi ? p[i + 2] : p[i]; const float x = DPP_F(snd, DPP_HMIR); p[i] = keep + DPP_F(x, DPP_QREV); }
    { const bool hi = (lane & 2) != 0; const float snd = hi ? p[0] : p[1]; const float keep = hi ? p[1] : p[0]; p[0] = keep + DPP_F(snd, DPP_XOR2); }
    return p[0] + DPP_F(p[0], DPP_XOR1);
}
__device__ __forceinline__ void ln16(float (&v)[16], const float (&lg)[16], const float (&lb)[16], int lane) {
    float sm = 0.f;
#pragma unroll
    for (int i = 0; i < 16; ++i) sm += v[i];
    const float mean = wave_sum(sm, lane) * (1.0f / D);
    float sq = 0.f;
#pragma unroll
    for (int i = 0; i < 16; ++i) { v[i] -= mean; sq += v[i] * v[i]; }
    const float rstd = 1.0f / sqrtf(wave_sum(sq, lane) * (1.0f / D) + LN_EPS);
#pragma unroll
    for (int i = 0; i < 16; ++i) v[i] = v[i] * rstd * lg[i] + lb[i];
}
__device__ __forceinline__ void route_token(const float logit, const int myexp, const int lane, const int t, int* TIDX, float* TGATE, LAS unsigned* hist, const bool count) {
    int rank = 0;
#pragma unroll
    for (int e = 0; e < 32; ++e) rank += (rdlane(logit, 2 * e) > logit) ? 1 : 0;
    unsigned long long mk[4]; bool clean = true;
#pragma unroll
    for (int r = 0; r < 4; ++r) { mk[r] = __ballot(rank == r); clean = clean && (__builtin_popcountll(mk[r]) == 2); }
    if (!clean) {
        rank = 0;
#pragma unroll
        for (int e = 0; e < 32; ++e) { const float se = rdlane(logit, 2 * e); rank += (se > logit || (se == logit && e < myexp)) ? 1 : 0; }
#pragma unroll
        for (int r = 0; r < 4; ++r) mk[r] = __ballot(rank == r);
    }
    float tv[4]; int tix[4];
#pragma unroll
    for (int r = 0; r < 4; ++r) { const int src = (int)__builtin_ctzll(mk[r] | (1ull << 63)); tv[r] = rdlane(logit, src); tix[r] = src >> 1; }
    const float e1 = __expf(tv[1] - tv[0]), e2 = __expf(tv[2] - tv[0]), e3 = __expf(tv[3] - tv[0]);
    const float inv = 1.0f / (1.0f + e1 + e2 + e3);
    if (lane < 4) {
        const int ix = lane == 0 ? tix[0] : lane == 1 ? tix[1] : lane == 2 ? tix[2] : tix[3];
        const float gv = (lane == 0 ? 1.0f : lane == 1 ? e1 : lane == 2 ? e2 : e3) * inv;
        gst<int>(TIDX + t * 4 + lane, ix); gst<float>(TGATE + t * 4 + lane, gv);
        if (count) __hip_atomic_fetch_add(hist + ix, 1u, __ATOMIC_RELAXED, __HIP_MEMORY_SCOPE_WORKGROUP);
    }
}
__device__ __forceinline__ void ln16_lds(float (&v)[16], const LAS f32x4* lnp, int lane) {
    float sm = 0.f;
#pragma unroll
    for (int i = 0; i < 16; ++i) sm += v[i];
    const float mean = wave_sum(sm, lane) * (1.0f / D);
    float sq = 0.f;
#pragma unroll
    for (int i = 0; i < 16; ++i) { v[i] -= mean; sq += v[i] * v[i]; }
    const float rstd = 1.0f / sqrtf(wave_sum(sq, lane) * (1.0f / D) + LN_EPS);
#pragma unroll
    for (int q = 0; q < 4; ++q) { const f32x4 g4 = lnp[q * 64 + lane], b4 = lnp[(4 + q) * 64 + lane];
#pragma unroll
        for (int i = 0; i < 4; ++i) v[4 * q + i] = v[4 * q + i] * rstd * g4[i] + b4[i]; }
}
template <bool F32IN>
__device__ __forceinline__ void pool_diff_run(const float* xf, const bf16* xb, bf16* M3, int t0, int lane) {
    const int s0 = t0 & (SEQ - 1);
#pragma unroll
    for (int g = 0; g < 4; ++g) {
        const int w = 2 << g, c = 256 * g + 4 * lane;
        f32x4 r[31];
#pragma unroll
        for (int j = 0; j < w + 15; ++j) {
            const int dt = j - (w - 1);
            if (dt >= 0 || s0 != 0) {
                const size_t o = (size_t)(t0 + dt) * D + c;
                if (F32IN) r[j] = gld<f32x4>(xf + o);
                else { const v2u q = gld<v2u>(xb + o); r[j] = (f32x4){bf_lo(q.x), bf_hi(q.x), bf_lo(q.y), bf_hi(q.y)}; }
            } else r[j] = (f32x4){0.f, 0.f, 0.f, 0.f};
        }
#pragma unroll
        for (int i = 0; i < 16; ++i) {
            f32x4 sum = r[i];
#pragma unroll
            for (int j = 1; j < w; ++j) sum += r[i + j];
            const int nv = (s0 + i + 1 < w) ? s0 + i + 1 : w;
            const f32x4 df = sum * (1.0f / (float)nv) - r[i + w - 1];
            v2u o; o.x = cvt_pk_bf16(df[0], df[1]); o.y = cvt_pk_bf16(df[2], df[3]);
            gst<v2u>(M3 + (size_t)(t0 + i) * D + c, o);
        }
    }
}

__global__ void __launch_bounds__(NTHR, 2) mega_fwd(Args args) {
    extern __shared__ __attribute__((aligned(16))) unsigned char lds_raw[];
    LAS unsigned char* lds = (LAS unsigned char*)lds_raw;
    volatile LAS unsigned* MISC = (volatile LAS unsigned*)(lds + MISC_OFF);
    const int G = gridDim.x, bx = blockIdx.x;
    const int vcu = (G % 8 == 0) ? (bx % 8) * (G / 8) + bx / 8 : bx;
    if (threadIdx.x < 128) MISC[threadIdx.x] = 0u;
    __syncthreads();
    (void)xcd_barrier_post((unsigned*)(ARG_WS() + WS_CTL) + CW_BAR, MISC + 0);
#define GRID_BAR() do { XcdBarrier b_; unsigned* bp_ = (unsigned*)(ARG_WS() + WS_CTL) + CW_BAR; asm volatile("" : "+s"(bp_)); b_.bar = (unsigned*)(GAS unsigned*)bp_; b_.x = xb_xcc_id(); b_.st = MISC; for (int rb_ = 0; rb_ < REP_BAR; ++rb_) xcd_barrier(b_); } while (0)

    {
        PHASE_BEGIN();
        {
            constexpr int TPITCH = 129, TBUF = 128 * TPITCH;
            LAS float* tl = (LAS float*)(lds + RING_OFF);
            constexpr int NT_GU = 128 * 8 * 16, NT_DN = 128 * 8 * 8, NT = NT_GU + NT_DN;
            struct WTile { const float* src; unsigned char* dst; int N, nb, kb, mode; };
#define WT_DECODE(ti_, d_) do { int r_ = (ti_); if (r_ < NT_GU) { const int mt_ = r_ >> 7; r_ &= 127; (d_).kb = r_ >> 4; (d_).nb = r_ & 15; (d_).N = 2048; (d_).mode = 1; \
                (d_).src = ARG_IN(18) + (size_t)mt_ * 1024 * 2048; (d_).dst = ws + WS_WGU + (size_t)mt_ * 2048 * 1024; } \
            else { r_ -= NT_GU; const int mt_ = r_ >> 6; r_ &= 63; (d_).kb = r_ >> 3; (d_).nb = r_ & 7; (d_).N = 1024; (d_).mode = 0; \
                (d_).src = ARG_IN(20) + (size_t)mt_ * 1024 * 1024; (d_).dst = ws + WS_WDN + (size_t)mt_ * 1024 * 1024; } } while (0)
#define WT_LOAD(R_, d_) do { _Pragma("unroll") for (int i = 0; i < 16; ++i) R_[i] = gld<v2u>((d_).src + (size_t)((d_).kb * 128 + wave * 16 + i) * (d_).N + (d_).nb * 128 + 2 * lane); } while (0)
#define WT_TOLDS(R_, buf_) do { const int col_ = (2 * lane + 4 * wave) & 127; _Pragma("unroll") for (int i = 0; i < 16; ++i) { LAS float* p_ = tl + (buf_) * TBUF + (wave * 16 + i) * TPITCH + col_; \
                p_[0] = __uint_as_float(R_[i].x); p_[1] = __uint_as_float(R_[i].y); } } while (0)
#define WT_OUT(d_, buf_) do { const int kc_ = tid & 7; _Pragma("unroll") for (int p = 0; p < 2; ++p) { const int n_ = (tid >> 3) + 64 * p; const LAS float* s_ = tl + (buf_) * TBUF + (16 * kc_) * TPITCH + ((n_ + 4 * kc_) & 127); \
                float v_[16]; _Pragma("unroll") for (int i = 0; i < 16; ++i) v_[i] = s_[i * TPITCH] * SW8; \
                const v2u a_ = pack8_fp8(v_), b_ = pack8_fp8(v_ + 8); v4u o_; o_.x = a_.x; o_.y = a_.y; o_.z = b_.x; o_.w = b_.y; \
                gst<v4u>((d_).dst + (size_t)drow_of((d_).mode, (d_).nb * 128 + n_) * 1024 + (d_).kb * 128 + 16 * kc_, o_); } } while (0)
#define WT_BAR() do { LDS_WAIT(); __builtin_amdgcn_s_barrier(); asm volatile("" ::: "memory"); } while (0)
            for (int rep = 0; rep < REP_P0; ++rep) {
                v2u R0[16], R1[16]; WTile d0, d1, dn;
                int ti = vcu;
                d0.src = nullptr; d1.src = nullptr;
                if (ti < NT) { WT_DECODE(ti, d0); WT_LOAD(R0, d0); }
                if (ti + G < NT) { WT_DECODE(ti + G, d1); WT_LOAD(R1, d1); }
                for (; ti < NT; ti += 2 * G) {
                    WT_TOLDS(R0, 0);
                    const bool h2 = (ti + 2 * G < NT);
                    if (h2) { WT_DECODE(ti + 2 * G, dn); WT_LOAD(R0, dn); }
                    WT_BAR();
                    WT_OUT(d0, 0);
                    if (h2) d0 = dn;
                    if (ti + G < NT) {
                        WT_TOLDS(R1, 1);
                        const bool h3 = (ti + 3 * G < NT);
                        if (h3) { WT_DECODE(ti + 3 * G, dn); WT_LOAD(R1, dn); }
                        WT_BAR();
                        WT_OUT(d1, 1);
                        if (h3) d1 = dn;
                    }
                }
                WT_BAR();
            }
#undef WT_DECODE
#undef WT_LOAD
#undef WT_TOLDS
#undef WT_OUT
#undef WT_BAR
        }
        LAS float* scr = (LAS float*)(lds + RING_OFF + wave * 16384);
        constexpr int I_POOL = 4 * 8, I_SCIN = 16 * 96, I_SQ = 16 * 32, I_CFIN = 16 * 64;
        constexpr int N_POOL = 8 * I_POOL;
        constexpr int NITEMS = N_POOL + I_SCIN + I_SQ + I_CFIN + I_SQ;
#define TITEM_SET(d_, src_, K_, N_, dst_, mode_, fp8_, item_) do { const int nb_ = (N_) / 32; (d_).src = (src_); (d_).dst = (unsigned char*)(dst_); (d_).N = (N_); (d_).Kout = (K_); \
        (d_).k0 = 64 * ((item_) / nb_); (d_).n0 = 32 * ((item_) % nb_); (d_).mode = (mode_); (d_).fp8 = (fp8_); } while (0)
#define TITEM_DECODE(it_, d_) do { int r_ = (it_); \
        if (r_ < N_POOL) { const int mt_ = r_ / I_POOL; TITEM_SET(d_, ARG_IN(1) + (size_t)mt_ * 256 * 256, 256, 256, ws + WS_WPOOL + (size_t)mt_ * 256 * 256 * 2, 0, 0, r_ % I_POOL); break; } r_ -= N_POOL; \
        if (r_ < I_SCIN) { TITEM_SET(d_, ARG_IN(3), 1024, 3072, ws + WS_WSCIN, 2, 0, r_); break; } r_ -= I_SCIN; \
        if (r_ < I_SQ) { TITEM_SET(d_, ARG_IN(5), 1024, 1024, ws + WS_WSCOUT, 0, 0, r_); break; } r_ -= I_SQ; \
        if (r_ < I_CFIN) { TITEM_SET(d_, ARG_IN(6), 1024, 2048, ws + WS_WCFIN, 3, 0, r_); break; } r_ -= I_CFIN; \
        TITEM_SET(d_, ARG_IN(12), 1024, 1024, ws + WS_WCFOUT, 0, 0, r_); } while (0)
        for (int it = gw; it < NITEMS; it += NGW) { TItem cur; float ta[32]; TITEM_DECODE(it, cur); titem_load(cur, lane, ta); titem_store(cur, lane, scr, ta); }
#undef TITEM_SET
#undef TITEM_DECODE
        const float* x0 = ARG_IN(0); bf16* XAb = (bf16*)(ws + WS_XAB);
        for (int t = gw; t < T; t += NGW) {
            float v[16];
#pragma unroll
            for (int q = 0; q < 4; ++q) { const f32x4 z = gld<f32x4>(x0 + (size_t)t * D + chq(lane, q)); v[4 * q] = z[0]; v[4 * q + 1] = z[1]; v[4 * q + 2] = z[2]; v[4 * q + 3] = z[3]; }
            gst<v4u>(XAb + (size_t)t * D + 8 * lane, pack8(v));
            gst<v4u>(XAb + (size_t)t * D + 512 + 8 * lane, pack8(v + 8));
        }
    }
    GRID_BAR();

    for (int layer = 0; layer < DEPTH; ++layer) {
        const int kind = layer % 3;

        if (kind == 0) {
            PHASE_BEGIN();
            bf16* M3 = (bf16*)(ws + WS_M3); const bf16* xb = (const bf16*)(ws + WS_XAB);
            for (int rep = 0; rep < REP_THIN; ++rep)
            for (int tb = vcu; tb < T / 128; tb += G) {
                const int t0 = tb * 128 + wave * 16;
                if (layer == 0) pool_diff_run<true>(ARG_IN(0), xb, M3, t0, lane);
                else pool_diff_run<false>(ARG_IN(0), xb, M3, t0, lane);
            }
        } else {
            {
                PHASE_BEGIN();
                bf16* M1 = (bf16*)(ws + WS_M1); bf16* M2 = (bf16*)(ws + WS_M2);
                const int nN = (kind == 1) ? 12 : 8;
                const int n_my = pg8::build_units(lds, tid, T / 256, nN, G, bx, false, nullptr, REP_MIXG);
                pg8::GemmP gp; gp.A = (const char*)(ws + WS_XAB); gp.lda2 = D * 2; gp.acol_pn = 0; gp.Bt = (const char*)(ws + ((kind == 1) ? WS_WSCIN : WS_WCFIN)); gp.b_estride = 0; gp.Kb = 2048; gp.sA = 0; gp.sB = 0;
                pg8::EpiPair E; E.O1 = (kind == 1) ? M2 : M1; E.O2 = M1; E.bias = ARG_IN(7); E.mode = (kind == 1) ? 0 : 1;
                pg8::gemm_phase<false, false, pg8::EpiPair>(lds, tid, gp, n_my, E);
            }
            GRID_BAR();
            if (kind == 1) {
                PHASE_BEGIN();
                const bf16* M1 = (const bf16*)(ws + WS_M1); const bf16* M2 = (const bf16*)(ws + WS_M2); bf16* M3 = (bf16*)(ws + WS_M3);
                const float* cw = ARG_IN(4);
                float wk[3][16];
#pragma unroll
                for (int k = 0; k < 3; ++k)
#pragma unroll
                    for (int q = 0; q < 4; ++q) { const f32x4 v = gld<f32x4>(cw + k * D + chq(lane, q)); wk[k][4 * q] = v[0]; wk[k][4 * q + 1] = v[1]; wk[k][4 * q + 2] = v[2]; wk[k][4 * q + 3] = v[3]; }
                for (int rep = 0; rep < REP_THIN; ++rep)
                for (int tb = vcu; tb < T / 128; tb += G) {
                    const int t0 = tb * 128 + wave * 16, s0 = t0 & (SEQ - 1);
                    float p2[16], p1[16];
                    if (s0 != 0) { unpack8(gld<v4u>(M2 + (size_t)(t0 - 2) * D + 8 * lane), p2); unpack8(gld<v4u>(M2 + (size_t)(t0 - 2) * D + 512 + 8 * lane), p2 + 8);
                                   unpack8(gld<v4u>(M2 + (size_t)(t0 - 1) * D + 8 * lane), p1); unpack8(gld<v4u>(M2 + (size_t)(t0 - 1) * D + 512 + 8 * lane), p1 + 8); }
                    else {
#pragma unroll
                        for (int i = 0; i < 16; ++i) { p2[i] = 0.f; p1[i] = 0.f; } }
                    for (int i0 = 0; i0 < 16; i0 += 4) {
                        v4u cv[4][2], gv[4][2];
#pragma unroll
                        for (int u = 0; u < 4; ++u)
#pragma unroll
                            for (int j = 0; j < 2; ++j) { const size_t o = (size_t)(t0 + i0 + u) * D + j * 512 + 8 * lane; cv[u][j] = gld<v4u>(M2 + o); gv[u][j] = gld<v4u>(M1 + o); }
#pragma unroll
                        for (int u = 0; u < 4; ++u) {
                            float c[16], gb[16], o[16];
                            unpack8(cv[u][0], c); unpack8(cv[u][1], c + 8); unpack8(gv[u][0], gb); unpack8(gv[u][1], gb + 8);
#pragma unroll
                            for (int i = 0; i < 16; ++i) { o[i] = gb[i] * (wk[0][i] * p2[i] + wk[1][i] * p1[i] + wk[2][i] * c[i]); p2[i] = p1[i]; p1[i] = c[i]; }
                            gst<v4u>(M3 + (size_t)(t0 + i0 + u) * D + 8 * lane, pack8(o));
                            gst<v4u>(M3 + (size_t)(t0 + i0 + u) * D + 512 + 8 * lane, pack8(o + 8));
                        }
                    }
                }
            } else {
                PHASE_BEGIN();
                const bf16* U = (const bf16*)(ws + WS_M1); bf16* M3 = (bf16*)(ws + WS_M3);
                const int c = 128 * wave + 2 * lane;
                float wk0[31], wk1[31];
#pragma unroll
                for (int k = 0; k < 31; ++k) { const v2u q = gld<v2u>(ARG_IN(8) + k * D + c); wk0[k] = __uint_as_float(q.x); wk1[k] = __uint_as_float(q.y); }
                const v2u qb = gld<v2u>(ARG_IN(9) + c), qg = gld<v2u>(ARG_IN(10) + c), ql = gld<v2u>(ARG_IN(11) + c);
                const float db0 = __uint_as_float(qb.x), db1 = __uint_as_float(qb.y), lg0 = __uint_as_float(qg.x), lg1 = __uint_as_float(qg.y), lb0 = __uint_as_float(ql.x), lb1 = __uint_as_float(ql.y);
                LAS float* part = (LAS float*)(lds + RING_OFF);
                LAS float* stat = part + 256;
                for (int rep = 0; rep < REP_THIN; ++rep)
                for (int run = vcu; run < T / 16; run += G) {
                    const int t0 = run * 16, s0 = t0 & (SEQ - 1);
                    unsigned r[46];
#pragma unroll
                    for (int j = 0; j < 46; ++j) r[j] = (s0 + j - 30 >= 0) ? gld<unsigned>(U + (size_t)(t0 + j - 30) * D + c) : 0u;
                    float a0[16], a1[16];
#pragma unroll
                    for (int i = 0; i < 16; ++i) { a0[i] = db0; a1[i] = db1; }
#pragma unroll
                    for (int j = 0; j < 46; ++j) { const float x0 = bf_lo(r[j]), x1 = bf_hi(r[j]);
#pragma unroll
                        for (int i = 0; i < 16; ++i) { const int k = j - i; if (k >= 0 && k <= 30) { a0[i] += wk0[k] * x0; a1[i] += wk1[k] * x1; } } }
                    float st[32];
#pragma unroll
                    for (int i = 0; i < 16; ++i) { st[2 * i] = a0[i] + a1[i]; st[2 * i + 1] = a0[i] * a0[i] + a1[i] * a1[i]; }
                    const float tot = butterfly32(st, lane);
                    if ((lane & 1) == 0) part[wave * 32 + (lane >> 1)] = tot;
                    __syncthreads();
                    if (tid < 16) { float S = 0.f, Q = 0.f;
#pragma unroll
                        for (int w8 = 0; w8 < 8; ++w8) { S += part[w8 * 32 + 2 * tid]; Q += part[w8 * 32 + 2 * tid + 1]; }
                        const float mean = S * (1.0f / D); const float var = fmaxf(Q * (1.0f / D) - mean * mean, 0.f);
                        stat[2 * tid] = mean; stat[2 * tid + 1] = 1.0f / sqrtf(var + LN_EPS); }
                    __syncthreads();
#pragma unroll
                    for (int i = 0; i < 16; ++i) { const float mean = stat[2 * i], rstd = stat[2 * i + 1];
                        const float y0 = (a0[i] - mean) * rstd * lg0 + lb0, y1 = (a1[i] - mean) * rstd * lg1 + lb1;
                        gst<unsigned>(M3 + (size_t)(t0 + i) * D + c, cvt_pk_bf16(y0 * sigmoidf_(y0), y1 * sigmoidf_(y1))); }
                }
                __syncthreads();
            }
        }
        GRID_BAR();

        {
            PHASE_BEGIN();
            const int n_my = pg8::build_units(lds, tid, T / 256, 4, G, bx, false, nullptr, REP_MIXG);
            pg8::GemmP gp; gp.A = (const char*)(ws + WS_M3); gp.lda2 = D * 2; gp.b_estride = 0; gp.sA = 0; gp.sB = 0;
            pg8::EpiOut E; E.xres = (const bf16*)(ws + WS_XAB); E.z = (bf16*)(ws + WS_ZB); E.bias = nullptr; E.scale = nullptr;
            if (kind == 0) { gp.acol_pn = 512; gp.Bt = (const char*)(ws + WS_WPOOL + (size_t)(layer / 3) * 1024 * 256 * 2); gp.Kb = 512; E.scale = ARG_IN(2) + (layer / 3) * D; }
            else if (kind == 1) { gp.acol_pn = 0; gp.Bt = (const char*)(ws + WS_WSCOUT); gp.Kb = 2048; }
            else { gp.acol_pn = 0; gp.Bt = (const char*)(ws + WS_WCFOUT); gp.Kb = 2048; E.bias = ARG_IN(13); }
            pg8::gemm_phase<false, false, pg8::EpiOut>(lds, tid, gp, n_my, E);
        }
        GRID_BAR();

        {
            PHASE_BEGIN();
            const bf16* Zb = (const bf16*)(ws + WS_ZB); bf16* X1b = (bf16*)(ws + WS_X1B); unsigned char* X18 = (unsigned char*)(ws + WS_X18);
            int* TIDX = (int*)(ws + WS_IDX); float* TGATE = (float*)(ws + WS_GATE);
            unsigned* CNT = ctl + CW_CNT + layer * NE;
            LAS float* rwl = (LAS float*)(lds + RING_OFF);
            const float* rw = ARG_IN(16) + (size_t)layer * D * NE;
            for (int idx = tid; idx < D * 8; idx += NTHR) { const int c = idx >> 3, eg = idx & 7; const int j = c >> 9, r = c & 511, l = r >> 3, ci = j * 8 + (r & 7);
                *(LAS f32x4*)(rwl + ((ci * 8 + eg) * 64 + l) * 4) = gld<f32x4>(rw + c * NE + eg * 4); }
            if (tid < NE) MISC[32 + tid] = 0u;
            __syncthreads();
            LAS f32x4* lnp = (LAS f32x4*)(lds + TOK_OFF);
            if (tid < 256) { const int q = tid >> 6, l = tid & 63; lnp[q * 64 + l] = gld<f32x4>(ARG_IN(14) + layer * D + chq(l, q)); lnp[(4 + q) * 64 + l] = gld<f32x4>(ARG_IN(15) + layer * D + chq(l, q)); }
            __syncthreads();
            const int myexp = (lane >> 1) & 31;
            const float rbias = gld<float>(ARG_IN(17) + layer * NE + myexp);
            LAS unsigned* hist = (LAS unsigned*)(lds + MISC_OFF) + 32;
            for (int rep = 0; rep < REP_LNR; ++rep)
            for (int tb = vcu; tb < T / 128; tb += G) {
                const int t0 = tb * 128 + wave * 16;
                v4u zn[2][2];
#pragma unroll
                for (int u = 0; u < 2; ++u)
#pragma unroll
                    for (int j = 0; j < 2; ++j) zn[u][j] = gld<v4u>(Zb + (size_t)(t0 + u) * D + j * 512 + 8 * lane);
                for (int ti = 0; ti < 16; ti += 2) {
                    const int t = t0 + ti;
                    float va[16], vb[16];
                    unpack8(zn[0][0], va); unpack8(zn[0][1], va + 8); unpack8(zn[1][0], vb); unpack8(zn[1][1], vb + 8);
                    if (ti + 2 < 16) {
#pragma unroll
                        for (int u = 0; u < 2; ++u)
#pragma unroll
                            for (int j = 0; j < 2; ++j) zn[u][j] = gld<v4u>(Zb + (size_t)(t + 2 + u) * D + j * 512 + 8 * lane); }
                    ln16_lds(va, lnp, lane); ln16_lds(vb, lnp, lane);
                    gst<v4u>(X1b + (size_t)t * D + 8 * lane, pack8(va)); gst<v4u>(X1b + (size_t)t * D + 512 + 8 * lane, pack8(va + 8));
                    gst<v4u>(X1b + (size_t)(t + 1) * D + 8 * lane, pack8(vb)); gst<v4u>(X1b + (size_t)(t + 1) * D + 512 + 8 * lane, pack8(vb + 8));
                    { float s8[16];
#pragma unroll
                      for (int i = 0; i < 16; ++i) s8[i] = va[i] * SX8;
                      gst<v2u>(X18 + (size_t)t * D + 8 * lane, pack8_fp8(s8)); gst<v2u>(X18 + (size_t)t * D + 512 + 8 * lane, pack8_fp8(s8 + 8));
#pragma unroll
                      for (int i = 0; i < 16; ++i) s8[i] = vb[i] * SX8;
                      gst<v2u>(X18 + (size_t)(t + 1) * D + 8 * lane, pack8_fp8(s8)); gst<v2u>(X18 + (size_t)(t + 1) * D + 512 + 8 * lane, pack8_fp8(s8 + 8)); }
                    f32x2 pa[16], pb[16];
#pragma unroll
                    for (int e = 0; e < 16; ++e) { pa[e] = (f32x2){0.f, 0.f}; pb[e] = (f32x2){0.f, 0.f}; }
                    f32x4 w0[8], w1[8];
#define RW_LOAD(dst, ci) do { _Pragma("unroll") for (int eg = 0; eg < 8; ++eg) dst[eg] = *(const LAS f32x4*)(rwl + (((ci) * 8 + eg) * 64 + lane) * 4); asm volatile("" ::: "memory"); } while (0)
#define RW_FMA(wsrc, ci) do { const f32x2 sa = (f32x2){va[ci], va[ci]}, sb = (f32x2){vb[ci], vb[ci]}; _Pragma("unroll") for (int eg = 0; eg < 8; ++eg) { \
                        const f32x2 lo = (f32x2){wsrc[eg][0], wsrc[eg][1]}, hi = (f32x2){wsrc[eg][2], wsrc[eg][3]}; \
                        pa[2 * eg] = __builtin_elementwise_fma(lo, sa, pa[2 * eg]); pa[2 * eg + 1] = __builtin_elementwise_fma(hi, sa, pa[2 * eg + 1]); \
                        pb[2 * eg] = __builtin_elementwise_fma(lo, sb, pb[2 * eg]); pb[2 * eg + 1] = __builtin_elementwise_fma(hi, sb, pb[2 * eg + 1]); } } while (0)
                    RW_LOAD(w0, 0);
#pragma unroll
                    for (int ci = 0; ci < 16; ci += 2) {
                        RW_LOAD(w1, ci + 1);
                        RW_FMA(w0, ci);
                        if (ci + 2 < 16) RW_LOAD(w0, ci + 2);
                        RW_FMA(w1, ci + 1);
                    }
#undef RW_LOAD
#undef RW_FMA
                    float qa[32], qb[32];
#pragma unroll
                    for (int e = 0; e < 16; ++e) { qa[2 * e] = pa[e][0]; qa[2 * e + 1] = pa[e][1]; qb[2 * e] = pb[e][0]; qb[2 * e + 1] = pb[e][1]; }
                    const float logitA = butterfly32(qa, lane) + rbias, logitB = butterfly32(qb, lane) + rbias;
                    route_token(logitA, myexp, lane, t, TIDX, TGATE, hist, rep == 0);
                    route_token(logitB, myexp, lane, t + 1, TIDX, TGATE, hist, rep == 0);
                }
            }
            __syncthreads();
            if (tid < NE) { const unsigned c = MISC[32 + tid]; if (c) (void)xb_add(CNT + tid, c); }
        }
        GRID_BAR();

        {
            PHASE_BEGIN();
            const int* TIDX = (const int*)(ws + WS_IDX); const float* TGATE = (const float*)(ws + WS_GATE);
            int* RTOK = (int*)(ws + WS_RTOK); int* RDST = (int*)(ws + WS_RDST); float* RGATE = (float*)(ws + WS_RGATE);
            unsigned* CNT = ctl + CW_CNT + layer * NE; unsigned* CUR = ctl + CW_CUR + layer * NE;
            LAS int* TS = (LAS int*)(lds + TS_OFF);
            if (tid == 0) { int a = 0; for (int e = 0; e < NE; ++e) { TS[e] = a; a += (int)((xb_ld(CNT + e) + 255u) >> 8); } TS[NE] = a; }
            for (int tb = vcu; tb < T / 128; tb += G) {
                __syncthreads();
                if (tid < NE) MISC[32 + tid] = 0u;
                __syncthreads();
                const int t = tb * 128 + (tid >> 2), k = tid & 3;
                const int e = gld<int>(TIDX + t * 4 + k); const float gv = gld<float>(TGATE + t * 4 + k);
                const unsigned rank = __hip_atomic_fetch_add((LAS unsigned*)(lds + MISC_OFF) + 32 + e, 1u, __ATOMIC_RELAXED, __HIP_MEMORY_SCOPE_WORKGROUP);
                __syncthreads();
                if (tid < NE) { const unsigned c = MISC[32 + tid]; MISC[64 + tid] = c ? xb_add(CUR + tid, c) : 0u; }
                __syncthreads();
                const int pos = TS[e] * 256 + (int)MISC[64 + e] + (int)rank;
                gst<int>(RTOK + pos, t); gst<int>(RDST + pos, t * 4 + k); gst<float>(RGATE + pos, gv);
            }
            __syncthreads();
            for (int e = vcu; e < NE; e += G) {
                const int beg = TS[e] * 256 + (int)xb_ld(CNT + e), end = TS[e + 1] * 256;
                for (int p = beg + tid; p < end; p += NTHR) { gst<int>(RTOK + p, 0); gst<int>(RDST + p, -1); gst<float>(RGATE + p, 0.f); }
            }
        }
        GRID_BAR();

        {
            PHASE_BEGIN();
            unsigned* CNT = ctl + CW_CNT + layer * NE;
            LAS int* TS = (LAS int*)(lds + TS_OFF);
            __syncthreads();
            if (tid == 0) { int a = 0; for (int e = 0; e < NE; ++e) { TS[e] = a; a += (int)((xb_ld(CNT + e) + 255u) >> 8); } TS[NE] = a; }
            __syncthreads();
            const int nM = TS[NE];
            const int n_my = pg8::build_units(lds, tid, nM, 8, G, bx, true, (const int*)(ws + WS_RTOK), REP_MOE1);
            pg8::GemmP gp; gp.A = (const char*)(ws + WS_X18); gp.lda2 = D; gp.acol_pn = 0; gp.Bt = (const char*)(ws + WS_WGU + (size_t)layer * NE * 2048 * 1024); gp.b_estride = (size_t)2048 * 1024; gp.Kb = 1024; gp.sA = E8_X; gp.sB = E8_W;
            pg8::EpiSwiglu E; E.act = (unsigned char*)(ws + WS_ACT); E.bgu = ARG_IN(19) + (size_t)layer * NE * 2048;
            pg8::gemm_phase<true, true, pg8::EpiSwiglu>(lds, tid, gp, n_my, E, REP_MOE1 > 1 ? n_my / 2 : (1 << 20));
        }
        GRID_BAR();

        {
            PHASE_BEGIN();
            LAS int* TS = (LAS int*)(lds + TS_OFF);
            const int nM = TS[NE];
            const int n_my = pg8::build_units(lds, tid, nM, 4, G, bx, true, nullptr, REP_MOE2);
            pg8::GemmP gp; gp.A = (const char*)(ws + WS_ACT); gp.lda2 = D; gp.acol_pn = 0; gp.Bt = (const char*)(ws + WS_WDN + (size_t)layer * NE * 1024 * 1024); gp.b_estride = (size_t)1024 * 1024; gp.Kb = 1024; gp.sA = E8_ACT; gp.sB = E8_W;
            pg8::EpiMoe2 E; E.Y = (unsigned char*)(ws + WS_Y); E.bdn = ARG_IN(21) + (size_t)layer * NE * D; E.rowdst = (const int*)(ws + WS_RDST); E.rowgate = (const float*)(ws + WS_RGATE);
            pg8::gemm_phase<false, true, pg8::EpiMoe2>(lds, tid, gp, n_my, E);
        }
        GRID_BAR();

        {
            PHASE_BEGIN();
            const bf16* X1b = (const bf16*)(ws + WS_X1B); const unsigned char* Y = (const unsigned char*)(ws + WS_Y); float* OUT = ARG_OUT(); bf16* XAb = (bf16*)(ws + WS_XAB);
            float lg[16], lb[16];
#pragma unroll
            for (int q = 0; q < 4; ++q) { const f32x4 b = gld<f32x4>(ARG_IN(22) + layer * D + 16 * lane + 4 * q), c = gld<f32x4>(ARG_IN(23) + layer * D + 16 * lane + 4 * q);
#pragma unroll
                for (int i = 0; i < 4; ++i) { lg[4 * q + i] = b[i]; lb[4 * q + i] = c[i]; } }
            for (int rep = 0; rep < REP_THIN; ++rep)
            for (int tb = vcu; tb < T / 128; tb += G) {
                const int t0 = tb * 128 + wave * 16;
                v4u nx[2], ny[4];
#pragma unroll
                for (int j = 0; j < 2; ++j) nx[j] = gld<v4u>(X1b + (size_t)t0 * D + 16 * lane + 8 * j);
#pragma unroll
                for (int k = 0; k < 4; ++k) ny[k] = gld<v4u>(Y + (size_t)(t0 * 4 + k) * D + 16 * lane);
                for (int ti = 0; ti < 16; ++ti) {
                    const int t = t0 + ti;
                    float v[16], h[16];
                    unpack8(nx[0], v); unpack8(nx[1], v + 8);
#pragma unroll
                    for (int i = 0; i < 16; ++i) h[i] = 0.f;
#pragma unroll
                    for (int k = 0; k < 4; ++k) { const unsigned wd[4] = {ny[k].x, ny[k].y, ny[k].z, ny[k].w};
#pragma unroll
                        for (int d = 0; d < 4; ++d) { const f32x2 lo = __builtin_amdgcn_cvt_pk_f32_fp8((int)wd[d], false), hi = __builtin_amdgcn_cvt_pk_f32_fp8((int)wd[d], true);
                            h[4 * d] += lo[0]; h[4 * d + 1] += lo[1]; h[4 * d + 2] += hi[0]; h[4 * d + 3] += hi[1]; } }
                    if (ti + 1 < 16) {
#pragma unroll
                        for (int j = 0; j < 2; ++j) nx[j] = gld<v4u>(X1b + (size_t)(t + 1) * D + 16 * lane + 8 * j);
#pragma unroll
                        for (int k = 0; k < 4; ++k) ny[k] = gld<v4u>(Y + (size_t)((t + 1) * 4 + k) * D + 16 * lane); }
#pragma unroll
                    for (int i = 0; i < 16; ++i) v[i] = v[i] * ALPHA + h[i] * (1.0f / SY8);
                    ln16(v, lg, lb, lane);
                    if (layer == DEPTH - 1) {
#pragma unroll
                        for (int q = 0; q < 4; ++q) gst<f32x4>(OUT + (size_t)t * D + 16 * lane + 4 * q, (f32x4){v[4 * q], v[4 * q + 1], v[4 * q + 2], v[4 * q + 3]});
                    } else {
                        gst<v4u>(XAb + (size_t)t * D + 16 * lane, pack8(v));
                        gst<v4u>(XAb + (size_t)t * D + 16 * lane + 8, pack8(v + 8));
                    }
                }
            }
        }
        if (layer + 1 < DEPTH) GRID_BAR();
    }
}

extern "C" void kernel_launch(void* const* d_in, const int* in_sizes, int n_in, void* d_out, int out_size, void* d_ws, size_t ws_size, hipStream_t stream) {
    static int grid = 0;
    if (grid == 0) {
        if (n_in != 24 || out_size != T * D || ws_size < WS_END) { fprintf(stderr, "kernel_launch: unexpected shapes (n_in %d out %d ws %zu)\n", n_in, out_size, ws_size); grid = -1; return; }
        if (hipFuncSetAttribute((const void*)mega_fwd, hipFuncAttributeMaxDynamicSharedMemorySize, LDS_BYTES) != hipSuccess) { fprintf(stderr, "kernel_launch: hipFuncSetAttribute failed\n"); grid = -1; return; }
        int dev = 0, cus = 0, per_cu = 0;
        (void)hipGetDevice(&dev); (void)hipDeviceGetAttribute(&cus, hipDeviceAttributeMultiprocessorCount, dev);
        if (hipOccupancyMaxActiveBlocksPerMultiprocessor(&per_cu, (const void*)mega_fwd, NTHR, LDS_BYTES) != hipSuccess || per_cu < 1) fprintf(stderr, "kernel_launch: occupancy query reports %d blocks per CU\n", per_cu);
        (void)hipGetLastError();
        grid = 256; if (cus > 0 && cus < grid) grid = cus;
    }
    if (grid < 0) return;
    (void)hipMemsetAsync((char*)d_ws + WS_CTL, 0, CTL_ZERO_BYTES, stream);
    Args a{};
    for (int i = 0; i < 24; ++i) a.in[i] = (const float*)d_in[i];
    a.out = (float*)d_out; a.ws = (unsigned char*)d_ws;
    hipLaunchKernelGGL(mega_fwd, dim3(grid), dim3(NTHR), LDS_BYTES, stream, a);
    const hipError_t le = hipPeekAtLastError();
    if (le != hipSuccess) fprintf(stderr, "kernel_launch: launch failed: %s\n", hipGetErrorName(le));
}
```

```cpp
#include <hip/hip_runtime.h>
#include <cstdio>
#include <cstdint>

#define GAS __attribute__((address_space(1)))
#define LAS __attribute__((address_space(3)))
typedef unsigned short bf16;
typedef unsigned v4u __attribute__((ext_vector_type(4)));
typedef unsigned v2u __attribute__((ext_vector_type(2)));
typedef float f32x4 __attribute__((ext_vector_type(4)));
typedef float f32x2 __attribute__((ext_vector_type(2)));
typedef short bf16x8 __attribute__((ext_vector_type(8)));
typedef int v4i __attribute__((ext_vector_type(4)));
typedef int v8i __attribute__((ext_vector_type(8)));

template <class V> __device__ __forceinline__ V gld(const void* p) { return *(const GAS V*)p; }
template <class V> __device__ __forceinline__ void gst(void* p, V v) { *(GAS V*)p = v; }

#ifndef REP_P0
#define REP_P0 1
#endif
#ifndef REP_MOE1
#define REP_MOE1 1
#endif
#ifndef REP_MOE2
#define REP_MOE2 1
#endif
#ifndef REP_THIN
#define REP_THIN 1
#endif
#ifndef REP_MIXG
#define REP_MIXG 1
#endif
#ifndef REP_LNR
#define REP_LNR 1
#endif
#ifndef REP_BAR
#define REP_BAR 1
#endif
#ifndef REP_EPI1
#define REP_EPI1 1
#endif
#ifndef REP_EPI2
#define REP_EPI2 1
#endif
constexpr int T = 32768, D = 1024, SEQ = 4096, NE = 32, TOPK = 4, NA = T * TOPK, DEPTH = 4;
constexpr int MAXTILES = NA / 256 + NE;
constexpr int NPAD = MAXTILES * 256;
constexpr float LN_EPS = 1e-5f;
constexpr float ALPHA = 1.681792830507429f;
constexpr int NWAVES = 8, NTHR = 512;
constexpr int MAXU = 17;
constexpr float SX8 = 16.0f, SACT8 = 4.0f, SW8 = 256.0f, SY8 = 64.0f;
constexpr int E8_X = 0x7B7B7B7B  , E8_ACT = 0x7D7D7D7D  , E8_W = 0x77777777  ;

constexpr size_t MiB = 1u << 20;
constexpr size_t WS_CTL = 0, CTL_ZERO_BYTES = 1 * MiB;
constexpr size_t WS_IDX = 1 * MiB;
constexpr size_t WS_GATE = 1 * MiB + 512 * 1024;
constexpr size_t WS_RTOK = 2 * MiB;
constexpr size_t WS_RDST = 3 * MiB;
constexpr size_t WS_RGATE = 4 * MiB;
constexpr size_t WS_WPOOL = 5 * MiB;
constexpr size_t WS_WSCIN = 6 * MiB;
constexpr size_t WS_WSCOUT = 12 * MiB;
constexpr size_t WS_WCFIN = 14 * MiB;
constexpr size_t WS_WCFOUT = 18 * MiB;
constexpr size_t WS_WGU = 32 * MiB;
constexpr size_t WS_WDN = 544 * MiB;
constexpr size_t WS_X18 = 704 * MiB;
constexpr size_t WS_ZB = 800 * MiB;
constexpr size_t WS_XAB = 864 * MiB;
constexpr size_t WS_X1B = 928 * MiB;
constexpr size_t WS_M1 = 992 * MiB;
constexpr size_t WS_M2 = 1056 * MiB;
constexpr size_t WS_M3 = 1120 * MiB;
constexpr size_t WS_ACT = 1184 * MiB;
constexpr size_t WS_Y = 1456 * MiB;
constexpr size_t WS_END = 1712 * MiB;
constexpr int CW_BAR = 4096;
constexpr int CW_CNT = 8192;
constexpr int CW_CUR = 8192 + 256;

constexpr int RING_OFF = 0, RING_BYTES = 131072;
constexpr int TOK_OFF = RING_BYTES;
constexpr int UT_OFF = TOK_OFF + MAXU * 1024;
constexpr int TS_OFF = UT_OFF + (2 * MAXU + 2) * 16;
constexpr int MISC_OFF = TS_OFF + 36 * 4;
constexpr int EPI_OFF = ((MISC_OFF + 128 * 4 + 255) / 256) * 256;
constexpr int LDS_BYTES = EPI_OFF + 2 * 4096;
static_assert(LDS_BYTES <= 160 * 1024 && (MISC_OFF % 16) == 0, "LDS map");

#define LDS_WAIT() asm volatile("s_waitcnt lgkmcnt(0)" ::: "memory")
#define VM_WAIT() asm volatile("s_waitcnt vmcnt(0)" ::: "memory")

__device__ __forceinline__ unsigned cvt_pk_bf16(float lo, float hi) { unsigned r; asm volatile("v_cvt_pk_bf16_f32 %0, %1, %2" : "=v"(r) : "v"(lo), "v"(hi)); return r; }
__device__ __forceinline__ v2u pack8_fp8(const float* v) { int a = __builtin_amdgcn_cvt_pk_fp8_f32(v[0], v[1], 0, false); a = __builtin_amdgcn_cvt_pk_fp8_f32(v[2], v[3], a, true);
    int b = __builtin_amdgcn_cvt_pk_fp8_f32(v[4], v[5], 0, false); b = __builtin_amdgcn_cvt_pk_fp8_f32(v[6], v[7], b, true); v2u w; w.x = (unsigned)a; w.y = (unsigned)b; return w; }
__device__ __forceinline__ float bf_lo(unsigned u) { return __uint_as_float(u << 16); }
__device__ __forceinline__ float bf_hi(unsigned u) { return __uint_as_float(u & 0xffff0000u); }
__device__ __forceinline__ float sigmoidf_(float x) { return __builtin_amdgcn_rcpf(1.0f + __expf(-x)); }
#define DPP_F(v, ctrl) __int_as_float(__builtin_amdgcn_update_dpp(0, __float_as_int(v), (ctrl), 0xf, 0xf, true))
#define DPP_XOR1 0xB1
#define DPP_XOR2 0x4E
#define DPP_QREV 0x1B
#define DPP_HMIR 0x141
#define DPP_RMIR 0x140
#define DPP_ROR8 0x128
__device__ __forceinline__ float rdlane(float v, int l) { return __uint_as_float((unsigned)__builtin_amdgcn_readlane((int)__float_as_uint(v), l)); }
__device__ __forceinline__ float wave_sum(float v, int lane) {
    (void)lane;
    v += DPP_F(v, DPP_XOR1); v += DPP_F(v, DPP_XOR2); v += DPP_F(v, DPP_HMIR); v += DPP_F(v, DPP_RMIR);
    return (rdlane(v, 0) + rdlane(v, 16)) + (rdlane(v, 32) + rdlane(v, 48));
}

#define XB_TMO      128
#define XB_XCNT(j)  (256  + 64 * (j))
#define XB_XSUB(j)  (1280 + 64 * (j))
#define XB_XGEN(j)  (2304 + 64 * (j))
#define XB_TOP      3328
#define XB_TOPGEN   3392
#define XCD_BAR_WORDS 3456
#define XB_SPIN_CAP (1u << 18)

__device__ __forceinline__ unsigned xb_ld(unsigned* p)              { return __hip_atomic_load((GAS unsigned*)p, __ATOMIC_RELAXED, __HIP_MEMORY_SCOPE_AGENT); }
__device__ __forceinline__ unsigned xb_add(unsigned* p, unsigned v) { return __hip_atomic_fetch_add((GAS unsigned*)p, v, __ATOMIC_RELAXED, __HIP_MEMORY_SCOPE_AGENT); }
__device__ __forceinline__ unsigned xb_xcc_id() { return (unsigned)__builtin_amdgcn_s_getreg((3 << 11) | 20) & 0xFu; }
#define XB_SPIN(cond, bar) do { unsigned _sp = 0; while (cond) { __builtin_amdgcn_s_sleep(1); \
    if ((++_sp & 255u) == 0u) { if (xb_ld(&(bar)[XB_TMO])) break; if (_sp > XB_SPIN_CAP) { (void)xb_add(&(bar)[XB_TMO], 1u); break; } } } } while (0)

struct XcdBarrier { unsigned* bar; unsigned x; volatile LAS unsigned* st; };

__device__ __forceinline__ XcdBarrier xcd_barrier_post(unsigned* bar, volatile LAS unsigned* st) {
    XcdBarrier b; b.bar = bar; b.x = xb_xcc_id(); b.st = st;
    if (threadIdx.x == 0) (void)xb_add(&bar[XB_XCNT(b.x)], 1u);
    return b;
}
__device__ __forceinline__ void xcd_barrier_complete(unsigned* bar, unsigned x, unsigned& nloc, unsigned& nx) {
    const unsigned G = gridDim.x * gridDim.y * gridDim.z;
    unsigned sum, cnt, mine, sp = 0u;
    for (;;) {
        sum = 0u; cnt = 0u; mine = 0u;
#pragma unroll
        for (unsigned j = 0; j < 16; ++j) { const unsigned c = xb_ld(&bar[XB_XCNT(j)]); sum += c; cnt += (c > 0u) ? 1u : 0u; mine = (j == x) ? c : mine; }
        if (sum == G) break;
        __builtin_amdgcn_s_sleep(1);
        if ((++sp & 255u) == 0u) { if (xb_ld(&bar[XB_TMO])) break; if (sp > XB_SPIN_CAP) { (void)xb_add(&bar[XB_TMO], 1u); break; } }
    }
    nloc = mine > 0u ? mine : 1u; nx = cnt > 0u ? cnt : 1u;
}
__device__ __forceinline__ void xcd_barrier(const XcdBarrier& b) {
    asm volatile("s_waitcnt vmcnt(0)" ::: "memory");
    __syncthreads();
    if (threadIdx.x == 0) {
        unsigned* bar = b.bar;
        __builtin_amdgcn_s_waitcnt(0);
        unsigned nloc = b.st[0], nx = b.st[1];
        if (nloc == 0u) { xcd_barrier_complete(bar, b.x, nloc, nx); b.st[0] = nloc; b.st[1] = nx; }
        const unsigned old = xb_add(&bar[XB_XSUB(b.x)], 1u);
        const unsigned gen = old / nloc;
        if (old + 1u == (gen + 1u) * nloc) {
            __builtin_amdgcn_fence(__ATOMIC_RELEASE, "agent");
            asm volatile("s_waitcnt vmcnt(0)" ::: "memory");
            const unsigned og = xb_add(&bar[XB_TOP], 1u);
            const unsigned tg = og / nx;
            if (og + 1u == (tg + 1u) * nx) xb_add(&bar[XB_TOPGEN], 1u);
            else XB_SPIN(xb_ld(&bar[XB_TOPGEN]) == tg, bar);
            __builtin_amdgcn_fence(__ATOMIC_ACQUIRE, "agent");
            xb_add(&bar[XB_XGEN(b.x)], 1u);
            asm volatile("s_waitcnt vmcnt(0)" ::: "memory");
        } else {
            XB_SPIN(xb_ld(&bar[XB_XGEN(b.x)]) == gen, bar);
            __builtin_amdgcn_fence(__ATOMIC_ACQUIRE, "agent");
            asm volatile("s_waitcnt vmcnt(0)" ::: "memory");
        }
    }
    __syncthreads();
}

namespace pg8 {
constexpr int BM = 256, BK = 64, HALF = 128, HTB = HALF * BK * 2, STAGE_BYTES = 8 * HTB, NXCD = 8, WGM = 8;
__host__ __device__ __forceinline__ int lds_byte(int r, int c) { const int st = (r >> 4) * 2 + (c >> 5), rr = r & 15, cc = c & 31, ob = rr * 64 + cc * 2; return st * 1024 + (ob ^ (((ob >> 9) & 1) << 5)); }
__host__ __device__ __forceinline__ void stage_rc(int b, int& R, int& C) { const int st = b / 1024, sb = b % 1024, swz = sb ^ (((sb >> 9) & 1) << 5); R = (st >> 1) * 16 + swz / 64; C = (st & 1) * 32 + (swz % 64) / 2; }
__host__ __device__ __forceinline__ int perm32(int rho) { const int n = rho >> 4, i = rho & 15; return 8 * (i >> 2) + 4 * n + (i & 3); }

struct Unit { int pm, pn, e; };
struct GemmP {
    const char* A; unsigned lda2;
    unsigned acol_pn;
    const char* Bt; size_t b_estride;
    int Kb;
    int sA, sB;
};

__device__ __forceinline__ void unit_of(int L, int nM, int nN, int& pm, int& pn) {
    const int nwg = nM * nN;
    int wgid = L; { const int q = nwg / NXCD, r = nwg % NXCD, xcd = wgid % NXCD, off = wgid / NXCD; wgid = (xcd < r ? xcd * (q + 1) : r * (q + 1) + (xcd - r) * q) + off; }
    const int nig = WGM * nN, gid = wgid / nig, fm = gid * WGM, gsz = (nM - fm) < WGM ? (nM - fm) : WGM;
    pm = fm + ((wgid % nig) % gsz); pn = (wgid % nig) / gsz;
}
__device__ __forceinline__ int build_units(LAS unsigned char* lds, const int tid, int nM, int nN, int G, int c, bool moe, const int* row_tok, const int dup = 1) {
    LAS int* UT = (LAS int*)(lds + UT_OFF); LAS const int* TS = (LAS const int*)(lds + TS_OFF); LAS int* TOK = (LAS int*)(lds + TOK_OFF);
    const int nwg = nM * nN;
    int n_my = (nwg > c) ? (nwg - c + G - 1) / G : 0; if (n_my > MAXU) n_my = MAXU;
    if (tid < n_my) {
        int pm, pn; unit_of(tid * G + c, nM, nN, pm, pn);
        int e = 0; if (moe) { while (e < NE - 1 && TS[e + 1] <= pm) ++e; }
        UT[4 * tid + 0] = pm; UT[4 * tid + 1] = pn; UT[4 * tid + 2] = e; UT[4 * tid + 3] = 0;
    }
    __syncthreads();
    if (row_tok) {
        for (int idx = tid; idx < n_my * 256; idx += NTHR) { const int i = idx >> 8, r = idx & 255; TOK[idx] = gld<int>(row_tok + UT[4 * i] * 256 + r); }
    }
    __syncthreads();
    if (dup > 1) { if (tid < n_my) { UT[4 * (tid + n_my) + 0] = UT[4 * tid]; UT[4 * (tid + n_my) + 1] = UT[4 * tid + 1]; UT[4 * (tid + n_my) + 2] = UT[4 * tid + 2]; UT[4 * (tid + n_my) + 3] = 0; } __syncthreads(); return 2 * n_my; }
    return n_my;
}
__device__ __forceinline__ Unit read_unit(LAS const int* UT, int i) {
    Unit u; u.pm = __builtin_amdgcn_readfirstlane(UT[4 * i]); u.pn = __builtin_amdgcn_readfirstlane(UT[4 * i + 1]); u.e = __builtin_amdgcn_readfirstlane(UT[4 * i + 2]); return u;
}
template <bool GATHER>
__device__ __forceinline__ void a_offsets(unsigned (&v)[2][2], const GemmP& g, const Unit& u, int ui, const int (&Rr)[2], const int (&Cc2)[2], LAS const int* TOK, const int tokn) {
#pragma unroll
    for (int h = 0; h < 2; ++h)
#pragma unroll
        for (int i = 0; i < 2; ++i) {
            const int row = GATHER ? TOK[(ui >= tokn ? ui - tokn : ui) * 256 + h * HALF + Rr[i]] : (u.pm * BM + h * HALF + Rr[i]);
            v[h][i] = (unsigned)row * g.lda2 + (unsigned)Cc2[i] + (unsigned)u.pn * g.acol_pn;
        }
}

template <bool GATHER, bool FP8, class Epi>
__device__ __forceinline__ void gemm_phase(LAS unsigned char* lds, const int tid, const GemmP g, const int n_my, const Epi& E, const int tokn = 1 << 20) {
    const int wid = __builtin_amdgcn_readfirstlane(tid >> 6), lane = tid & 63, wr = wid >> 2, wc = wid & 3, fr = lane & 15, fq = lane >> 4;
    const int Kb = g.Kb, nt = Kb / (BK * 2);
    if (n_my <= 0) return;
    int Rr[2], Cc2[2]; unsigned voffB[2];
#pragma unroll
    for (int i = 0; i < 2; ++i) { int R, C; stage_rc(tid * 16 + i * 8192, R, C); const int Rb = Epi::PERM ? ((R & ~31) + perm32(R & 31)) : R;
        Rr[i] = R; Cc2[i] = C * 2; voffB[i] = (unsigned)(Rb * Kb + C * 2); }
    const size_t kstep = (size_t)(BK * 2);
    const size_t hstep = (size_t)HALF * Kb;
    const size_t tstepB = 2 * hstep;
    const unsigned ldsw = (unsigned)wid * 1024u;
    const int aoff = lds_byte(wr * 64 + fr, fq * 8), boff = lds_byte(wc * 32 + fr, fq * 8);
    LAS const int* UT = (LAS const int*)(lds + UT_OFF); LAS const int* TOK = (LAS const int*)(lds + TOK_OFF);
#define PG8_SA(b, h) (((b) * 2 + (h)) * HTB)
#define PG8_SB(b, h) ((4 + (b) * 2 + (h)) * HTB)
#define PG8_STAGE(bufoff, gbase, voff) do { _Pragma("unroll") for (int _i = 0; _i < 2; ++_i) \
        __builtin_amdgcn_global_load_lds((const unsigned*)((const char*)(gbase) + (voff)[_i]), (LAS unsigned*)(lds + (bufoff) + ldsw + _i * 8192), 16, 0, 0); } while (0)
#define PG8_LDA(dst, b, h) do { _Pragma("unroll") for (int m = 0; m < 4; ++m) _Pragma("unroll") for (int k = 0; k < 2; ++k) dst[m][k] = *(const LAS bf16x8*)(lds + PG8_SA(b, h) + aoff + m * 2048 + k * 1024); } while (0)
#define PG8_LDB(dst, b, h) do { _Pragma("unroll") for (int n = 0; n < 2; ++n) _Pragma("unroll") for (int k = 0; k < 2; ++k) dst[n][k] = *(const LAS bf16x8*)(lds + PG8_SB(b, h) + boff + n * 2048 + k * 1024); } while (0)
#define PG8_CAT(x) __builtin_shufflevector(__builtin_bit_cast(v4i, (x)[0]), __builtin_bit_cast(v4i, (x)[1]), 0, 1, 2, 3, 4, 5, 6, 7)
#define PG8_MMA(ai, bj, At, Bt) do { __builtin_amdgcn_s_setprio(1); _Pragma("unroll") for (int m = 0; m < 4; ++m) _Pragma("unroll") for (int n = 0; n < 2; ++n) { \
        if constexpr (FP8) { const v8i b8_ = PG8_CAT(Bt[n]), a8_ = PG8_CAT(At[m]); asm volatile("v_mfma_scale_f32_16x16x128_f8f6f4 %0, %1, %2, %0, %3, %4 op_sel_hi:[0,0,0]" : "+v"(acc[ai][bj][m][n]) : "v"(b8_), "v"(a8_), "v"(vsB), "v"(vsA)); } \
        else { _Pragma("unroll") for (int k = 0; k < 2; ++k) acc[ai][bj][m][n] = __builtin_amdgcn_mfma_f32_16x16x32_bf16(Bt[n][k], At[m][k], acc[ai][bj][m][n], 0, 0, 0); } } \
        __builtin_amdgcn_s_setprio(0); } while (0)
#define PG8_MMA0(ai, bj, At, Bt) do { __builtin_amdgcn_s_setprio(1); _Pragma("unroll") for (int m = 0; m < 4; ++m) _Pragma("unroll") for (int n = 0; n < 2; ++n) { \
        if constexpr (FP8) { const v8i b8_ = PG8_CAT(Bt[n]), a8_ = PG8_CAT(At[m]); asm volatile("v_mfma_scale_f32_16x16x128_f8f6f4 %0, %1, %2, 0, %3, %4 op_sel_hi:[0,0,0]" : "=&v"(acc[ai][bj][m][n]) : "v"(b8_), "v"(a8_), "v"(vsB), "v"(vsA)); } \
        else { acc[ai][bj][m][n] = __builtin_amdgcn_mfma_f32_16x16x32_bf16(Bt[n][0], At[m][0], (f32x4){0.f, 0.f, 0.f, 0.f}, 0, 0, 0); acc[ai][bj][m][n] = __builtin_amdgcn_mfma_f32_16x16x32_bf16(Bt[n][1], At[m][1], acc[ai][bj][m][n], 0, 0, 0); } } \
        __builtin_amdgcn_s_setprio(0); } while (0)
#define PG8_WAIT_V(n) asm volatile("s_waitcnt vmcnt(" #n ")" ::: "memory")
#define PG8_WAIT_L(n) asm volatile("s_waitcnt lgkmcnt(" #n ")" ::: "memory")
#define PG8_BAR __builtin_amdgcn_s_barrier()
#define PG8_SCHED __builtin_amdgcn_sched_barrier(0)
    Unit cur = read_unit(UT, 0), nxt; int ui = 0;
    f32x4 acc[2][2][4][2];
    if constexpr (!FP8) {
#pragma unroll
    for (int a = 0; a < 2; ++a)
#pragma unroll
        for (int b = 0; b < 2; ++b)
#pragma unroll
            for (int m = 0; m < 4; ++m)
#pragma unroll
                for (int n = 0; n < 2; ++n) acc[a][b][m][n] = (f32x4){0.f, 0.f, 0.f, 0.f};
    }
#define PG8_PIN_ACC() do { if constexpr (FP8) { _Pragma("unroll") for (int a_ = 0; a_ < 2; ++a_) _Pragma("unroll") for (int b_ = 0; b_ < 2; ++b_) \
        asm volatile("" : "+v"(acc[a_][b_][0][0]), "+v"(acc[a_][b_][0][1]), "+v"(acc[a_][b_][1][0]), "+v"(acc[a_][b_][1][1]), "+v"(acc[a_][b_][2][0]), "+v"(acc[a_][b_][2][1]), "+v"(acc[a_][b_][3][0]), "+v"(acc[a_][b_][3][1])); \
        asm volatile("s_nop 1" ::: "memory"); } } while (0)
    bf16x8 At[4][2], B0[2][2], B1[2][2];
    int vsA = g.sA, vsB = g.sB; asm volatile("" : "+v"(vsA), "+v"(vsB));
    unsigned vAc[2][2], vAn[2][2];
    a_offsets<GATHER>(vAc, g, cur, 0, Rr, Cc2, TOK, tokn);
    const char* const Ab = g.A;
    const char* cB = g.Bt + (size_t)cur.e * g.b_estride + (size_t)cur.pn * tstepB;
    PG8_STAGE(PG8_SB(0, 0), cB, voffB); PG8_STAGE(PG8_SB(0, 1), cB + hstep, voffB); PG8_STAGE(PG8_SA(0, 0), Ab, vAc[0]); PG8_STAGE(PG8_SA(0, 1), Ab, vAc[1]);
    if (wr == 1) PG8_BAR;
    PG8_WAIT_V(2); PG8_BAR;
    PG8_STAGE(PG8_SB(1, 0), cB + kstep, voffB); PG8_STAGE(PG8_SA(1, 0), Ab + kstep, vAc[0]); PG8_STAGE(PG8_SB(1, 1), cB + hstep + kstep, voffB);
    PG8_WAIT_V(6); PG8_BAR;
    for (;;) {
        const bool has_next = (ui + 1 < n_my);
        nxt = cur; if (has_next) nxt = read_unit(UT, ui + 1);
        const char* nB = has_next ? g.Bt + (size_t)nxt.e * g.b_estride + (size_t)nxt.pn * tstepB : cB;
        for (int t = 0; t < nt; t += 2) {
            const bool last = (t == nt - 2);
            if (t == 0) E.prefetch(lds + EPI_OFF + (ui & 1) * 4096, cur, wid, lane);
            const char* a1 = Ab + (size_t)(t + 1) * kstep;
            const char* a2 = last ? Ab : Ab + (size_t)(t + 2) * kstep; const char* b2 = last ? nB : cB + (size_t)(t + 2) * kstep;
            const char* a3 = a2 + kstep; const char* b3 = b2 + kstep;
            unsigned o2[2][2];
            if (last) {
                if (has_next) a_offsets<GATHER>(vAn, g, nxt, ui + 1, Rr, Cc2, TOK, tokn);
                else { vAn[0][0] = vAc[0][0]; vAn[0][1] = vAc[0][1]; vAn[1][0] = vAc[1][0]; vAn[1][1] = vAc[1][1]; }
                o2[0][0] = vAn[0][0]; o2[0][1] = vAn[0][1]; o2[1][0] = vAn[1][0]; o2[1][1] = vAn[1][1];
            } else { o2[0][0] = vAc[0][0]; o2[0][1] = vAc[0][1]; o2[1][0] = vAc[1][0]; o2[1][1] = vAc[1][1]; }
            PG8_LDB(B0, 0, 0); PG8_LDB(B1, 0, 1); PG8_SCHED; PG8_LDA(At, 0, 0); PG8_STAGE(PG8_SA(1, 1), a1, vAc[1]);
            PG8_WAIT_V(8); PG8_WAIT_L(0); PG8_BAR; if (FP8 && t == 0) { PG8_MMA0(0, 0, At, B0); PG8_MMA0(0, 1, At, B1); } else { PG8_MMA(0, 0, At, B0); PG8_MMA(0, 1, At, B1); } PG8_BAR; PG8_SCHED;
            PG8_LDA(At, 0, 1); PG8_STAGE(PG8_SB(0, 0), b2, voffB); PG8_STAGE(PG8_SB(0, 1), b2 + hstep, voffB); PG8_STAGE(PG8_SA(0, 0), a2, o2[0]);
            PG8_WAIT_V(8); PG8_WAIT_L(0); PG8_BAR; if (FP8 && t == 0) { PG8_MMA0(1, 0, At, B0); PG8_MMA0(1, 1, At, B1); } else { PG8_MMA(1, 0, At, B0); PG8_MMA(1, 1, At, B1); } PG8_BAR; PG8_SCHED;
            PG8_LDB(B0, 1, 0); PG8_LDB(B1, 1, 1); PG8_SCHED; PG8_LDA(At, 1, 0); PG8_STAGE(PG8_SA(0, 1), a2, o2[1]);
            PG8_WAIT_V(8); PG8_WAIT_L(0); PG8_BAR; PG8_MMA(0, 0, At, B0); PG8_MMA(0, 1, At, B1); PG8_BAR; PG8_SCHED;
            PG8_LDA(At, 1, 1); PG8_STAGE(PG8_SB(1, 0), b3, voffB); PG8_STAGE(PG8_SB(1, 1), b3 + hstep, voffB); PG8_STAGE(PG8_SA(1, 0), a3, o2[0]);
            PG8_WAIT_V(8); PG8_WAIT_L(0); PG8_BAR; PG8_MMA(1, 0, At, B0); PG8_MMA(1, 1, At, B1); PG8_BAR; PG8_SCHED;
        }
        if (wr == 0) PG8_BAR;
        if constexpr (FP8) asm volatile("s_nop 15" ::: "memory");
        for (int re_ = 0; re_ < Epi::REPS; ++re_) E(acc, cur, wr, wc, fr, fq, lds + EPI_OFF + (ui & 1) * 4096);
        if (!has_next) break;
        if constexpr (!FP8) {
#pragma unroll
        for (int a = 0; a < 2; ++a)
#pragma unroll
            for (int b = 0; b < 2; ++b)
#pragma unroll
                for (int m = 0; m < 4; ++m)
#pragma unroll
                    for (int n = 0; n < 2; ++n) acc[a][b][m][n] = (f32x4){0.f, 0.f, 0.f, 0.f};
        }
        cur = nxt; cB = nB; ++ui;
        vAc[0][0] = vAn[0][0]; vAc[0][1] = vAn[0][1]; vAc[1][0] = vAn[1][0]; vAc[1][1] = vAn[1][1];
        if (wr == 1) PG8_BAR;
    }
    PG8_WAIT_V(0);
    PG8_BAR;
#undef PG8_SA
#undef PG8_SB
#undef PG8_STAGE
#undef PG8_LDA
#undef PG8_LDB
#undef PG8_MMA
#undef PG8_MMA0
#undef PG8_PIN_ACC
#undef PG8_CAT
#undef PG8_WAIT_V
#undef PG8_WAIT_L
#undef PG8_BAR
#undef PG8_SCHED
}

struct EpiOut {
    static constexpr bool PERM = true; static constexpr int REPS = 1;
    const bf16* xres; bf16* z; const float* bias; const float* scale;
    __device__ __forceinline__ void prefetch(LAS unsigned char*, const Unit&, int, int) const {}
    __device__ __forceinline__ void operator()(const f32x4 (&acc)[2][2][4][2], const Unit& u, int wr, int wc, int fr, int fq, const LAS unsigned char*) const {
        const int row0 = u.pm * BM + wr * 64 + fr, c0 = u.pn * BM + wc * 32 + 8 * fq;
        f32x4 bv[2][2], sv[2][2];
#pragma unroll
        for (int bj = 0; bj < 2; ++bj)
#pragma unroll
            for (int n = 0; n < 2; ++n) {
                bv[bj][n] = bias ? gld<f32x4>(bias + c0 + bj * HALF + 4 * n) : (f32x4){0.f, 0.f, 0.f, 0.f};
                sv[bj][n] = scale ? gld<f32x4>(scale + c0 + bj * HALF + 4 * n) : (f32x4){1.f, 1.f, 1.f, 1.f};
            }
#pragma unroll
        for (int ai = 0; ai < 2; ++ai)
#pragma unroll
            for (int m = 0; m < 4; ++m) { const size_t off = (size_t)(row0 + ai * HALF + m * 16) * D + c0;
#pragma unroll
                for (int bj = 0; bj < 2; ++bj) { const v4u xr = gld<v4u>(xres + off + bj * HALF);
                    const f32x4 x0 = (f32x4){bf_lo(xr.x), bf_hi(xr.x), bf_lo(xr.y), bf_hi(xr.y)}, x1 = (f32x4){bf_lo(xr.z), bf_hi(xr.z), bf_lo(xr.w), bf_hi(xr.w)};
                    const f32x4 o0 = x0 * ALPHA + (acc[ai][bj][m][0] + bv[bj][0]) * sv[bj][0], o1 = x1 * ALPHA + (acc[ai][bj][m][1] + bv[bj][1]) * sv[bj][1];
                    v4u w; w.x = cvt_pk_bf16(o0[0], o0[1]); w.y = cvt_pk_bf16(o0[2], o0[3]); w.z = cvt_pk_bf16(o1[0], o1[1]); w.w = cvt_pk_bf16(o1[2], o1[3]);
                    gst<v4u>(z + off + bj * HALF, w); }
                asm volatile("" ::: "memory"); }
    }
};
struct EpiPair {
    static constexpr bool PERM = true; static constexpr int REPS = 1;
    bf16* O1; bf16* O2; const float* bias; int mode;
    __device__ __forceinline__ void prefetch(LAS unsigned char*, const Unit&, int, int) const {}
    __device__ __forceinline__ void operator()(const f32x4 (&acc)[2][2][4][2], const Unit& u, int wr, int wc, int fr, int fq, const LAS unsigned char*) const {
        const int row0 = u.pm * BM + wr * 64 + fr;
        if (u.pn < 8) {
            const int j0 = u.pn * HALF + wc * 32 + 8 * fq;
            f32x4 b1[2], b2[2];
#pragma unroll
            for (int n = 0; n < 2; ++n) { b1[n] = mode ? gld<f32x4>(bias + j0 + 4 * n) : (f32x4){0.f, 0.f, 0.f, 0.f}; b2[n] = mode ? gld<f32x4>(bias + 1024 + j0 + 4 * n) : (f32x4){0.f, 0.f, 0.f, 0.f}; }
#pragma unroll
            for (int ai = 0; ai < 2; ++ai)
#pragma unroll
                for (int m = 0; m < 4; ++m) { bf16* rowp = O1 + (size_t)(row0 + ai * HALF + m * 16) * D + j0; f32x4 r[2];
#pragma unroll
                    for (int n = 0; n < 2; ++n) { const f32x4 g1 = acc[ai][0][m][n] + b1[n], g2 = acc[ai][1][m][n] + b2[n];
                        if (mode) { r[n][0] = g1[0] * sigmoidf_(g2[0]); r[n][1] = g1[1] * sigmoidf_(g2[1]); r[n][2] = g1[2] * sigmoidf_(g2[2]); r[n][3] = g1[3] * sigmoidf_(g2[3]); }
                        else r[n] = g1 * g2; }
                    v4u w; w.x = cvt_pk_bf16(r[0][0], r[0][1]); w.y = cvt_pk_bf16(r[0][2], r[0][3]); w.z = cvt_pk_bf16(r[1][0], r[1][1]); w.w = cvt_pk_bf16(r[1][2], r[1][3]);
                    gst<v4u>(rowp, w); }
        } else {
            const int c0 = (u.pn - 8) * BM + wc * 32 + 8 * fq;
#pragma unroll
            for (int ai = 0; ai < 2; ++ai)
#pragma unroll
                for (int m = 0; m < 4; ++m) { bf16* rowp = O2 + (size_t)(row0 + ai * HALF + m * 16) * D + c0;
#pragma unroll
                    for (int bj = 0; bj < 2; ++bj) { const f32x4 v0 = acc[ai][bj][m][0], v1 = acc[ai][bj][m][1];
                        v4u w; w.x = cvt_pk_bf16(v0[0], v0[1]); w.y = cvt_pk_bf16(v0[2], v0[3]); w.z = cvt_pk_bf16(v1[0], v1[1]); w.w = cvt_pk_bf16(v1[2], v1[3]);
                        gst<v4u>(rowp + bj * HALF, w); } }
        }
    }
};
struct EpiSwiglu {
    static constexpr bool PERM = true; static constexpr int REPS = REP_EPI1;
    unsigned char* act; const float* bgu;
    __device__ __forceinline__ void prefetch(LAS unsigned char* slot, const Unit& u, int wid, int lane) const {
        if (wid == 0) __builtin_amdgcn_global_load_lds((const unsigned*)(bgu + (size_t)u.e * 2048 + 2 * u.pn * HALF + 4 * lane), (LAS unsigned*)slot, 16, 0, 0);
    }
    __device__ __forceinline__ void operator()(const f32x4 (&acc)[2][2][4][2], const Unit& u, int wr, int wc, int fr, int fq, const LAS unsigned char* slot) const {
        const int row0 = u.pm * BM + wr * 64 + fr, j0 = u.pn * HALF + wc * 32 + 8 * fq;
        const LAS float* bp = (const LAS float*)slot + 2 * (wc * 32 + 8 * fq);
        f32x2 gb[4], ub[4];
#pragma unroll
        for (int i = 0; i < 4; ++i) { const f32x4 b = *(const LAS f32x4*)(bp + 4 * i); gb[i] = (f32x2){b[0], b[2]}; ub[i] = (f32x2){b[1], b[3]}; }
        const f32x2 one = {1.0f, 1.0f}, k4 = {SACT8, SACT8}, kc = {-1.702f * 1.4426950408889634f, -1.702f * 1.4426950408889634f};
#pragma unroll
        for (int ai = 0; ai < 2; ++ai)
#pragma unroll
            for (int m = 0; m < 4; ++m) { unsigned char* rowp = act + (size_t)(row0 + ai * HALF + m * 16) * D + j0; float r[8];
#pragma unroll
                for (int p = 0; p < 4; ++p) { const int n = p >> 1, q = 2 * (p & 1);
                    f32x2 g = (f32x2){acc[ai][0][m][n][q], acc[ai][0][m][n][q + 1]} + gb[p];
                    f32x2 uu = (f32x2){acc[ai][1][m][n][q], acc[ai][1][m][n][q + 1]} + ub[p];
                    g[0] = fminf(g[0], 7.0f); g[1] = fminf(g[1], 7.0f);
                    uu[0] = __builtin_amdgcn_fmed3f(uu[0], -7.0f, 7.0f); uu[1] = __builtin_amdgcn_fmed3f(uu[1], -7.0f, 7.0f);
                    f32x2 t = g * kc; t[0] = __builtin_amdgcn_exp2f(t[0]); t[1] = __builtin_amdgcn_exp2f(t[1]);
                    f32x2 d = t + one; d[0] = __builtin_amdgcn_rcpf(d[0]); d[1] = __builtin_amdgcn_rcpf(d[1]);
                    const f32x2 g4 = g * k4;
                    const f32x2 o = __builtin_elementwise_fma(uu, g4, g4) * d;
                    r[2 * p] = o[0]; r[2 * p + 1] = o[1]; }
                gst<v2u>(rowp, pack8_fp8(r)); }
    }
};
struct EpiMoe2 {
    static constexpr bool PERM = true; static constexpr int REPS = REP_EPI2;
    unsigned char* Y; const float* bdn; const int* rowdst; const float* rowgate;
    __device__ __forceinline__ void prefetch(LAS unsigned char* slot, const Unit& u, int wid, int lane) const {
        if (wid == 0) __builtin_amdgcn_global_load_lds((const unsigned*)(bdn + (size_t)u.e * D + u.pn * BM + 4 * lane), (LAS unsigned*)slot, 16, 0, 0);
        else if (wid == 1) __builtin_amdgcn_global_load_lds((const unsigned*)(rowdst + u.pm * BM + 4 * lane), (LAS unsigned*)(slot + 1024), 16, 0, 0);
        else if (wid == 2) __builtin_amdgcn_global_load_lds((const unsigned*)(rowgate + u.pm * BM + 4 * lane), (LAS unsigned*)(slot + 2048), 16, 0, 0);
    }
    __device__ __forceinline__ void operator()(const f32x4 (&acc)[2][2][4][2], const Unit& u, int wr, int wc, int fr, int fq, const LAS unsigned char* slot) const {
        const int pos0 = wr * 64 + fr, c0 = u.pn * BM + wc * 32 + 8 * fq;
        const LAS float* bp = (const LAS float*)slot + wc * 32 + 8 * fq;
        f32x4 bv[2][2];
#pragma unroll
        for (int bj = 0; bj < 2; ++bj)
#pragma unroll
            for (int n = 0; n < 2; ++n) bv[bj][n] = *(const LAS f32x4*)(bp + bj * HALF + 4 * n);
        int dst[2][4]; float gt[2][4];
#pragma unroll
        for (int ai = 0; ai < 2; ++ai)
#pragma unroll
            for (int m = 0; m < 4; ++m) { const int pos = pos0 + ai * HALF + m * 16; dst[ai][m] = *((const LAS int*)(slot + 1024) + pos); gt[ai][m] = *((const LAS float*)(slot + 2048) + pos) * SY8; }
#pragma unroll
        for (int ai = 0; ai < 2; ++ai)
#pragma unroll
            for (int m = 0; m < 4; ++m) {
                if (dst[ai][m] >= 0) { unsigned char* rowp = Y + (size_t)dst[ai][m] * D + c0; const float s = gt[ai][m];
#pragma unroll
                    for (int bj = 0; bj < 2; ++bj) { const f32x4 v0 = (acc[ai][bj][m][0] + bv[bj][0]) * s, v1 = (acc[ai][bj][m][1] + bv[bj][1]) * s;
                        const float r[8] = {v0[0], v0[1], v0[2], v0[3], v1[0], v1[1], v1[2], v1[3]};
                        gst<v2u>(rowp + bj * HALF, pack8_fp8(r)); } } }
    }
};
}

__device__ __forceinline__ int chq(int lane, int q) { return (q >> 1) * 512 + 8 * lane + (q & 1) * 4; }
__device__ __forceinline__ v4u pack8(const float* v) { v4u w; w.x = cvt_pk_bf16(v[0], v[1]); w.y = cvt_pk_bf16(v[2], v[3]); w.z = cvt_pk_bf16(v[4], v[5]); w.w = cvt_pk_bf16(v[6], v[7]); return w; }
__device__ __forceinline__ void unpack8(const v4u w, float* v) { v[0] = bf_lo(w.x); v[1] = bf_hi(w.x); v[2] = bf_lo(w.y); v[3] = bf_hi(w.y); v[4] = bf_lo(w.z); v[5] = bf_hi(w.z); v[6] = bf_lo(w.w); v[7] = bf_hi(w.w); }

__device__ __forceinline__ int drow_of(int mode, int c) {
    if (mode == 1) { const int j = c >> 1, p = c & 1; return (j >> 7) * 256 + p * 128 + (j & 127); }
    if (mode == 2) { if (c < 1024) return 2048 + c; const int j = (c - 1024) & 1023, p = (c - 1024) >> 10; return (j >> 7) * 256 + p * 128 + (j & 127); }
    if (mode == 3) { const int j = c & 1023, p = c >> 10; return (j >> 7) * 256 + p * 128 + (j & 127); }
    return c;
}
struct TItem { const float* src; unsigned char* dst; int N, Kout  , k0, n0, mode, fp8; };
__device__ __forceinline__ void titem_load(const TItem& d, int lane, float (&tmp)[32]) {
#pragma unroll
    for (int i = 0; i < 32; ++i) { const int kk = 2 * i + (lane >> 5); tmp[i] = gld<float>(d.src + (size_t)(d.k0 + kk) * d.N + d.n0 + (lane & 31)); }
}
__device__ __forceinline__ void titem_store(const TItem& d, int lane, LAS float* scr, const float (&tmp)[32]) {
#pragma unroll
    for (int i = 0; i < 32; ++i) { const int kk = 2 * i + (lane >> 5); scr[kk * 33 + (lane & 31)] = tmp[i]; }
    LDS_WAIT(); asm volatile("" ::: "memory");
    const int c = lane & 7;
#pragma unroll
    for (int j = 0; j < 4; ++j) { const int n = (lane >> 3) + 8 * j; const LAS float* s = scr + (8 * c) * 33 + n;
        float v[8];
#pragma unroll
        for (int i = 0; i < 8; ++i) v[i] = s[i * 33];
        const size_t e = (size_t)drow_of(d.mode, d.n0 + n) * d.Kout + d.k0 + 8 * c;
        if (d.fp8) {
#pragma unroll
            for (int i = 0; i < 8; ++i) v[i] *= SW8;
            gst<v2u>(d.dst + e, pack8_fp8(v));
        } else gst<v4u>(d.dst + 2 * e, pack8(v)); }
    LDS_WAIT(); asm volatile("" ::: "memory");
}

struct Args { const float* in[24]; float* out; unsigned char* ws; };
#define CAS __attribute__((address_space(4)))
__device__ __forceinline__ const void* karg_ptr(int off) {
    const CAS char* kp = (const CAS char*)__builtin_amdgcn_kernarg_segment_ptr();
    asm volatile("" : "+s"(off));
    return *(const void* const CAS*)(kp + off);
}
#define ARG_IN(i) ((const float*)karg_ptr(8 * (i)))
#define ARG_OUT() ((float*)karg_ptr(8 * 24))
#define ARG_WS() ((unsigned char*)karg_ptr(8 * 25))

#define PHASE_BEGIN() \
    int tid = threadIdx.x; asm volatile("" : "+v"(tid)); \
    const int lane = tid & 63, wave = __builtin_amdgcn_readfirstlane(tid >> 6); \
    unsigned char* ws_ = ARG_WS(); asm volatile("" : "+s"(ws_)); unsigned char* ws = (unsigned char*)(GAS unsigned char*)ws_; \
    unsigned* ctl = (unsigned*)(ws + WS_CTL); \
    const int gw = vcu * NWAVES + wave, NGW = G * NWAVES; (void)gw; (void)NGW; (void)lane; (void)ctl;

__device__ __forceinline__ float butterfly32(float (&p)[32], int lane) {
#pragma unroll
    for (int i = 0; i < 16; ++i) { const auto r = __builtin_amdgcn_permlane32_swap(__float_as_uint(p[i]), __float_as_uint(p[i + 16]), false, false); p[i] = __uint_as_float(r[0]) + __uint_as_float(r[1]); }
#pragma unroll
    for (int i = 0; i < 8; ++i) { const auto r = __builtin_amdgcn_permlane16_swap(__float_as_uint(p[i]), __float_as_uint(p[i + 8]), false, false); p[i] = __uint_as_float(r[0]) + __uint_as_float(r[1]); }
#pragma unroll
    for (int i = 0; i < 4; ++i) { const bool hi = (lane & 8) != 0; const float snd = hi ? p[i] : p[i + 4]; const float keep = hi ? p[i + 4] : p[i]; p[i] = keep + DPP_F(snd, DPP_ROR8); }
#pragma unroll
    for (int i = 0; i < 2; ++i) { const bool hi = (lane & 4) != 0; const float snd = hi ? p[i] : p[i + 2]; const float keep = hi ? p[i + 2] : p[i]; const float x = DPP_F(snd, DPP_HMIR); p[i] = keep + DPP_F(x, DPP_QREV); }
    { const bool hi = (lane & 2) != 0; const float snd = hi ? p[0] : p[1]; const float keep = hi ? p[1] : p[0]; p[0] = keep + DPP_F(snd, DPP_XOR2); }
    return p[0] + DPP_F(p[0], DPP_XOR1);
}
__device__ __forceinline__ void ln16(float (&v)[16], const float (&lg)[16], const float (&lb)[16], int lane) {
    float sm = 0.f;
#pragma unroll
    for (int i = 0; i < 16; ++i) sm += v[i];
    const float mean = wave_sum(sm, lane) * (1.0f / D);
    float sq = 0.f;
#pragma unroll
    for (int i = 0; i < 16; ++i) { v[i] -= mean; sq += v[i] * v[i]; }
    const float rstd = 1.0f / sqrtf(wave_sum(sq, lane) * (1.0f / D) + LN_EPS);
#pragma unroll
    for (int i = 0; i < 16; ++i) v[i] = v[i] * rstd * lg[i] + lb[i];
}
__device__ __forceinline__ void route_token(const float logit, const int myexp, const int lane, const int t, int* TIDX, float* TGATE, LAS unsigned* hist, const bool count) {
    int rank = 0;
#pragma unroll
    for (int e = 0; e < 32; ++e) rank += (rdlane(logit, 2 * e) > logit) ? 1 : 0;
    unsigned long long mk[4]; bool clean = true;
#pragma unroll
    for (int r = 0; r < 4; ++r) { mk[r] = __ballot(rank == r); clean = clean && (__builtin_popcountll(mk[r]) == 2); }
    if (!clean) {
        rank = 0;
#pragma unroll
        for (int e = 0; e < 32; ++e) { const float se = rdlane(logit, 2 * e); rank += (se > logit || (se == logit && e < myexp)) ? 1 : 0; }
#pragma unroll
        for (int r = 0; r < 4; ++r) mk[r] = __ballot(rank == r);
    }
    float tv[4]; int tix[4];
#pragma unroll
    for (int r = 0; r < 4; ++r) { const int src = (int)__builtin_ctzll(mk[r] | (1ull << 63)); tv[r] = rdlane(logit, src); tix[r] = src >> 1; }
    const float e1 = __expf(tv[1] - tv[0]), e2 = __expf(tv[2] - tv[0]), e3 = __expf(tv[3] - tv[0]);
    const float inv = 1.0f / (1.0f + e1 + e2 + e3);
    if (lane < 4) {
        const int ix = lane == 0 ? tix[0] : lane == 1 ? tix[1] : lane == 2 ? tix[2] : tix[3];
        const float gv = (lane == 0 ? 1.0f : lane == 1 ? e1 : lane == 2 ? e2 : e3) * inv;
        gst<int>(TIDX + t * 4 + lane, ix); gst<float>(TGATE + t * 4 + lane, gv);
        if (count) __hip_atomic_fetch_add(hist + ix, 1u, __ATOMIC_RELAXED, __HIP_MEMORY_SCOPE_WORKGROUP);
    }
}
__device__ __forceinline__ void ln16_lds(float (&v)[16], const LAS f32x4* lnp, int lane) {
    float sm = 0.f;
#pragma unroll
    for (int i = 0; i < 16; ++i) sm += v[i];
    const float mean = wave_sum(sm, lane) * (1.0f / D);
    float sq = 0.f;
#pragma unroll
    for (int i = 0; i < 16; ++i) { v[i] -= mean; sq += v[i] * v[i]; }
    const float rstd = 1.0f / sqrtf(wave_sum(sq, lane) * (1.0f / D) + LN_EPS);
#pragma unroll
    for (int q = 0; q < 4; ++q) { const f32x4 g4 = lnp[q * 64 + lane], b4 = lnp[(4 + q) * 64 + lane];
#pragma unroll
        for (int i = 0; i < 4; ++i) v[4 * q + i] = v[4 * q + i] * rstd * g4[i] + b4[i]; }
}
template <bool F32IN>
__device__ __forceinline__ void pool_diff_run(const float* xf, const bf16* xb, bf16* M3, int t0, int lane) {
    const int s0 = t0 & (SEQ - 1);
#pragma unroll
    for (int g = 0; g < 4; ++g) {
        const int w = 2 << g, c = 256 * g + 4 * lane;
        f32x4 r[31];
#pragma unroll
        for (int j = 0; j < w + 15; ++j) {
            const int dt = j - (w - 1);
            if (dt >= 0 || s0 != 0) {
                const size_t o = (size_t)(t0 + dt) * D + c;
                if (F32IN) r[j] = gld<f32x4>(xf + o);
                else { const v2u q = gld<v2u>(xb + o); r[j] = (f32x4){bf_lo(q.x), bf_hi(q.x), bf_lo(q.y), bf_hi(q.y)}; }
            } else r[j] = (f32x4){0.f, 0.f, 0.f, 0.f};
        }
#pragma unroll
        for (int i = 0; i < 16; ++i) {
            f32x4 sum = r[i];
#pragma unroll
            for (int j = 1; j < w; ++j) sum += r[i + j];
            const int nv = (s0 + i + 1 < w) ? s0 + i + 1 : w;
            const f32x4 df = sum * (1.0f / (float)nv) - r[i + w - 1];
            v2u o; o.x = cvt_pk_bf16(df[0], df[1]); o.y = cvt_pk_bf16(df[2], df[3]);
            gst<v2u>(M3 + (size_t)(t0 + i) * D + c, o);
        }
    }
}

__global__ void __launch_bounds__(NTHR, 2) mega_fwd(Args args) {
    extern __shared__ __attribute__((aligned(16))) unsigned char lds_raw[];
    LAS unsigned char* lds = (LAS unsigned char*)lds_raw;
    volatile LAS unsigned* MISC = (volatile LAS unsigned*)(lds + MISC_OFF);
    const int G = gridDim.x, bx = blockIdx.x;
    const int vcu = (G % 8 == 0) ? (bx % 8) * (G / 8) + bx / 8 : bx;
    if (threadIdx.x < 128) MISC[threadIdx.x] = 0u;
    __syncthreads();
    (void)xcd_barrier_post((unsigned*)(ARG_WS() + WS_CTL) + CW_BAR, MISC + 0);
#define GRID_BAR() do { XcdBarrier b_; unsigned* bp_ = (unsigned*)(ARG_WS() + WS_CTL) + CW_BAR; asm volatile("" : "+s"(bp_)); b_.bar = (unsigned*)(GAS unsigned*)bp_; b_.x = xb_xcc_id(); b_.st = MISC; for (int rb_ = 0; rb_ < REP_BAR; ++rb_) xcd_barrier(b_); } while (0)

    {
        PHASE_BEGIN();
        {
            constexpr int TPITCH = 129, TBUF = 128 * TPITCH;
            LAS float* tl = (LAS float*)(lds + RING_OFF);
            constexpr int NT_GU = 128 * 8 * 16, NT_DN = 128 * 8 * 8, NT = NT_GU + NT_DN;
            struct WTile { const float* src; unsigned char* dst; int N, nb, kb, mode; };
#define WT_DECODE(ti_, d_) do { int r_ = (ti_); if (r_ < NT_GU) { const int mt_ = r_ >> 7; r_ &= 127; (d_).kb = r_ >> 4; (d_).nb = r_ & 15; (d_).N = 2048; (d_).mode = 1; \
                (d_).src = ARG_IN(18) + (size_t)mt_ * 1024 * 2048; (d_).dst = ws + WS_WGU + (size_t)mt_ * 2048 * 1024; } \
            else { r_ -= NT_GU; const int mt_ = r_ >> 6; r_ &= 63; (d_).kb = r_ >> 3; (d_).nb = r_ & 7; (d_).N = 1024; (d_).mode = 0; \
                (d_).src = ARG_IN(20) + (size_t)mt_ * 1024 * 1024; (d_).dst = ws + WS_WDN + (size_t)mt_ * 1024 * 1024; } } while (0)
#define WT_LOAD(R_, d_) do { _Pragma("unroll") for (int i = 0; i < 16; ++i) R_[i] = gld<v2u>((d_).src + (size_t)((d_).kb * 128 + wave * 16 + i) * (d_).N + (d_).nb * 128 + 2 * lane); } while (0)
#define WT_TOLDS(R_, buf_) do { const int col_ = (2 * lane + 4 * wave) & 127; _Pragma("unroll") for (int i = 0; i < 16; ++i) { LAS float* p_ = tl + (buf_) * TBUF + (wave * 16 + i) * TPITCH + col_; \
                p_[0] = __uint_as_float(R_[i].x); p_[1] = __uint_as_float(R_[i].y); } } while (0)
#define WT_OUT(d_, buf_) do { const int kc_ = tid & 7; _Pragma("unroll") for (int p = 0; p < 2; ++p) { const int n_ = (tid >> 3) + 64 * p; const LAS float* s_ = tl + (buf_) * TBUF + (16 * kc_) * TPITCH + ((n_ + 4 * kc_) & 127); \
                float v_[16]; _Pragma("unroll") for (int i = 0; i < 16; ++i) v_[i] = s_[i * TPITCH] * SW8; \
                const v2u a_ = pack8_fp8(v_), b_ = pack8_fp8(v_ + 8); v4u o_; o_.x = a_.x; o_.y = a_.y; o_.z = b_.x; o_.w = b_.y; \
                gst<v4u>((d_).dst + (size_t)drow_of((d_).mode, (d_).nb * 128 + n_) * 1024 + (d_).kb * 128 + 16 * kc_, o_); } } while (0)
#define WT_BAR() do { LDS_WAIT(); __builtin_amdgcn_s_barrier(); asm volatile("" ::: "memory"); } while (0)
            for (int rep = 0; rep < REP_P0; ++rep) {
                v2u R0[16], R1[16]; WTile d0, d1, dn;
                int ti = vcu;
                d0.src = nullptr; d1.src = nullptr;
                if (ti < NT) { WT_DECODE(ti, d0); WT_LOAD(R0, d0); }
                if (ti + G < NT) { WT_DECODE(ti + G, d1); WT_LOAD(R1, d1); }
                for (; ti < NT; ti += 2 * G) {
                    WT_TOLDS(R0, 0);
                    const bool h2 = (ti + 2 * G < NT);
                    if (h2) { WT_DECODE(ti + 2 * G, dn); WT_LOAD(R0, dn); }
                    WT_BAR();
                    WT_OUT(d0, 0);
                    if (h2) d0 = dn;
                    if (ti + G < NT) {
                        WT_TOLDS(R1, 1);
                        const bool h3 = (ti + 3 * G < NT);
                        if (h3) { WT_DECODE(ti + 3 * G, dn); WT_LOAD(R1, dn); }
                        WT_BAR();
                        WT_OUT(d1, 1);
                        if (h3) d1 = dn;
                    }
                }
                WT_BAR();
            }
#undef WT_DECODE
#undef WT_LOAD
#undef WT_TOLDS
#undef WT_OUT
#undef WT_BAR
        }
        LAS float* scr = (LAS float*)(lds + RING_OFF + wave * 16384);
        constexpr int I_POOL = 4 * 8, I_SCIN = 16 * 96, I_SQ = 16 * 32, I_CFIN = 16 * 64;
        constexpr int N_POOL = 8 * I_POOL;
        constexpr int NITEMS = N_POOL + I_SCIN + I_SQ + I_CFIN + I_SQ;
#define TITEM_SET(d_, src_, K_, N_, dst_, mode_, fp8_, item_) do { const int nb_ = (N_) / 32; (d_).src = (src_); (d_).dst = (unsigned char*)(dst_); (d_).N = (N_); (d_).Kout = (K_); \
        (d_).k0 = 64 * ((item_) / nb_); (d_).n0 = 32 * ((item_) % nb_); (d_).mode = (mode_); (d_).fp8 = (fp8_); } while (0)
#define TITEM_DECODE(it_, d_) do { int r_ = (it_); \
        if (r_ < N_POOL) { const int mt_ = r_ / I_POOL; TITEM_SET(d_, ARG_IN(1) + (size_t)mt_ * 256 * 256, 256, 256, ws + WS_WPOOL + (size_t)mt_ * 256 * 256 * 2, 0, 0, r_ % I_POOL); break; } r_ -= N_POOL; \
        if (r_ < I_SCIN) { TITEM_SET(d_, ARG_IN(3), 1024, 3072, ws + WS_WSCIN, 2, 0, r_); break; } r_ -= I_SCIN; \
        if (r_ < I_SQ) { TITEM_SET(d_, ARG_IN(5), 1024, 1024, ws + WS_WSCOUT, 0, 0, r_); break; } r_ -= I_SQ; \
        if (r_ < I_CFIN) { TITEM_SET(d_, ARG_IN(6), 1024, 2048, ws + WS_WCFIN, 3, 0, r_); break; } r_ -= I_CFIN; \
        TITEM_SET(d_, ARG_IN(12), 1024, 1024, ws + WS_WCFOUT, 0, 0, r_); } while (0)
        for (int it = gw; it < NITEMS; it += NGW) { TItem cur; float ta[32]; TITEM_DECODE(it, cur); titem_load(cur, lane, ta); titem_store(cur, lane, scr, ta); }
#undef TITEM_SET
#undef TITEM_DECODE
        const float* x0 = ARG_IN(0); bf16* XAb = (bf16*)(ws + WS_XAB);
        for (int t = gw; t < T; t += NGW) {
            float v[16];
#pragma unroll
            for (int q = 0; q < 4; ++q) { const f32x4 z = gld<f32x4>(x0 + (size_t)t * D + chq(lane, q)); v[4 * q] = z[0]; v[4 * q + 1] = z[1]; v[4 * q + 2] = z[2]; v[4 * q + 3] = z[3]; }
            gst<v4u>(XAb + (size_t)t * D + 8 * lane, pack8(v));
            gst<v4u>(XAb + (size_t)t * D + 512 + 8 * lane, pack8(v + 8));
        }
    }
    GRID_BAR();

    for (int layer = 0; layer < DEPTH; ++layer) {
        const int kind = layer % 3;

        if (kind == 0) {
            PHASE_BEGIN();
            bf16* M3 = (bf16*)(ws + WS_M3); const bf16* xb = (const bf16*)(ws + WS_XAB);
            for (int rep = 0; rep < REP_THIN; ++rep)
            for (int tb = vcu; tb < T / 128; tb += G) {
                const int t0 = tb * 128 + wave * 16;
                if (layer == 0) pool_diff_run<true>(ARG_IN(0), xb, M3, t0, lane);
                else pool_diff_run<false>(ARG_IN(0), xb, M3, t0, lane);
            }
        } else {
            {
                PHASE_BEGIN();
                bf16* M1 = (bf16*)(ws + WS_M1); bf16* M2 = (bf16*)(ws + WS_M2);
                const int nN = (kind == 1) ? 12 : 8;
                const int n_my = pg8::build_units(lds, tid, T / 256, nN, G, bx, false, nullptr, REP_MIXG);
                pg8::GemmP gp; gp.A = (const char*)(ws + WS_XAB); gp.lda2 = D * 2; gp.acol_pn = 0; gp.Bt = (const char*)(ws + ((kind == 1) ? WS_WSCIN : WS_WCFIN)); gp.b_estride = 0; gp.Kb = 2048; gp.sA = 0; gp.sB = 0;
                pg8::EpiPair E; E.O1 = (kind == 1) ? M2 : M1; E.O2 = M1; E.bias = ARG_IN(7); E.mode = (kind == 1) ? 0 : 1;
                pg8::gemm_phase<false, false, pg8::EpiPair>(lds, tid, gp, n_my, E);
            }
            GRID_BAR();
            if (kind == 1) {
                PHASE_BEGIN();
                const bf16* M1 = (const bf16*)(ws + WS_M1); const bf16* M2 = (const bf16*)(ws + WS_M2); bf16* M3 = (bf16*)(ws + WS_M3);
                const float* cw = ARG_IN(4);
                float wk[3][16];
#pragma unroll
                for (int k = 0; k < 3; ++k)
#pragma unroll
                    for (int q = 0; q < 4; ++q) { const f32x4 v = gld<f32x4>(cw + k * D + chq(lane, q)); wk[k][4 * q] = v[0]; wk[k][4 * q + 1] = v[1]; wk[k][4 * q + 2] = v[2]; wk[k][4 * q + 3] = v[3]; }
                for (int rep = 0; rep < REP_THIN; ++rep)
                for (int tb = vcu; tb < T / 128; tb += G) {
                    const int t0 = tb * 128 + wave * 16, s0 = t0 & (SEQ - 1);
                    float p2[16], p1[16];
                    if (s0 != 0) { unpack8(gld<v4u>(M2 + (size_t)(t0 - 2) * D + 8 * lane), p2); unpack8(gld<v4u>(M2 + (size_t)(t0 - 2) * D + 512 + 8 * lane), p2 + 8);
                                   unpack8(gld<v4u>(M2 + (size_t)(t0 - 1) * D + 8 * lane), p1); unpack8(gld<v4u>(M2 + (size_t)(t0 - 1) * D + 512 + 8 * lane), p1 + 8); }
                    else {
#pragma unroll
                        for (int i = 0; i < 16; ++i) { p2[i] = 0.f; p1[i] = 0.f; } }
                    for (int i0 = 0; i0 < 16; i0 += 4) {
                        v4u cv[4][2], gv[4][2];
#pragma unroll
                        for (int u = 0; u < 4; ++u)
#pragma unroll
                            for (int j = 0; j < 2; ++j) { const size_t o = (size_t)(t0 + i0 + u) * D + j * 512 + 8 * lane; cv[u][j] = gld<v4u>(M2 + o); gv[u][j] = gld<v4u>(M1 + o); }
#pragma unroll
                        for (int u = 0; u < 4; ++u) {
                            float c[16], gb[16], o[16];
                            unpack8(cv[u][0], c); unpack8(cv[u][1], c + 8); unpack8(gv[u][0], gb); unpack8(gv[u][1], gb + 8);
#pragma unroll
                            for (int i = 0; i < 16; ++i) { o[i] = gb[i] * (wk[0][i] * p2[i] + wk[1][i] * p1[i] + wk[2][i] * c[i]); p2[i] = p1[i]; p1[i] = c[i]; }
                            gst<v4u>(M3 + (size_t)(t0 + i0 + u) * D + 8 * lane, pack8(o));
                            gst<v4u>(M3 + (size_t)(t0 + i0 + u) * D + 512 + 8 * lane, pack8(o + 8));
                        }
                    }
                }
            } else {
                PHASE_BEGIN();
                const bf16* U = (const bf16*)(ws + WS_M1); bf16* M3 = (bf16*)(ws + WS_M3);
                const int c = 128 * wave + 2 * lane;
                float wk0[31], wk1[31];
#pragma unroll
                for (int k = 0; k < 31; ++k) { const v2u q = gld<v2u>(ARG_IN(8) + k * D + c); wk0[k] = __uint_as_float(q.x); wk1[k] = __uint_as_float(q.y); }
                const v2u qb = gld<v2u>(ARG_IN(9) + c), qg = gld<v2u>(ARG_IN(10) + c), ql = gld<v2u>(ARG_IN(11) + c);
                const float db0 = __uint_as_float(qb.x), db1 = __uint_as_float(qb.y), lg0 = __uint_as_float(qg.x), lg1 = __uint_as_float(qg.y), lb0 = __uint_as_float(ql.x), lb1 = __uint_as_float(ql.y);
                LAS float* part = (LAS float*)(lds + RING_OFF);
                LAS float* stat = part + 256;
                for (int rep = 0; rep < REP_THIN; ++rep)
                for (int run = vcu; run < T / 16; run += G) {
                    const int t0 = run * 16, s0 = t0 & (SEQ - 1);
                    unsigned r[46];
#pragma unroll
                    for (int j = 0; j < 46; ++j) r[j] = (s0 + j - 30 >= 0) ? gld<unsigned>(U + (size_t)(t0 + j - 30) * D + c) : 0u;
                    float a0[16], a1[16];
#pragma unroll
                    for (int i = 0; i < 16; ++i) { a0[i] = db0; a1[i] = db1; }
#pragma unroll
                    for (int j = 0; j < 46; ++j) { const float x0 = bf_lo(r[j]), x1 = bf_hi(r[j]);
#pragma unroll
                        for (int i = 0; i < 16; ++i) { const int k = j - i; if (k >= 0 && k <= 30) { a0[i] += wk0[k] * x0; a1[i] += wk1[k] * x1; } } }
                    float st[32];
#pragma unroll
                    for (int i = 0; i < 16; ++i) { st[2 * i] = a0[i] + a1[i]; st[2 * i + 1] = a0[i] * a0[i] + a1[i] * a1[i]; }
                    const float tot = butterfly32(st, lane);
                    if ((lane & 1) == 0) part[wave * 32 + (lane >> 1)] = tot;
                    __syncthreads();
                    if (tid < 16) { float S = 0.f, Q = 0.f;
#pragma unroll
                        for (int w8 = 0; w8 < 8; ++w8) { S += part[w8 * 32 + 2 * tid]; Q += part[w8 * 32 + 2 * tid + 1]; }
                        const float mean = S * (1.0f / D); const float var = fmaxf(Q * (1.0f / D) - mean * mean, 0.f);
                        stat[2 * tid] = mean; stat[2 * tid + 1] = 1.0f / sqrtf(var + LN_EPS); }
                    __syncthreads();
#pragma unroll
                    for (int i = 0; i < 16; ++i) { const float mean = stat[2 * i], rstd = stat[2 * i + 1];
                        const float y0 = (a0[i] - mean) * rstd * lg0 + lb0, y1 = (a1[i] - mean) * rstd * lg1 + lb1;
                        gst<unsigned>(M3 + (size_t)(t0 + i) * D + c, cvt_pk_bf16(y0 * sigmoidf_(y0), y1 * sigmoidf_(y1))); }
                }
                __syncthreads();
            }
        }
        GRID_BAR();

        {
            PHASE_BEGIN();
            const int n_my = pg8::build_units(lds, tid, T / 256, 4, G, bx, false, nullptr, REP_MIXG);
            pg8::GemmP gp; gp.A = (const char*)(ws + WS_M3); gp.lda2 = D * 2; gp.b_estride = 0; gp.sA = 0; gp.sB = 0;
            pg8::EpiOut E; E.xres = (const bf16*)(ws + WS_XAB); E.z = (bf16*)(ws + WS_ZB); E.bias = nullptr; E.scale = nullptr;
            if (kind == 0) { gp.acol_pn = 512; gp.Bt = (const char*)(ws + WS_WPOOL + (size_t)(layer / 3) * 1024 * 256 * 2); gp.Kb = 512; E.scale = ARG_IN(2) + (layer / 3) * D; }
            else if (kind == 1) { gp.acol_pn = 0; gp.Bt = (const char*)(ws + WS_WSCOUT); gp.Kb = 2048; }
            else { gp.acol_pn = 0; gp.Bt = (const char*)(ws + WS_WCFOUT); gp.Kb = 2048; E.bias = ARG_IN(13); }
            pg8::gemm_phase<false, false, pg8::EpiOut>(lds, tid, gp, n_my, E);
        }
        GRID_BAR();

        {
            PHASE_BEGIN();
            const bf16* Zb = (const bf16*)(ws + WS_ZB); bf16* X1b = (bf16*)(ws + WS_X1B); unsigned char* X18 = (unsigned char*)(ws + WS_X18);
            int* TIDX = (int*)(ws + WS_IDX); float* TGATE = (float*)(ws + WS_GATE);
            unsigned* CNT = ctl + CW_CNT + layer * NE;
            LAS float* rwl = (LAS float*)(lds + RING_OFF);
            const float* rw = ARG_IN(16) + (size_t)layer * D * NE;
            for (int idx = tid; idx < D * 8; idx += NTHR) { const int c = idx >> 3, eg = idx & 7; const int j = c >> 9, r = c & 511, l = r >> 3, ci = j * 8 + (r & 7);
                *(LAS f32x4*)(rwl + ((ci * 8 + eg) * 64 + l) * 4) = gld<f32x4>(rw + c * NE + eg * 4); }
            if (tid < NE) MISC[32 + tid] = 0u;
            __syncthreads();
            LAS f32x4* lnp = (LAS f32x4*)(lds + TOK_OFF);
            if (tid < 256) { const int q = tid >> 6, l = tid & 63; lnp[q * 64 + l] = gld<f32x4>(ARG_IN(14) + layer * D + chq(l, q)); lnp[(4 + q) * 64 + l] = gld<f32x4>(ARG_IN(15) + layer * D + chq(l, q)); }
            __syncthreads();
            const int myexp = (lane >> 1) & 31;
            const float rbias = gld<float>(ARG_IN(17) + layer * NE + myexp);
            LAS unsigned* hist = (LAS unsigned*)(lds + MISC_OFF) + 32;
            for (int rep = 0; rep < REP_LNR; ++rep)
            for (int tb = vcu; tb < T / 128; tb += G) {
                const int t0 = tb * 128 + wave * 16;
                v4u zn[2][2];
#pragma unroll
                for (int u = 0; u < 2; ++u)
#pragma unroll
                    for (int j = 0; j < 2; ++j) zn[u][j] = gld<v4u>(Zb + (size_t)(t0 + u) * D + j * 512 + 8 * lane);
                for (int ti = 0; ti < 16; ti += 2) {
                    const int t = t0 + ti;
                    float va[16], vb[16];
                    unpack8(zn[0][0], va); unpack8(zn[0][1], va + 8); unpack8(zn[1][0], vb); unpack8(zn[1][1], vb + 8);
                    if (ti + 2 < 16) {
#pragma unroll
                        for (int u = 0; u < 2; ++u)
#pragma unroll
                            for (int j = 0; j < 2; ++j) zn[u][j] = gld<v4u>(Zb + (size_t)(t + 2 + u) * D + j * 512 + 8 * lane); }
                    ln16_lds(va, lnp, lane); ln16_lds(vb, lnp, lane);
                    gst<v4u>(X1b + (size_t)t * D + 8 * lane, pack8(va)); gst<v4u>(X1b + (size_t)t * D + 512 + 8 * lane, pack8(va + 8));
                    gst<v4u>(X1b + (size_t)(t + 1) * D + 8 * lane, pack8(vb)); gst<v4u>(X1b + (size_t)(t + 1) * D + 512 + 8 * lane, pack8(vb + 8));
                    { float s8[16];
#pragma unroll
                      for (int i = 0; i < 16; ++i) s8[i] = va[i] * SX8;
                      gst<v2u>(X18 + (size_t)t * D + 8 * lane, pack8_fp8(s8)); gst<v2u>(X18 + (size_t)t * D + 512 + 8 * lane, pack8_fp8(s8 + 8));
#pragma unroll
                      for (int i = 0; i < 16; ++i) s8[i] = vb[i] * SX8;
                      gst<v2u>(X18 + (size_t)(t + 1) * D + 8 * lane, pack8_fp8(s8)); gst<v2u>(X18 + (size_t)(t + 1) * D + 512 + 8 * lane, pack8_fp8(s8 + 8)); }
                    f32x2 pa[16], pb[16];
#pragma unroll
                    for (int e = 0; e < 16; ++e) { pa[e] = (f32x2){0.f, 0.f}; pb[e] = (f32x2){0.f, 0.f}; }
                    f32x4 w0[8], w1[8];
#define RW_LOAD(dst, ci) do { _Pragma("unroll") for (int eg = 0; eg < 8; ++eg) dst[eg] = *(const LAS f32x4*)(rwl + (((ci) * 8 + eg) * 64 + lane) * 4); asm volatile("" ::: "memory"); } while (0)
#define RW_FMA(wsrc, ci) do { const f32x2 sa = (f32x2){va[ci], va[ci]}, sb = (f32x2){vb[ci], vb[ci]}; _Pragma("unroll") for (int eg = 0; eg < 8; ++eg) { \
                        const f32x2 lo = (f32x2){wsrc[eg][0], wsrc[eg][1]}, hi = (f32x2){wsrc[eg][2], wsrc[eg][3]}; \
                        pa[2 * eg] = __builtin_elementwise_fma(lo, sa, pa[2 * eg]); pa[2 * eg + 1] = __builtin_elementwise_fma(hi, sa, pa[2 * eg + 1]); \
                        pb[2 * eg] = __builtin_elementwise_fma(lo, sb, pb[2 * eg]); pb[2 * eg + 1] = __builtin_elementwise_fma(hi, sb, pb[2 * eg + 1]); } } while (0)
                    RW_LOAD(w0, 0);
#pragma unroll
                    for (int ci = 0; ci < 16; ci += 2) {
                        RW_LOAD(w1, ci + 1);
                        RW_FMA(w0, ci);
                        if (ci + 2 < 16) RW_LOAD(w0, ci + 2);
                        RW_FMA(w1, ci + 1);
                    }
#undef RW_LOAD
#undef RW_FMA
                    float qa[32], qb[32];
#pragma unroll
                    for (int e = 0; e < 16; ++e) { qa[2 * e] = pa[e][0]; qa[2 * e + 1] = pa[e][1]; qb[2 * e] = pb[e][0]; qb[2 * e + 1] = pb[e][1]; }
                    const float logitA = butterfly32(qa, lane) + rbias, logitB = butterfly32(qb, lane) + rbias;
                    route_token(logitA, myexp, lane, t, TIDX, TGATE, hist, rep == 0);
                    route_token(logitB, myexp, lane, t + 1, TIDX, TGATE, hist, rep == 0);
                }
            }
            __syncthreads();
            if (tid < NE) { const unsigned c = MISC[32 + tid]; if (c) (void)xb_add(CNT + tid, c); }
        }
        GRID_BAR();

        {
            PHASE_BEGIN();
            const int* TIDX = (const int*)(ws + WS_IDX); const float* TGATE = (const float*)(ws + WS_GATE);
            int* RTOK = (int*)(ws + WS_RTOK); int* RDST = (int*)(ws + WS_RDST); float* RGATE = (float*)(ws + WS_RGATE);
            unsigned* CNT = ctl + CW_CNT + layer * NE; unsigned* CUR = ctl + CW_CUR + layer * NE;
            LAS int* TS = (LAS int*)(lds + TS_OFF);
            if (tid == 0) { int a = 0; for (int e = 0; e < NE; ++e) { TS[e] = a; a += (int)((xb_ld(CNT + e) + 255u) >> 8); } TS[NE] = a; }
            for (int tb = vcu; tb < T / 128; tb += G) {
                __syncthreads();
                if (tid < NE) MISC[32 + tid] = 0u;
                __syncthreads();
                const int t = tb * 128 + (tid >> 2), k = tid & 3;
                const int e = gld<int>(TIDX + t * 4 + k); const float gv = gld<float>(TGATE + t * 4 + k);
                const unsigned rank = __hip_atomic_fetch_add((LAS unsigned*)(lds + MISC_OFF) + 32 + e, 1u, __ATOMIC_RELAXED, __HIP_MEMORY_SCOPE_WORKGROUP);
                __syncthreads();
                if (tid < NE) { const unsigned c = MISC[32 + tid]; MISC[64 + tid] = c ? xb_add(CUR + tid, c) : 0u; }
                __syncthreads();
                const int pos = TS[e] * 256 + (int)MISC[64 + e] + (int)rank;
                gst<int>(RTOK + pos, t); gst<int>(RDST + pos, t * 4 + k); gst<float>(RGATE + pos, gv);
            }
            __syncthreads();
            for (int e = vcu; e < NE; e += G) {
                const int beg = TS[e] * 256 + (int)xb_ld(CNT + e), end = TS[e + 1] * 256;
                for (int p = beg + tid; p < end; p += NTHR) { gst<int>(RTOK + p, 0); gst<int>(RDST + p, -1); gst<float>(RGATE + p, 0.f); }
            }
        }
        GRID_BAR();

        {
            PHASE_BEGIN();
            unsigned* CNT = ctl + CW_CNT + layer * NE;
            LAS int* TS = (LAS int*)(lds + TS_OFF);
            __syncthreads();
            if (tid == 0) { int a = 0; for (int e = 0; e < NE; ++e) { TS[e] = a; a += (int)((xb_ld(CNT + e) + 255u) >> 8); } TS[NE] = a; }
            __syncthreads();
            const int nM = TS[NE];
            const int n_my = pg8::build_units(lds, tid, nM, 8, G, bx, true, (const int*)(ws + WS_RTOK), REP_MOE1);
            pg8::GemmP gp; gp.A = (const char*)(ws + WS_X18); gp.lda2 = D; gp.acol_pn = 0; gp.Bt = (const char*)(ws + WS_WGU + (size_t)layer * NE * 2048 * 1024); gp.b_estride = (size_t)2048 * 1024; gp.Kb = 1024; gp.sA = E8_X; gp.sB = E8_W;
            pg8::EpiSwiglu E; E.act = (unsigned char*)(ws + WS_ACT); E.bgu = ARG_IN(19) + (size_t)layer * NE * 2048;
            pg8::gemm_phase<true, true, pg8::EpiSwiglu>(lds, tid, gp, n_my, E, REP_MOE1 > 1 ? n_my / 2 : (1 << 20));
        }
        GRID_BAR();

        {
            PHASE_BEGIN();
            LAS int* TS = (LAS int*)(lds + TS_OFF);
            const int nM = TS[NE];
            const int n_my = pg8::build_units(lds, tid, nM, 4, G, bx, true, nullptr, REP_MOE2);
            pg8::GemmP gp; gp.A = (const char*)(ws + WS_ACT); gp.lda2 = D; gp.acol_pn = 0; gp.Bt = (const char*)(ws + WS_WDN + (size_t)layer * NE * 1024 * 1024); gp.b_estride = (size_t)1024 * 1024; gp.Kb = 1024; gp.sA = E8_ACT; gp.sB = E8_W;
            pg8::EpiMoe2 E; E.Y = (unsigned char*)(ws + WS_Y); E.bdn = ARG_IN(21) + (size_t)layer * NE * D; E.rowdst = (const int*)(ws + WS_RDST); E.rowgate = (const float*)(ws + WS_RGATE);
            pg8::gemm_phase<false, true, pg8::EpiMoe2>(lds, tid, gp, n_my, E);
        }
        GRID_BAR();

        {
            PHASE_BEGIN();
            const bf16* X1b = (const bf16*)(ws + WS_X1B); const unsigned char* Y = (const unsigned char*)(ws + WS_Y); float* OUT = ARG_OUT(); bf16* XAb = (bf16*)(ws + WS_XAB);
            float lg[16], lb[16];
#pragma unroll
            for (int q = 0; q < 4; ++q) { const f32x4 b = gld<f32x4>(ARG_IN(22) + layer * D + 16 * lane + 4 * q), c = gld<f32x4>(ARG_IN(23) + layer * D + 16 * lane + 4 * q);
#pragma unroll
                for (int i = 0; i < 4; ++i) { lg[4 * q + i] = b[i]; lb[4 * q + i] = c[i]; } }
            for (int rep = 0; rep < REP_THIN; ++rep)
            for (int tb = vcu; tb < T / 128; tb += G) {
                const int t0 = tb * 128 + wave * 16;
                v4u nx[2], ny[4];
#pragma unroll
                for (int j = 0; j < 2; ++j) nx[j] = gld<v4u>(X1b + (size_t)t0 * D + 16 * lane + 8 * j);
#pragma unroll
                for (int k = 0; k < 4; ++k) ny[k] = gld<v4u>(Y + (size_t)(t0 * 4 + k) * D + 16 * lane);
                for (int ti = 0; ti < 16; ++ti) {
                    const int t = t0 + ti;
                    float v[16], h[16];
                    unpack8(nx[0], v); unpack8(nx[1], v + 8);
#pragma unroll
                    for (int i = 0; i < 16; ++i) h[i] = 0.f;
#pragma unroll
                    for (int k = 0; k < 4; ++k) { const unsigned wd[4] = {ny[k].x, ny[k].y, ny[k].z, ny[k].w};
#pragma unroll
                        for (int d = 0; d < 4; ++d) { const f32x2 lo = __builtin_amdgcn_cvt_pk_f32_fp8((int)wd[d], false), hi = __builtin_amdgcn_cvt_pk_f32_fp8((int)wd[d], true);
                            h[4 * d] += lo[0]; h[4 * d + 1] += lo[1]; h[4 * d + 2] += hi[0]; h[4 * d + 3] += hi[1]; } }
                    if (ti + 1 < 16) {
#pragma unroll
                        for (int j = 0; j < 2; ++j) nx[j] = gld<v4u>(X1b + (size_t)(t + 1) * D + 16 * lane + 8 * j);
#pragma unroll
                        for (int k = 0; k < 4; ++k) ny[k] = gld<v4u>(Y + (size_t)((t + 1) * 4 + k) * D + 16 * lane); }
#pragma unroll
                    for (int i = 0; i < 16; ++i) v[i] = v[i] * ALPHA + h[i] * (1.0f / SY8);
                    ln16(v, lg, lb, lane);
                    if (layer == DEPTH - 1) {
#pragma unroll
                        for (int q = 0; q < 4; ++q) gst<f32x4>(OUT + (size_t)t * D + 16 * lane + 4 * q, (f32x4){v[4 * q], v[4 * q + 1], v[4 * q + 2], v[4 * q + 3]});
                    } else {
                        gst<v4u>(XAb + (size_t)t * D + 16 * lane, pack8(v));
                        gst<v4u>(XAb + (size_t)t * D + 16 * lane + 8, pack8(v + 8));
                    }
                }
            }
        }
        if (layer + 1 < DEPTH) GRID_BAR();
    }
}

extern "C" void kernel_launch(void* const* d_in, const int* in_sizes, int n_in, void* d_out, int out_size, void* d_ws, size_t ws_size, hipStream_t stream) {
    static int grid = 0;
    if (grid == 0) {
        if (n_in != 24 || out_size != T * D || ws_size < WS_END) { fprintf(stderr, "kernel_launch: unexpected shapes (n_in %d out %d ws %zu)\n", n_in, out_size, ws_size); grid = -1; return; }
        if (hipFuncSetAttribute((const void*)mega_fwd, hipFuncAttributeMaxDynamicSharedMemorySize, LDS_BYTES) != hipSuccess) { fprintf(stderr, "kernel_launch: hipFuncSetAttribute failed\n"); grid = -1; return; }
        int dev = 0, cus = 0, per_cu = 0;
        (void)hipGetDevice(&dev); (void)hipDeviceGetAttribute(&cus, hipDeviceAttributeMultiprocessorCount, dev);
        if (hipOccupancyMaxActiveBlocksPerMultiprocessor(&per_cu, (const void*)mega_fwd, NTHR, LDS_BYTES) != hipSuccess || per_cu < 1) fprintf(stderr, "kernel_launch: occupancy query reports %d blocks per CU\n", per_cu);
        (void)hipGetLastError();
        grid = 256; if (cus > 0 && cus < grid) grid = cus;
    }
    if (grid < 0) return;
    (void)hipMemsetAsync((char*)d_ws + WS_CTL, 0, CTL_ZERO_BYTES, stream);
    Args a{};
    for (int i = 0; i < 24; ++i) a.in[i] = (const float*)d_in[i];
    a.out = (float*)d_out; a.ws = (unsigned char*)d_ws;
    hipLaunchKernelGGL(mega_fwd, dim3(grid), dim3(NTHR), LDS_BYTES, stream, a);
    const hipError_t le = hipPeekAtLastError();
    if (le != hipSuccess) fprintf(stderr, "kernel_launch: launch failed: %s\n", hipGetErrorName(le));
}
```

```cpp
#include <hip/hip_runtime.h>
#include <cstdio>
#include <cstdint>

#define GAS __attribute__((address_space(1)))
#define LAS __attribute__((address_space(3)))
typedef unsigned short bf16;
typedef unsigned v4u __attribute__((ext_vector_type(4)));
typedef unsigned v2u __attribute__((ext_vector_type(2)));
typedef float f32x4 __attribute__((ext_vector_type(4)));
typedef float f32x2 __attribute__((ext_vector_type(2)));
typedef short bf16x8 __attribute__((ext_vector_type(8)));
typedef int v4i __attribute__((ext_vector_type(4)));
typedef int v8i __attribute__((ext_vector_type(8)));

template <class V> __device__ __forceinline__ V gld(const void* p) { return *(const GAS V*)p; }
template <class V> __device__ __forceinline__ void gst(void* p, V v) { *(GAS V*)p = v; }

#ifndef REP_P0
#define REP_P0 1
#endif
#ifndef REP_MOE1
#define REP_MOE1 1
#endif
#ifndef REP_MOE2
#define REP_MOE2 1
#endif
#ifndef REP_THIN
#define REP_THIN 1
#endif
#ifndef REP_MIXG
#define REP_MIXG 1
#endif
#ifndef REP_LNR
#define REP_LNR 1
#endif
#ifndef REP_BAR
#define REP_BAR 1
#endif
#ifndef PROBE_CLOCK
#define PROBE_CLOCK 0
#endif
#ifndef SC_OUT_FP8
#define SC_OUT_FP8 0
#endif
#ifndef SC_IN_FP8
#define SC_IN_FP8 1
#endif
#ifndef CF_OUT_FP8
#define CF_OUT_FP8 1
#endif
#ifndef CF_IN_FP8
#define CF_IN_FP8 1
#endif
#ifndef REP_EPI1
#define REP_EPI1 1
#endif
#ifndef REP_EPI2
#define REP_EPI2 1
#endif
constexpr int T = 32768, D = 1024, SEQ = 4096, NE = 32, TOPK = 4, NA = T * TOPK, DEPTH = 4;
constexpr int MAXTILES = NA / 256 + NE;
constexpr int ECAP = T, ETILES = ECAP / 256;
constexpr int NPAD = MAXTILES * 256;
constexpr float LN_EPS = 1e-5f;
constexpr float ALPHA = 1.681792830507429f;
constexpr int NWAVES = 8, NTHR = 512;
constexpr int MAXU = 19;
constexpr float SX8 = 16.0f, SACT8 = 4.0f, SW8 = 256.0f, SY8 = 32.0f;
constexpr int E8_X = 0x7B7B7B7B  , E8_ACT = 0x7D7D7D7D  , E8_W = 0x77777777  ;

constexpr size_t MiB = 1u << 20;
constexpr size_t WS_CTL = 0, CTL_ZERO_BYTES = 64 * 1024;
constexpr size_t WS_IDX = 1 * MiB;
constexpr size_t WS_GATE = 1 * MiB + 512 * 1024;
constexpr size_t WS_RTOK = 1712 * MiB;
constexpr size_t WS_RDST = 3 * MiB;
constexpr size_t WS_RGATE = 1716 * MiB;
constexpr size_t WS_WPOOL = 5 * MiB;
constexpr size_t WS_WSCIN = 6 * MiB;
constexpr size_t WS_WSCOUT = 12 * MiB;
constexpr size_t WS_WCFIN = 14 * MiB;
constexpr size_t WS_WCFOUT = 18 * MiB;
constexpr size_t WS_WGU = 32 * MiB;
constexpr size_t WS_WDN = 544 * MiB;
constexpr size_t WS_X18 = 704 * MiB;
constexpr size_t WS_ZB = 800 * MiB;
constexpr size_t WS_XAB = 864 * MiB;
constexpr size_t WS_M1 = 992 * MiB;
constexpr size_t WS_M2 = 1056 * MiB;
constexpr size_t WS_M3 = 1120 * MiB;
constexpr size_t WS_ACT = 1720 * MiB;
constexpr size_t WS_Y = 2744 * MiB;
constexpr size_t WS_END = 3768 * MiB;
constexpr int CW_BAR = 4096;
constexpr int CW_CNT = 8192;
constexpr int CW_CUR = 8192 + 256;
constexpr int CW_DQ = 8192 + 512;
constexpr int CW_GDONE = 8192 + 512 + 64;

constexpr int RING_OFF = 0, RING_BYTES = 131072;
constexpr int TOK_OFF = RING_BYTES;
constexpr int UT_OFF = TOK_OFF + MAXU * 1024;
constexpr int TS_OFF = UT_OFF + (2 * MAXU + 2) * 16;
constexpr int MISC_OFF = TS_OFF + 36 * 4;
constexpr int EPI_OFF = ((MISC_OFF + 128 * 4 + 255) / 256) * 256;
constexpr int LDS_BYTES = EPI_OFF + 2 * 4096;
static_assert(LDS_BYTES <= 160 * 1024 && (MISC_OFF % 16) == 0, "LDS map");

#define LDS_WAIT() asm volatile("s_waitcnt lgkmcnt(0)" ::: "memory")
#define VM_WAIT() asm volatile("s_waitcnt vmcnt(0)" ::: "memory")

__device__ __forceinline__ unsigned cvt_pk_bf16(float lo, float hi) { unsigned r; asm volatile("v_cvt_pk_bf16_f32 %0, %1, %2" : "=v"(r) : "v"(lo), "v"(hi)); return r; }
__device__ __forceinline__ v2u pack8_fp8(const float* c) {
    int a = __builtin_amdgcn_cvt_pk_fp8_f32(c[0], c[1], 0, false); a = __builtin_amdgcn_cvt_pk_fp8_f32(c[2], c[3], a, true);
    int b = __builtin_amdgcn_cvt_pk_fp8_f32(c[4], c[5], 0, false); b = __builtin_amdgcn_cvt_pk_fp8_f32(c[6], c[7], b, true); v2u w; w.x = (unsigned)a; w.y = (unsigned)b; return w; }
__device__ __forceinline__ v2u pack8_fp8_sat(const float* v) { float c[8];
    float lim = 448.0f; asm volatile("" : "+v"(lim));
#pragma unroll
    for (int i = 0; i < 8; ++i) c[i] = __builtin_amdgcn_fmed3f(v[i], -lim, lim);
    return pack8_fp8(c); }
__device__ __forceinline__ float bf_lo(unsigned u) { return __uint_as_float(u << 16); }
__device__ __forceinline__ float bf_hi(unsigned u) { return __uint_as_float(u & 0xffff0000u); }
__device__ __forceinline__ float sigmoidf_(float x) { return __builtin_amdgcn_rcpf(1.0f + __expf(-x)); }
#define DPP_F(v, ctrl) __int_as_float(__builtin_amdgcn_update_dpp(0, __float_as_int(v), (ctrl), 0xf, 0xf, true))
#define DPP_XOR1 0xB1
#define DPP_XOR2 0x4E
#define DPP_QREV 0x1B
#define DPP_HMIR 0x141
#define DPP_RMIR 0x140
#define DPP_ROR8 0x128
__device__ __forceinline__ float rdlane(float v, int l) { return __uint_as_float((unsigned)__builtin_amdgcn_readlane((int)__float_as_uint(v), l)); }
__device__ __forceinline__ float wave_sum(float v, int lane) {
    (void)lane;
    v += DPP_F(v, DPP_XOR1); v += DPP_F(v, DPP_XOR2); v += DPP_F(v, DPP_HMIR); v += DPP_F(v, DPP_RMIR);
    return (rdlane(v, 0) + rdlane(v, 16)) + (rdlane(v, 32) + rdlane(v, 48));
}

#define XB_TMO      128
#define XB_XCNT(j)  (256  + 64 * (j))
#define XB_XSUB(j)  (1280 + 64 * (j))
#define XB_XGEN(j)  (2304 + 64 * (j))
#define XB_TOP      3328
#define XB_TOPGEN   3392
#define XCD_BAR_WORDS 3456
#define XB_SPIN_CAP (1u << 18)

__device__ __forceinline__ unsigned xb_ld(unsigned* p)              { return __hip_atomic_load((GAS unsigned*)p, __ATOMIC_RELAXED, __HIP_MEMORY_SCOPE_AGENT); }
__device__ __forceinline__ unsigned xb_add(unsigned* p, unsigned v) { return __hip_atomic_fetch_add((GAS unsigned*)p, v, __ATOMIC_RELAXED, __HIP_MEMORY_SCOPE_AGENT); }
__device__ __forceinline__ unsigned xb_xcc_id() { return (unsigned)__builtin_amdgcn_s_getreg((3 << 11) | 20) & 0xFu; }
#define XB_SPIN(cond, bar) do { unsigned _sp = 0; while (cond) { __builtin_amdgcn_s_sleep(1); \
    if ((++_sp & 255u) == 0u) { if (xb_ld(&(bar)[XB_TMO])) break; if (_sp > XB_SPIN_CAP) { (void)xb_add(&(bar)[XB_TMO], 1u); break; } } } } while (0)

struct XcdBarrier { unsigned* bar; unsigned x; volatile LAS unsigned* st; };

__device__ __forceinline__ XcdBarrier xcd_barrier_post(unsigned* bar, volatile LAS unsigned* st) {
    XcdBarrier b; b.bar = bar; b.x = xb_xcc_id(); b.st = st;
    if (threadIdx.x == 0) (void)xb_add(&bar[XB_XCNT(b.x)], 1u);
    return b;
}
__device__ __forceinline__ void xcd_barrier_complete(unsigned* bar, unsigned x, unsigned& nloc, unsigned& nx) {
    const unsigned G = gridDim.x * gridDim.y * gridDim.z;
    unsigned sum, cnt, mine, sp = 0u;
    for (;;) {
        sum = 0u; cnt = 0u; mine = 0u;
#pragma unroll
        for (unsigned j = 0; j < 16; ++j) { const unsigned c = xb_ld(&bar[XB_XCNT(j)]); sum += c; cnt += (c > 0u) ? 1u : 0u; mine = (j == x) ? c : mine; }
        if (sum == G) break;
        __builtin_amdgcn_s_sleep(1);
        if ((++sp & 255u) == 0u) { if (xb_ld(&bar[XB_TMO])) break; if (sp > XB_SPIN_CAP) { (void)xb_add(&bar[XB_TMO], 1u); break; } }
    }
    nloc = mine > 0u ? mine : 1u; nx = cnt > 0u ? cnt : 1u;
}
__device__ __forceinline__ void xcd_barrier(const XcdBarrier& b) {
    asm volatile("s_waitcnt vmcnt(0)" ::: "memory");
    __syncthreads();
    if (threadIdx.x == 0) {
        unsigned* bar = b.bar;
        __builtin_amdgcn_s_waitcnt(0);
        unsigned nloc = b.st[0], nx = b.st[1];
        if (nloc == 0u) { xcd_barrier_complete(bar, b.x, nloc, nx); b.st[0] = nloc; b.st[1] = nx; }
        const unsigned old = xb_add(&bar[XB_XSUB(b.x)], 1u);
        const unsigned gen = old / nloc;
        if (old + 1u == (gen + 1u) * nloc) {
            __builtin_amdgcn_fence(__ATOMIC_RELEASE, "agent");
            asm volatile("s_waitcnt vmcnt(0)" ::: "memory");
            const unsigned og = xb_add(&bar[XB_TOP], 1u);
            const unsigned tg = og / nx;
            if (og + 1u == (tg + 1u) * nx) xb_add(&bar[XB_TOPGEN], 1u);
            else XB_SPIN(xb_ld(&bar[XB_TOPGEN]) == tg, bar);
            __builtin_amdgcn_fence(__ATOMIC_ACQUIRE, "agent");
            xb_add(&bar[XB_XGEN(b.x)], 1u);
            asm volatile("s_waitcnt vmcnt(0)" ::: "memory");
        } else {
            XB_SPIN(xb_ld(&bar[XB_XGEN(b.x)]) == gen, bar);
            __builtin_amdgcn_fence(__ATOMIC_ACQUIRE, "agent");
            asm volatile("s_waitcnt vmcnt(0)" ::: "memory");
        }
    }
    __syncthreads();
}

__device__ __forceinline__ bool xcd_barrier_arrive(const XcdBarrier& b) {
    asm volatile("s_waitcnt vmcnt(0)" ::: "memory");
    __syncthreads();
    if (threadIdx.x == 0) {
        unsigned* bar = b.bar;
        __builtin_amdgcn_s_waitcnt(0);
        unsigned nloc = b.st[0], nx = b.st[1];
        if (nloc == 0u) { xcd_barrier_complete(bar, b.x, nloc, nx); b.st[0] = nloc; b.st[1] = nx; }
        const unsigned old = xb_add(&bar[XB_XSUB(b.x)], 1u);
        const unsigned gen = old / nloc;
        b.st[9] = gen; b.st[10] = (old + 1u == (gen + 1u) * nloc) ? 1u : 0u;
    }
    __syncthreads();
    return __builtin_amdgcn_readfirstlane((int)b.st[10]) != 0;
}
__device__ __forceinline__ void xcd_barrier_finish(const XcdBarrier& b) {
    __syncthreads();
    if (threadIdx.x == 0) {
        unsigned* bar = b.bar;
        const unsigned gen = b.st[9], nx = b.st[1];
        if (b.st[10] != 0u) {
            __builtin_amdgcn_fence(__ATOMIC_RELEASE, "agent");
            asm volatile("s_waitcnt vmcnt(0)" ::: "memory");
            const unsigned og = xb_add(&bar[XB_TOP], 1u);
            const unsigned tg = og / nx;
            if (og + 1u == (tg + 1u) * nx) xb_add(&bar[XB_TOPGEN], 1u);
            else XB_SPIN(xb_ld(&bar[XB_TOPGEN]) == tg, bar);
            __builtin_amdgcn_fence(__ATOMIC_ACQUIRE, "agent");
            xb_add(&bar[XB_XGEN(b.x)], 1u);
            asm volatile("s_waitcnt vmcnt(0)" ::: "memory");
        } else {
            XB_SPIN(xb_ld(&bar[XB_XGEN(b.x)]) == gen, bar);
            __builtin_amdgcn_fence(__ATOMIC_ACQUIRE, "agent");
            asm volatile("s_waitcnt vmcnt(0)" ::: "memory");
        }
    }
    __syncthreads();
}

namespace pg8 {
constexpr int BM = 256, BK = 64, HALF = 128, HTB = HALF * BK * 2, STAGE_BYTES = 8 * HTB, NXCD = 8, WGM = 8;
__host__ __device__ __forceinline__ int lds_byte(int r, int c) { const int st = (r >> 4) * 2 + (c >> 5), rr = r & 15, cc = c & 31, ob = rr * 64 + cc * 2; return st * 1024 + (ob ^ (((ob >> 9) & 1) << 5)); }
__host__ __device__ __forceinline__ void stage_rc(int b, int& R, int& C) { const int st = b / 1024, sb = b % 1024, swz = sb ^ (((sb >> 9) & 1) << 5); R = (st >> 1) * 16 + swz / 64; C = (st & 1) * 32 + (swz % 64) / 2; }
__host__ __device__ __forceinline__ int perm32(int rho) { const int n = rho >> 4, i = rho & 15; return 8 * (i >> 2) + 4 * n + (i & 3); }

struct Unit { int pm, pn, e; };
struct GemmP {
    const char* A; unsigned lda2;
    unsigned acol_pn;
    const char* Bt; size_t b_estride;
    int Kb;
    int sA, sB;
};

__device__ __forceinline__ void unit_of(int L, int nM, int nN, int& pm, int& pn) {
    const int nwg = nM * nN;
    int wgid = L; { const int q = nwg / NXCD, r = nwg % NXCD, xcd = wgid % NXCD, off = wgid / NXCD; wgid = (xcd < r ? xcd * (q + 1) : r * (q + 1) + (xcd - r) * q) + off; }
    const int nig = WGM * nN, gid = wgid / nig, fm = gid * WGM, gsz = (nM - fm) < WGM ? (nM - fm) : WGM;
    pm = fm + ((wgid % nig) % gsz); pn = (wgid % nig) / gsz;
}
__device__ __forceinline__ int build_units(LAS unsigned char* lds, const int tid, int nM, int nN, int G, int c, bool moe, const int* row_tok, const int dup = 1) {
    LAS int* UT = (LAS int*)(lds + UT_OFF); LAS const int* TS = (LAS const int*)(lds + TS_OFF); LAS int* TOK = (LAS int*)(lds + TOK_OFF);
    LAS const int* CNTL = (LAS const int*)(lds + MISC_OFF) + 64;
    const int nwg = nM * nN;
    int n_my = (nwg > c) ? (nwg - c + G - 1) / G : 0; if (n_my > MAXU) n_my = MAXU;
    if (tid < n_my) {
        int pm, pn; unit_of(tid * G + c, nM, nN, pm, pn);
        int e = 0, j = 0; if (moe) { int lo = 1, hi = NE;
#pragma unroll
            for (int it = 0; it < 5; ++it) { const int mid = (lo + hi) >> 1; if (TS[mid] > pm) hi = mid; else lo = mid + 1; }
            e = lo - 1; j = pm - TS[e]; pm = e * ETILES + j; }
        UT[4 * tid + 0] = pm; UT[4 * tid + 1] = pn; UT[4 * tid + 2] = e; UT[4 * tid + 3] = j;
    }
    __syncthreads();
    if (row_tok) {
        for (int idx = tid; idx < n_my * 256; idx += NTHR) { const int i = idx >> 8, r = idx & 255; const bool valid = UT[4 * i + 3] * 256 + r < CNTL[UT[4 * i + 2]];
            TOK[idx] = valid ? gld<int>(row_tok + UT[4 * i] * 256 + r) : 0; }
    }
    __syncthreads();
    if (dup > 1) { if (tid < n_my) { UT[4 * (tid + n_my) + 0] = UT[4 * tid]; UT[4 * (tid + n_my) + 1] = UT[4 * tid + 1]; UT[4 * (tid + n_my) + 2] = UT[4 * tid + 2]; UT[4 * (tid + n_my) + 3] = UT[4 * tid + 3]; } __syncthreads(); return 2 * n_my; }
    return n_my;
}
__device__ __forceinline__ Unit read_unit(LAS const int* UT, int i) {
    Unit u; u.pm = __builtin_amdgcn_readfirstlane(UT[4 * i]); u.pn = __builtin_amdgcn_readfirstlane(UT[4 * i + 1]); u.e = __builtin_amdgcn_readfirstlane(UT[4 * i + 2]); return u;
}
template <bool GATHER>
__device__ __forceinline__ void a_offsets(unsigned (&v)[2][2], const GemmP& g, const Unit& u, int ui, const int (&Rr)[2], const int (&Cc2)[2], LAS const int* TOK, const int tokn) {
#pragma unroll
    for (int h = 0; h < 2; ++h)
#pragma unroll
        for (int i = 0; i < 2; ++i) {
            const int row = GATHER ? TOK[(ui >= tokn ? ui - tokn : ui) * 256 + h * HALF + Rr[i]] : (u.pm * BM + h * HALF + Rr[i]);
            v[h][i] = (unsigned)row * g.lda2 + (unsigned)Cc2[i] + (unsigned)u.pn * g.acol_pn;
        }
}

template <bool GATHER, bool FP8, class Epi>
__device__ __forceinline__ void gemm_phase(LAS unsigned char* lds, const int tid, const GemmP g, const int n_my, const Epi& E, const int tokn = 1 << 20, unsigned* last_ctr = nullptr) {
    const int wid = __builtin_amdgcn_readfirstlane(tid >> 6), lane = tid & 63, wr = wid >> 2, wc = wid & 3, fr = lane & 15, fq = lane >> 4;
    const int Kb = g.Kb, nt = Kb / (BK * 2);
    if (n_my <= 0) return;
    int Rr[2], Cc2[2]; unsigned voffB[2];
#pragma unroll
    for (int i = 0; i < 2; ++i) { int R, C; stage_rc(tid * 16 + i * 8192, R, C); const int Rb = Epi::PERM ? ((R & ~31) + perm32(R & 31)) : R;
        Rr[i] = R; Cc2[i] = C * 2; voffB[i] = (unsigned)(Rb * Kb + C * 2); }
    const size_t kstep = (size_t)(BK * 2);
    const size_t hstep = (size_t)HALF * Kb;
    const size_t tstepB = 2 * hstep;
    const unsigned ldsw = (unsigned)wid * 1024u;
    const int aoff = lds_byte(wr * 64 + fr, fq * 8), boff = lds_byte(wc * 32 + fr, fq * 8);
    LAS const int* UT = (LAS const int*)(lds + UT_OFF); LAS const int* TOK = (LAS const int*)(lds + TOK_OFF);
#define PG8_SA(b, h) (((b) * 2 + (h)) * HTB)
#define PG8_SB(b, h) ((4 + (b) * 2 + (h)) * HTB)
#define PG8_STAGE(bufoff, gbase, voff) do { _Pragma("unroll") for (int _i = 0; _i < 2; ++_i) \
        __builtin_amdgcn_global_load_lds((const unsigned*)((const char*)(gbase) + (voff)[_i]), (LAS unsigned*)(lds + (bufoff) + ldsw + _i * 8192), 16, 0, 0); } while (0)
#define PG8_LDA(dst, b, h) do { _Pragma("unroll") for (int m = 0; m < 4; ++m) _Pragma("unroll") for (int k = 0; k < 2; ++k) dst[m][k] = *(const LAS bf16x8*)(lds + PG8_SA(b, h) + aoff + m * 2048 + k * 1024); } while (0)
#define PG8_LDB(dst, b, h) do { _Pragma("unroll") for (int n = 0; n < 2; ++n) _Pragma("unroll") for (int k = 0; k < 2; ++k) dst[n][k] = *(const LAS bf16x8*)(lds + PG8_SB(b, h) + boff + n * 2048 + k * 1024); } while (0)
#define PG8_CAT(x) __builtin_shufflevector(__builtin_bit_cast(v4i, (x)[0]), __builtin_bit_cast(v4i, (x)[1]), 0, 1, 2, 3, 4, 5, 6, 7)
#define PG8_MMA(ai, bj, At, Bt) do { __builtin_amdgcn_s_setprio(1); _Pragma("unroll") for (int m = 0; m < 4; ++m) _Pragma("unroll") for (int n = 0; n < 2; ++n) { \
        if constexpr (FP8) { const v8i b8_ = PG8_CAT(Bt[n]), a8_ = PG8_CAT(At[m]); asm volatile("v_mfma_scale_f32_16x16x128_f8f6f4 %0, %1, %2, %0, %3, %4 op_sel_hi:[0,0,0]" : "+v"(acc[ai][bj][m][n]) : "v"(b8_), "v"(a8_), "v"(vsB), "v"(vsA)); } \
        else { _Pragma("unroll") for (int k = 0; k < 2; ++k) acc[ai][bj][m][n] = __builtin_amdgcn_mfma_f32_16x16x32_bf16(Bt[n][k], At[m][k], acc[ai][bj][m][n], 0, 0, 0); } } \
        __builtin_amdgcn_s_setprio(0); } while (0)
#define PG8_MMA0(ai, bj, At, Bt) do { __builtin_amdgcn_s_setprio(1); _Pragma("unroll") for (int m = 0; m < 4; ++m) _Pragma("unroll") for (int n = 0; n < 2; ++n) { \
        if constexpr (FP8) { const v8i b8_ = PG8_CAT(Bt[n]), a8_ = PG8_CAT(At[m]); asm volatile("v_mfma_scale_f32_16x16x128_f8f6f4 %0, %1, %2, 0, %3, %4 op_sel_hi:[0,0,0]" : "=&v"(acc[ai][bj][m][n]) : "v"(b8_), "v"(a8_), "v"(vsB), "v"(vsA)); } \
        else { acc[ai][bj][m][n] = __builtin_amdgcn_mfma_f32_16x16x32_bf16(Bt[n][0], At[m][0], (f32x4){0.f, 0.f, 0.f, 0.f}, 0, 0, 0); acc[ai][bj][m][n] = __builtin_amdgcn_mfma_f32_16x16x32_bf16(Bt[n][1], At[m][1], acc[ai][bj][m][n], 0, 0, 0); } } \
        __builtin_amdgcn_s_setprio(0); } while (0)
#define PG8_WAIT_V(n) asm volatile("s_waitcnt vmcnt(" #n ")" ::: "memory")
#define PG8_WAIT_L(n) asm volatile("s_waitcnt lgkmcnt(" #n ")" ::: "memory")
#define PG8_BAR __builtin_amdgcn_s_barrier()
#define PG8_SCHED __builtin_amdgcn_sched_barrier(0)
    Unit cur = read_unit(UT, 0), nxt; int ui = 0;
    f32x4 acc[2][2][4][2];
    if constexpr (!FP8) {
#pragma unroll
    for (int a = 0; a < 2; ++a)
#pragma unroll
        for (int b = 0; b < 2; ++b)
#pragma unroll
            for (int m = 0; m < 4; ++m)
#pragma unroll
                for (int n = 0; n < 2; ++n) acc[a][b][m][n] = (f32x4){0.f, 0.f, 0.f, 0.f};
    }
#define PG8_PIN_ACC() do { if constexpr (FP8) { _Pragma("unroll") for (int a_ = 0; a_ < 2; ++a_) _Pragma("unroll") for (int b_ = 0; b_ < 2; ++b_) \
        asm volatile("" : "+v"(acc[a_][b_][0][0]), "+v"(acc[a_][b_][0][1]), "+v"(acc[a_][b_][1][0]), "+v"(acc[a_][b_][1][1]), "+v"(acc[a_][b_][2][0]), "+v"(acc[a_][b_][2][1]), "+v"(acc[a_][b_][3][0]), "+v"(acc[a_][b_][3][1])); \
        asm volatile("s_nop 1" ::: "memory"); } } while (0)
    bf16x8 At[4][2], B0[2][2], B1[2][2];
    int vsA = g.sA, vsB = g.sB; asm volatile("" : "+v"(vsA), "+v"(vsB));
    unsigned vAc[2][2], vAn[2][2];
    a_offsets<GATHER>(vAc, g, cur, 0, Rr, Cc2, TOK, tokn);
    const char* const Ab = g.A;
    const char* cB = g.Bt + (size_t)cur.e * g.b_estride + (size_t)cur.pn * tstepB;
    PG8_STAGE(PG8_SB(0, 0), cB, voffB); PG8_STAGE(PG8_SB(0, 1), cB + hstep, voffB); PG8_STAGE(PG8_SA(0, 0), Ab, vAc[0]); PG8_STAGE(PG8_SA(0, 1), Ab, vAc[1]);
    if (wr == 1) PG8_BAR;
    PG8_WAIT_V(2); PG8_BAR;
    PG8_STAGE(PG8_SB(1, 0), cB + kstep, voffB); PG8_STAGE(PG8_SA(1, 0), Ab + kstep, vAc[0]); PG8_STAGE(PG8_SB(1, 1), cB + hstep + kstep, voffB);
    PG8_WAIT_V(6); PG8_BAR;
    for (;;) {
        const bool has_next = (ui + 1 < n_my);
        if (!has_next && last_ctr != nullptr && tid == 0) (void)xb_add(last_ctr, 1u);
        nxt = cur; if (has_next) nxt = read_unit(UT, ui + 1);
        const char* nB = has_next ? g.Bt + (size_t)nxt.e * g.b_estride + (size_t)nxt.pn * tstepB : cB;
        for (int t = 0; t < nt; t += 2) {
            const bool last = (t == nt - 2);
            if (t == 0) E.prefetch(lds + EPI_OFF + (ui & 1) * 4096, cur, wid, lane);
            const char* a1 = Ab + (size_t)(t + 1) * kstep;
            const char* a2 = last ? Ab : Ab + (size_t)(t + 2) * kstep; const char* b2 = last ? nB : cB + (size_t)(t + 2) * kstep;
            const char* a3 = a2 + kstep; const char* b3 = b2 + kstep;
            unsigned o2[2][2];
            if (last) {
                if (has_next) a_offsets<GATHER>(vAn, g, nxt, ui + 1, Rr, Cc2, TOK, tokn);
                else { vAn[0][0] = vAc[0][0]; vAn[0][1] = vAc[0][1]; vAn[1][0] = vAc[1][0]; vAn[1][1] = vAc[1][1]; }
                o2[0][0] = vAn[0][0]; o2[0][1] = vAn[0][1]; o2[1][0] = vAn[1][0]; o2[1][1] = vAn[1][1];
            } else { o2[0][0] = vAc[0][0]; o2[0][1] = vAc[0][1]; o2[1][0] = vAc[1][0]; o2[1][1] = vAc[1][1]; }
            PG8_LDB(B0, 0, 0); PG8_LDB(B1, 0, 1); PG8_SCHED; PG8_LDA(At, 0, 0); PG8_STAGE(PG8_SA(1, 1), a1, vAc[1]);
            PG8_WAIT_V(8); PG8_WAIT_L(0); PG8_BAR; if (FP8 && t == 0) { PG8_MMA0(0, 0, At, B0); PG8_MMA0(0, 1, At, B1); } else { PG8_MMA(0, 0, At, B0); PG8_MMA(0, 1, At, B1); } PG8_BAR; PG8_SCHED;
            PG8_LDA(At, 0, 1); PG8_STAGE(PG8_SB(0, 0), b2, voffB); PG8_STAGE(PG8_SB(0, 1), b2 + hstep, voffB); PG8_STAGE(PG8_SA(0, 0), a2, o2[0]);
            PG8_WAIT_V(8); PG8_WAIT_L(0); PG8_BAR; if (FP8 && t == 0) { PG8_MMA0(1, 0, At, B0); PG8_MMA0(1, 1, At, B1); } else { PG8_MMA(1, 0, At, B0); PG8_MMA(1, 1, At, B1); } PG8_BAR; PG8_SCHED;
            PG8_LDB(B0, 1, 0); PG8_LDB(B1, 1, 1); PG8_SCHED; PG8_LDA(At, 1, 0); PG8_STAGE(PG8_SA(0, 1), a2, o2[1]);
            PG8_WAIT_V(8); PG8_WAIT_L(0); PG8_BAR; PG8_MMA(0, 0, At, B0); PG8_MMA(0, 1, At, B1); PG8_BAR; PG8_SCHED;
            PG8_LDA(At, 1, 1); PG8_STAGE(PG8_SB(1, 0), b3, voffB); PG8_STAGE(PG8_SB(1, 1), b3 + hstep, voffB); PG8_STAGE(PG8_SA(1, 0), a3, o2[0]);
            PG8_WAIT_V(8); PG8_WAIT_L(0); PG8_BAR; PG8_MMA(1, 0, At, B0); PG8_MMA(1, 1, At, B1); PG8_BAR; PG8_SCHED;
        }
        if (wr == 0) PG8_BAR;
        if constexpr (FP8) asm volatile("s_nop 15" ::: "memory");
        for (int re_ = 0; re_ < Epi::REPS; ++re_) E(acc, cur, wr, wc, fr, fq, lds + EPI_OFF + (ui & 1) * 4096);
        if (!has_next) break;
        if constexpr (!FP8) {
#pragma unroll
        for (int a = 0; a < 2; ++a)
#pragma unroll
            for (int b = 0; b < 2; ++b)
#pragma unroll
                for (int m = 0; m < 4; ++m)
#pragma unroll
                    for (int n = 0; n < 2; ++n) acc[a][b][m][n] = (f32x4){0.f, 0.f, 0.f, 0.f};
        }
        cur = nxt; cB = nB; ++ui;
        vAc[0][0] = vAn[0][0]; vAc[0][1] = vAn[0][1]; vAc[1][0] = vAn[1][0]; vAc[1][1] = vAn[1][1];
        if (wr == 1) PG8_BAR;
    }
    PG8_WAIT_V(0);
    PG8_BAR;
#undef PG8_SA
#undef PG8_SB
#undef PG8_STAGE
#undef PG8_LDA
#undef PG8_LDB
#undef PG8_MMA
#undef PG8_MMA0
#undef PG8_PIN_ACC
#undef PG8_CAT
#undef PG8_WAIT_V
#undef PG8_WAIT_L
#undef PG8_BAR
#undef PG8_SCHED
}

__device__ __forceinline__ v4u widen16(const v2u X, const v2u Y) {
    const auto a = __builtin_amdgcn_permlane16_swap(X.x, Y.x, false, false), b = __builtin_amdgcn_permlane16_swap(X.y, Y.y, false, false);
    v4u o; o.x = a[0]; o.y = b[0]; o.z = a[1]; o.w = b[1]; return o;
}
struct EpiOut {
    static constexpr bool PERM = true; static constexpr int REPS = 1;
    const bf16* xres; const float* xres32; bf16* z; const float* bias; const float* scale;
    __device__ __forceinline__ void prefetch(LAS unsigned char*, const Unit&, int, int) const {}
    __device__ __forceinline__ void operator()(const f32x4 (&acc)[2][2][4][2], const Unit& u, int wr, int wc, int fr, int fq, const LAS unsigned char*) const {
        const int row0 = u.pm * BM + wr * 64 + fr, c0 = u.pn * BM + wc * 32 + 8 * fq;
        f32x4 bv[2][2], sv[2][2];
#pragma unroll
        for (int bj = 0; bj < 2; ++bj)
#pragma unroll
            for (int n = 0; n < 2; ++n) {
                bv[bj][n] = bias ? gld<f32x4>(bias + c0 + bj * HALF + 4 * n) : (f32x4){0.f, 0.f, 0.f, 0.f};
                sv[bj][n] = scale ? gld<f32x4>(scale + c0 + bj * HALF + 4 * n) : (f32x4){1.f, 1.f, 1.f, 1.f};
            }
#pragma unroll
        for (int ai = 0; ai < 2; ++ai)
#pragma unroll
            for (int m = 0; m < 4; ++m) { const size_t off = (size_t)(row0 + ai * HALF + m * 16) * D + c0;
#pragma unroll
                for (int bj = 0; bj < 2; ++bj) { f32x4 x0, x1;
                    if (xres32) { x0 = gld<f32x4>(xres32 + off + bj * HALF); x1 = gld<f32x4>(xres32 + off + bj * HALF + 4); }
                    else { const v4u xr = gld<v4u>(xres + off + bj * HALF); x0 = (f32x4){bf_lo(xr.x), bf_hi(xr.x), bf_lo(xr.y), bf_hi(xr.y)}; x1 = (f32x4){bf_lo(xr.z), bf_hi(xr.z), bf_lo(xr.w), bf_hi(xr.w)}; }
                    const f32x4 o0 = x0 * ALPHA + (acc[ai][bj][m][0] + bv[bj][0]) * sv[bj][0], o1 = x1 * ALPHA + (acc[ai][bj][m][1] + bv[bj][1]) * sv[bj][1];
                    v4u w; w.x = cvt_pk_bf16(o0[0], o0[1]); w.y = cvt_pk_bf16(o0[2], o0[3]); w.z = cvt_pk_bf16(o1[0], o1[1]); w.w = cvt_pk_bf16(o1[2], o1[3]);
                    gst<v4u>(z + off + bj * HALF, w); }
                asm volatile("" ::: "memory"); }
    }
};
struct EpiPair {
    static constexpr bool PERM = true; static constexpr int REPS = 1;
    bf16* O1; bf16* O2; const float* bias; int mode;
    __device__ __forceinline__ void prefetch(LAS unsigned char*, const Unit&, int, int) const {}
    __device__ __forceinline__ void operator()(const f32x4 (&acc)[2][2][4][2], const Unit& u, int wr, int wc, int fr, int fq, const LAS unsigned char*) const {
        const int row0 = u.pm * BM + wr * 64 + fr;
        if (u.pn < 8) {
            const int j0 = u.pn * HALF + wc * 32 + 8 * fq;
            f32x4 b1[2], b2[2];
#pragma unroll
            for (int n = 0; n < 2; ++n) { b1[n] = mode ? gld<f32x4>(bias + j0 + 4 * n) : (f32x4){0.f, 0.f, 0.f, 0.f}; b2[n] = mode ? gld<f32x4>(bias + 1024 + j0 + 4 * n) : (f32x4){0.f, 0.f, 0.f, 0.f}; }
#pragma unroll
            for (int ai = 0; ai < 2; ++ai)
#pragma unroll
                for (int m = 0; m < 4; ++m) { bf16* rowp = O1 + (size_t)(row0 + ai * HALF + m * 16) * D + j0; f32x4 r[2];
#pragma unroll
                    for (int n = 0; n < 2; ++n) { const f32x4 g1 = acc[ai][0][m][n] + b1[n], g2 = acc[ai][1][m][n] + b2[n];
                        if (mode) { r[n][0] = g1[0] * sigmoidf_(g2[0]); r[n][1] = g1[1] * sigmoidf_(g2[1]); r[n][2] = g1[2] * sigmoidf_(g2[2]); r[n][3] = g1[3] * sigmoidf_(g2[3]); }
                        else r[n] = g1 * g2; }
                    v4u w; w.x = cvt_pk_bf16(r[0][0], r[0][1]); w.y = cvt_pk_bf16(r[0][2], r[0][3]); w.z = cvt_pk_bf16(r[1][0], r[1][1]); w.w = cvt_pk_bf16(r[1][2], r[1][3]);
                    gst<v4u>(rowp, w); }
        } else {
            const int c0 = (u.pn - 8) * BM + wc * 32 + 8 * fq;
#pragma unroll
            for (int ai = 0; ai < 2; ++ai)
#pragma unroll
                for (int m = 0; m < 4; ++m) { bf16* rowp = O2 + (size_t)(row0 + ai * HALF + m * 16) * D + c0;
#pragma unroll
                    for (int bj = 0; bj < 2; ++bj) { const f32x4 v0 = acc[ai][bj][m][0], v1 = acc[ai][bj][m][1];
                        v4u w; w.x = cvt_pk_bf16(v0[0], v0[1]); w.y = cvt_pk_bf16(v0[2], v0[3]); w.z = cvt_pk_bf16(v1[0], v1[1]); w.w = cvt_pk_bf16(v1[2], v1[3]);
                        gst<v4u>(rowp + bj * HALF, w); } }
        }
    }
};
struct EpiSwiglu {
    static constexpr bool PERM = true; static constexpr int REPS = REP_EPI1;
    unsigned char* act; const float* bgu;
    __device__ __forceinline__ void prefetch(LAS unsigned char* slot, const Unit& u, int wid, int lane) const {
        if (wid == 0) __builtin_amdgcn_global_load_lds((const unsigned*)(bgu + (size_t)u.e * 2048 + 2 * u.pn * HALF + 4 * lane), (LAS unsigned*)slot, 16, 0, 0);
    }
    __device__ __forceinline__ void operator()(const f32x4 (&acc)[2][2][4][2], const Unit& u, int wr, int wc, int fr, int fq, const LAS unsigned char* slot) const {
        const int row0 = u.pm * BM + wr * 64 + fr, j0 = u.pn * HALF + wc * 32 + 8 * fq;
        const LAS float* bp = (const LAS float*)slot + 2 * (wc * 32 + 8 * fq);
        f32x2 gb[4], ub[4];
#pragma unroll
        for (int i = 0; i < 4; ++i) { const f32x4 b = *(const LAS f32x4*)(bp + 4 * i); gb[i] = (f32x2){b[0], b[2]}; ub[i] = (f32x2){b[1], b[3]}; }
        const f32x2 q4 = {1.0f / SACT8, 1.0f / SACT8}, kc = {-1.702f * 1.4426950408889634f, -1.702f * 1.4426950408889634f};
        const int j16 = u.pn * HALF + wc * 32 + 16 * (fq >> 1); v2u wprev = {0u, 0u};
#pragma unroll
        for (int ai = 0; ai < 2; ++ai)
#pragma unroll
            for (int m = 0; m < 4; ++m) { float r[8];
#pragma unroll
                for (int p = 0; p < 4; ++p) { const int n = p >> 1, q = 2 * (p & 1);
                    f32x2 g = (f32x2){acc[ai][0][m][n][q], acc[ai][0][m][n][q + 1]} + gb[p];
                    f32x2 uu = (f32x2){acc[ai][1][m][n][q], acc[ai][1][m][n][q + 1]} + ub[p];
                    g[0] = fminf(g[0], 7.0f); g[1] = fminf(g[1], 7.0f);
                    uu[0] = __builtin_amdgcn_fmed3f(uu[0], -7.0f, 7.0f); uu[1] = __builtin_amdgcn_fmed3f(uu[1], -7.0f, 7.0f);
                    f32x2 t = g * kc; t[0] = __builtin_amdgcn_exp2f(t[0]); t[1] = __builtin_amdgcn_exp2f(t[1]);
                    f32x2 d = __builtin_elementwise_fma(t, q4, q4); d[0] = __builtin_amdgcn_rcpf(d[0]); d[1] = __builtin_amdgcn_rcpf(d[1]);
                    const f32x2 o = __builtin_elementwise_fma(uu, g, g) * d;
                    r[2 * p] = o[0]; r[2 * p + 1] = o[1]; }
                const v2u w8 = pack8_fp8(r);
                if (m & 1) { const v4u o16 = widen16(wprev, w8);
                    gst<v4u>(act + (size_t)(row0 + ai * HALF + (m - 1 + (fq & 1)) * 16) * D + j16, o16); }
                else wprev = w8; }
    }
};
struct EpiMoe2 {
    static constexpr bool PERM = true; static constexpr int REPS = REP_EPI2;
    unsigned char* Y; const float* bdn; const float* rowgate;
    __device__ __forceinline__ void prefetch(LAS unsigned char* slot, const Unit& u, int wid, int lane) const {
        if (wid == 0) __builtin_amdgcn_global_load_lds((const unsigned*)(bdn + (size_t)u.e * D + u.pn * BM + 4 * lane), (LAS unsigned*)slot, 16, 0, 0);
        else if (wid == 1) __builtin_amdgcn_global_load_lds((const unsigned*)(rowgate + u.pm * BM + 4 * lane), (LAS unsigned*)(slot + 1024), 16, 0, 0);
    }
    __device__ __forceinline__ void operator()(const f32x4 (&acc)[2][2][4][2], const Unit& u, int wr, int wc, int fr, int fq, const LAS unsigned char* slot) const {
        const int pos0 = wr * 64 + fr, c16 = u.pn * BM + wc * 32 + 16 * (fq >> 1);
        const LAS float* bp = (const LAS float*)slot + wc * 32 + 8 * fq;
        f32x4 bv[2][2]; v2u wprev[2] = {{0u, 0u}, {0u, 0u}};
#pragma unroll
        for (int bj = 0; bj < 2; ++bj)
#pragma unroll
            for (int n = 0; n < 2; ++n) bv[bj][n] = *(const LAS f32x4*)(bp + bj * HALF + 4 * n);
#pragma unroll
        for (int ai = 0; ai < 2; ++ai)
#pragma unroll
            for (int m = 0; m < 4; ++m) { const int pos = pos0 + ai * HALF + m * 16; const float s = *((const LAS float*)(slot + 1024) + pos) * SY8;
#pragma unroll
                for (int bj = 0; bj < 2; ++bj) { const f32x4 v0 = (acc[ai][bj][m][0] + bv[bj][0]) * s, v1 = (acc[ai][bj][m][1] + bv[bj][1]) * s;
                    const float r[8] = {v0[0], v0[1], v0[2], v0[3], v1[0], v1[1], v1[2], v1[3]};
                    const v2u w8 = pack8_fp8(r);
                    if (m & 1) { const v4u o16 = widen16(wprev[bj], w8);
                        gst<v4u>(Y + (size_t)(u.pm * BM + pos0 + ai * HALF + (m - 1 + (fq & 1)) * 16) * D + c16 + bj * HALF, o16); }
                    else wprev[bj] = w8; } }
    }
};
}

__device__ __forceinline__ int chq(int lane, int q) { return (q >> 1) * 512 + 8 * lane + (q & 1) * 4; }
__device__ __forceinline__ v4u pack8(const float* v) { v4u w; w.x = cvt_pk_bf16(v[0], v[1]); w.y = cvt_pk_bf16(v[2], v[3]); w.z = cvt_pk_bf16(v[4], v[5]); w.w = cvt_pk_bf16(v[6], v[7]); return w; }
__device__ __forceinline__ void unpack8(const v4u w, float* v) { v[0] = bf_lo(w.x); v[1] = bf_hi(w.x); v[2] = bf_lo(w.y); v[3] = bf_hi(w.y); v[4] = bf_lo(w.z); v[5] = bf_hi(w.z); v[6] = bf_lo(w.w); v[7] = bf_hi(w.w); }

__device__ __forceinline__ int drow_of(int mode, int c) {
    if (mode == 1) { const int j = c >> 1, p = c & 1; return (j >> 7) * 256 + p * 128 + (j & 127); }
    if (mode == 2) { if (c < 1024) return 2048 + c; const int j = (c - 1024) & 1023, p = (c - 1024) >> 10; return (j >> 7) * 256 + p * 128 + (j & 127); }
    if (mode == 3) { const int j = c & 1023, p = c >> 10; return (j >> 7) * 256 + p * 128 + (j & 127); }
    return c;
}
struct TItem { const float* src; unsigned char* dst; int N, Kout  , k0, n0, mode, fp8; };
__device__ __forceinline__ void titem_load(const TItem& d, int lane, float (&tmp)[32]) {
#pragma unroll
    for (int i = 0; i < 32; ++i) { const int kk = 2 * i + (lane >> 5); tmp[i] = gld<float>(d.src + (size_t)(d.k0 + kk) * d.N + d.n0 + (lane & 31)); }
}
__device__ __forceinline__ void titem_store(const TItem& d, int lane, LAS float* scr, const float (&tmp)[32]) {
#pragma unroll
    for (int i = 0; i < 32; ++i) { const int kk = 2 * i + (lane >> 5); scr[kk * 33 + (lane & 31)] = tmp[i]; }
    LDS_WAIT(); asm volatile("" ::: "memory");
    const int c = lane & 7;
#pragma unroll
    for (int j = 0; j < 4; ++j) { const int n = (lane >> 3) + 8 * j; const LAS float* s = scr + (8 * c) * 33 + n;
        float v[8];
#pragma unroll
        for (int i = 0; i < 8; ++i) v[i] = s[i * 33];
        const size_t e = (size_t)drow_of(d.mode, d.n0 + n) * d.Kout + d.k0 + 8 * c;
        if (d.fp8) {
#pragma unroll
            for (int i = 0; i < 8; ++i) v[i] *= SW8;
            gst<v2u>(d.dst + e, pack8_fp8_sat(v));
        } else gst<v4u>(d.dst + 2 * e, pack8(v)); }
    LDS_WAIT(); asm volatile("" ::: "memory");
}

struct Args { const float* in[24]; float* out; unsigned char* ws; };
#define CAS __attribute__((address_space(4)))
__device__ __forceinline__ const void* karg_ptr(int off) {
    const CAS char* kp = (const CAS char*)__builtin_amdgcn_kernarg_segment_ptr();
    asm volatile("" : "+s"(off));
    return *(const void* const CAS*)(kp + off);
}
#define ARG_IN(i) ((const float*)karg_ptr(8 * (i)))
#define ARG_OUT() ((float*)karg_ptr(8 * 24))
#define ARG_WS() ((unsigned char*)karg_ptr(8 * 25))

constexpr int TPITCH = 129, TBUF = 128 * TPITCH;
constexpr int NT_GU = 128 * 8 * 16, NT_DN = 128 * 8 * 8, NT = NT_GU + NT_DN;
constexpr int NQ = 4096 + 2048, NT_P0 = NQ, NCONV1 = 16, NCONV2 = 0;
__host__ __device__ __forceinline__ int qtile(int L, int k) { return k < 4096 ? L * 4096 + k : NT_GU + L * 2048 + (k - 4096); }
struct WTile { const float* src; unsigned char* dst; int N, nb, kb, mode; };
#define WT_DECODE(ti_, d_) do { int r_ = (ti_); if (r_ < NT_GU) { const int mt_ = r_ >> 7; r_ &= 127; (d_).kb = r_ >> 4; (d_).nb = r_ & 15; (d_).N = 2048; (d_).mode = 1; \
                (d_).src = ARG_IN(18) + (size_t)mt_ * 1024 * 2048; (d_).dst = ws + WS_WGU + (size_t)mt_ * 2048 * 1024; } \
            else { r_ -= NT_GU; const int mt_ = r_ >> 6; r_ &= 63; (d_).kb = r_ >> 3; (d_).nb = r_ & 7; (d_).N = 1024; (d_).mode = 0; \
                (d_).src = ARG_IN(20) + (size_t)mt_ * 1024 * 1024; (d_).dst = ws + WS_WDN + (size_t)mt_ * 1024 * 1024; } } while (0)
#define WT_LOAD(R_, d_) do { _Pragma("unroll") for (int i = 0; i < 16; ++i) R_[i] = __builtin_nontemporal_load((const GAS v2u*)((d_).src + (size_t)((d_).kb * 128 + wave * 16 + i) * (d_).N + (d_).nb * 128 + 2 * lane)); } while (0)
#define WT_TOLDS(R_, buf_) do { const int col_ = (2 * lane + 4 * wave) & 127; _Pragma("unroll") for (int i = 0; i < 16; ++i) { LAS float* p_ = tl + (buf_) * TBUF + (wave * 16 + i) * TPITCH + col_; \
                p_[0] = __uint_as_float(R_[i].x); p_[1] = __uint_as_float(R_[i].y); } } while (0)
#define WT_OUT(d_, buf_) do { const int kc_ = tid & 7; _Pragma("unroll") for (int p = 0; p < 2; ++p) { const int n_ = (tid >> 3) + 64 * p; const LAS float* s_ = tl + (buf_) * TBUF + (16 * kc_) * TPITCH + ((n_ + 4 * kc_) & 127); \
                float v_[16]; _Pragma("unroll") for (int i = 0; i < 16; ++i) v_[i] = s_[i * TPITCH] * SW8; \
                const v2u a_ = pack8_fp8_sat(v_), b_ = pack8_fp8_sat(v_ + 8); v4u o_; o_.x = a_.x; o_.y = a_.y; o_.z = b_.x; o_.w = b_.y; \
                gst<v4u>((d_).dst + (size_t)drow_of((d_).mode, (d_).nb * 128 + n_) * 1024 + (d_).kb * 128 + 16 * kc_, o_); } } while (0)
#define WT_BAR() do { LDS_WAIT(); __builtin_amdgcn_s_barrier(); asm volatile("" ::: "memory"); } while (0)
constexpr int CBAND = 16 * 512 + 32, CBUF = 8 * CBAND;
static_assert(RING_OFF + 2 * CBUF <= UT_OFF, "converter buffers");
#define CV_DMA(d_, buf_) do { const char* gp_ = (const char*)((d_).src + (size_t)((d_).kb * 128 + wave * 16 + (lane >> 5)) * (d_).N + (d_).nb * 128 + 4 * (lane & 31)); \
        _Pragma("unroll") for (int j = 0; j < 8; ++j) __builtin_amdgcn_global_load_lds((const unsigned*)(gp_ + (size_t)(2 * j) * (d_).N * 4), (LAS unsigned*)(lds + RING_OFF + (buf_) * CBUF + wave * CBAND + j * 1024), 16, 0, 2); } while (0)
#define CV_OUT(d_, buf_) do { const int kq_ = tid & 7; _Pragma("unroll") for (int p = 0; p < 2; ++p) { const int n_ = (tid >> 3) + 64 * p; const LAS float* s_ = (const LAS float*)(lds + RING_OFF + (buf_) * CBUF + kq_ * CBAND) + n_; \
                float v_[16]; _Pragma("unroll") for (int i = 0; i < 16; ++i) v_[i] = s_[i * 128] * SW8; \
                const v2u a_ = pack8_fp8_sat(v_), b_ = pack8_fp8_sat(v_ + 8); v4u o_; o_.x = a_.x; o_.y = a_.y; o_.z = b_.x; o_.w = b_.y; \
                gst<v4u>((d_).dst + (size_t)drow_of((d_).mode, (d_).nb * 128 + n_) * 1024 + (d_).kb * 128 + 16 * kq_, o_); } } while (0)
#define CV_SYNC() do { LDS_WAIT(); __builtin_amdgcn_s_barrier(); asm volatile("" ::: "memory"); } while (0)
#define CONV_RUN(L_, maxpairs_, stopp_, stopn_) do { \
    int wv_ = wave0; unsigned z_ = 0u; asm volatile("" : "+s"(wv_), "+s"(z_)); int tid = (wv_ << 6) | (int)__builtin_amdgcn_mbcnt_hi(~0u, __builtin_amdgcn_mbcnt_lo(~0u, z_)); asm volatile("" : "+v"(tid)); const int lane = tid & 63, wave = wave0; (void)lane; (void)wave;   \
    unsigned char* wsq_ = ARG_WS(); asm volatile("" : "+s"(wsq_)); unsigned char* ws = wsq_; unsigned* dq_ = (unsigned*)(ws + WS_CTL) + CW_DQ + (L_); unsigned* sp_ = (stopp_); \
    WTile d0, d1; int left_ = (maxpairs_); unsigned sf_ = 0u; \
    __syncthreads(); \
    if (tid == 0) { unsigned a_ = 0xFFFFFFFFu, b_ = 0xFFFFFFFFu; if (sp_) sf_ = (xb_ld(sp_) >= (unsigned)(stopn_)) ? 1u : 0u; if (!sf_) { a_ = xb_add(dq_, 2u); if (left_ > 1) b_ = xb_add(dq_, 2u); } MISC[4] = a_; MISC[5] = b_; } \
    __syncthreads(); \
    unsigned kcur_ = (unsigned)__builtin_amdgcn_readfirstlane((int)MISC[4]), knxt_ = (unsigned)__builtin_amdgcn_readfirstlane((int)MISC[5]); left_ -= 2; \
    d0.src = nullptr; d1.src = nullptr; \
    if (kcur_ < (unsigned)NQ) { WT_DECODE(qtile((L_), (int)kcur_), d0); WT_DECODE(qtile((L_), (int)kcur_ + 1), d1); CV_DMA(d0, 0); CV_DMA(d1, 1); } \
    while (kcur_ < (unsigned)NQ) { \
        unsigned nk_ = 0xFFFFFFFFu, dv_ = 0u; \
        if (tid == 0) { if (left_ > 0 && !sf_) nk_ = xb_add(dq_, 2u); if (sp_) dv_ = xb_ld(sp_); } \
        --left_; \
        const bool vn_ = knxt_ < (unsigned)NQ; WTile e0 = d0, e1 = d1; \
        if (vn_) { WT_DECODE(qtile((L_), (int)knxt_), e0); WT_DECODE(qtile((L_), (int)knxt_ + 1), e1); } \
        asm volatile("s_waitcnt vmcnt(8)" ::: "memory"); CV_SYNC(); CV_OUT(d0, 0); CV_SYNC(); if (vn_) CV_DMA(e0, 0); \
        if (vn_) asm volatile("s_waitcnt vmcnt(8)" ::: "memory"); else asm volatile("s_waitcnt vmcnt(0)" ::: "memory"); \
        CV_SYNC(); CV_OUT(d1, 1); CV_SYNC(); if (vn_) CV_DMA(e1, 1); \
        if (tid == 0) { MISC[4] = nk_; if (sp_ && dv_ >= (unsigned)(stopn_)) sf_ = 1u; } \
        __syncthreads(); kcur_ = knxt_; knxt_ = (unsigned)__builtin_amdgcn_readfirstlane((int)MISC[4]); d0 = e0; d1 = e1; \
    } \
    __syncthreads(); } while (0)

#define PHASE_BEGIN() \
    int wv_ = wave0; unsigned z_ = 0u; asm volatile("" : "+s"(wv_), "+s"(z_)); int tid = (wv_ << 6) | (int)__builtin_amdgcn_mbcnt_hi(~0u, __builtin_amdgcn_mbcnt_lo(~0u, z_)); asm volatile("" : "+v"(tid)); \
    const int lane = tid & 63, wave = wave0; \
    unsigned char* ws_ = ARG_WS(); asm volatile("" : "+s"(ws_)); unsigned char* ws = (unsigned char*)(GAS unsigned char*)ws_; \
    unsigned* ctl = (unsigned*)(ws + WS_CTL); \
    const int gw = vcu * NWAVES + wave, NGW = G * NWAVES; (void)gw; (void)NGW; (void)lane; (void)ctl;

__device__ __forceinline__ float butterfly32(float (&p)[32], int lane) {
#pragma unroll
    for (int i = 0; i < 16; ++i) { const auto r = __builtin_amdgcn_permlane32_swap(__float_as_uint(p[i]), __float_as_uint(p[i + 16]), false, false); p[i] = __uint_as_float(r[0]) + __uint_as_float(r[1]); }
#pragma unroll
    for (int i = 0; i < 8; ++i) { const auto r = __builtin_amdgcn_permlane16_swap(__float_as_uint(p[i]), __float_as_uint(p[i + 8]), false, false); p[i] = __uint_as_float(r[0]) + __uint_as_float(r[1]); }
#pragma unroll
    for (int i = 0; i < 4; ++i) { const bool hi = (lane & 8) != 0; const float snd = hi ? p[i] : p[i + 4]; const float keep = hi ? p[i + 4] : p[i]; p[i] = keep + DPP_F(snd, DPP_ROR8); }
#pragma unroll
    for (int i = 0; i < 2; ++i) { const bool hi = (lane & 4) != 0; const float snd = hi ? p[i] : p[i + 2]; const float keep = hi ? p[i + 2] : p[i]; const float x = DPP_F(snd, DPP_HMIR); p[i] = keep + DPP_F(x, DPP_QREV); }
    { const bool hi = (lane & 2) != 0; const float snd = hi ? p[0] : p[1]; const float keep = hi ? p[1] : p[0]; p[0] = keep + DPP_F(snd, DPP_XOR2); }
    return p[0] + DPP_F(p[0], DPP_XOR1);
}
__device__ __forceinline__ void ln16(float (&v)[16], const float (&lg)[16], const float (&lb)[16], int lane) {
    float sm = 0.f;
#pragma unroll
    for (int i = 0; i < 16; ++i) sm += v[i];
    const float mean = wave_sum(sm, lane) * (1.0f / D);
    float sq = 0.f;
#pragma unroll
    for (int i = 0; i < 16; ++i) { v[i] -= mean; sq += v[i] * v[i]; }
    const float rstd = 1.0f / sqrtf(wave_sum(sq, lane) * (1.0f / D) + LN_EPS);
#pragma unroll
    for (int i = 0; i < 16; ++i) v[i] = v[i] * rstd * lg[i] + lb[i];
}
__device__ __forceinline__ void route_token(const float logit, const int myexp, const int lane, const int t, int* TIDX, float* TGATE, LAS unsigned* hist, const bool count) {
    int rank = 0;
#pragma unroll
    for (int e = 0; e < 32; ++e) rank += (rdlane(logit, 2 * e) > logit) ? 1 : 0;
    unsigned long long mk[4]; bool clean = true;
#pragma unroll
    for (int r = 0; r < 4; ++r) { mk[r] = __ballot(rank == r); clean = clean && (__builtin_popcountll(mk[r]) == 2); }
    if (__builtin_expect(!clean, 0)) {
        asm volatile("" ::: "memory");
        rank = 0;
#pragma unroll
        for (int e = 0; e < 32; ++e) { const float se = rdlane(logit, 2 * e); rank += (se > logit || (se == logit && e < myexp)) ? 1 : 0; }
#pragma unroll
        for (int r = 0; r < 4; ++r) mk[r] = __ballot(rank == r);
    }
    float tv[4]; int tix[4];
#pragma unroll
    for (int r = 0; r < 4; ++r) { const int src = (int)__builtin_ctzll(mk[r] | (1ull << 63)); tv[r] = rdlane(logit, src); tix[r] = src >> 1; }
    const float e1 = __expf(tv[1] - tv[0]), e2 = __expf(tv[2] - tv[0]), e3 = __expf(tv[3] - tv[0]);
    const float inv = 1.0f / (1.0f + e1 + e2 + e3);
    if (lane < 4) {
        const int ix = lane == 0 ? tix[0] : lane == 1 ? tix[1] : lane == 2 ? tix[2] : tix[3];
        const float gv = (lane == 0 ? 1.0f : lane == 1 ? e1 : lane == 2 ? e2 : e3) * inv;
        gst<int>(TIDX + t * 4 + lane, ix); gst<float>(TGATE + t * 4 + lane, gv);
        if (count) __hip_atomic_fetch_add(hist + ix, 1u, __ATOMIC_RELAXED, __HIP_MEMORY_SCOPE_WORKGROUP);
    }
}
__device__ __forceinline__ void ln16_lds(float (&v)[16], const LAS f32x4* lnp, int lane) {
    float sm = 0.f;
#pragma unroll
    for (int i = 0; i < 16; ++i) sm += v[i];
    const float mean = wave_sum(sm, lane) * (1.0f / D);
    float sq = 0.f;
#pragma unroll
    for (int i = 0; i < 16; ++i) { v[i] -= mean; sq += v[i] * v[i]; }
    const float rstd = 1.0f / sqrtf(wave_sum(sq, lane) * (1.0f / D) + LN_EPS);
#pragma unroll
    for (int q = 0; q < 4; ++q) { const f32x4 g4 = lnp[q * 64 + lane], b4 = lnp[(4 + q) * 64 + lane];
#pragma unroll
        for (int i = 0; i < 4; ++i) v[4 * q + i] = v[4 * q + i] * rstd * g4[i] + b4[i]; }
}
template <bool F32IN>
__device__ __forceinline__ void pool_diff_run(const float* xf, const bf16* xb, bf16* M3, int t0, int lane) {
    const int s0 = t0 & (SEQ - 1);
#pragma unroll
    for (int g = 0; g < 4; ++g) {
        const int w = 2 << g, c = 256 * g + 4 * lane;
        f32x4 r[31];
#pragma unroll
        for (int j = 0; j < w + 15; ++j) {
            const int dt = j - (w - 1);
            if (dt >= 0 || s0 != 0) {
                const size_t o = (size_t)(t0 + dt) * D + c;
                if (F32IN) r[j] = gld<f32x4>(xf + o);
                else { const v2u q = gld<v2u>(xb + o); r[j] = (f32x4){bf_lo(q.x), bf_hi(q.x), bf_lo(q.y), bf_hi(q.y)}; }
            } else r[j] = (f32x4){0.f, 0.f, 0.f, 0.f};
        }
#pragma unroll
        for (int i = 0; i < 16; ++i) {
            f32x4 sum = r[i];
#pragma unroll
            for (int j = 1; j < w; ++j) sum += r[i + j];
            const int nv = (s0 + i + 1 < w) ? s0 + i + 1 : w;
            const f32x4 df = sum * (1.0f / (float)nv) - r[i + w - 1];
            v2u o; o.x = cvt_pk_bf16(df[0], df[1]); o.y = cvt_pk_bf16(df[2], df[3]);
            gst<v2u>(M3 + (size_t)(t0 + i) * D + c, o);
        }
    }
}

__global__ void __launch_bounds__(NTHR, 2) mega_fwd(Args args) {
    extern __shared__ __attribute__((aligned(16))) unsigned char lds_raw[];
    LAS unsigned char* lds = (LAS unsigned char*)lds_raw;
    volatile LAS unsigned* MISC = (volatile LAS unsigned*)(lds + MISC_OFF);
    const int G = gridDim.x, bx = blockIdx.x;
    const int wave0 = __builtin_amdgcn_readfirstlane((int)(threadIdx.x >> 6));
    const int vcu = (G % 8 == 0) ? (bx % 8) * (G / 8) + bx / 8 : bx;
    if (threadIdx.x < 128) MISC[threadIdx.x] = 0u;
    __syncthreads();
    (void)xcd_barrier_post((unsigned*)(ARG_WS() + WS_CTL) + CW_BAR, MISC + 0);
#define GRID_BAR() do { XcdBarrier b_; unsigned* bp_ = (unsigned*)(ARG_WS() + WS_CTL) + CW_BAR; asm volatile("" : "+s"(bp_)); b_.bar = (unsigned*)(GAS unsigned*)bp_; b_.x = xb_xcc_id(); b_.st = MISC; for (int rb_ = 0; rb_ < REP_BAR; ++rb_) xcd_barrier(b_); } while (0)
#define GRID_BAR_CONV(Lq_) do { XcdBarrier b_; unsigned* bp_ = (unsigned*)(ARG_WS() + WS_CTL) + CW_BAR; asm volatile("" : "+s"(bp_)); b_.bar = (unsigned*)(GAS unsigned*)bp_; b_.x = xb_xcc_id(); b_.st = MISC; \
    const bool last_ = xcd_barrier_arrive(b_); if (!last_) CONV_RUN((Lq_), 1, nullptr, 0); xcd_barrier_finish(b_); } while (0)
#define BAR_L() do { if (layer + 1 < DEPTH) GRID_BAR_CONV(layer + 1); else GRID_BAR(); } while (0)

    {
        PHASE_BEGIN();
        {
            LAS float* tl = (LAS float*)(lds + RING_OFF);
            for (int rep = 0; rep < REP_P0; ++rep) {
                v2u R0[16], R1[16]; WTile d0, d1, dn;
                int ti = vcu;
                d0.src = nullptr; d1.src = nullptr;
                if (ti < NT_P0) { WT_DECODE(qtile(0, ti), d0); WT_LOAD(R0, d0); }
                if (ti + G < NT_P0) { WT_DECODE(qtile(0, ti + G), d1); WT_LOAD(R1, d1); }
                for (; ti < NT_P0; ti += 2 * G) {
                    WT_TOLDS(R0, 0);
                    const bool h2 = (ti + 2 * G < NT_P0);
                    if (h2) { WT_DECODE(qtile(0, ti + 2 * G), dn); WT_LOAD(R0, dn); }
                    WT_BAR();
                    WT_OUT(d0, 0);
                    if (h2) d0 = dn;
                    if (ti + G < NT_P0) {
                        WT_TOLDS(R1, 1);
                        const bool h3 = (ti + 3 * G < NT_P0);
                        if (h3) { WT_DECODE(qtile(0, ti + 3 * G), dn); WT_LOAD(R1, dn); }
                        WT_BAR();
                        WT_OUT(d1, 1);
                        if (h3) d1 = dn;
                    }
                }
                WT_BAR();
            }
        }
        LAS float* scr = (LAS float*)(lds + RING_OFF + wave * 16384);
        constexpr int I_POOL = 4 * 8, I_SCIN = 16 * 96, I_SQ = 16 * 32, I_CFIN = 16 * 64;
        constexpr int N_POOL = 8 * I_POOL;
        constexpr int NITEMS = N_POOL + I_SCIN + I_SQ + I_CFIN + I_SQ;
#define TITEM_SET(d_, src_, K_, N_, dst_, mode_, fp8_, item_) do { const int nb_ = (N_) / 32; (d_).src = (src_); (d_).dst = (unsigned char*)(dst_); (d_).N = (N_); (d_).Kout = (K_); \
        (d_).k0 = 64 * ((item_) / nb_); (d_).n0 = 32 * ((item_) % nb_); (d_).mode = (mode_); (d_).fp8 = (fp8_); } while (0)
#define TITEM_DECODE(it_, d_) do { int r_ = (it_); \
        if (r_ < N_POOL) { const int mt_ = r_ / I_POOL; TITEM_SET(d_, ARG_IN(1) + (size_t)mt_ * 256 * 256, 256, 256, ws + WS_WPOOL + (size_t)mt_ * 256 * 256 * 2, 0, 0, r_ % I_POOL); break; } r_ -= N_POOL; \
        if (r_ < I_SCIN) { TITEM_SET(d_, ARG_IN(3), 1024, 3072, ws + WS_WSCIN, 2, SC_IN_FP8, r_); break; } r_ -= I_SCIN; \
        if (r_ < I_SQ) { TITEM_SET(d_, ARG_IN(5), 1024, 1024, ws + WS_WSCOUT, 0, SC_OUT_FP8, r_); break; } r_ -= I_SQ; \
        if (r_ < I_CFIN) { TITEM_SET(d_, ARG_IN(6), 1024, 2048, ws + WS_WCFIN, 3, CF_IN_FP8, r_); break; } r_ -= I_CFIN; \
        TITEM_SET(d_, ARG_IN(12), 1024, 1024, ws + WS_WCFOUT, 0, CF_OUT_FP8, r_); } while (0)
        for (int it = gw; it < NITEMS; it += NGW) { TItem cur; float ta[32]; TITEM_DECODE(it, cur); titem_load(cur, lane, ta); titem_store(cur, lane, scr, ta); }
#undef TITEM_SET
#undef TITEM_DECODE
        { bf16* M3 = (bf16*)(ws + WS_M3);
          for (int tb = vcu; tb < T / 128; tb += G) pool_diff_run<true>(ARG_IN(0), nullptr, M3, tb * 128 + wave * 16, lane); }
    }
    GRID_BAR_CONV(1);

    for (int layer = 0; layer < DEPTH; ++layer) {
        const int kind = layer % 3;

        if (kind == 0) {
            if (layer != 0) {
                PHASE_BEGIN();
                bf16* M3 = (bf16*)(ws + WS_M3); const bf16* xb = (const bf16*)(ws + WS_XAB);
                for (int rep = 0; rep < REP_THIN; ++rep)
                for (int tb = vcu; tb < T / 128; tb += G) pool_diff_run<false>(nullptr, xb, M3, tb * 128 + wave * 16, lane);
            }
        } else {
            {
                PHASE_BEGIN();
                bf16* M1 = (bf16*)(ws + WS_M1); bf16* M2 = (bf16*)(ws + WS_M2);
                const int nN = (kind == 1) ? 12 : 8;
                const int n_my = pg8::build_units(lds, tid, T / 256, nN, G, bx, false, nullptr, REP_MIXG);
                pg8::EpiPair E; E.O1 = (kind == 1) ? M2 : M1; E.O2 = M1; E.bias = ARG_IN(7); E.mode = (kind == 1) ? 0 : 1;
                if ((CF_IN_FP8 && kind == 2) || (SC_IN_FP8 && kind == 1)) {
                    pg8::GemmP gp; gp.A = (const char*)(ws + WS_X18); gp.lda2 = D; gp.acol_pn = 0; gp.Bt = (const char*)(ws + ((kind == 1) ? WS_WSCIN : WS_WCFIN)); gp.b_estride = 0; gp.Kb = 1024; gp.sA = E8_X; gp.sB = E8_W;
                    pg8::gemm_phase<false, true, pg8::EpiPair>(lds, tid, gp, n_my, E);
                } else {
                    pg8::GemmP gp; gp.A = (const char*)(ws + WS_XAB); gp.lda2 = D * 2; gp.acol_pn = 0; gp.Bt = (const char*)(ws + ((kind == 1) ? WS_WSCIN : WS_WCFIN)); gp.b_estride = 0; gp.Kb = 2048; gp.sA = 0; gp.sB = 0;
                    pg8::gemm_phase<false, false, pg8::EpiPair>(lds, tid, gp, n_my, E);
                }
            }
            BAR_L();
            if (kind == 1) {
                PHASE_BEGIN();
                const bf16* M1 = (const bf16*)(ws + WS_M1); const bf16* M2 = (const bf16*)(ws + WS_M2); bf16* M3 = (bf16*)(ws + WS_M3);
                const float* cw = ARG_IN(4);
                float wk[3][16];
#pragma unroll
                for (int k = 0; k < 3; ++k)
#pragma unroll
                    for (int q = 0; q < 4; ++q) { const f32x4 v = gld<f32x4>(cw + k * D + chq(lane, q)); wk[k][4 * q] = v[0]; wk[k][4 * q + 1] = v[1]; wk[k][4 * q + 2] = v[2]; wk[k][4 * q + 3] = v[3]; }
                for (int rep = 0; rep < REP_THIN; ++rep)
                for (int tb = vcu; tb < T / 128; tb += G) {
                    const int t0 = tb * 128 + wave * 16, s0 = t0 & (SEQ - 1);
                    float p2[16], p1[16];
                    if (s0 != 0) { unpack8(gld<v4u>(M2 + (size_t)(t0 - 2) * D + 8 * lane), p2); unpack8(gld<v4u>(M2 + (size_t)(t0 - 2) * D + 512 + 8 * lane), p2 + 8);
                                   unpack8(gld<v4u>(M2 + (size_t)(t0 - 1) * D + 8 * lane), p1); unpack8(gld<v4u>(M2 + (size_t)(t0 - 1) * D + 512 + 8 * lane), p1 + 8); }
                    else {
#pragma unroll
                        for (int i = 0; i < 16; ++i) { p2[i] = 0.f; p1[i] = 0.f; } }
                    for (int i0 = 0; i0 < 16; i0 += 4) {
                        v4u cv[4][2], gv[4][2];
#pragma unroll
                        for (int u = 0; u < 4; ++u)
#pragma unroll
                            for (int j = 0; j < 2; ++j) { const size_t o = (size_t)(t0 + i0 + u) * D + j * 512 + 8 * lane; cv[u][j] = gld<v4u>(M2 + o); gv[u][j] = gld<v4u>(M1 + o); }
#pragma unroll
                        for (int u = 0; u < 4; ++u) {
                            float c[16], gb[16], o[16];
                            unpack8(cv[u][0], c); unpack8(cv[u][1], c + 8); unpack8(gv[u][0], gb); unpack8(gv[u][1], gb + 8);
#pragma unroll
                            for (int i = 0; i < 16; ++i) { o[i] = gb[i] * (wk[0][i] * p2[i] + wk[1][i] * p1[i] + wk[2][i] * c[i]); p2[i] = p1[i]; p1[i] = c[i]; }
                            if (SC_OUT_FP8) { float s8[16];
#pragma unroll
                                for (int i = 0; i < 16; ++i) s8[i] = o[i] * SX8;
                                unsigned char* m8 = (unsigned char*)M3 + (size_t)(t0 + i0 + u) * D; gst<v2u>(m8 + 8 * lane, pack8_fp8_sat(s8)); gst<v2u>(m8 + 512 + 8 * lane, pack8_fp8_sat(s8 + 8)); }
                            else { gst<v4u>(M3 + (size_t)(t0 + i0 + u) * D + 8 * lane, pack8(o));
                                   gst<v4u>(M3 + (size_t)(t0 + i0 + u) * D + 512 + 8 * lane, pack8(o + 8)); }
                        }
                    }
                }
            } else {
                PHASE_BEGIN();
                const bf16* U = (const bf16*)(ws + WS_M1); bf16* M3 = (bf16*)(ws + WS_M3);
                const int c = 128 * wave + 2 * lane;
                float wk0[31], wk1[31];
#pragma unroll
                for (int k = 0; k < 31; ++k) { const v2u q = gld<v2u>(ARG_IN(8) + k * D + c); wk0[k] = __uint_as_float(q.x); wk1[k] = __uint_as_float(q.y); }
                const v2u qb = gld<v2u>(ARG_IN(9) + c), qg = gld<v2u>(ARG_IN(10) + c), ql = gld<v2u>(ARG_IN(11) + c);
                const float db0 = __uint_as_float(qb.x), db1 = __uint_as_float(qb.y), lg0 = __uint_as_float(qg.x), lg1 = __uint_as_float(qg.y), lb0 = __uint_as_float(ql.x), lb1 = __uint_as_float(ql.y);
                LAS float* part = (LAS float*)(lds + RING_OFF);
                LAS float* stat = part + 256;
                LAS unsigned short* ostg = (LAS unsigned short*)(lds + RING_OFF + 4096 + wave * 2048);
                for (int rep = 0; rep < REP_THIN; ++rep)
                for (int run = vcu; run < T / 16; run += G) {
                    const int t0 = run * 16, s0 = t0 & (SEQ - 1);
                    unsigned r[46];
#pragma unroll
                    for (int j = 0; j < 46; ++j) r[j] = (s0 + j - 30 >= 0) ? gld<unsigned>(U + (size_t)(t0 + j - 30) * D + c) : 0u;
                    float a0[16], a1[16];
#pragma unroll
                    for (int i = 0; i < 16; ++i) { a0[i] = db0; a1[i] = db1; }
#pragma unroll
                    for (int j = 0; j < 46; ++j) { const float x0 = bf_lo(r[j]), x1 = bf_hi(r[j]);
#pragma unroll
                        for (int i = 0; i < 16; ++i) { const int k = j - i; if (k >= 0 && k <= 30) { a0[i] += wk0[k] * x0; a1[i] += wk1[k] * x1; } } }
                    float st[32];
#pragma unroll
                    for (int i = 0; i < 16; ++i) { st[2 * i] = a0[i] + a1[i]; st[2 * i + 1] = a0[i] * a0[i] + a1[i] * a1[i]; }
                    const float tot = butterfly32(st, lane);
                    if ((lane & 1) == 0) part[wave * 32 + (lane >> 1)] = tot;
                    __syncthreads();
                    if (tid < 16) { float S = 0.f, Q = 0.f;
#pragma unroll
                        for (int w8 = 0; w8 < 8; ++w8) { S += part[w8 * 32 + 2 * tid]; Q += part[w8 * 32 + 2 * tid + 1]; }
                        const float mean = S * (1.0f / D); const float var = fmaxf(Q * (1.0f / D) - mean * mean, 0.f);
                        stat[2 * tid] = mean; stat[2 * tid + 1] = 1.0f / sqrtf(var + LN_EPS); }
                    __syncthreads();
#pragma unroll
                    for (int i = 0; i < 16; ++i) { const float mean = stat[2 * i], rstd = stat[2 * i + 1];
                        const float y0 = (a0[i] - mean) * rstd * lg0 + lb0, y1 = (a1[i] - mean) * rstd * lg1 + lb1;
                        const float z0 = y0 * sigmoidf_(y0), z1 = y1 * sigmoidf_(y1);
                        if (CF_OUT_FP8) { const float lim = 448.0f; const int w8 = __builtin_amdgcn_cvt_pk_fp8_f32(__builtin_amdgcn_fmed3f(z0 * SX8, -lim, lim), __builtin_amdgcn_fmed3f(z1 * SX8, -lim, lim), 0, false);
                            ostg[i * 64 + lane] = (unsigned short)(w8 & 0xffff); }
                        else gst<unsigned>(M3 + (size_t)(t0 + i) * D + c, cvt_pk_bf16(z0, z1)); }
                    if (CF_OUT_FP8) {
                        LDS_WAIT();
                        const LAS v4u* rd = (const LAS v4u*)(ostg + (lane >> 2) * 64) + 2 * (lane & 3);
                        const v4u o0 = rd[0], o1 = rd[1];
                        unsigned char* dst = (unsigned char*)M3 + (size_t)(t0 + (lane >> 2)) * D + 128 * wave + 32 * (lane & 3);
                        gst<v4u>(dst, o0); gst<v4u>(dst + 16, o1);
                        LDS_WAIT();
                    }
                }
                __syncthreads();
            }
        }
        if (layer != 0) BAR_L();

        {
            PHASE_BEGIN();
            const int n_my = pg8::build_units(lds, tid, T / 256, 4, G, bx, false, nullptr, REP_MIXG);
            pg8::GemmP gp; gp.A = (const char*)(ws + WS_M3); gp.lda2 = D * 2; gp.b_estride = 0; gp.sA = 0; gp.sB = 0;
            pg8::EpiOut E; E.xres = (const bf16*)(ws + WS_XAB); E.xres32 = (layer == 0) ? ARG_IN(0) : nullptr; E.z = (bf16*)(ws + WS_ZB); E.bias = nullptr; E.scale = nullptr;
            if (kind == 0) { gp.acol_pn = 512; gp.Bt = (const char*)(ws + WS_WPOOL + (size_t)(layer / 3) * 1024 * 256 * 2); gp.Kb = 512; E.scale = ARG_IN(2) + (layer / 3) * D; }
            else if (kind == 1) { gp.acol_pn = 0; gp.Bt = (const char*)(ws + WS_WSCOUT); gp.Kb = 2048; }
            else { gp.acol_pn = 0; gp.Bt = (const char*)(ws + WS_WCFOUT); gp.Kb = 2048; E.bias = ARG_IN(13); }
            if ((SC_OUT_FP8 && kind == 1) || (CF_OUT_FP8 && kind == 2)) {
                gp.lda2 = D; gp.Kb = 1024; gp.sA = E8_X; gp.sB = E8_W;
                pg8::gemm_phase<false, true, pg8::EpiOut>(lds, tid, gp, n_my, E);
            } else
            pg8::gemm_phase<false, false, pg8::EpiOut>(lds, tid, gp, n_my, E);
        }
        BAR_L();

        if (layer > 0) CONV_RUN(layer, 1 << 30, nullptr, 0);
        {
            PHASE_BEGIN();
            const bf16* Zb = (const bf16*)(ws + WS_ZB); unsigned char* X18 = (unsigned char*)(ws + WS_X18);
            int* RTOK = (int*)(ws + WS_RTOK); float* RGATE = (float*)(ws + WS_RGATE); int* APOS = (int*)(ws + WS_RDST);
            unsigned* CUR = ctl + CW_CUR + layer * NE;
            LAS v4u* rwf = (LAS v4u*)(lds + RING_OFF);
            LAS f32x4* lnp = (LAS f32x4*)(lds + TOK_OFF);
            const float* rw = ARG_IN(16) + (size_t)layer * D * NE;
            for (int f = tid; f < 32 * 2 * 64; f += NTHR) { const int s = f >> 7, nt = (f >> 6) & 1, l = f & 63, e = 16 * nt + (l & 15), kq = l >> 4;
                float w[8], hf[8], lo[8];
#pragma unroll
                for (int j = 0; j < 8; ++j) w[j] = gld<float>(rw + (32 * s + 8 * kq + j) * NE + e);
                const v4u hp = pack8(w); unpack8(hp, hf);
#pragma unroll
                for (int j = 0; j < 8; ++j) lo[j] = w[j] - hf[j];
                rwf[((s * 2 + nt) * 2 + 0) * 64 + l] = hp; rwf[((s * 2 + nt) * 2 + 1) * 64 + l] = pack8(lo); }
            if (tid < 256) { lnp[tid] = gld<f32x4>(ARG_IN(14) + layer * D + 4 * tid); lnp[256 + tid] = gld<f32x4>(ARG_IN(15) + layer * D + 4 * tid); }
            if (tid < NE) MISC[32 + tid] = 0u;
            __syncthreads();
            const int tau = lane & 15, kg = lane >> 4;
            float rb8[8];
#pragma unroll
            for (int i = 0; i < 8; ++i) rb8[i] = gld<float>(ARG_IN(17) + layer * NE + 16 * (i >> 2) + 4 * kg + (i & 3));
            LAS unsigned* hist = (LAS unsigned*)(lds + MISC_OFF) + 32;
#define BPERM_F(v, m) __uint_as_float((unsigned)__builtin_amdgcn_ds_bpermute((lane ^ (m)) << 2, (int)__float_as_uint(v)))
#define BPERM_I(v, m) __builtin_amdgcn_ds_bpermute((lane ^ (m)) << 2, (v))
            for (int rep = 0; rep < REP_LNR; ++rep)
            for (int tb = vcu; tb < T / 128; tb += G) {
                const int t = tb * 128 + wave * 16 + tau;
                const size_t rowo = (size_t)t * D + 8 * kg;
                v4u zp[32];
#pragma unroll
                for (int s = 0; s < 32; ++s) zp[s] = gld<v4u>(Zb + rowo + 32 * s);
                f32x2 S2 = {0.f, 0.f}, Q2 = {0.f, 0.f};
#pragma unroll
                for (int s = 0; s < 32; ++s) { float v[8]; unpack8(zp[s], v);
#pragma unroll
                    for (int j = 0; j < 4; ++j) { const f32x2 p = {v[2 * j], v[2 * j + 1]}; S2 += p; Q2 = __builtin_elementwise_fma(p, p, Q2); } }
                float S = S2[0] + S2[1], Q = Q2[0] + Q2[1];
                S += BPERM_F(S, 16); Q += BPERM_F(Q, 16); S += BPERM_F(S, 32); Q += BPERM_F(Q, 32);
                const float mean = S * (1.0f / D);
                const float rstd = 1.0f / sqrtf(fmaxf(Q * (1.0f / D) - mean * mean, 0.f) + LN_EPS);
                f32x4 a0 = {0.f, 0.f, 0.f, 0.f}, a1 = {0.f, 0.f, 0.f, 0.f};
                v2u x8prev = {0u, 0u};
#pragma unroll
                for (int s = 0; s < 32; ++s) {
                    asm volatile("" : "+v"(zp[s]));
                    float v[8]; unpack8(zp[s], v);
                    const f32x4 g0 = lnp[8 * s + 2 * kg], g1 = lnp[8 * s + 2 * kg + 1], b0 = lnp[256 + 8 * s + 2 * kg], b1 = lnp[256 + 8 * s + 2 * kg + 1];
                    { const f32x2 rstd2 = {rstd, rstd}, nmr2 = {-mean * rstd, -mean * rstd};
                      const f32x2 p0 = __builtin_elementwise_fma(__builtin_elementwise_fma((f32x2){v[0], v[1]}, rstd2, nmr2), (f32x2){g0[0], g0[1]}, (f32x2){b0[0], b0[1]});
                      const f32x2 p1 = __builtin_elementwise_fma(__builtin_elementwise_fma((f32x2){v[2], v[3]}, rstd2, nmr2), (f32x2){g0[2], g0[3]}, (f32x2){b0[2], b0[3]});
                      const f32x2 p2 = __builtin_elementwise_fma(__builtin_elementwise_fma((f32x2){v[4], v[5]}, rstd2, nmr2), (f32x2){g1[0], g1[1]}, (f32x2){b1[0], b1[1]});
                      const f32x2 p3 = __builtin_elementwise_fma(__builtin_elementwise_fma((f32x2){v[6], v[7]}, rstd2, nmr2), (f32x2){g1[2], g1[3]}, (f32x2){b1[2], b1[3]});
                      v[0] = p0[0]; v[1] = p0[1]; v[2] = p1[0]; v[3] = p1[1]; v[4] = p2[0]; v[5] = p2[1]; v[6] = p3[0]; v[7] = p3[1]; }
                    const v4u xp = pack8(v);
                    { float s8[8];
#pragma unroll
                      for (int j = 0; j < 4; ++j) { const f32x2 q = (f32x2){v[2 * j], v[2 * j + 1]} * (f32x2){SX8, SX8}; s8[2 * j] = q[0]; s8[2 * j + 1] = q[1]; }
                      const v2u w8 = pack8_fp8_sat(s8);
                      if (s & 1) { const v4u o16 = pg8::widen16(x8prev, w8);
                          gst<v4u>(X18 + (size_t)t * D + 32 * (s - 1 + (kg & 1)) + 8 * (kg & ~1), o16); }
                      else x8prev = w8; }
                    const bf16x8 xb = __builtin_bit_cast(bf16x8, xp);
                    a0 = __builtin_amdgcn_mfma_f32_16x16x32_bf16(__builtin_bit_cast(bf16x8, rwf[((s * 2 + 0) * 2 + 0) * 64 + lane]), xb, a0, 0, 0, 0);
                    a0 = __builtin_amdgcn_mfma_f32_16x16x32_bf16(__builtin_bit_cast(bf16x8, rwf[((s * 2 + 0) * 2 + 1) * 64 + lane]), xb, a0, 0, 0, 0);
                    a1 = __builtin_amdgcn_mfma_f32_16x16x32_bf16(__builtin_bit_cast(bf16x8, rwf[((s * 2 + 1) * 2 + 0) * 64 + lane]), xb, a1, 0, 0, 0);
                    a1 = __builtin_amdgcn_mfma_f32_16x16x32_bf16(__builtin_bit_cast(bf16x8, rwf[((s * 2 + 1) * 2 + 1) * 64 + lane]), xb, a1, 0, 0, 0);
                }
                float val[8]; int eid[8];
#pragma unroll
                for (int r = 0; r < 4; ++r) { val[r] = a0[r] + rb8[r]; eid[r] = 4 * kg + r; val[4 + r] = a1[r] + rb8[4 + r]; eid[4 + r] = 16 + 4 * kg + r; }
                float tv[4]; int tix[4];
#pragma unroll
                for (int k = 0; k < 4; ++k) {
                    float bv = val[0]; int bi = eid[0];
#pragma unroll
                    for (int i = 1; i < 8; ++i) if (val[i] > bv) { bv = val[i]; bi = eid[i]; }
#pragma unroll
                    for (int m = 16; m <= 32; m <<= 1) { const float ov = BPERM_F(bv, m); const int oi = BPERM_I(bi, m); if (ov > bv || (ov == bv && oi < bi)) { bv = ov; bi = oi; } }
                    tv[k] = bv; tix[k] = bi;
#pragma unroll
                    for (int i = 0; i < 8; ++i) if (eid[i] == bi) val[i] = -3.0e38f;
                }
                const float e1 = __expf(tv[1] - tv[0]), e2 = __expf(tv[2] - tv[0]), e3 = __expf(tv[3] - tv[0]);
                const float inv = 1.0f / (1.0f + e1 + e2 + e3);
                unsigned rk[4] = {0u, 0u, 0u, 0u};
                if (kg == 0) {
#pragma unroll
                    for (int k = 0; k < 4; ++k) rk[k] = __hip_atomic_fetch_add(hist + tix[k], 1u, __ATOMIC_RELAXED, __HIP_MEMORY_SCOPE_WORKGROUP);
                }
                __syncthreads();
                if (tid < NE) { const unsigned c = MISC[32 + tid]; MISC[64 + tid] = c ? xb_add(CUR + tid, c) : 0u; MISC[32 + tid] = 0u; }
                __syncthreads();
                if (kg == 0) {
                    const float gk[4] = {inv, e1 * inv, e2 * inv, e3 * inv};
                    v4u ps;
#pragma unroll
                    for (int k = 0; k < 4; ++k) { const int pos = tix[k] * ECAP + (int)MISC[64 + tix[k]] + (int)rk[k]; gst<int>(RTOK + pos, t); gst<float>(RGATE + pos, gk[k]);
                        if (k == 0) ps.x = (unsigned)pos; else if (k == 1) ps.y = (unsigned)pos; else if (k == 2) ps.z = (unsigned)pos; else ps.w = (unsigned)pos; }
                    gst<v4u>(APOS + t * 4, ps);
                }
            }
#undef BPERM_F
#undef BPERM_I
        }
        BAR_L();

        {
            const bool conv_layer = (layer + 1 < DEPTH) && (G == 256);
            const int Gg = conv_layer ? G - NCONV1 : G;
            unsigned* gdone = (unsigned*)(ARG_WS() + WS_CTL) + CW_GDONE + layer * 2;
            if (bx >= Gg) { CONV_RUN(layer + 1, 1 << 30, gdone, Gg); }
            else {
            PHASE_BEGIN();
            LAS int* TS = (LAS int*)(lds + TS_OFF);
            unsigned* CUR = ctl + CW_CUR + layer * NE;
            if (tid < NE) MISC[64 + tid] = xb_ld(CUR + tid);
            __syncthreads();
            if (tid == 0) { int a = 0; for (int e = 0; e < NE; ++e) { TS[e] = a; a += (int)((MISC[64 + e] + 255u) >> 8); } TS[NE] = a; }
            __syncthreads();
            const int nM = TS[NE];
            const int n_my = pg8::build_units(lds, tid, nM, 8, Gg, bx, true, (const int*)(ws + WS_RTOK), REP_MOE1);
            pg8::GemmP gp; gp.A = (const char*)(ws + WS_X18); gp.lda2 = D; gp.acol_pn = 0; gp.Bt = (const char*)(ws + WS_WGU + (size_t)layer * NE * 2048 * 1024); gp.b_estride = (size_t)2048 * 1024; gp.Kb = 1024; gp.sA = E8_X; gp.sB = E8_W;
            pg8::EpiSwiglu E; E.act = (unsigned char*)(ws + WS_ACT); E.bgu = ARG_IN(19) + (size_t)layer * NE * 2048;
            if (n_my <= 0 && conv_layer && tid == 0) (void)xb_add(gdone, 1u);
            pg8::gemm_phase<true, true, pg8::EpiSwiglu>(lds, tid, gp, n_my, E, REP_MOE1 > 1 ? n_my / 2 : (1 << 20), conv_layer ? gdone : nullptr);
            if (layer + 1 < DEPTH && n_my < (nM * 8 * REP_MOE1 + Gg - 1) / Gg) CONV_RUN(layer + 1, 2, nullptr, 0);
            }
        }
        BAR_L();

        {
            const bool conv_layer = (layer + 1 < DEPTH) && (G == 256);
            const int Gg = conv_layer ? G - NCONV2 : G;
            unsigned* gdone = (unsigned*)(ARG_WS() + WS_CTL) + CW_GDONE + layer * 2 + 1;
            if (bx >= Gg) { CONV_RUN(layer + 1, 1 << 30, gdone, Gg); }
            else {
            PHASE_BEGIN();
            LAS int* TS = (LAS int*)(lds + TS_OFF);
            if (conv_layer && bx >= G - NCONV1) {
                unsigned* CUR = ctl + CW_CUR + layer * NE;
                if (tid < NE) MISC[64 + tid] = xb_ld(CUR + tid);
                __syncthreads();
                if (tid == 0) { int a = 0; for (int e = 0; e < NE; ++e) { TS[e] = a; a += (int)((MISC[64 + e] + 255u) >> 8); } TS[NE] = a; }
                __syncthreads();
            }
            const int nM = TS[NE];
            const int n_my = pg8::build_units(lds, tid, nM, 4, Gg, bx, true, nullptr, REP_MOE2);
            pg8::GemmP gp; gp.A = (const char*)(ws + WS_ACT); gp.lda2 = D; gp.acol_pn = 0; gp.Bt = (const char*)(ws + WS_WDN + (size_t)layer * NE * 1024 * 1024); gp.b_estride = (size_t)1024 * 1024; gp.Kb = 1024; gp.sA = E8_ACT; gp.sB = E8_W;
            pg8::EpiMoe2 E; E.Y = (unsigned char*)(ws + WS_Y); E.bdn = ARG_IN(21) + (size_t)layer * NE * D; E.rowgate = (const float*)(ws + WS_RGATE);
            if (n_my <= 0 && conv_layer && tid == 0) (void)xb_add(gdone, 1u);
            pg8::gemm_phase<false, true, pg8::EpiMoe2>(lds, tid, gp, n_my, E, 1 << 20, conv_layer ? gdone : nullptr);
            if (layer + 1 < DEPTH && n_my < (nM * 4 * REP_MOE2 + Gg - 1) / Gg) CONV_RUN(layer + 1, 2, nullptr, 0);
            }
        }
        BAR_L();

        {
            PHASE_BEGIN();
            const bf16* Zr = (const bf16*)(ws + WS_ZB); const unsigned char* Y = (const unsigned char*)(ws + WS_Y); const int* APOS = (const int*)(ws + WS_RDST); float* OUT = ARG_OUT(); bf16* XAb = (bf16*)(ws + WS_XAB);
            float lg[16], lb[16], mg[16], mb[16];
#pragma unroll
            for (int q = 0; q < 4; ++q) { const f32x4 b = gld<f32x4>(ARG_IN(22) + layer * D + 16 * lane + 4 * q), c = gld<f32x4>(ARG_IN(23) + layer * D + 16 * lane + 4 * q);
                const f32x4 b1 = gld<f32x4>(ARG_IN(14) + layer * D + 16 * lane + 4 * q), c1 = gld<f32x4>(ARG_IN(15) + layer * D + 16 * lane + 4 * q);
#pragma unroll
                for (int i = 0; i < 4; ++i) { lg[4 * q + i] = b[i]; lb[4 * q + i] = c[i]; mg[4 * q + i] = b1[i]; mb[4 * q + i] = c1[i]; } }
            for (int rep = 0; rep < REP_THIN; ++rep)
            for (int tb = vcu; tb < T / 128; tb += G) {
                const int t0 = tb * 128 + wave * 16;
                const int apos = gld<int>(APOS + t0 * 4 + lane);
#define YROW(ti_, k_) ((size_t)(unsigned)__builtin_amdgcn_readlane(apos, 4 * (ti_) + (k_)) * D)
                v4u nx[2], ny[4];
#pragma unroll
                for (int j = 0; j < 2; ++j) nx[j] = gld<v4u>(Zr + (size_t)t0 * D + 16 * lane + 8 * j);
#pragma unroll
                for (int k = 0; k < 4; ++k) ny[k] = gld<v4u>(Y + YROW(0, k) + 16 * lane);
                for (int ti = 0; ti < 16; ++ti) {
                    const int t = t0 + ti;
                    float v[16], h[16];
                    unpack8(nx[0], v); unpack8(nx[1], v + 8);
#pragma unroll
                    for (int i = 0; i < 16; ++i) h[i] = 0.f;
#pragma unroll
                    for (int k = 0; k < 4; ++k) { const unsigned wd[4] = {ny[k].x, ny[k].y, ny[k].z, ny[k].w};
#pragma unroll
                        for (int d = 0; d < 4; ++d) { const f32x2 lo = __builtin_amdgcn_cvt_pk_f32_fp8((int)wd[d], false), hi = __builtin_amdgcn_cvt_pk_f32_fp8((int)wd[d], true);
                            h[4 * d] += lo[0]; h[4 * d + 1] += lo[1]; h[4 * d + 2] += hi[0]; h[4 * d + 3] += hi[1]; } }
                    if (ti + 1 < 16) {
#pragma unroll
                        for (int j = 0; j < 2; ++j) nx[j] = gld<v4u>(Zr + (size_t)(t + 1) * D + 16 * lane + 8 * j);
#pragma unroll
                        for (int k = 0; k < 4; ++k) ny[k] = gld<v4u>(Y + YROW(ti + 1, k) + 16 * lane); }
                    ln16(v, mg, mb, lane);
#pragma unroll
                    for (int i = 0; i < 16; ++i) v[i] = v[i] * ALPHA + h[i] * (1.0f / SY8);
                    ln16(v, lg, lb, lane);
                    if (layer == DEPTH - 1) {
#pragma unroll
                        for (int q = 0; q < 4; ++q) gst<f32x4>(OUT + (size_t)t * D + 16 * lane + 4 * q, (f32x4){v[4 * q], v[4 * q + 1], v[4 * q + 2], v[4 * q + 3]});
                    } else {
                        gst<v4u>(XAb + (size_t)t * D + 16 * lane, pack8(v));
                        gst<v4u>(XAb + (size_t)t * D + 16 * lane + 8, pack8(v + 8));
                        if ((CF_IN_FP8 && layer == 1) || (SC_IN_FP8 && layer == 0)) {
                            float s8[16];
#pragma unroll
                            for (int i = 0; i < 16; ++i) s8[i] = v[i] * SX8;
                            const v2u a8 = pack8_fp8_sat(s8), b8 = pack8_fp8_sat(s8 + 8); v4u o8; o8.x = a8.x; o8.y = a8.y; o8.z = b8.x; o8.w = b8.y;
                            gst<v4u>((unsigned char*)(ws + WS_X18) + (size_t)t * D + 16 * lane, o8);
                        }
                    }
                }
            }
        }
        if (layer + 1 < DEPTH) GRID_BAR_CONV(layer + 1);
    }
    if (PROBE_CLOCK && bx == 0 && threadIdx.x == 0) {
        const unsigned mhz_ = gld<unsigned>((unsigned*)(ARG_WS() + WS_CTL) + 16); const unsigned long long t0_ = wall_clock64();
        while (wall_clock64() - t0_ < (unsigned long long)mhz_ * 10ull) __builtin_amdgcn_s_sleep(8);
    }
}

extern "C" void kernel_launch(void* const* d_in, const int* in_sizes, int n_in, void* d_out, int out_size, void* d_ws, size_t ws_size, hipStream_t stream) {
    static int grid = 0;
    if (grid == 0) {
        if (n_in != 24 || out_size != T * D || ws_size < WS_END) { fprintf(stderr, "kernel_launch: unexpected shapes (n_in %d out %d ws %zu)\n", n_in, out_size, ws_size); grid = -1; return; }
        if (hipFuncSetAttribute((const void*)mega_fwd, hipFuncAttributeMaxDynamicSharedMemorySize, LDS_BYTES) != hipSuccess) { fprintf(stderr, "kernel_launch: hipFuncSetAttribute failed\n"); grid = -1; return; }
        int dev = 0, cus = 0, per_cu = 0;
        (void)hipGetDevice(&dev); (void)hipDeviceGetAttribute(&cus, hipDeviceAttributeMultiprocessorCount, dev);
        if (hipOccupancyMaxActiveBlocksPerMultiprocessor(&per_cu, (const void*)mega_fwd, NTHR, LDS_BYTES) != hipSuccess || per_cu < 1) fprintf(stderr, "kernel_launch: occupancy query reports %d blocks per CU\n", per_cu);
        (void)hipGetLastError();
        grid = 256; if (cus > 0 && cus < grid) grid = cus;
    }
    if (grid < 0) return;
    (void)hipMemsetAsync((char*)d_ws + WS_CTL, 0, CTL_ZERO_BYTES, stream);
    Args a{};
    for (int i = 0; i < 24; ++i) a.in[i] = (const float*)d_in[i];
    a.out = (float*)d_out; a.ws = (unsigned char*)d_ws;
    hipLaunchKernelGGL(mega_fwd, dim3(grid), dim3(NTHR), LDS_BYTES, stream, a);
    const hipError_t le = hipPeekAtLastError();
    if (le != hipSuccess) fprintf(stderr, "kernel_launch: launch failed: %s\n", hipGetErrorName(le));
}
```

```cpp
#include <hip/hip_runtime.h>
#include <cstdio>
#include <cstdint>

#define GAS __attribute__((address_space(1)))
#define LAS __attribute__((address_space(3)))
typedef unsigned short bf16;
typedef unsigned v4u __attribute__((ext_vector_type(4)));
typedef unsigned v2u __attribute__((ext_vector_type(2)));
typedef float f32x4 __attribute__((ext_vector_type(4)));
typedef float f32x2 __attribute__((ext_vector_type(2)));
typedef short bf16x8 __attribute__((ext_vector_type(8)));
typedef int v4i __attribute__((ext_vector_type(4)));
typedef int v8i __attribute__((ext_vector_type(8)));

template <class V> __device__ __forceinline__ V gld(const void* p) { return *(const GAS V*)p; }
template <class V> __device__ __forceinline__ void gst(void* p, V v) { *(GAS V*)p = v; }

#ifndef REP_P0
#define REP_P0 1
#endif
#ifndef REP_MOE1
#define REP_MOE1 1
#endif
#ifndef REP_MOE2
#define REP_MOE2 1
#endif
#ifndef REP_THIN
#define REP_THIN 1
#endif
#ifndef REP_MIXG
#define REP_MIXG 1
#endif
#ifndef REP_LNR
#define REP_LNR 1
#endif
#ifndef REP_BAR
#define REP_BAR 1
#endif
#ifndef PROBE_CLOCK
#define PROBE_CLOCK 0
#endif
#ifndef SC_OUT_FP8
#define SC_OUT_FP8 0
#endif
#ifndef SC_IN_FP8
#define SC_IN_FP8 1
#endif
#ifndef CF_OUT_FP8
#define CF_OUT_FP8 1
#endif
#ifndef CF_IN_FP8
#define CF_IN_FP8 1
#endif
#ifndef REP_EPI1
#define REP_EPI1 1
#endif
#ifndef REP_EPI2
#define REP_EPI2 1
#endif
constexpr int T = 32768, D = 1024, SEQ = 4096, NE = 32, TOPK = 4, NA = T * TOPK, DEPTH = 4;
constexpr int MAXTILES = NA / 256 + NE;
constexpr int ECAP = T, ETILES = ECAP / 256;
constexpr int NPAD = MAXTILES * 256;
constexpr float LN_EPS = 1e-5f;
constexpr float ALPHA = 1.681792830507429f;
constexpr int NWAVES = 8, NTHR = 512;
constexpr int MAXU = 19;
constexpr float SX8 = 16.0f, SACT8 = 4.0f, SW8 = 256.0f, SY8 = 32.0f;
constexpr int E8_X = 0x7B7B7B7B  , E8_ACT = 0x7D7D7D7D  , E8_W = 0x77777777  ;

constexpr size_t MiB = 1u << 20;
constexpr size_t WS_CTL = 0, CTL_ZERO_BYTES = 64 * 1024;
constexpr size_t WS_IDX = 1 * MiB;
constexpr size_t WS_GATE = 1 * MiB + 512 * 1024;
constexpr size_t WS_RTOK = 1712 * MiB;
constexpr size_t WS_RDST = 3 * MiB;
constexpr size_t WS_RGATE = 1716 * MiB;
constexpr size_t WS_WPOOL = 5 * MiB;
constexpr size_t WS_WSCIN = 6 * MiB;
constexpr size_t WS_WSCOUT = 12 * MiB;
constexpr size_t WS_WCFIN = 14 * MiB;
constexpr size_t WS_WCFOUT = 18 * MiB;
constexpr size_t WS_WGU = 32 * MiB;
constexpr size_t WS_WDN = 544 * MiB;
constexpr size_t WS_X18 = 704 * MiB;
constexpr size_t WS_ZB = 800 * MiB;
constexpr size_t WS_XAB = 864 * MiB;
constexpr size_t WS_M1 = 992 * MiB;
constexpr size_t WS_M2 = 1056 * MiB;
constexpr size_t WS_M3 = 1120 * MiB;
constexpr size_t WS_ACT = 1720 * MiB;
constexpr size_t WS_Y = 2744 * MiB;
constexpr size_t WS_END = 3768 * MiB;
constexpr int CW_BAR = 4096;
constexpr int CW_CNT = 8192;
constexpr int CW_CUR = 8192 + 256;
constexpr int CW_DQ = 8192 + 512;
constexpr int CW_GDONE = 8192 + 512 + 64;

constexpr int RING_OFF = 0, RING_BYTES = 131072;
constexpr int TOK_OFF = RING_BYTES;
constexpr int UT_OFF = TOK_OFF + MAXU * 1024;
constexpr int TS_OFF = UT_OFF + (2 * MAXU + 2) * 16;
constexpr int MISC_OFF = TS_OFF + 36 * 4;
constexpr int EPI_OFF = ((MISC_OFF + 128 * 4 + 255) / 256) * 256;
constexpr int LDS_BYTES = EPI_OFF + 2 * 4096;
static_assert(LDS_BYTES <= 160 * 1024 && (MISC_OFF % 16) == 0, "LDS map");

#define LDS_WAIT() asm volatile("s_waitcnt lgkmcnt(0)" ::: "memory")
#define VM_WAIT() asm volatile("s_waitcnt vmcnt(0)" ::: "memory")

__device__ __forceinline__ unsigned cvt_pk_bf16(float lo, float hi) { unsigned r; asm volatile("v_cvt_pk_bf16_f32 %0, %1, %2" : "=v"(r) : "v"(lo), "v"(hi)); return r; }
__device__ __forceinline__ v2u pack8_fp8(const float* c) {
    int a = __builtin_amdgcn_cvt_pk_fp8_f32(c[0], c[1], 0, false); a = __builtin_amdgcn_cvt_pk_fp8_f32(c[2], c[3], a, true);
    int b = __builtin_amdgcn_cvt_pk_fp8_f32(c[4], c[5], 0, false); b = __builtin_amdgcn_cvt_pk_fp8_f32(c[6], c[7], b, true); v2u w; w.x = (unsigned)a; w.y = (unsigned)b; return w; }
__device__ __forceinline__ v2u pack8_fp8_sat(const float* v) { float c[8];
    float lim = 448.0f; asm volatile("" : "+v"(lim));
#pragma unroll
    for (int i = 0; i < 8; ++i) c[i] = __builtin_amdgcn_fmed3f(v[i], -lim, lim);
    return pack8_fp8(c); }
__device__ __forceinline__ float bf_lo(unsigned u) { return __uint_as_float(u << 16); }
__device__ __forceinline__ float bf_hi(unsigned u) { return __uint_as_float(u & 0xffff0000u); }
__device__ __forceinline__ float sigmoidf_(float x) { return __builtin_amdgcn_rcpf(1.0f + __expf(-x)); }
#define DPP_F(v, ctrl) __int_as_float(__builtin_amdgcn_update_dpp(0, __float_as_int(v), (ctrl), 0xf, 0xf, true))
#define DPP_XOR1 0xB1
#define DPP_XOR2 0x4E
#define DPP_QREV 0x1B
#define DPP_HMIR 0x141
#define DPP_RMIR 0x140
#define DPP_ROR8 0x128
__device__ __forceinline__ float rdlane(float v, int l) { return __uint_as_float((unsigned)__builtin_amdgcn_readlane((int)__float_as_uint(v), l)); }
__device__ __forceinline__ float wave_sum(float v, int lane) {
    (void)lane;
    v += DPP_F(v, DPP_XOR1); v += DPP_F(v, DPP_XOR2); v += DPP_F(v, DPP_HMIR); v += DPP_F(v, DPP_RMIR);
    return (rdlane(v, 0) + rdlane(v, 16)) + (rdlane(v, 32) + rdlane(v, 48));
}

#define XB_TMO      128
#define XB_XCNT(j)  (256  + 64 * (j))
#define XB_XSUB(j)  (1280 + 64 * (j))
#define XB_XGEN(j)  (2304 + 64 * (j))
#define XB_TOP      3328
#define XB_TOPGEN   3392
#define XCD_BAR_WORDS 3456
#define XB_SPIN_CAP (1u << 18)

__device__ __forceinline__ unsigned xb_ld(unsigned* p)              { return __hip_atomic_load((GAS unsigned*)p, __ATOMIC_RELAXED, __HIP_MEMORY_SCOPE_AGENT); }
__device__ __forceinline__ unsigned xb_add(unsigned* p, unsigned v) { return __hip_atomic_fetch_add((GAS unsigned*)p, v, __ATOMIC_RELAXED, __HIP_MEMORY_SCOPE_AGENT); }
__device__ __forceinline__ unsigned xb_xcc_id() { return (unsigned)__builtin_amdgcn_s_getreg((3 << 11) | 20) & 0xFu; }
#define XB_SPIN(cond, bar) do { unsigned _sp = 0; while (cond) { __builtin_amdgcn_s_sleep(1); \
    if ((++_sp & 255u) == 0u) { if (xb_ld(&(bar)[XB_TMO])) break; if (_sp > XB_SPIN_CAP) { (void)xb_add(&(bar)[XB_TMO], 1u); break; } } } } while (0)

struct XcdBarrier { unsigned* bar; unsigned x; volatile LAS unsigned* st; };

__device__ __forceinline__ XcdBarrier xcd_barrier_post(unsigned* bar, volatile LAS unsigned* st) {
    XcdBarrier b; b.bar = bar; b.x = xb_xcc_id(); b.st = st;
    if (threadIdx.x == 0) (void)xb_add(&bar[XB_XCNT(b.x)], 1u);
    return b;
}
__device__ __forceinline__ void xcd_barrier_complete(unsigned* bar, unsigned x, unsigned& nloc, unsigned& nx) {
    const unsigned G = gridDim.x * gridDim.y * gridDim.z;
    unsigned sum, cnt, mine, sp = 0u;
    for (;;) {
        sum = 0u; cnt = 0u; mine = 0u;
#pragma unroll
        for (unsigned j = 0; j < 16; ++j) { const unsigned c = xb_ld(&bar[XB_XCNT(j)]); sum += c; cnt += (c > 0u) ? 1u : 0u; mine = (j == x) ? c : mine; }
        if (sum == G) break;
        __builtin_amdgcn_s_sleep(1);
        if ((++sp & 255u) == 0u) { if (xb_ld(&bar[XB_TMO])) break; if (sp > XB_SPIN_CAP) { (void)xb_add(&bar[XB_TMO], 1u); break; } }
    }
    nloc = mine > 0u ? mine : 1u; nx = cnt > 0u ? cnt : 1u;
}
__device__ __forceinline__ void xcd_barrier(const XcdBarrier& b) {
    asm volatile("s_waitcnt vmcnt(0)" ::: "memory");
    __syncthreads();
    if (threadIdx.x == 0) {
        unsigned* bar = b.bar;
        __builtin_amdgcn_s_waitcnt(0);
        unsigned nloc = b.st[0], nx = b.st[1];
        if (nloc == 0u) { xcd_barrier_complete(bar, b.x, nloc, nx); b.st[0] = nloc; b.st[1] = nx; }
        const unsigned old = xb_add(&bar[XB_XSUB(b.x)], 1u);
        const unsigned gen = old / nloc;
        if (old + 1u == (gen + 1u) * nloc) {
            __builtin_amdgcn_fence(__ATOMIC_RELEASE, "agent");
            asm volatile("s_waitcnt vmcnt(0)" ::: "memory");
            const unsigned og = xb_add(&bar[XB_TOP], 1u);
            const unsigned tg = og / nx;
            if (og + 1u == (tg + 1u) * nx) xb_add(&bar[XB_TOPGEN], 1u);
            else XB_SPIN(xb_ld(&bar[XB_TOPGEN]) == tg, bar);
            __builtin_amdgcn_fence(__ATOMIC_ACQUIRE, "agent");
            xb_add(&bar[XB_XGEN(b.x)], 1u);
            asm volatile("s_waitcnt vmcnt(0)" ::: "memory");
        } else {
            XB_SPIN(xb_ld(&bar[XB_XGEN(b.x)]) == gen, bar);
            __builtin_amdgcn_fence(__ATOMIC_ACQUIRE, "agent");
            asm volatile("s_waitcnt vmcnt(0)" ::: "memory");
        }
    }
    __syncthreads();
}

__device__ __forceinline__ bool xcd_barrier_arrive(const XcdBarrier& b) {
    asm volatile("s_waitcnt vmcnt(0)" ::: "memory");
    __syncthreads();
    if (threadIdx.x == 0) {
        unsigned* bar = b.bar;
        __builtin_amdgcn_s_waitcnt(0);
        unsigned nloc = b.st[0], nx = b.st[1];
        if (nloc == 0u) { xcd_barrier_complete(bar, b.x, nloc, nx); b.st[0] = nloc; b.st[1] = nx; }
        const unsigned old = xb_add(&bar[XB_XSUB(b.x)], 1u);
        const unsigned gen = old / nloc;
        b.st[9] = gen; b.st[10] = (old + 1u == (gen + 1u) * nloc) ? 1u : 0u;
    }
    __syncthreads();
    return __builtin_amdgcn_readfirstlane((int)b.st[10]) != 0;
}
__device__ __forceinline__ void xcd_barrier_finish(const XcdBarrier& b) {
    __syncthreads();
    if (threadIdx.x == 0) {
        unsigned* bar = b.bar;
        const unsigned gen = b.st[9], nx = b.st[1];
        if (b.st[10] != 0u) {
            __builtin_amdgcn_fence(__ATOMIC_RELEASE, "agent");
            asm volatile("s_waitcnt vmcnt(0)" ::: "memory");
            const unsigned og = xb_add(&bar[XB_TOP], 1u);
            const unsigned tg = og / nx;
            if (og + 1u == (tg + 1u) * nx) xb_add(&bar[XB_TOPGEN], 1u);
            else XB_SPIN(xb_ld(&bar[XB_TOPGEN]) == tg, bar);
            __builtin_amdgcn_fence(__ATOMIC_ACQUIRE, "agent");
            xb_add(&bar[XB_XGEN(b.x)], 1u);
            asm volatile("s_waitcnt vmcnt(0)" ::: "memory");
        } else {
            XB_SPIN(xb_ld(&bar[XB_XGEN(b.x)]) == gen, bar);
            __builtin_amdgcn_fence(__ATOMIC_ACQUIRE, "agent");
            asm volatile("s_waitcnt vmcnt(0)" ::: "memory");
        }
    }
    __syncthreads();
}

namespace pg8 {
constexpr int BM = 256, BK = 64, HALF = 128, HTB = HALF * BK * 2, STAGE_BYTES = 8 * HTB, NXCD = 8, WGM = 8;
__host__ __device__ __forceinline__ int lds_byte(int r, int c) { const int st = (r >> 4) * 2 + (c >> 5), rr = r & 15, cc = c & 31, ob = rr * 64 + cc * 2; return st * 1024 + (ob ^ (((ob >> 9) & 1) << 5)); }
__host__ __device__ __forceinline__ void stage_rc(int b, int& R, int& C) { const int st = b / 1024, sb = b % 1024, swz = sb ^ (((sb >> 9) & 1) << 5); R = (st >> 1) * 16 + swz / 64; C = (st & 1) * 32 + (swz % 64) / 2; }
__host__ __device__ __forceinline__ int perm32(int rho) { const int n = rho >> 4, i = rho & 15; return 8 * (i >> 2) + 4 * n + (i & 3); }

struct Unit { int pm, pn, e; };
struct GemmP {
    const char* A; unsigned lda2;
    unsigned acol_pn;
    const char* Bt; size_t b_estride;
    int Kb;
    int sA, sB;
};

__device__ __forceinline__ void unit_of(int L, int nM, int nN, int& pm, int& pn) {
    const int nwg = nM * nN;
    int wgid = L; { const int q = nwg / NXCD, r = nwg % NXCD, xcd = wgid % NXCD, off = wgid / NXCD; wgid = (xcd < r ? xcd * (q + 1) : r * (q + 1) + (xcd - r) * q) + off; }
    const int nig = WGM * nN, gid = wgid / nig, fm = gid * WGM, gsz = (nM - fm) < WGM ? (nM - fm) : WGM;
    pm = fm + ((wgid % nig) % gsz); pn = (wgid % nig) / gsz;
}
__device__ __forceinline__ int build_units(LAS unsigned char* lds, const int tid, int nM, int nN, int G, int c, bool moe, const int* row_tok, const int dup = 1) {
    LAS int* UT = (LAS int*)(lds + UT_OFF); LAS const int* TS = (LAS const int*)(lds + TS_OFF); LAS int* TOK = (LAS int*)(lds + TOK_OFF);
    LAS const int* CNTL = (LAS const int*)(lds + MISC_OFF) + 64;
    const int nwg = nM * nN;
    int n_my = (nwg > c) ? (nwg - c + G - 1) / G : 0; if (n_my > MAXU) n_my = MAXU;
    if (tid < n_my) {
        int pm, pn; unit_of(tid * G + c, nM, nN, pm, pn);
        int e = 0, j = 0; if (moe) { int lo = 1, hi = NE;
#pragma unroll
            for (int it = 0; it < 5; ++it) { const int mid = (lo + hi) >> 1; if (TS[mid] > pm) hi = mid; else lo = mid + 1; }
            e = lo - 1; j = pm - TS[e]; pm = e * ETILES + j; }
        UT[4 * tid + 0] = pm; UT[4 * tid + 1] = pn; UT[4 * tid + 2] = e; UT[4 * tid + 3] = j;
    }
    __syncthreads();
    if (row_tok) {
        for (int idx = tid; idx < n_my * 256; idx += NTHR) { const int i = idx >> 8, r = idx & 255; const bool valid = UT[4 * i + 3] * 256 + r < CNTL[UT[4 * i + 2]];
            TOK[idx] = valid ? gld<int>(row_tok + UT[4 * i] * 256 + r) : 0; }
    }
    __syncthreads();
    if (dup > 1) { if (tid < n_my) { UT[4 * (tid + n_my) + 0] = UT[4 * tid]; UT[4 * (tid + n_my) + 1] = UT[4 * tid + 1]; UT[4 * (tid + n_my) + 2] = UT[4 * tid + 2]; UT[4 * (tid + n_my) + 3] = UT[4 * tid + 3]; } __syncthreads(); return 2 * n_my; }
    return n_my;
}
__device__ __forceinline__ Unit read_unit(LAS const int* UT, int i) {
    Unit u; u.pm = __builtin_amdgcn_readfirstlane(UT[4 * i]); u.pn = __builtin_amdgcn_readfirstlane(UT[4 * i + 1]); u.e = __builtin_amdgcn_readfirstlane(UT[4 * i + 2]); return u;
}
template <bool GATHER>
__device__ __forceinline__ void a_offsets(unsigned (&v)[2][2], const GemmP& g, const Unit& u, int ui, const int (&Rr)[2], const int (&Cc2)[2], LAS const int* TOK, const int tokn) {
#pragma unroll
    for (int h = 0; h < 2; ++h)
#pragma unroll
        for (int i = 0; i < 2; ++i) {
            const int row = GATHER ? TOK[(ui >= tokn ? ui - tokn : ui) * 256 + h * HALF + Rr[i]] : (u.pm * BM + h * HALF + Rr[i]);
            v[h][i] = (unsigned)row * g.lda2 + (unsigned)Cc2[i] + (unsigned)u.pn * g.acol_pn;
        }
}

template <bool GATHER, bool FP8, class Epi>
__device__ __forceinline__ void gemm_phase(LAS unsigned char* lds, const int tid, const GemmP g, const int n_my, const Epi& E, const int tokn = 1 << 20, unsigned* last_ctr = nullptr) {
    const int wid = __builtin_amdgcn_readfirstlane(tid >> 6), lane = tid & 63, wr = wid >> 2, wc = wid & 3, fr = lane & 15, fq = lane >> 4;
    const int Kb = g.Kb, nt = Kb / (BK * 2);
    if (n_my <= 0) return;
    int Rr[2], Cc2[2]; unsigned voffB[2];
#pragma unroll
    for (int i = 0; i < 2; ++i) { int R, C; stage_rc(tid * 16 + i * 8192, R, C); const int Rb = Epi::PERM ? ((R & ~31) + perm32(R & 31)) : R;
        Rr[i] = R; Cc2[i] = C * 2; voffB[i] = (unsigned)(Rb * Kb + C * 2); }
    const size_t kstep = (size_t)(BK * 2);
    const size_t hstep = (size_t)HALF * Kb;
    const size_t tstepB = 2 * hstep;
    const unsigned ldsw = (unsigned)wid * 1024u;
    const int aoff = lds_byte(wr * 64 + fr, fq * 8), boff = lds_byte(wc * 32 + fr, fq * 8);
    LAS const int* UT = (LAS const int*)(lds + UT_OFF); LAS const int* TOK = (LAS const int*)(lds + TOK_OFF);
#define PG8_SA(b, h) (((b) * 2 + (h)) * HTB)
#define PG8_SB(b, h) ((4 + (b) * 2 + (h)) * HTB)
#define PG8_STAGE(bufoff, gbase, voff) do { _Pragma("unroll") for (int _i = 0; _i < 2; ++_i) \
        __builtin_amdgcn_global_load_lds((const unsigned*)((const char*)(gbase) + (voff)[_i]), (LAS unsigned*)(lds + (bufoff) + ldsw + _i * 8192), 16, 0, 0); } while (0)
#define PG8_LDA(dst, b, h) do { _Pragma("unroll") for (int m = 0; m < 4; ++m) _Pragma("unroll") for (int k = 0; k < 2; ++k) dst[m][k] = *(const LAS bf16x8*)(lds + PG8_SA(b, h) + aoff + m * 2048 + k * 1024); } while (0)
#define PG8_LDB(dst, b, h) do { _Pragma("unroll") for (int n = 0; n < 2; ++n) _Pragma("unroll") for (int k = 0; k < 2; ++k) dst[n][k] = *(const LAS bf16x8*)(lds + PG8_SB(b, h) + boff + n * 2048 + k * 1024); } while (0)
#define PG8_CAT(x) __builtin_shufflevector(__builtin_bit_cast(v4i, (x)[0]), __builtin_bit_cast(v4i, (x)[1]), 0, 1, 2, 3, 4, 5, 6, 7)
#define PG8_MMA(ai, bj, At, Bt) do { __builtin_amdgcn_s_setprio(1); _Pragma("unroll") for (int m = 0; m < 4; ++m) _Pragma("unroll") for (int n = 0; n < 2; ++n) { \
        if constexpr (FP8) { const v8i b8_ = PG8_CAT(Bt[n]), a8_ = PG8_CAT(At[m]); asm volatile("v_mfma_scale_f32_16x16x128_f8f6f4 %0, %1, %2, %0, %3, %4 op_sel_hi:[0,0,0]" : "+v"(acc[ai][bj][m][n]) : "v"(b8_), "v"(a8_), "v"(vsB), "v"(vsA)); } \
        else { _Pragma("unroll") for (int k = 0; k < 2; ++k) acc[ai][bj][m][n] = __builtin_amdgcn_mfma_f32_16x16x32_bf16(Bt[n][k], At[m][k], acc[ai][bj][m][n], 0, 0, 0); } } \
        __builtin_amdgcn_s_setprio(0); } while (0)
#define PG8_MMA0(ai, bj, At, Bt) do { __builtin_amdgcn_s_setprio(1); _Pragma("unroll") for (int m = 0; m < 4; ++m) _Pragma("unroll") for (int n = 0; n < 2; ++n) { \
        if constexpr (FP8) { const v8i b8_ = PG8_CAT(Bt[n]), a8_ = PG8_CAT(At[m]); asm volatile("v_mfma_scale_f32_16x16x128_f8f6f4 %0, %1, %2, 0, %3, %4 op_sel_hi:[0,0,0]" : "=&v"(acc[ai][bj][m][n]) : "v"(b8_), "v"(a8_), "v"(vsB), "v"(vsA)); } \
        else { acc[ai][bj][m][n] = __builtin_amdgcn_mfma_f32_16x16x32_bf16(Bt[n][0], At[m][0], (f32x4){0.f, 0.f, 0.f, 0.f}, 0, 0, 0); acc[ai][bj][m][n] = __builtin_amdgcn_mfma_f32_16x16x32_bf16(Bt[n][1], At[m][1], acc[ai][bj][m][n], 0, 0, 0); } } \
        __builtin_amdgcn_s_setprio(0); } while (0)
#define PG8_WAIT_V(n) asm volatile("s_waitcnt vmcnt(" #n ")" ::: "memory")
#define PG8_WAIT_L(n) asm volatile("s_waitcnt lgkmcnt(" #n ")" ::: "memory")
#define PG8_BAR __builtin_amdgcn_s_barrier()
#define PG8_SCHED __builtin_amdgcn_sched_barrier(0)
    Unit cur = read_unit(UT, 0), nxt; int ui = 0;
    f32x4 acc[2][2][4][2];
    if constexpr (!FP8) {
#pragma unroll
    for (int a = 0; a < 2; ++a)
#pragma unroll
        for (int b = 0; b < 2; ++b)
#pragma unroll
            for (int m = 0; m < 4; ++m)
#pragma unroll
                for (int n = 0; n < 2; ++n) acc[a][b][m][n] = (f32x4){0.f, 0.f, 0.f, 0.f};
    }
#define PG8_PIN_ACC() do { if constexpr (FP8) { _Pragma("unroll") for (int a_ = 0; a_ < 2; ++a_) _Pragma("unroll") for (int b_ = 0; b_ < 2; ++b_) \
        asm volatile("" : "+v"(acc[a_][b_][0][0]), "+v"(acc[a_][b_][0][1]), "+v"(acc[a_][b_][1][0]), "+v"(acc[a_][b_][1][1]), "+v"(acc[a_][b_][2][0]), "+v"(acc[a_][b_][2][1]), "+v"(acc[a_][b_][3][0]), "+v"(acc[a_][b_][3][1])); \
        asm volatile("s_nop 1" ::: "memory"); } } while (0)
    bf16x8 At[4][2], B0[2][2], B1[2][2];
    int vsA = g.sA, vsB = g.sB; asm volatile("" : "+v"(vsA), "+v"(vsB));
    unsigned vAc[2][2], vAn[2][2];
    a_offsets<GATHER>(vAc, g, cur, 0, Rr, Cc2, TOK, tokn);
    const char* const Ab = g.A;
    const char* cB = g.Bt + (size_t)cur.e * g.b_estride + (size_t)cur.pn * tstepB;
    PG8_STAGE(PG8_SB(0, 0), cB, voffB); PG8_STAGE(PG8_SB(0, 1), cB + hstep, voffB); PG8_STAGE(PG8_SA(0, 0), Ab, vAc[0]); PG8_STAGE(PG8_SA(0, 1), Ab, vAc[1]);
    if (wr == 1) PG8_BAR;
    PG8_WAIT_V(2); PG8_BAR;
    PG8_STAGE(PG8_SB(1, 0), cB + kstep, voffB); PG8_STAGE(PG8_SA(1, 0), Ab + kstep, vAc[0]); PG8_STAGE(PG8_SB(1, 1), cB + hstep + kstep, voffB);
    PG8_WAIT_V(6); PG8_BAR;
    for (;;) {
        const bool has_next = (ui + 1 < n_my);
        if (!has_next && last_ctr != nullptr && tid == 0) (void)xb_add(last_ctr, 1u);
        nxt = cur; if (has_next) nxt = read_unit(UT, ui + 1);
        const char* nB = has_next ? g.Bt + (size_t)nxt.e * g.b_estride + (size_t)nxt.pn * tstepB : cB;
        for (int t = 0; t < nt; t += 2) {
            const bool last = (t == nt - 2);
            if (t == 0) E.prefetch(lds + EPI_OFF + (ui & 1) * 4096, cur, wid, lane);
            const char* a1 = Ab + (size_t)(t + 1) * kstep;
            const char* a2 = last ? Ab : Ab + (size_t)(t + 2) * kstep; const char* b2 = last ? nB : cB + (size_t)(t + 2) * kstep;
            const char* a3 = a2 + kstep; const char* b3 = b2 + kstep;
            unsigned o2[2][2];
            if (last) {
                if (has_next) a_offsets<GATHER>(vAn, g, nxt, ui + 1, Rr, Cc2, TOK, tokn);
                else { vAn[0][0] = vAc[0][0]; vAn[0][1] = vAc[0][1]; vAn[1][0] = vAc[1][0]; vAn[1][1] = vAc[1][1]; }
                o2[0][0] = vAn[0][0]; o2[0][1] = vAn[0][1]; o2[1][0] = vAn[1][0]; o2[1][1] = vAn[1][1];
            } else { o2[0][0] = vAc[0][0]; o2[0][1] = vAc[0][1]; o2[1][0] = vAc[1][0]; o2[1][1] = vAc[1][1]; }
            PG8_LDB(B0, 0, 0); PG8_LDB(B1, 0, 1); PG8_SCHED; PG8_LDA(At, 0, 0); PG8_STAGE(PG8_SA(1, 1), a1, vAc[1]);
            PG8_WAIT_V(8); PG8_WAIT_L(0); PG8_BAR; if (FP8 && t == 0) { PG8_MMA0(0, 0, At, B0); PG8_MMA0(0, 1, At, B1); } else { PG8_MMA(0, 0, At, B0); PG8_MMA(0, 1, At, B1); } PG8_BAR; PG8_SCHED;
            PG8_LDA(At, 0, 1); PG8_STAGE(PG8_SB(0, 0), b2, voffB); PG8_STAGE(PG8_SB(0, 1), b2 + hstep, voffB); PG8_STAGE(PG8_SA(0, 0), a2, o2[0]);
            PG8_WAIT_V(8); PG8_WAIT_L(0); PG8_BAR; if (FP8 && t == 0) { PG8_MMA0(1, 0, At, B0); PG8_MMA0(1, 1, At, B1); } else { PG8_MMA(1, 0, At, B0); PG8_MMA(1, 1, At, B1); } PG8_BAR; PG8_SCHED;
            PG8_LDB(B0, 1, 0); PG8_LDB(B1, 1, 1); PG8_SCHED; PG8_LDA(At, 1, 0); PG8_STAGE(PG8_SA(0, 1), a2, o2[1]);
            PG8_WAIT_V(8); PG8_WAIT_L(0); PG8_BAR; PG8_MMA(0, 0, At, B0); PG8_MMA(0, 1, At, B1); PG8_BAR; PG8_SCHED;
            PG8_LDA(At, 1, 1); PG8_STAGE(PG8_SB(1, 0), b3, voffB); PG8_STAGE(PG8_SB(1, 1), b3 + hstep, voffB); PG8_STAGE(PG8_SA(1, 0), a3, o2[0]);
            PG8_WAIT_V(8); PG8_WAIT_L(0); PG8_BAR; PG8_MMA(1, 0, At, B0); PG8_MMA(1, 1, At, B1); PG8_BAR; PG8_SCHED;
        }
        if (wr == 0) PG8_BAR;
        if constexpr (FP8) asm volatile("s_nop 15" ::: "memory");
        for (int re_ = 0; re_ < Epi::REPS; ++re_) E(acc, cur, wr, wc, fr, fq, lds + EPI_OFF + (ui & 1) * 4096);
        if (!has_next) break;
        if constexpr (!FP8) {
#pragma unroll
        for (int a = 0; a < 2; ++a)
#pragma unroll
            for (int b = 0; b < 2; ++b)
#pragma unroll
                for (int m = 0; m < 4; ++m)
#pragma unroll
                    for (int n = 0; n < 2; ++n) acc[a][b][m][n] = (f32x4){0.f, 0.f, 0.f, 0.f};
        }
        cur = nxt; cB = nB; ++ui;
        vAc[0][0] = vAn[0][0]; vAc[0][1] = vAn[0][1]; vAc[1][0] = vAn[1][0]; vAc[1][1] = vAn[1][1];
        if (wr == 1) PG8_BAR;
    }
    PG8_WAIT_V(0);
    PG8_BAR;
#undef PG8_SA
#undef PG8_SB
#undef PG8_STAGE
#undef PG8_LDA
#undef PG8_LDB
#undef PG8_MMA
#undef PG8_MMA0
#undef PG8_PIN_ACC
#undef PG8_CAT
#undef PG8_WAIT_V
#undef PG8_WAIT_L
#undef PG8_BAR
#undef PG8_SCHED
}

__device__ __forceinline__ v4u widen16(const v2u X, const v2u Y) {
    const auto a = __builtin_amdgcn_permlane16_swap(X.x, Y.x, false, false), b = __builtin_amdgcn_permlane16_swap(X.y, Y.y, false, false);
    v4u o; o.x = a[0]; o.y = b[0]; o.z = a[1]; o.w = b[1]; return o;
}
struct EpiOut {
    static constexpr bool PERM = true; static constexpr int REPS = 1;
    const bf16* xres; const float* xres32; bf16* z; const float* bias; const float* scale;
    __device__ __forceinline__ void prefetch(LAS unsigned char*, const Unit&, int, int) const {}
    __device__ __forceinline__ void operator()(const f32x4 (&acc)[2][2][4][2], const Unit& u, int wr, int wc, int fr, int fq, const LAS unsigned char*) const {
        const int row0 = u.pm * BM + wr * 64 + fr, c0 = u.pn * BM + wc * 32 + 8 * fq;
        f32x4 bv[2][2], sv[2][2];
#pragma unroll
        for (int bj = 0; bj < 2; ++bj)
#pragma unroll
            for (int n = 0; n < 2; ++n) {
                bv[bj][n] = bias ? gld<f32x4>(bias + c0 + bj * HALF + 4 * n) : (f32x4){0.f, 0.f, 0.f, 0.f};
                sv[bj][n] = scale ? gld<f32x4>(scale + c0 + bj * HALF + 4 * n) : (f32x4){1.f, 1.f, 1.f, 1.f};
            }
#pragma unroll
        for (int ai = 0; ai < 2; ++ai)
#pragma unroll
            for (int m = 0; m < 4; ++m) { const size_t off = (size_t)(row0 + ai * HALF + m * 16) * D + c0;
#pragma unroll
                for (int bj = 0; bj < 2; ++bj) { f32x4 x0, x1;
                    if (xres32) { x0 = gld<f32x4>(xres32 + off + bj * HALF); x1 = gld<f32x4>(xres32 + off + bj * HALF + 4); }
                    else { const v4u xr = gld<v4u>(xres + off + bj * HALF); x0 = (f32x4){bf_lo(xr.x), bf_hi(xr.x), bf_lo(xr.y), bf_hi(xr.y)}; x1 = (f32x4){bf_lo(xr.z), bf_hi(xr.z), bf_lo(xr.w), bf_hi(xr.w)}; }
                    const f32x4 o0 = x0 * ALPHA + (acc[ai][bj][m][0] + bv[bj][0]) * sv[bj][0], o1 = x1 * ALPHA + (acc[ai][bj][m][1] + bv[bj][1]) * sv[bj][1];
                    v4u w; w.x = cvt_pk_bf16(o0[0], o0[1]); w.y = cvt_pk_bf16(o0[2], o0[3]); w.z = cvt_pk_bf16(o1[0], o1[1]); w.w = cvt_pk_bf16(o1[2], o1[3]);
                    gst<v4u>(z + off + bj * HALF, w); }
                asm volatile("" ::: "memory"); }
    }
};
struct EpiPair {
    static constexpr bool PERM = true; static constexpr int REPS = 1;
    bf16* O1; bf16* O2; const float* bias; int mode;
    __device__ __forceinline__ void prefetch(LAS unsigned char*, const Unit&, int, int) const {}
    __device__ __forceinline__ void operator()(const f32x4 (&acc)[2][2][4][2], const Unit& u, int wr, int wc, int fr, int fq, const LAS unsigned char*) const {
        const int row0 = u.pm * BM + wr * 64 + fr;
        if (u.pn < 8) {
            const int j0 = u.pn * HALF + wc * 32 + 8 * fq;
            f32x4 b1[2], b2[2];
#pragma unroll
            for (int n = 0; n < 2; ++n) { b1[n] = mode ? gld<f32x4>(bias + j0 + 4 * n) : (f32x4){0.f, 0.f, 0.f, 0.f}; b2[n] = mode ? gld<f32x4>(bias + 1024 + j0 + 4 * n) : (f32x4){0.f, 0.f, 0.f, 0.f}; }
#pragma unroll
            for (int ai = 0; ai < 2; ++ai)
#pragma unroll
                for (int m = 0; m < 4; ++m) { bf16* rowp = O1 + (size_t)(row0 + ai * HALF + m * 16) * D + j0; f32x4 r[2];
#pragma unroll
                    for (int n = 0; n < 2; ++n) { const f32x4 g1 = acc[ai][0][m][n] + b1[n], g2 = acc[ai][1][m][n] + b2[n];
                        if (mode) { r[n][0] = g1[0] * sigmoidf_(g2[0]); r[n][1] = g1[1] * sigmoidf_(g2[1]); r[n][2] = g1[2] * sigmoidf_(g2[2]); r[n][3] = g1[3] * sigmoidf_(g2[3]); }
                        else r[n] = g1 * g2; }
                    v4u w; w.x = cvt_pk_bf16(r[0][0], r[0][1]); w.y = cvt_pk_bf16(r[0][2], r[0][3]); w.z = cvt_pk_bf16(r[1][0], r[1][1]); w.w = cvt_pk_bf16(r[1][2], r[1][3]);
                    gst<v4u>(rowp, w); }
        } else {
            const int c0 = (u.pn - 8) * BM + wc * 32 + 8 * fq;
#pragma unroll
            for (int ai = 0; ai < 2; ++ai)
#pragma unroll
                for (int m = 0; m < 4; ++m) { bf16* rowp = O2 + (size_t)(row0 + ai * HALF + m * 16) * D + c0;
#pragma unroll
                    for (int bj = 0; bj < 2; ++bj) { const f32x4 v0 = acc[ai][bj][m][0], v1 = acc[ai][bj][m][1];
                        v4u w; w.x = cvt_pk_bf16(v0[0], v0[1]); w.y = cvt_pk_bf16(v0[2], v0[3]); w.z = cvt_pk_bf16(v1[0], v1[1]); w.w = cvt_pk_bf16(v1[2], v1[3]);
                        gst<v4u>(rowp + bj * HALF, w); } }
        }
    }
};
struct EpiSwiglu {
    static constexpr bool PERM = true; static constexpr int REPS = REP_EPI1;
    unsigned char* act; const float* bgu;
    __device__ __forceinline__ void prefetch(LAS unsigned char* slot, const Unit& u, int wid, int lane) const {
        if (wid == 0) __builtin_amdgcn_global_load_lds((const unsigned*)(bgu + (size_t)u.e * 2048 + 2 * u.pn * HALF + 4 * lane), (LAS unsigned*)slot, 16, 0, 0);
    }
    __device__ __forceinline__ void operator()(const f32x4 (&acc)[2][2][4][2], const Unit& u, int wr, int wc, int fr, int fq, const LAS unsigned char* slot) const {
        const int row0 = u.pm * BM + wr * 64 + fr, j0 = u.pn * HALF + wc * 32 + 8 * fq;
        const LAS float* bp = (const LAS float*)slot + 2 * (wc * 32 + 8 * fq);
        f32x2 gb[4], ub[4];
#pragma unroll
        for (int i = 0; i < 4; ++i) { const f32x4 b = *(const LAS f32x4*)(bp + 4 * i); gb[i] = (f32x2){b[0], b[2]}; ub[i] = (f32x2){b[1], b[3]}; }
        const f32x2 q4 = {1.0f / SACT8, 1.0f / SACT8}, kc = {-1.702f * 1.4426950408889634f, -1.702f * 1.4426950408889634f};
        const int j16 = u.pn * HALF + wc * 32 + 16 * (fq >> 1); v2u wprev = {0u, 0u};
#pragma unroll
        for (int ai = 0; ai < 2; ++ai)
#pragma unroll
            for (int m = 0; m < 4; ++m) { float r[8];
#pragma unroll
                for (int p = 0; p < 4; ++p) { const int n = p >> 1, q = 2 * (p & 1);
                    f32x2 g = (f32x2){acc[ai][0][m][n][q], acc[ai][0][m][n][q + 1]} + gb[p];
                    f32x2 uu = (f32x2){acc[ai][1][m][n][q], acc[ai][1][m][n][q + 1]} + ub[p];
                    g[0] = fminf(g[0], 7.0f); g[1] = fminf(g[1], 7.0f);
                    uu[0] = __builtin_amdgcn_fmed3f(uu[0], -7.0f, 7.0f); uu[1] = __builtin_amdgcn_fmed3f(uu[1], -7.0f, 7.0f);
                    f32x2 t = g * kc; t[0] = __builtin_amdgcn_exp2f(t[0]); t[1] = __builtin_amdgcn_exp2f(t[1]);
                    f32x2 d = __builtin_elementwise_fma(t, q4, q4); d[0] = __builtin_amdgcn_rcpf(d[0]); d[1] = __builtin_amdgcn_rcpf(d[1]);
                    const f32x2 o = __builtin_elementwise_fma(uu, g, g) * d;
                    r[2 * p] = o[0]; r[2 * p + 1] = o[1]; }
                const v2u w8 = pack8_fp8(r);
                if (m & 1) { const v4u o16 = widen16(wprev, w8);
                    gst<v4u>(act + (size_t)(row0 + ai * HALF + (m - 1 + (fq & 1)) * 16) * D + j16, o16); }
                else wprev = w8; }
    }
};
struct EpiMoe2 {
    static constexpr bool PERM = true; static constexpr int REPS = REP_EPI2;
    unsigned char* Y; const float* bdn; const float* rowgate;
    __device__ __forceinline__ void prefetch(LAS unsigned char* slot, const Unit& u, int wid, int lane) const {
        if (wid == 0) __builtin_amdgcn_global_load_lds((const unsigned*)(bdn + (size_t)u.e * D + u.pn * BM + 4 * lane), (LAS unsigned*)slot, 16, 0, 0);
        else if (wid == 1) __builtin_amdgcn_global_load_lds((const unsigned*)(rowgate + u.pm * BM + 4 * lane), (LAS unsigned*)(slot + 1024), 16, 0, 0);
    }
    __device__ __forceinline__ void operator()(const f32x4 (&acc)[2][2][4][2], const Unit& u, int wr, int wc, int fr, int fq, const LAS unsigned char* slot) const {
        const int pos0 = wr * 64 + fr, c16 = u.pn * BM + wc * 32 + 16 * (fq >> 1);
        const LAS float* bp = (const LAS float*)slot + wc * 32 + 8 * fq;
        f32x4 bv[2][2]; v2u wprev[2] = {{0u, 0u}, {0u, 0u}};
#pragma unroll
        for (int bj = 0; bj < 2; ++bj)
#pragma unroll
            for (int n = 0; n < 2; ++n) bv[bj][n] = *(const LAS f32x4*)(bp + bj * HALF + 4 * n);
#pragma unroll
        for (int ai = 0; ai < 2; ++ai)
#pragma unroll
            for (int m = 0; m < 4; ++m) { const int pos = pos0 + ai * HALF + m * 16; const float s = *((const LAS float*)(slot + 1024) + pos) * SY8;
#pragma unroll
                for (int bj = 0; bj < 2; ++bj) { const f32x4 v0 = (acc[ai][bj][m][0] + bv[bj][0]) * s, v1 = (acc[ai][bj][m][1] + bv[bj][1]) * s;
                    const float r[8] = {v0[0], v0[1], v0[2], v0[3], v1[0], v1[1], v1[2], v1[3]};
                    const v2u w8 = pack8_fp8(r);
                    if (m & 1) { const v4u o16 = widen16(wprev[bj], w8);
                        gst<v4u>(Y + (size_t)(u.pm * BM + pos0 + ai * HALF + (m - 1 + (fq & 1)) * 16) * D + c16 + bj * HALF, o16); }
                    else wprev[bj] = w8; } }
    }
};
}

__device__ __forceinline__ int chq(int lane, int q) { return (q >> 1) * 512 + 8 * lane + (q & 1) * 4; }
__device__ __forceinline__ v4u pack8(const float* v) { v4u w; w.x = cvt_pk_bf16(v[0], v[1]); w.y = cvt_pk_bf16(v[2], v[3]); w.z = cvt_pk_bf16(v[4], v[5]); w.w = cvt_pk_bf16(v[6], v[7]); return w; }
__device__ __forceinline__ void unpack8(const v4u w, float* v) { v[0] = bf_lo(w.x); v[1] = bf_hi(w.x); v[2] = bf_lo(w.y); v[3] = bf_hi(w.y); v[4] = bf_lo(w.z); v[5] = bf_hi(w.z); v[6] = bf_lo(w.w); v[7] = bf_hi(w.w); }

__device__ __forceinline__ int drow_of(int mode, int c) {
    if (mode == 1) { const int j = c >> 1, p = c & 1; return (j >> 7) * 256 + p * 128 + (j & 127); }
    if (mode == 2) { if (c < 1024) return 2048 + c; const int j = (c - 1024) & 1023, p = (c - 1024) >> 10; return (j >> 7) * 256 + p * 128 + (j & 127); }
    if (mode == 3) { const int j = c & 1023, p = c >> 10; return (j >> 7) * 256 + p * 128 + (j & 127); }
    return c;
}
struct TItem { const float* src; unsigned char* dst; int N, Kout  , k0, n0, mode, fp8; };
__device__ __forceinline__ void titem_load(const TItem& d, int lane, float (&tmp)[32]) {
#pragma unroll
    for (int i = 0; i < 32; ++i) { const int kk = 2 * i + (lane >> 5); tmp[i] = gld<float>(d.src + (size_t)(d.k0 + kk) * d.N + d.n0 + (lane & 31)); }
}
__device__ __forceinline__ void titem_store(const TItem& d, int lane, LAS float* scr, const float (&tmp)[32]) {
#pragma unroll
    for (int i = 0; i < 32; ++i) { const int kk = 2 * i + (lane >> 5); scr[kk * 33 + (lane & 31)] = tmp[i]; }
    LDS_WAIT(); asm volatile("" ::: "memory");
    const int c = lane & 7;
#pragma unroll
    for (int j = 0; j < 4; ++j) { const int n = (lane >> 3) + 8 * j; const LAS float* s = scr + (8 * c) * 33 + n;
        float v[8];
#pragma unroll
        for (int i = 0; i < 8; ++i) v[i] = s[i * 33];
        const size_t e = (size_t)drow_of(d.mode, d.n0 + n) * d.Kout + d.k0 + 8 * c;
        if (d.fp8) {
#pragma unroll
            for (int i = 0; i < 8; ++i) v[i] *= SW8;
            gst<v2u>(d.dst + e, pack8_fp8_sat(v));
        } else gst<v4u>(d.dst + 2 * e, pack8(v)); }
    LDS_WAIT(); asm volatile("" ::: "memory");
}

struct Args { const float* in[24]; float* out; unsigned char* ws; };
#define CAS __attribute__((address_space(4)))
__device__ __forceinline__ const void* karg_ptr(int off) {
    const CAS char* kp = (const CAS char*)__builtin_amdgcn_kernarg_segment_ptr();
    asm volatile("" : "+s"(off));
    return *(const void* const CAS*)(kp + off);
}
#define ARG_IN(i) ((const float*)karg_ptr(8 * (i)))
#define ARG_OUT() ((float*)karg_ptr(8 * 24))
#define ARG_WS() ((unsigned char*)karg_ptr(8 * 25))

constexpr int TPITCH = 129, TBUF = 128 * TPITCH;
constexpr int NT_GU = 128 * 8 * 16, NT_DN = 128 * 8 * 8, NT = NT_GU + NT_DN;
constexpr int NQ = 4096 + 2048, NT_P0 = 4096, NCONV = 16;
__host__ __device__ __forceinline__ int qtile(int L, int k) { return k < 4096 ? L * 4096 + k : NT_GU + L * 2048 + (k - 4096); }
struct WTile { const float* src; unsigned char* dst; int N, nb, kb, mode; };
#define WT_DECODE(ti_, d_) do { int r_ = (ti_); if (r_ < NT_GU) { const int mt_ = r_ >> 7; r_ &= 127; (d_).kb = r_ >> 4; (d_).nb = r_ & 15; (d_).N = 2048; (d_).mode = 1; \
                (d_).src = ARG_IN(18) + (size_t)mt_ * 1024 * 2048; (d_).dst = ws + WS_WGU + (size_t)mt_ * 2048 * 1024; } \
            else { r_ -= NT_GU; const int mt_ = r_ >> 6; r_ &= 63; (d_).kb = r_ >> 3; (d_).nb = r_ & 7; (d_).N = 1024; (d_).mode = 0; \
                (d_).src = ARG_IN(20) + (size_t)mt_ * 1024 * 1024; (d_).dst = ws + WS_WDN + (size_t)mt_ * 1024 * 1024; } } while (0)
#define WT_LOAD(R_, d_) do { _Pragma("unroll") for (int i = 0; i < 16; ++i) R_[i] = __builtin_nontemporal_load((const GAS v2u*)((d_).src + (size_t)((d_).kb * 128 + wave * 16 + i) * (d_).N + (d_).nb * 128 + 2 * lane)); } while (0)
#define WT_TOLDS(R_, buf_) do { const int col_ = (2 * lane + 4 * wave) & 127; _Pragma("unroll") for (int i = 0; i < 16; ++i) { LAS float* p_ = tl + (buf_) * TBUF + (wave * 16 + i) * TPITCH + col_; \
                p_[0] = __uint_as_float(R_[i].x); p_[1] = __uint_as_float(R_[i].y); } } while (0)
#define WT_OUT(d_, buf_) do { const int kc_ = tid & 7; _Pragma("unroll") for (int p = 0; p < 2; ++p) { const int n_ = (tid >> 3) + 64 * p; const LAS float* s_ = tl + (buf_) * TBUF + (16 * kc_) * TPITCH + ((n_ + 4 * kc_) & 127); \
                float v_[16]; _Pragma("unroll") for (int i = 0; i < 16; ++i) v_[i] = s_[i * TPITCH] * SW8; \
                const v2u a_ = pack8_fp8_sat(v_), b_ = pack8_fp8_sat(v_ + 8); v4u o_; o_.x = a_.x; o_.y = a_.y; o_.z = b_.x; o_.w = b_.y; \
                gst<v4u>((d_).dst + (size_t)drow_of((d_).mode, (d_).nb * 128 + n_) * 1024 + (d_).kb * 128 + 16 * kc_, o_); } } while (0)
#define WT_BAR() do { LDS_WAIT(); __builtin_amdgcn_s_barrier(); asm volatile("" ::: "memory"); } while (0)
constexpr int CBAND = 16 * 512 + 32, CBUF = 8 * CBAND;
static_assert(RING_OFF + 2 * CBUF <= UT_OFF, "converter buffers");
#define CV_DMA(d_, buf_) do { const char* gp_ = (const char*)((d_).src + (size_t)((d_).kb * 128 + wave * 16 + (lane >> 5)) * (d_).N + (d_).nb * 128 + 4 * (lane & 31)); \
        _Pragma("unroll") for (int j = 0; j < 8; ++j) __builtin_amdgcn_global_load_lds((const unsigned*)(gp_ + (size_t)(2 * j) * (d_).N * 4), (LAS unsigned*)(lds + RING_OFF + (buf_) * CBUF + wave * CBAND + j * 1024), 16, 0, 2); } while (0)
#define CV_OUT(d_, buf_) do { const int kq_ = tid & 7; _Pragma("unroll") for (int p = 0; p < 2; ++p) { const int n_ = (tid >> 3) + 64 * p; const LAS float* s_ = (const LAS float*)(lds + RING_OFF + (buf_) * CBUF + kq_ * CBAND) + n_; \
                float v_[16]; _Pragma("unroll") for (int i = 0; i < 16; ++i) v_[i] = s_[i * 128] * SW8; \
                const v2u a_ = pack8_fp8_sat(v_), b_ = pack8_fp8_sat(v_ + 8); v4u o_; o_.x = a_.x; o_.y = a_.y; o_.z = b_.x; o_.w = b_.y; \
                gst<v4u>((d_).dst + (size_t)drow_of((d_).mode, (d_).nb * 128 + n_) * 1024 + (d_).kb * 128 + 16 * kq_, o_); } } while (0)
#define CV_SYNC() do { LDS_WAIT(); __builtin_amdgcn_s_barrier(); asm volatile("" ::: "memory"); } while (0)
#define CONV_RUN(L_, maxpairs_, stopp_, stopn_) CONV_RUN_LIM(L_, maxpairs_, stopp_, stopn_, NQ)
#define CONV_RUN_LIM(L_, maxpairs_, stopp_, stopn_, lim_) do { \
    int wv_ = wave0; unsigned z_ = 0u; asm volatile("" : "+s"(wv_), "+s"(z_)); int tid = (wv_ << 6) | (int)__builtin_amdgcn_mbcnt_hi(~0u, __builtin_amdgcn_mbcnt_lo(~0u, z_)); asm volatile("" : "+v"(tid)); const int lane = tid & 63, wave = wave0; (void)lane; (void)wave;   \
    unsigned char* wsq_ = ARG_WS(); asm volatile("" : "+s"(wsq_)); unsigned char* ws = wsq_; unsigned* dq_ = (unsigned*)(ws + WS_CTL) + CW_DQ + (L_); unsigned* sp_ = (stopp_); \
    WTile d0, d1; int left_ = (maxpairs_); unsigned sf_ = 0u; \
    __syncthreads(); \
    const unsigned kofs_ = ((L_) == 0) ? 4096u : 0u; \
    if (tid == 0) { unsigned a_ = 0xFFFFFFFFu, b_ = 0xFFFFFFFFu; if (sp_) sf_ = (xb_ld(sp_) >= (unsigned)(stopn_)) ? 1u : 0u; if (!sf_) { a_ = xb_add(dq_, 2u) + kofs_; if (a_ >= (unsigned)(lim_)) sf_ = 1u; if (!sf_ && left_ > 1) { b_ = xb_add(dq_, 2u) + kofs_; if (b_ >= (unsigned)(lim_)) sf_ = 1u; } } MISC[4] = a_; MISC[5] = b_; } \
    __syncthreads(); \
    unsigned kcur_ = (unsigned)__builtin_amdgcn_readfirstlane((int)MISC[4]), knxt_ = (unsigned)__builtin_amdgcn_readfirstlane((int)MISC[5]); left_ -= 2; \
    d0.src = nullptr; d1.src = nullptr; \
    if (kcur_ < (unsigned)NQ) { WT_DECODE(qtile((L_), (int)kcur_), d0); WT_DECODE(qtile((L_), (int)kcur_ + 1), d1); CV_DMA(d0, 0); CV_DMA(d1, 1); } \
    while (kcur_ < (unsigned)NQ) { \
        unsigned nk_ = 0xFFFFFFFFu, dv_ = 0u; \
        if (tid == 0) { if (left_ > 0 && !sf_) nk_ = xb_add(dq_, 2u) + kofs_; if (sp_) dv_ = xb_ld(sp_); } \
        --left_; \
        const bool vn_ = knxt_ < (unsigned)NQ; WTile e0 = d0, e1 = d1; \
        if (vn_) { WT_DECODE(qtile((L_), (int)knxt_), e0); WT_DECODE(qtile((L_), (int)knxt_ + 1), e1); } \
        asm volatile("s_waitcnt vmcnt(8)" ::: "memory"); CV_SYNC(); CV_OUT(d0, 0); CV_SYNC(); if (vn_) CV_DMA(e0, 0); \
        if (vn_) asm volatile("s_waitcnt vmcnt(8)" ::: "memory"); else asm volatile("s_waitcnt vmcnt(0)" ::: "memory"); \
        CV_SYNC(); CV_OUT(d1, 1); CV_SYNC(); if (vn_) CV_DMA(e1, 1); \
        if (tid == 0) { MISC[4] = nk_; if ((sp_ && dv_ >= (unsigned)(stopn_)) || nk_ >= (unsigned)(lim_)) sf_ = 1u; } \
        __syncthreads(); kcur_ = knxt_; knxt_ = (unsigned)__builtin_amdgcn_readfirstlane((int)MISC[4]); d0 = e0; d1 = e1; \
    } \
    __syncthreads(); } while (0)

#define PHASE_BEGIN() \
    int wv_ = wave0; unsigned z_ = 0u; asm volatile("" : "+s"(wv_), "+s"(z_)); int tid = (wv_ << 6) | (int)__builtin_amdgcn_mbcnt_hi(~0u, __builtin_amdgcn_mbcnt_lo(~0u, z_)); asm volatile("" : "+v"(tid)); \
    const int lane = tid & 63, wave = wave0; \
    unsigned char* ws_ = ARG_WS(); asm volatile("" : "+s"(ws_)); unsigned char* ws = (unsigned char*)(GAS unsigned char*)ws_; \
    unsigned* ctl = (unsigned*)(ws + WS_CTL); \
    const int gw = vcu * NWAVES + wave, NGW = G * NWAVES; (void)gw; (void)NGW; (void)lane; (void)ctl;

__device__ __forceinline__ float butterfly32(float (&p)[32], int lane) {
#pragma unroll
    for (int i = 0; i < 16; ++i) { const auto r = __builtin_amdgcn_permlane32_swap(__float_as_uint(p[i]), __float_as_uint(p[i + 16]), false, false); p[i] = __uint_as_float(r[0]) + __uint_as_float(r[1]); }
#pragma unroll
    for (int i = 0; i < 8; ++i) { const auto r = __builtin_amdgcn_permlane16_swap(__float_as_uint(p[i]), __float_as_uint(p[i + 8]), false, false); p[i] = __uint_as_float(r[0]) + __uint_as_float(r[1]); }
#pragma unroll
    for (int i = 0; i < 4; ++i) { const bool hi = (lane & 8) != 0; const float snd = hi ? p[i] : p[i + 4]; const float keep = hi ? p[i + 4] : p[i]; p[i] = keep + DPP_F(snd, DPP_ROR8); }
#pragma unroll
    for (int i = 0; i < 2; ++i) { const bool hi = (lane & 4) != 0; const float snd = hi ? p[i] : p[i + 2]; const float keep = hi ? p[i + 2] : p[i]; const float x = DPP_F(snd, DPP_HMIR); p[i] = keep + DPP_F(x, DPP_QREV); }
    { const bool hi = (lane & 2) != 0; const float snd = hi ? p[0] : p[1]; const float keep = hi ? p[1] : p[0]; p[0] = keep + DPP_F(snd, DPP_XOR2); }
    return p[0] + DPP_F(p[0], DPP_XOR1);
}
__device__ __forceinline__ void ln16(float (&v)[16], const float (&lg)[16], const float (&lb)[16], int lane) {
    float sm = 0.f;
#pragma unroll
    for (int i = 0; i < 16; ++i) sm += v[i];
    const float mean = wave_sum(sm, lane) * (1.0f / D);
    float sq = 0.f;
#pragma unroll
    for (int i = 0; i < 16; ++i) { v[i] -= mean; sq += v[i] * v[i]; }
    const float rstd = 1.0f / sqrtf(wave_sum(sq, lane) * (1.0f / D) + LN_EPS);
#pragma unroll
    for (int i = 0; i < 16; ++i) v[i] = v[i] * rstd * lg[i] + lb[i];
}
__device__ __forceinline__ void route_token(const float logit, const int myexp, const int lane, const int t, int* TIDX, float* TGATE, LAS unsigned* hist, const bool count) {
    int rank = 0;
#pragma unroll
    for (int e = 0; e < 32; ++e) rank += (rdlane(logit, 2 * e) > logit) ? 1 : 0;
    unsigned long long mk[4]; bool clean = true;
#pragma unroll
    for (int r = 0; r < 4; ++r) { mk[r] = __ballot(rank == r); clean = clean && (__builtin_popcountll(mk[r]) == 2); }
    if (__builtin_expect(!clean, 0)) {
        asm volatile("" ::: "memory");
        rank = 0;
#pragma unroll
        for (int e = 0; e < 32; ++e) { const float se = rdlane(logit, 2 * e); rank += (se > logit || (se == logit && e < myexp)) ? 1 : 0; }
#pragma unroll
        for (int r = 0; r < 4; ++r) mk[r] = __ballot(rank == r);
    }
    float tv[4]; int tix[4];
#pragma unroll
    for (int r = 0; r < 4; ++r) { const int src = (int)__builtin_ctzll(mk[r] | (1ull << 63)); tv[r] = rdlane(logit, src); tix[r] = src >> 1; }
    const float e1 = __expf(tv[1] - tv[0]), e2 = __expf(tv[2] - tv[0]), e3 = __expf(tv[3] - tv[0]);
    const float inv = 1.0f / (1.0f + e1 + e2 + e3);
    if (lane < 4) {
        const int ix = lane == 0 ? tix[0] : lane == 1 ? tix[1] : lane == 2 ? tix[2] : tix[3];
        const float gv = (lane == 0 ? 1.0f : lane == 1 ? e1 : lane == 2 ? e2 : e3) * inv;
        gst<int>(TIDX + t * 4 + lane, ix); gst<float>(TGATE + t * 4 + lane, gv);
        if (count) __hip_atomic_fetch_add(hist + ix, 1u, __ATOMIC_RELAXED, __HIP_MEMORY_SCOPE_WORKGROUP);
    }
}
__device__ __forceinline__ void ln16_lds(float (&v)[16], const LAS f32x4* lnp, int lane) {
    float sm = 0.f;
#pragma unroll
    for (int i = 0; i < 16; ++i) sm += v[i];
    const float mean = wave_sum(sm, lane) * (1.0f / D);
    float sq = 0.f;
#pragma unroll
    for (int i = 0; i < 16; ++i) { v[i] -= mean; sq += v[i] * v[i]; }
    const float rstd = 1.0f / sqrtf(wave_sum(sq, lane) * (1.0f / D) + LN_EPS);
#pragma unroll
    for (int q = 0; q < 4; ++q) { const f32x4 g4 = lnp[q * 64 + lane], b4 = lnp[(4 + q) * 64 + lane];
#pragma unroll
        for (int i = 0; i < 4; ++i) v[4 * q + i] = v[4 * q + i] * rstd * g4[i] + b4[i]; }
}
template <bool F32IN>
__device__ __forceinline__ void pool_diff_run(const float* xf, const bf16* xb, bf16* M3, int t0, int lane) {
    const int s0 = t0 & (SEQ - 1);
#pragma unroll
    for (int g = 0; g < 4; ++g) {
        const int w = 2 << g, c = 256 * g + 4 * lane;
        f32x4 r[31];
#pragma unroll
        for (int j = 0; j < w + 15; ++j) {
            const int dt = j - (w - 1);
            if (dt >= 0 || s0 != 0) {
                const size_t o = (size_t)(t0 + dt) * D + c;
                if (F32IN) r[j] = gld<f32x4>(xf + o);
                else { const v2u q = gld<v2u>(xb + o); r[j] = (f32x4){bf_lo(q.x), bf_hi(q.x), bf_lo(q.y), bf_hi(q.y)}; }
            } else r[j] = (f32x4){0.f, 0.f, 0.f, 0.f};
        }
#pragma unroll
        for (int i = 0; i < 16; ++i) {
            f32x4 sum = r[i];
#pragma unroll
            for (int j = 1; j < w; ++j) sum += r[i + j];
            const int nv = (s0 + i + 1 < w) ? s0 + i + 1 : w;
            const f32x4 df = sum * (1.0f / (float)nv) - r[i + w - 1];
            v2u o; o.x = cvt_pk_bf16(df[0], df[1]); o.y = cvt_pk_bf16(df[2], df[3]);
            gst<v2u>(M3 + (size_t)(t0 + i) * D + c, o);
        }
    }
}

__global__ void __launch_bounds__(NTHR, 2) mega_fwd(Args args) {
    extern __shared__ __attribute__((aligned(16))) unsigned char lds_raw[];
    LAS unsigned char* lds = (LAS unsigned char*)lds_raw;
    volatile LAS unsigned* MISC = (volatile LAS unsigned*)(lds + MISC_OFF);
    const int G = gridDim.x, bx = blockIdx.x;
    const int wave0 = __builtin_amdgcn_readfirstlane((int)(threadIdx.x >> 6));
    const int vcu = (G % 8 == 0) ? (bx % 8) * (G / 8) + bx / 8 : bx;
    if (threadIdx.x < 128) MISC[threadIdx.x] = 0u;
    __syncthreads();
    (void)xcd_barrier_post((unsigned*)(ARG_WS() + WS_CTL) + CW_BAR, MISC + 0);
#define GRID_BAR() do { XcdBarrier b_; unsigned* bp_ = (unsigned*)(ARG_WS() + WS_CTL) + CW_BAR; asm volatile("" : "+s"(bp_)); b_.bar = (unsigned*)(GAS unsigned*)bp_; b_.x = xb_xcc_id(); b_.st = MISC; for (int rb_ = 0; rb_ < REP_BAR; ++rb_) xcd_barrier(b_); } while (0)
#define GRID_BAR_CONV(Lq_) do { XcdBarrier b_; unsigned* bp_ = (unsigned*)(ARG_WS() + WS_CTL) + CW_BAR; asm volatile("" : "+s"(bp_)); b_.bar = (unsigned*)(GAS unsigned*)bp_; b_.x = xb_xcc_id(); b_.st = MISC; \
    const bool last_ = xcd_barrier_arrive(b_); if (!last_) CONV_RUN((Lq_), 1, nullptr, 0); xcd_barrier_finish(b_); } while (0)
#define BAR_L() do { if (layer + 1 < DEPTH) GRID_BAR_CONV(layer + 1); else GRID_BAR(); } while (0)
#define BAR_A() GRID_BAR_CONV(layer)

    {
        PHASE_BEGIN();
        {
            LAS float* tl = (LAS float*)(lds + RING_OFF);
            for (int rep = 0; rep < REP_P0; ++rep) {
                v2u R0[16], R1[16]; WTile d0, d1, dn;
                int ti = vcu;
                d0.src = nullptr; d1.src = nullptr;
                if (ti < NT_P0) { WT_DECODE(qtile(0, ti), d0); WT_LOAD(R0, d0); }
                if (ti + G < NT_P0) { WT_DECODE(qtile(0, ti + G), d1); WT_LOAD(R1, d1); }
                for (; ti < NT_P0; ti += 2 * G) {
                    WT_TOLDS(R0, 0);
                    const bool h2 = (ti + 2 * G < NT_P0);
                    if (h2) { WT_DECODE(qtile(0, ti + 2 * G), dn); WT_LOAD(R0, dn); }
                    WT_BAR();
                    WT_OUT(d0, 0);
                    if (h2) d0 = dn;
                    if (ti + G < NT_P0) {
                        WT_TOLDS(R1, 1);
                        const bool h3 = (ti + 3 * G < NT_P0);
                        if (h3) { WT_DECODE(qtile(0, ti + 3 * G), dn); WT_LOAD(R1, dn); }
                        WT_BAR();
                        WT_OUT(d1, 1);
                        if (h3) d1 = dn;
                    }
                }
                WT_BAR();
            }
        }
        LAS float* scr = (LAS float*)(lds + RING_OFF + wave * 16384);
        constexpr int I_POOL = 4 * 8, I_SCIN = 16 * 96, I_SQ = 16 * 32, I_CFIN = 16 * 64;
        constexpr int N_POOL = 8 * I_POOL;
        constexpr int NITEMS = N_POOL + I_SCIN + I_SQ + I_CFIN + I_SQ;
#define TITEM_SET(d_, src_, K_, N_, dst_, mode_, fp8_, item_) do { const int nb_ = (N_) / 32; (d_).src = (src_); (d_).dst = (unsigned char*)(dst_); (d_).N = (N_); (d_).Kout = (K_); \
        (d_).k0 = 64 * ((item_) / nb_); (d_).n0 = 32 * ((item_) % nb_); (d_).mode = (mode_); (d_).fp8 = (fp8_); } while (0)
#define TITEM_DECODE(it_, d_) do { int r_ = (it_); \
        if (r_ < N_POOL) { const int mt_ = r_ / I_POOL; TITEM_SET(d_, ARG_IN(1) + (size_t)mt_ * 256 * 256, 256, 256, ws + WS_WPOOL + (size_t)mt_ * 256 * 256 * 2, 0, 0, r_ % I_POOL); break; } r_ -= N_POOL; \
        if (r_ < I_SCIN) { TITEM_SET(d_, ARG_IN(3), 1024, 3072, ws + WS_WSCIN, 2, SC_IN_FP8, r_); break; } r_ -= I_SCIN; \
        if (r_ < I_SQ) { TITEM_SET(d_, ARG_IN(5), 1024, 1024, ws + WS_WSCOUT, 0, SC_OUT_FP8, r_); break; } r_ -= I_SQ; \
        if (r_ < I_CFIN) { TITEM_SET(d_, ARG_IN(6), 1024, 2048, ws + WS_WCFIN, 3, CF_IN_FP8, r_); break; } r_ -= I_CFIN; \
        TITEM_SET(d_, ARG_IN(12), 1024, 1024, ws + WS_WCFOUT, 0, CF_OUT_FP8, r_); } while (0)
        for (int it = gw; it < NITEMS; it += NGW) { TItem cur; float ta[32]; TITEM_DECODE(it, cur); titem_load(cur, lane, ta); titem_store(cur, lane, scr, ta); }
#undef TITEM_SET
#undef TITEM_DECODE
        { bf16* M3 = (bf16*)(ws + WS_M3);
          for (int tb = vcu; tb < T / 128; tb += G) pool_diff_run<true>(ARG_IN(0), nullptr, M3, tb * 128 + wave * 16, lane); }
    }
    GRID_BAR_CONV(0);

    for (int layer = 0; layer < DEPTH; ++layer) {
        const int kind = layer % 3;

        if (kind == 0) {
            if (layer != 0) {
                PHASE_BEGIN();
                bf16* M3 = (bf16*)(ws + WS_M3); const bf16* xb = (const bf16*)(ws + WS_XAB);
                for (int rep = 0; rep < REP_THIN; ++rep)
                for (int tb = vcu; tb < T / 128; tb += G) pool_diff_run<false>(nullptr, xb, M3, tb * 128 + wave * 16, lane);
            }
        } else {
            {
                PHASE_BEGIN();
                bf16* M1 = (bf16*)(ws + WS_M1); bf16* M2 = (bf16*)(ws + WS_M2);
                const int nN = (kind == 1) ? 12 : 8;
                const int n_my = pg8::build_units(lds, tid, T / 256, nN, G, bx, false, nullptr, REP_MIXG);
                pg8::EpiPair E; E.O1 = (kind == 1) ? M2 : M1; E.O2 = M1; E.bias = ARG_IN(7); E.mode = (kind == 1) ? 0 : 1;
                if ((CF_IN_FP8 && kind == 2) || (SC_IN_FP8 && kind == 1)) {
                    pg8::GemmP gp; gp.A = (const char*)(ws + WS_X18); gp.lda2 = D; gp.acol_pn = 0; gp.Bt = (const char*)(ws + ((kind == 1) ? WS_WSCIN : WS_WCFIN)); gp.b_estride = 0; gp.Kb = 1024; gp.sA = E8_X; gp.sB = E8_W;
                    pg8::gemm_phase<false, true, pg8::EpiPair>(lds, tid, gp, n_my, E);
                } else {
                    pg8::GemmP gp; gp.A = (const char*)(ws + WS_XAB); gp.lda2 = D * 2; gp.acol_pn = 0; gp.Bt = (const char*)(ws + ((kind == 1) ? WS_WSCIN : WS_WCFIN)); gp.b_estride = 0; gp.Kb = 2048; gp.sA = 0; gp.sB = 0;
                    pg8::gemm_phase<false, false, pg8::EpiPair>(lds, tid, gp, n_my, E);
                }
            }
            BAR_A();
            if (kind == 1) {
                PHASE_BEGIN();
                const bf16* M1 = (const bf16*)(ws + WS_M1); const bf16* M2 = (const bf16*)(ws + WS_M2); bf16* M3 = (bf16*)(ws + WS_M3);
                const float* cw = ARG_IN(4);
                float wk[3][16];
#pragma unroll
                for (int k = 0; k < 3; ++k)
#pragma unroll
                    for (int q = 0; q < 4; ++q) { const f32x4 v = gld<f32x4>(cw + k * D + chq(lane, q)); wk[k][4 * q] = v[0]; wk[k][4 * q + 1] = v[1]; wk[k][4 * q + 2] = v[2]; wk[k][4 * q + 3] = v[3]; }
                for (int rep = 0; rep < REP_THIN; ++rep)
                for (int tb = vcu; tb < T / 128; tb += G) {
                    const int t0 = tb * 128 + wave * 16, s0 = t0 & (SEQ - 1);
                    float p2[16], p1[16];
                    if (s0 != 0) { unpack8(gld<v4u>(M2 + (size_t)(t0 - 2) * D + 8 * lane), p2); unpack8(gld<v4u>(M2 + (size_t)(t0 - 2) * D + 512 + 8 * lane), p2 + 8);
                                   unpack8(gld<v4u>(M2 + (size_t)(t0 - 1) * D + 8 * lane), p1); unpack8(gld<v4u>(M2 + (size_t)(t0 - 1) * D + 512 + 8 * lane), p1 + 8); }
                    else {
#pragma unroll
                        for (int i = 0; i < 16; ++i) { p2[i] = 0.f; p1[i] = 0.f; } }
                    for (int i0 = 0; i0 < 16; i0 += 4) {
                        v4u cv[4][2], gv[4][2];
#pragma unroll
                        for (int u = 0; u < 4; ++u)
#pragma unroll
                            for (int j = 0; j < 2; ++j) { const size_t o = (size_t)(t0 + i0 + u) * D + j * 512 + 8 * lane; cv[u][j] = gld<v4u>(M2 + o); gv[u][j] = gld<v4u>(M1 + o); }
#pragma unroll
                        for (int u = 0; u < 4; ++u) {
                            float c[16], gb[16], o[16];
                            unpack8(cv[u][0], c); unpack8(cv[u][1], c + 8); unpack8(gv[u][0], gb); unpack8(gv[u][1], gb + 8);
#pragma unroll
                            for (int i = 0; i < 16; ++i) { o[i] = gb[i] * (wk[0][i] * p2[i] + wk[1][i] * p1[i] + wk[2][i] * c[i]); p2[i] = p1[i]; p1[i] = c[i]; }
                            if (SC_OUT_FP8) { float s8[16];
#pragma unroll
                                for (int i = 0; i < 16; ++i) s8[i] = o[i] * SX8;
                                unsigned char* m8 = (unsigned char*)M3 + (size_t)(t0 + i0 + u) * D; gst<v2u>(m8 + 8 * lane, pack8_fp8_sat(s8)); gst<v2u>(m8 + 512 + 8 * lane, pack8_fp8_sat(s8 + 8)); }
                            else { gst<v4u>(M3 + (size_t)(t0 + i0 + u) * D + 8 * lane, pack8(o));
                                   gst<v4u>(M3 + (size_t)(t0 + i0 + u) * D + 512 + 8 * lane, pack8(o + 8)); }
                        }
                    }
                }
            } else {
                PHASE_BEGIN();
                const bf16* U = (const bf16*)(ws + WS_M1); bf16* M3 = (bf16*)(ws + WS_M3);
                const int c = 128 * wave + 2 * lane;
                float wk0[31], wk1[31];
#pragma unroll
                for (int k = 0; k < 31; ++k) { const v2u q = gld<v2u>(ARG_IN(8) + k * D + c); wk0[k] = __uint_as_float(q.x); wk1[k] = __uint_as_float(q.y); }
                const v2u qb = gld<v2u>(ARG_IN(9) + c), qg = gld<v2u>(ARG_IN(10) + c), ql = gld<v2u>(ARG_IN(11) + c);
                const float db0 = __uint_as_float(qb.x), db1 = __uint_as_float(qb.y), lg0 = __uint_as_float(qg.x), lg1 = __uint_as_float(qg.y), lb0 = __uint_as_float(ql.x), lb1 = __uint_as_float(ql.y);
                LAS float* part = (LAS float*)(lds + RING_OFF);
                LAS float* stat = part + 256;
                LAS unsigned short* ostg = (LAS unsigned short*)(lds + RING_OFF + 4096 + wave * 2048);
                for (int rep = 0; rep < REP_THIN; ++rep)
                for (int run = vcu; run < T / 16; run += G) {
                    const int t0 = run * 16, s0 = t0 & (SEQ - 1);
                    unsigned r[46];
#pragma unroll
                    for (int j = 0; j < 46; ++j) r[j] = (s0 + j - 30 >= 0) ? gld<unsigned>(U + (size_t)(t0 + j - 30) * D + c) : 0u;
                    float a0[16], a1[16];
#pragma unroll
                    for (int i = 0; i < 16; ++i) { a0[i] = db0; a1[i] = db1; }
#pragma unroll
                    for (int j = 0; j < 46; ++j) { const float x0 = bf_lo(r[j]), x1 = bf_hi(r[j]);
#pragma unroll
                        for (int i = 0; i < 16; ++i) { const int k = j - i; if (k >= 0 && k <= 30) { a0[i] += wk0[k] * x0; a1[i] += wk1[k] * x1; } } }
                    float st[32];
#pragma unroll
                    for (int i = 0; i < 16; ++i) { st[2 * i] = a0[i] + a1[i]; st[2 * i + 1] = a0[i] * a0[i] + a1[i] * a1[i]; }
                    const float tot = butterfly32(st, lane);
                    if ((lane & 1) == 0) part[wave * 32 + (lane >> 1)] = tot;
                    __syncthreads();
                    if (tid < 16) { float S = 0.f, Q = 0.f;
#pragma unroll
                        for (int w8 = 0; w8 < 8; ++w8) { S += part[w8 * 32 + 2 * tid]; Q += part[w8 * 32 + 2 * tid + 1]; }
                        const float mean = S * (1.0f / D); const float var = fmaxf(Q * (1.0f / D) - mean * mean, 0.f);
                        stat[2 * tid] = mean; stat[2 * tid + 1] = 1.0f / sqrtf(var + LN_EPS); }
                    __syncthreads();
#pragma unroll
                    for (int i = 0; i < 16; ++i) { const float mean = stat[2 * i], rstd = stat[2 * i + 1];
                        const float y0 = (a0[i] - mean) * rstd * lg0 + lb0, y1 = (a1[i] - mean) * rstd * lg1 + lb1;
                        const float z0 = y0 * sigmoidf_(y0), z1 = y1 * sigmoidf_(y1);
                        if (CF_OUT_FP8) { const float lim = 448.0f; const int w8 = __builtin_amdgcn_cvt_pk_fp8_f32(__builtin_amdgcn_fmed3f(z0 * SX8, -lim, lim), __builtin_amdgcn_fmed3f(z1 * SX8, -lim, lim), 0, false);
                            ostg[i * 64 + lane] = (unsigned short)(w8 & 0xffff); }
                        else gst<unsigned>(M3 + (size_t)(t0 + i) * D + c, cvt_pk_bf16(z0, z1)); }
                    if (CF_OUT_FP8) {
                        LDS_WAIT();
                        const LAS v4u* rd = (const LAS v4u*)(ostg + (lane >> 2) * 64) + 2 * (lane & 3);
                        const v4u o0 = rd[0], o1 = rd[1];
                        unsigned char* dst = (unsigned char*)M3 + (size_t)(t0 + (lane >> 2)) * D + 128 * wave + 32 * (lane & 3);
                        gst<v4u>(dst, o0); gst<v4u>(dst + 16, o1);
                        LDS_WAIT();
                    }
                }
                __syncthreads();
            }
        }
        if (layer != 0) BAR_A();

        {
            PHASE_BEGIN();
            const int n_my = pg8::build_units(lds, tid, T / 256, 4, G, bx, false, nullptr, REP_MIXG);
            pg8::GemmP gp; gp.A = (const char*)(ws + WS_M3); gp.lda2 = D * 2; gp.b_estride = 0; gp.sA = 0; gp.sB = 0;
            pg8::EpiOut E; E.xres = (const bf16*)(ws + WS_XAB); E.xres32 = (layer == 0) ? ARG_IN(0) : nullptr; E.z = (bf16*)(ws + WS_ZB); E.bias = nullptr; E.scale = nullptr;
            if (kind == 0) { gp.acol_pn = 512; gp.Bt = (const char*)(ws + WS_WPOOL + (size_t)(layer / 3) * 1024 * 256 * 2); gp.Kb = 512; E.scale = ARG_IN(2) + (layer / 3) * D; }
            else if (kind == 1) { gp.acol_pn = 0; gp.Bt = (const char*)(ws + WS_WSCOUT); gp.Kb = 2048; }
            else { gp.acol_pn = 0; gp.Bt = (const char*)(ws + WS_WCFOUT); gp.Kb = 2048; E.bias = ARG_IN(13); }
            if ((SC_OUT_FP8 && kind == 1) || (CF_OUT_FP8 && kind == 2)) {
                gp.lda2 = D; gp.Kb = 1024; gp.sA = E8_X; gp.sB = E8_W;
                pg8::gemm_phase<false, true, pg8::EpiOut>(lds, tid, gp, n_my, E);
            } else
            pg8::gemm_phase<false, false, pg8::EpiOut>(lds, tid, gp, n_my, E);
        }
        BAR_A();

        if (layer > 0) CONV_RUN_LIM(layer, 1 << 30, nullptr, 0, 4096);
        {
            PHASE_BEGIN();
            const bf16* Zb = (const bf16*)(ws + WS_ZB); unsigned char* X18 = (unsigned char*)(ws + WS_X18);
            int* RTOK = (int*)(ws + WS_RTOK); float* RGATE = (float*)(ws + WS_RGATE); int* APOS = (int*)(ws + WS_RDST);
            unsigned* CUR = ctl + CW_CUR + layer * NE;
            LAS v4u* rwf = (LAS v4u*)(lds + RING_OFF);
            LAS f32x4* lnp = (LAS f32x4*)(lds + TOK_OFF);
            const float* rw = ARG_IN(16) + (size_t)layer * D * NE;
            for (int f = tid; f < 32 * 2 * 64; f += NTHR) { const int s = f >> 7, nt = (f >> 6) & 1, l = f & 63, e = 16 * nt + (l & 15), kq = l >> 4;
                float w[8], hf[8], lo[8];
#pragma unroll
                for (int j = 0; j < 8; ++j) w[j] = gld<float>(rw + (32 * s + 8 * kq + j) * NE + e);
                const v4u hp = pack8(w); unpack8(hp, hf);
#pragma unroll
                for (int j = 0; j < 8; ++j) lo[j] = w[j] - hf[j];
                rwf[((s * 2 + nt) * 2 + 0) * 64 + l] = hp; rwf[((s * 2 + nt) * 2 + 1) * 64 + l] = pack8(lo); }
            if (tid < 256) { lnp[tid] = gld<f32x4>(ARG_IN(14) + layer * D + 4 * tid); lnp[256 + tid] = gld<f32x4>(ARG_IN(15) + layer * D + 4 * tid); }
            if (tid < NE) MISC[32 + tid] = 0u;
            __syncthreads();
            const int tau = lane & 15, kg = lane >> 4;
            float rb8[8];
#pragma unroll
            for (int i = 0; i < 8; ++i) rb8[i] = gld<float>(ARG_IN(17) + layer * NE + 16 * (i >> 2) + 4 * kg + (i & 3));
            LAS unsigned* hist = (LAS unsigned*)(lds + MISC_OFF) + 32;
#define BPERM_F(v, m) __uint_as_float((unsigned)__builtin_amdgcn_ds_bpermute((lane ^ (m)) << 2, (int)__float_as_uint(v)))
#define BPERM_I(v, m) __builtin_amdgcn_ds_bpermute((lane ^ (m)) << 2, (v))
            for (int rep = 0; rep < REP_LNR; ++rep)
            for (int tb = vcu; tb < T / 128; tb += G) {
                const int t = tb * 128 + wave * 16 + tau;
                const size_t rowo = (size_t)t * D + 8 * kg;
                v4u zp[32];
#pragma unroll
                for (int s = 0; s < 32; ++s) zp[s] = gld<v4u>(Zb + rowo + 32 * s);
                f32x2 S2 = {0.f, 0.f}, Q2 = {0.f, 0.f};
#pragma unroll
                for (int s = 0; s < 32; ++s) { float v[8]; unpack8(zp[s], v);
#pragma unroll
                    for (int j = 0; j < 4; ++j) { const f32x2 p = {v[2 * j], v[2 * j + 1]}; S2 += p; Q2 = __builtin_elementwise_fma(p, p, Q2); } }
                float S = S2[0] + S2[1], Q = Q2[0] + Q2[1];
                S += BPERM_F(S, 16); Q += BPERM_F(Q, 16); S += BPERM_F(S, 32); Q += BPERM_F(Q, 32);
                const float mean = S * (1.0f / D);
                const float rstd = 1.0f / sqrtf(fmaxf(Q * (1.0f / D) - mean * mean, 0.f) + LN_EPS);
                f32x4 a0 = {0.f, 0.f, 0.f, 0.f}, a1 = {0.f, 0.f, 0.f, 0.f};
                v2u x8prev = {0u, 0u};
#pragma unroll
                for (int s = 0; s < 32; ++s) {
                    asm volatile("" : "+v"(zp[s]));
                    float v[8]; unpack8(zp[s], v);
                    const f32x4 g0 = lnp[8 * s + 2 * kg], g1 = lnp[8 * s + 2 * kg + 1], b0 = lnp[256 + 8 * s + 2 * kg], b1 = lnp[256 + 8 * s + 2 * kg + 1];
                    { const f32x2 rstd2 = {rstd, rstd}, nmr2 = {-mean * rstd, -mean * rstd};
                      const f32x2 p0 = __builtin_elementwise_fma(__builtin_elementwise_fma((f32x2){v[0], v[1]}, rstd2, nmr2), (f32x2){g0[0], g0[1]}, (f32x2){b0[0], b0[1]});
                      const f32x2 p1 = __builtin_elementwise_fma(__builtin_elementwise_fma((f32x2){v[2], v[3]}, rstd2, nmr2), (f32x2){g0[2], g0[3]}, (f32x2){b0[2], b0[3]});
                      const f32x2 p2 = __builtin_elementwise_fma(__builtin_elementwise_fma((f32x2){v[4], v[5]}, rstd2, nmr2), (f32x2){g1[0], g1[1]}, (f32x2){b1[0], b1[1]});
                      const f32x2 p3 = __builtin_elementwise_fma(__builtin_elementwise_fma((f32x2){v[6], v[7]}, rstd2, nmr2), (f32x2){g1[2], g1[3]}, (f32x2){b1[2], b1[3]});
                      v[0] = p0[0]; v[1] = p0[1]; v[2] = p1[0]; v[3] = p1[1]; v[4] = p2[0]; v[5] = p2[1]; v[6] = p3[0]; v[7] = p3[1]; }
                    const v4u xp = pack8(v);
                    { float s8[8];
#pragma unroll
                      for (int j = 0; j < 4; ++j) { const f32x2 q = (f32x2){v[2 * j], v[2 * j + 1]} * (f32x2){SX8, SX8}; s8[2 * j] = q[0]; s8[2 * j + 1] = q[1]; }
                      const v2u w8 = pack8_fp8_sat(s8);
                      if (s & 1) { const v4u o16 = pg8::widen16(x8prev, w8);
                          gst<v4u>(X18 + (size_t)t * D + 32 * (s - 1 + (kg & 1)) + 8 * (kg & ~1), o16); }
                      else x8prev = w8; }
                    const bf16x8 xb = __builtin_bit_cast(bf16x8, xp);
                    a0 = __builtin_amdgcn_mfma_f32_16x16x32_bf16(__builtin_bit_cast(bf16x8, rwf[((s * 2 + 0) * 2 + 0) * 64 + lane]), xb, a0, 0, 0, 0);
                    a0 = __builtin_amdgcn_mfma_f32_16x16x32_bf16(__builtin_bit_cast(bf16x8, rwf[((s * 2 + 0) * 2 + 1) * 64 + lane]), xb, a0, 0, 0, 0);
                    a1 = __builtin_amdgcn_mfma_f32_16x16x32_bf16(__builtin_bit_cast(bf16x8, rwf[((s * 2 + 1) * 2 + 0) * 64 + lane]), xb, a1, 0, 0, 0);
                    a1 = __builtin_amdgcn_mfma_f32_16x16x32_bf16(__builtin_bit_cast(bf16x8, rwf[((s * 2 + 1) * 2 + 1) * 64 + lane]), xb, a1, 0, 0, 0);
                }
                float val[8]; int eid[8];
#pragma unroll
                for (int r = 0; r < 4; ++r) { val[r] = a0[r] + rb8[r]; eid[r] = 4 * kg + r; val[4 + r] = a1[r] + rb8[4 + r]; eid[4 + r] = 16 + 4 * kg + r; }
                float tv[4]; int tix[4];
#pragma unroll
                for (int k = 0; k < 4; ++k) {
                    float bv = val[0]; int bi = eid[0];
#pragma unroll
                    for (int i = 1; i < 8; ++i) if (val[i] > bv) { bv = val[i]; bi = eid[i]; }
#pragma unroll
                    for (int m = 16; m <= 32; m <<= 1) { const float ov = BPERM_F(bv, m); const int oi = BPERM_I(bi, m); if (ov > bv || (ov == bv && oi < bi)) { bv = ov; bi = oi; } }
                    tv[k] = bv; tix[k] = bi;
#pragma unroll
                    for (int i = 0; i < 8; ++i) if (eid[i] == bi) val[i] = -3.0e38f;
                }
                const float e1 = __expf(tv[1] - tv[0]), e2 = __expf(tv[2] - tv[0]), e3 = __expf(tv[3] - tv[0]);
                const float inv = 1.0f / (1.0f + e1 + e2 + e3);
                unsigned rk[4] = {0u, 0u, 0u, 0u};
                if (kg == 0) {
#pragma unroll
                    for (int k = 0; k < 4; ++k) rk[k] = __hip_atomic_fetch_add(hist + tix[k], 1u, __ATOMIC_RELAXED, __HIP_MEMORY_SCOPE_WORKGROUP);
                }
                __syncthreads();
                if (tid < NE) { const unsigned c = MISC[32 + tid]; MISC[64 + tid] = c ? xb_add(CUR + tid, c) : 0u; MISC[32 + tid] = 0u; }
                __syncthreads();
                if (kg == 0) {
                    const float gk[4] = {inv, e1 * inv, e2 * inv, e3 * inv};
                    v4u ps;
#pragma unroll
                    for (int k = 0; k < 4; ++k) { const int pos = tix[k] * ECAP + (int)MISC[64 + tix[k]] + (int)rk[k]; gst<int>(RTOK + pos, t); gst<float>(RGATE + pos, gk[k]);
                        if (k == 0) ps.x = (unsigned)pos; else if (k == 1) ps.y = (unsigned)pos; else if (k == 2) ps.z = (unsigned)pos; else ps.w = (unsigned)pos; }
                    gst<v4u>(APOS + t * 4, ps);
                }
            }
#undef BPERM_F
#undef BPERM_I
        }
        BAR_A();

        {
            const bool conv_layer = (layer + 1 < DEPTH) && (G == 256);
            const int Gg = conv_layer ? G - NCONV : G;
            unsigned* gdone = (unsigned*)(ARG_WS() + WS_CTL) + CW_GDONE + layer * 2;
            if (bx >= Gg) { CONV_RUN(layer, 1 << 30, gdone, Gg); CONV_RUN(layer + 1, 1 << 30, gdone, Gg); }
            else {
            PHASE_BEGIN();
            LAS int* TS = (LAS int*)(lds + TS_OFF);
            unsigned* CUR = ctl + CW_CUR + layer * NE;
            if (tid < NE) MISC[64 + tid] = xb_ld(CUR + tid);
            __syncthreads();
            if (tid == 0) { int a = 0; for (int e = 0; e < NE; ++e) { TS[e] = a; a += (int)((MISC[64 + e] + 255u) >> 8); } TS[NE] = a; }
            __syncthreads();
            const int nM = TS[NE];
            const int n_my = pg8::build_units(lds, tid, nM, 8, Gg, bx, true, (const int*)(ws + WS_RTOK), REP_MOE1);
            pg8::GemmP gp; gp.A = (const char*)(ws + WS_X18); gp.lda2 = D; gp.acol_pn = 0; gp.Bt = (const char*)(ws + WS_WGU + (size_t)layer * NE * 2048 * 1024); gp.b_estride = (size_t)2048 * 1024; gp.Kb = 1024; gp.sA = E8_X; gp.sB = E8_W;
            pg8::EpiSwiglu E; E.act = (unsigned char*)(ws + WS_ACT); E.bgu = ARG_IN(19) + (size_t)layer * NE * 2048;
            if (n_my <= 0 && conv_layer && tid == 0) (void)xb_add(gdone, 1u);
            pg8::gemm_phase<true, true, pg8::EpiSwiglu>(lds, tid, gp, n_my, E, REP_MOE1 > 1 ? n_my / 2 : (1 << 20), conv_layer ? gdone : nullptr);
            if (layer + 1 < DEPTH && n_my < (nM * 8 * REP_MOE1 + Gg - 1) / Gg) CONV_RUN(layer + 1, 2, nullptr, 0);
            CONV_RUN(layer, 1 << 30, nullptr, 0);
            }
        }
        BAR_L();

        {
            const bool conv_layer = (layer + 1 < DEPTH) && (G == 256);
            const int Gg = conv_layer ? G - NCONV : G;
            unsigned* gdone = (unsigned*)(ARG_WS() + WS_CTL) + CW_GDONE + layer * 2 + 1;
            if (bx >= Gg) { CONV_RUN(layer + 1, 1 << 30, gdone, Gg); }
            else {
            PHASE_BEGIN();
            LAS int* TS = (LAS int*)(lds + TS_OFF);
            const int nM = TS[NE];
            const int n_my = pg8::build_units(lds, tid, nM, 4, Gg, bx, true, nullptr, REP_MOE2);
            pg8::GemmP gp; gp.A = (const char*)(ws + WS_ACT); gp.lda2 = D; gp.acol_pn = 0; gp.Bt = (const char*)(ws + WS_WDN + (size_t)layer * NE * 1024 * 1024); gp.b_estride = (size_t)1024 * 1024; gp.Kb = 1024; gp.sA = E8_ACT; gp.sB = E8_W;
            pg8::EpiMoe2 E; E.Y = (unsigned char*)(ws + WS_Y); E.bdn = ARG_IN(21) + (size_t)layer * NE * D; E.rowgate = (const float*)(ws + WS_RGATE);
            if (n_my <= 0 && conv_layer && tid == 0) (void)xb_add(gdone, 1u);
            pg8::gemm_phase<false, true, pg8::EpiMoe2>(lds, tid, gp, n_my, E, 1 << 20, conv_layer ? gdone : nullptr);
            if (layer + 1 < DEPTH && n_my < (nM * 4 * REP_MOE2 + Gg - 1) / Gg) CONV_RUN(layer + 1, 2, nullptr, 0);
            }
        }
        BAR_L();

        {
            PHASE_BEGIN();
            const bf16* Zr = (const bf16*)(ws + WS_ZB); const unsigned char* Y = (const unsigned char*)(ws + WS_Y); const int* APOS = (const int*)(ws + WS_RDST); float* OUT = ARG_OUT(); bf16* XAb = (bf16*)(ws + WS_XAB);
            float lg[16], lb[16], mg[16], mb[16];
#pragma unroll
            for (int q = 0; q < 4; ++q) { const f32x4 b = gld<f32x4>(ARG_IN(22) + layer * D + 16 * lane + 4 * q), c = gld<f32x4>(ARG_IN(23) + layer * D + 16 * lane + 4 * q);
                const f32x4 b1 = gld<f32x4>(ARG_IN(14) + layer * D + 16 * lane + 4 * q), c1 = gld<f32x4>(ARG_IN(15) + layer * D + 16 * lane + 4 * q);
#pragma unroll
                for (int i = 0; i < 4; ++i) { lg[4 * q + i] = b[i]; lb[4 * q + i] = c[i]; mg[4 * q + i] = b1[i]; mb[4 * q + i] = c1[i]; } }
            for (int rep = 0; rep < REP_THIN; ++rep)
            for (int tb = vcu; tb < T / 128; tb += G) {
                const int t0 = tb * 128 + wave * 16;
                const int apos = gld<int>(APOS + t0 * 4 + lane);
#define YROW(ti_, k_) ((size_t)(unsigned)__builtin_amdgcn_readlane(apos, 4 * (ti_) + (k_)) * D)
                v4u nx[2], ny[4];
#pragma unroll
                for (int j = 0; j < 2; ++j) nx[j] = gld<v4u>(Zr + (size_t)t0 * D + 16 * lane + 8 * j);
#pragma unroll
                for (int k = 0; k < 4; ++k) ny[k] = gld<v4u>(Y + YROW(0, k) + 16 * lane);
                for (int ti = 0; ti < 16; ++ti) {
                    const int t = t0 + ti;
                    float v[16], h[16];
                    unpack8(nx[0], v); unpack8(nx[1], v + 8);
#pragma unroll
                    for (int i = 0; i < 16; ++i) h[i] = 0.f;
#pragma unroll
                    for (int k = 0; k < 4; ++k) { const unsigned wd[4] = {ny[k].x, ny[k].y, ny[k].z, ny[k].w};
#pragma unroll
                        for (int d = 0; d < 4; ++d) { const f32x2 lo = __builtin_amdgcn_cvt_pk_f32_fp8((int)wd[d], false), hi = __builtin_amdgcn_cvt_pk_f32_fp8((int)wd[d], true);
                            h[4 * d] += lo[0]; h[4 * d + 1] += lo[1]; h[4 * d + 2] += hi[0]; h[4 * d + 3] += hi[1]; } }
                    if (ti + 1 < 16) {
#pragma unroll
                        for (int j = 0; j < 2; ++j) nx[j] = gld<v4u>(Zr + (size_t)(t + 1) * D + 16 * lane + 8 * j);
#pragma unroll
                        for (int k = 0; k < 4; ++k) ny[k] = gld<v4u>(Y + YROW(ti + 1, k) + 16 * lane); }
                    ln16(v, mg, mb, lane);
#pragma unroll
                    for (int i = 0; i < 16; ++i) v[i] = v[i] * ALPHA + h[i] * (1.0f / SY8);
                    ln16(v, lg, lb, lane);
                    if (layer == DEPTH - 1) {
#pragma unroll
                        for (int q = 0; q < 4; ++q) gst<f32x4>(OUT + (size_t)t * D + 16 * lane + 4 * q, (f32x4){v[4 * q], v[4 * q + 1], v[4 * q + 2], v[4 * q + 3]});
                    } else {
                        gst<v4u>(XAb + (size_t)t * D + 16 * lane, pack8(v));
                        gst<v4u>(XAb + (size_t)t * D + 16 * lane + 8, pack8(v + 8));
                        if ((CF_IN_FP8 && layer == 1) || (SC_IN_FP8 && layer == 0)) {
                            float s8[16];
#pragma unroll
                            for (int i = 0; i < 16; ++i) s8[i] = v[i] * SX8;
                            const v2u a8 = pack8_fp8_sat(s8), b8 = pack8_fp8_sat(s8 + 8); v4u o8; o8.x = a8.x; o8.y = a8.y; o8.z = b8.x; o8.w = b8.y;
                            gst<v4u>((unsigned char*)(ws + WS_X18) + (size_t)t * D + 16 * lane, o8);
                        }
                    }
                }
            }
        }
        if (layer + 1 < DEPTH) GRID_BAR_CONV(layer + 1);
    }
    if (PROBE_CLOCK && bx == 0 && threadIdx.x == 0) {
        const unsigned mhz_ = gld<unsigned>((unsigned*)(ARG_WS() + WS_CTL) + 16); const unsigned long long t0_ = wall_clock64();
        while (wall_clock64() - t0_ < (unsigned long long)mhz_ * 10ull) __builtin_amdgcn_s_sleep(8);
    }
}

extern "C" void kernel_launch(void* const* d_in, const int* in_sizes, int n_in, void* d_out, int out_size, void* d_ws, size_t ws_size, hipStream_t stream) {
    static int grid = 0;
    if (grid == 0) {
        if (n_in != 24 || out_size != T * D || ws_size < WS_END) { fprintf(stderr, "kernel_launch: unexpected shapes (n_in %d out %d ws %zu)\n", n_in, out_size, ws_size); grid = -1; return; }
        if (hipFuncSetAttribute((const void*)mega_fwd, hipFuncAttributeMaxDynamicSharedMemorySize, LDS_BYTES) != hipSuccess) { fprintf(stderr, "kernel_launch: hipFuncSetAttribute failed\n"); grid = -1; return; }
        int dev = 0, cus = 0, per_cu = 0;
        (void)hipGetDevice(&dev); (void)hipDeviceGetAttribute(&cus, hipDeviceAttributeMultiprocessorCount, dev);
        if (hipOccupancyMaxActiveBlocksPerMultiprocessor(&per_cu, (const void*)mega_fwd, NTHR, LDS_BYTES) != hipSuccess || per_cu < 1) fprintf(stderr, "kernel_launch: occupancy query reports %d blocks per CU\n", per_cu);
        (void)hipGetLastError();
        grid = 256; if (cus > 0 && cus < grid) grid = cus;
    }
    if (grid < 0) return;
    (void)hipMemsetAsync((char*)d_ws + WS_CTL, 0, CTL_ZERO_BYTES, stream);
    Args a{};
    for (int i = 0; i < 24; ++i) a.in[i] = (const float*)d_in[i];
    a.out = (float*)d_out; a.ws = (unsigned char*)d_ws;
    hipLaunchKernelGGL(mega_fwd, dim3(grid), dim3(NTHR), LDS_BYTES, stream, a);
    const hipError_t le = hipPeekAtLastError();
    if (le != hipSuccess) fprintf(stderr, "kernel_launch: launch failed: %s\n", hipGetErrorName(le));
}
```

```cpp
#include <hip/hip_runtime.h>
#include <cstdio>
#include <cstdint>

#define GAS __attribute__((address_space(1)))
#define LAS __attribute__((address_space(3)))
typedef unsigned short bf16;
typedef unsigned v4u __attribute__((ext_vector_type(4)));
typedef unsigned v2u __attribute__((ext_vector_type(2)));
typedef float f32x4 __attribute__((ext_vector_type(4)));
typedef float f32x2 __attribute__((ext_vector_type(2)));
typedef short bf16x8 __attribute__((ext_vector_type(8)));
typedef int v4i __attribute__((ext_vector_type(4)));
typedef int v8i __attribute__((ext_vector_type(8)));

template <class V> __device__ __forceinline__ V gld(const void* p) { return *(const GAS V*)p; }
template <class V> __device__ __forceinline__ void gst(void* p, V v) { *(GAS V*)p = v; }

#ifndef REP_P0
#define REP_P0 1
#endif
#ifndef REP_MOE1
#define REP_MOE1 1
#endif
#ifndef REP_MOE2
#define REP_MOE2 1
#endif
#ifndef REP_THIN
#define REP_THIN 1
#endif
#ifndef REP_MIXG
#define REP_MIXG 1
#endif
#ifndef REP_LNR
#define REP_LNR 1
#endif
#ifndef REP_BAR
#define REP_BAR 1
#endif
#ifndef PROBE_CLOCK
#define PROBE_CLOCK 0
#endif
#ifndef SC_OUT_FP8
#define SC_OUT_FP8 0
#endif
#ifndef SC_IN_FP8
#define SC_IN_FP8 1
#endif
#ifndef CF_OUT_FP8
#define CF_OUT_FP8 1
#endif
#ifndef CF_IN_FP8
#define CF_IN_FP8 1
#endif
#ifndef REP_EPI1
#define REP_EPI1 1
#endif
#ifndef REP_EPI2
#define REP_EPI2 1
#endif
constexpr int T = 32768, D = 1024, SEQ = 4096, NE = 32, TOPK = 4, NA = T * TOPK, DEPTH = 4;
constexpr int MAXTILES = NA / 256 + NE;
constexpr int ECAP = T, ETILES = ECAP / 256;
constexpr int NPAD = MAXTILES * 256;
constexpr float LN_EPS = 1e-5f;
constexpr float ALPHA = 1.681792830507429f;
constexpr int NWAVES = 8, NTHR = 512;
constexpr int MAXU = 19;
constexpr float SX8 = 16.0f, SACT8 = 4.0f, SW8 = 256.0f, SY8 = 32.0f;
constexpr int E8_X = 0x7B7B7B7B  , E8_ACT = 0x7D7D7D7D  , E8_W = 0x77777777  ;

constexpr size_t MiB = 1u << 20;
constexpr size_t WS_CTL = 0, CTL_ZERO_BYTES = 64 * 1024;
constexpr size_t WS_IDX = 1 * MiB;
constexpr size_t WS_GATE = 1 * MiB + 512 * 1024;
constexpr size_t WS_RTOK = 1712 * MiB;
constexpr size_t WS_RDST = 3 * MiB;
constexpr size_t WS_RGATE = 1716 * MiB;
constexpr size_t WS_WPOOL = 5 * MiB;
constexpr size_t WS_WSCIN = 6 * MiB;
constexpr size_t WS_WSCOUT = 12 * MiB;
constexpr size_t WS_WCFIN = 14 * MiB;
constexpr size_t WS_WCFOUT = 18 * MiB;
constexpr size_t WS_WGU = 32 * MiB;
constexpr size_t WS_WDN = 544 * MiB;
constexpr size_t WS_X18 = 704 * MiB;
constexpr size_t WS_ZB = 800 * MiB;
constexpr size_t WS_XAB = 864 * MiB;
constexpr size_t WS_M1 = 992 * MiB;
constexpr size_t WS_M2 = 1056 * MiB;
constexpr size_t WS_M3 = 1120 * MiB;
constexpr size_t WS_ACT = 1720 * MiB;
constexpr size_t WS_Y = 2744 * MiB;
constexpr size_t WS_END = 3768 * MiB;
constexpr int CW_BAR = 4096;
constexpr int CW_CNT = 8192;
constexpr int CW_CUR = 8192 + 256;
constexpr int CW_DQ = 8192 + 512;
constexpr int CW_GDONE = 8192 + 512 + 64;

constexpr int RING_OFF = 0, RING_BYTES = 131072;
constexpr int TOK_OFF = RING_BYTES;
constexpr int UT_OFF = TOK_OFF + MAXU * 1024;
constexpr int TS_OFF = UT_OFF + (2 * MAXU + 2) * 16;
constexpr int MISC_OFF = TS_OFF + 36 * 4;
constexpr int EPI_OFF = ((MISC_OFF + 128 * 4 + 255) / 256) * 256;
constexpr int LDS_BYTES = EPI_OFF + 2 * 4096;
static_assert(LDS_BYTES <= 160 * 1024 && (MISC_OFF % 16) == 0, "LDS map");

#define LDS_WAIT() asm volatile("s_waitcnt lgkmcnt(0)" ::: "memory")
#define VM_WAIT() asm volatile("s_waitcnt vmcnt(0)" ::: "memory")

__device__ __forceinline__ unsigned cvt_pk_bf16(float lo, float hi) { unsigned r; asm volatile("v_cvt_pk_bf16_f32 %0, %1, %2" : "=v"(r) : "v"(lo), "v"(hi)); return r; }
__device__ __forceinline__ v2u pack8_fp8(const float* c) {
    int a = __builtin_amdgcn_cvt_pk_fp8_f32(c[0], c[1], 0, false); a = __builtin_amdgcn_cvt_pk_fp8_f32(c[2], c[3], a, true);
    int b = __builtin_amdgcn_cvt_pk_fp8_f32(c[4], c[5], 0, false); b = __builtin_amdgcn_cvt_pk_fp8_f32(c[6], c[7], b, true); v2u w; w.x = (unsigned)a; w.y = (unsigned)b; return w; }
__device__ __forceinline__ v2u pack8_fp8_sat(const float* v) { float c[8];
    float lim = 448.0f; asm volatile("" : "+v"(lim));
#pragma unroll
    for (int i = 0; i < 8; ++i) c[i] = __builtin_amdgcn_fmed3f(v[i], -lim, lim);
    return pack8_fp8(c); }
__device__ __forceinline__ float bf_lo(unsigned u) { return __uint_as_float(u << 16); }
__device__ __forceinline__ float bf_hi(unsigned u) { return __uint_as_float(u & 0xffff0000u); }
__device__ __forceinline__ float sigmoidf_(float x) { return __builtin_amdgcn_rcpf(1.0f + __expf(-x)); }
#define DPP_F(v, ctrl) __int_as_float(__builtin_amdgcn_update_dpp(0, __float_as_int(v), (ctrl), 0xf, 0xf, true))
#define DPP_XOR1 0xB1
#define DPP_XOR2 0x4E
#define DPP_QREV 0x1B
#define DPP_HMIR 0x141
#define DPP_RMIR 0x140
#define DPP_ROR8 0x128
__device__ __forceinline__ float rdlane(float v, int l) { return __uint_as_float((unsigned)__builtin_amdgcn_readlane((int)__float_as_uint(v), l)); }
__device__ __forceinline__ float wave_sum(float v, int lane) {
    (void)lane;
    v += DPP_F(v, DPP_XOR1); v += DPP_F(v, DPP_XOR2); v += DPP_F(v, DPP_HMIR); v += DPP_F(v, DPP_RMIR);
    return (rdlane(v, 0) + rdlane(v, 16)) + (rdlane(v, 32) + rdlane(v, 48));
}

#define XB_TMO      128
#define XB_XCNT(j)  (256  + 64 * (j))
#define XB_XSUB(j)  (1280 + 64 * (j))
#define XB_XGEN(j)  (2304 + 64 * (j))
#define XB_TOP      3328
#define XB_TOPGEN   3392
#define XCD_BAR_WORDS 3456
#define XB_SPIN_CAP (1u << 18)

__device__ __forceinline__ unsigned xb_ld(unsigned* p)              { return __hip_atomic_load((GAS unsigned*)p, __ATOMIC_RELAXED, __HIP_MEMORY_SCOPE_AGENT); }
__device__ __forceinline__ unsigned xb_add(unsigned* p, unsigned v) { return __hip_atomic_fetch_add((GAS unsigned*)p, v, __ATOMIC_RELAXED, __HIP_MEMORY_SCOPE_AGENT); }
__device__ __forceinline__ unsigned xb_xcc_id() { return (unsigned)__builtin_amdgcn_s_getreg((3 << 11) | 20) & 0xFu; }
#define XB_SPIN(cond, bar) do { unsigned _sp = 0; while (cond) { __builtin_amdgcn_s_sleep(1); \
    if ((++_sp & 255u) == 0u) { if (xb_ld(&(bar)[XB_TMO])) break; if (_sp > XB_SPIN_CAP) { (void)xb_add(&(bar)[XB_TMO], 1u); break; } } } } while (0)

struct XcdBarrier { unsigned* bar; unsigned x; volatile LAS unsigned* st; };

__device__ __forceinline__ XcdBarrier xcd_barrier_post(unsigned* bar, volatile LAS unsigned* st) {
    XcdBarrier b; b.bar = bar; b.x = xb_xcc_id(); b.st = st;
    if (threadIdx.x == 0) (void)xb_add(&bar[XB_XCNT(b.x)], 1u);
    return b;
}
__device__ __forceinline__ void xcd_barrier_complete(unsigned* bar, unsigned x, unsigned& nloc, unsigned& nx) {
    const unsigned G = gridDim.x * gridDim.y * gridDim.z;
    unsigned sum, cnt, mine, sp = 0u;
    for (;;) {
        sum = 0u; cnt = 0u; mine = 0u;
#pragma unroll
        for (unsigned j = 0; j < 16; ++j) { const unsigned c = xb_ld(&bar[XB_XCNT(j)]); sum += c; cnt += (c > 0u) ? 1u : 0u; mine = (j == x) ? c : mine; }
        if (sum == G) break;
        __builtin_amdgcn_s_sleep(1);
        if ((++sp & 255u) == 0u) { if (xb_ld(&bar[XB_TMO])) break; if (sp > XB_SPIN_CAP) { (void)xb_add(&bar[XB_TMO], 1u); break; } }
    }
    nloc = mine > 0u ? mine : 1u; nx = cnt > 0u ? cnt : 1u;
}
__device__ __forceinline__ void xcd_barrier(const XcdBarrier& b) {
    asm volatile("s_waitcnt vmcnt(0)" ::: "memory");
    __syncthreads();
    if (threadIdx.x == 0) {
        unsigned* bar = b.bar;
        __builtin_amdgcn_s_waitcnt(0);
        unsigned nloc = b.st[0], nx = b.st[1];
        if (nloc == 0u) { xcd_barrier_complete(bar, b.x, nloc, nx); b.st[0] = nloc; b.st[1] = nx; }
        const unsigned old = xb_add(&bar[XB_XSUB(b.x)], 1u);
        const unsigned gen = old / nloc;
        if (old + 1u == (gen + 1u) * nloc) {
            __builtin_amdgcn_fence(__ATOMIC_RELEASE, "agent");
            asm volatile("s_waitcnt vmcnt(0)" ::: "memory");
            const unsigned og = xb_add(&bar[XB_TOP], 1u);
            const unsigned tg = og / nx;
            if (og + 1u == (tg + 1u) * nx) xb_add(&bar[XB_TOPGEN], 1u);
            else XB_SPIN(xb_ld(&bar[XB_TOPGEN]) == tg, bar);
            __builtin_amdgcn_fence(__ATOMIC_ACQUIRE, "agent");
            xb_add(&bar[XB_XGEN(b.x)], 1u);
            asm volatile("s_waitcnt vmcnt(0)" ::: "memory");
        } else {
            XB_SPIN(xb_ld(&bar[XB_XGEN(b.x)]) == gen, bar);
            __builtin_amdgcn_fence(__ATOMIC_ACQUIRE, "agent");
            asm volatile("s_waitcnt vmcnt(0)" ::: "memory");
        }
    }
    __syncthreads();
}

__device__ __forceinline__ bool xcd_barrier_arrive(const XcdBarrier& b) {
    asm volatile("s_waitcnt vmcnt(0)" ::: "memory");
    __syncthreads();
    if (threadIdx.x == 0) {
        unsigned* bar = b.bar;
        __builtin_amdgcn_s_waitcnt(0);
        unsigned nloc = b.st[0], nx = b.st[1];
        if (nloc == 0u) { xcd_barrier_complete(bar, b.x, nloc, nx); b.st[0] = nloc; b.st[1] = nx; }
        const unsigned old = xb_add(&bar[XB_XSUB(b.x)], 1u);
        const unsigned gen = old / nloc;
        b.st[9] = gen; b.st[10] = (old + 1u == (gen + 1u) * nloc) ? 1u : 0u;
    }
    __syncthreads();
    return __builtin_amdgcn_readfirstlane((int)b.st[10]) != 0;
}
__device__ __forceinline__ void xcd_barrier_finish(const XcdBarrier& b) {
    __syncthreads();
    if (threadIdx.x == 0) {
        unsigned* bar = b.bar;
        const unsigned gen = b.st[9], nx = b.st[1];
        if (b.st[10] != 0u) {
            __builtin_amdgcn_fence(__ATOMIC_RELEASE, "agent");
            asm volatile("s_waitcnt vmcnt(0)" ::: "memory");
            const unsigned og = xb_add(&bar[XB_TOP], 1u);
            const unsigned tg = og / nx;
            if (og + 1u == (tg + 1u) * nx) xb_add(&bar[XB_TOPGEN], 1u);
            else XB_SPIN(xb_ld(&bar[XB_TOPGEN]) == tg, bar);
            __builtin_amdgcn_fence(__ATOMIC_ACQUIRE, "agent");
            xb_add(&bar[XB_XGEN(b.x)], 1u);
            asm volatile("s_waitcnt vmcnt(0)" ::: "memory");
        } else {
            XB_SPIN(xb_ld(&bar[XB_XGEN(b.x)]) == gen, bar);
            __builtin_amdgcn_fence(__ATOMIC_ACQUIRE, "agent");
            asm volatile("s_waitcnt vmcnt(0)" ::: "memory");
        }
    }
    __syncthreads();
}

namespace pg8 {
constexpr int BM = 256, BK = 64, HALF = 128, HTB = HALF * BK * 2, STAGE_BYTES = 8 * HTB, NXCD = 8, WGM = 8;
__host__ __device__ __forceinline__ int lds_byte(int r, int c) { const int st = (r >> 4) * 2 + (c >> 5), rr = r & 15, cc = c & 31, ob = rr * 64 + cc * 2; return st * 1024 + (ob ^ (((ob >> 9) & 1) << 5)); }
__host__ __device__ __forceinline__ void stage_rc(int b, int& R, int& C) { const int st = b / 1024, sb = b % 1024, swz = sb ^ (((sb >> 9) & 1) << 5); R = (st >> 1) * 16 + swz / 64; C = (st & 1) * 32 + (swz % 64) / 2; }
__host__ __device__ __forceinline__ int perm32(int rho) { const int n = rho >> 4, i = rho & 15; return 8 * (i >> 2) + 4 * n + (i & 3); }

struct Unit { int pm, pn, e; };
struct GemmP {
    const char* A; unsigned lda2;
    unsigned acol_pn;
    const char* Bt; size_t b_estride;
    int Kb;
    int sA, sB;
};

__device__ __forceinline__ void unit_of(int L, int nM, int nN, int& pm, int& pn) {
    const int nwg = nM * nN;
    int wgid = L; { const int q = nwg / NXCD, r = nwg % NXCD, xcd = wgid % NXCD, off = wgid / NXCD; wgid = (xcd < r ? xcd * (q + 1) : r * (q + 1) + (xcd - r) * q) + off; }
    const int nig = WGM * nN, gid = wgid / nig, fm = gid * WGM, gsz = (nM - fm) < WGM ? (nM - fm) : WGM;
    pm = fm + ((wgid % nig) % gsz); pn = (wgid % nig) / gsz;
}
__device__ __forceinline__ int build_units(LAS unsigned char* lds, const int tid, int nM, int nN, int G, int c, bool moe, const int* row_tok, const int dup = 1) {
    LAS int* UT = (LAS int*)(lds + UT_OFF); LAS const int* TS = (LAS const int*)(lds + TS_OFF); LAS int* TOK = (LAS int*)(lds + TOK_OFF);
    LAS const int* CNTL = (LAS const int*)(lds + MISC_OFF) + 64;
    const int nwg = nM * nN;
    int n_my = (nwg > c) ? (nwg - c + G - 1) / G : 0; if (n_my > MAXU) n_my = MAXU;
    if (tid < n_my) {
        int pm, pn; unit_of(tid * G + c, nM, nN, pm, pn);
        int e = 0, j = 0; if (moe) { int lo = 1, hi = NE;
#pragma unroll
            for (int it = 0; it < 5; ++it) { const int mid = (lo + hi) >> 1; if (TS[mid] > pm) hi = mid; else lo = mid + 1; }
            e = lo - 1; j = pm - TS[e]; pm = e * ETILES + j; }
        UT[4 * tid + 0] = pm; UT[4 * tid + 1] = pn; UT[4 * tid + 2] = e; UT[4 * tid + 3] = j;
    }
    __syncthreads();
    if (row_tok) {
        for (int idx = tid; idx < n_my * 256; idx += NTHR) { const int i = idx >> 8, r = idx & 255; const bool valid = UT[4 * i + 3] * 256 + r < CNTL[UT[4 * i + 2]];
            TOK[idx] = valid ? gld<int>(row_tok + UT[4 * i] * 256 + r) : 0; }
    }
    __syncthreads();
    if (dup > 1) { if (tid < n_my) { UT[4 * (tid + n_my) + 0] = UT[4 * tid]; UT[4 * (tid + n_my) + 1] = UT[4 * tid + 1]; UT[4 * (tid + n_my) + 2] = UT[4 * tid + 2]; UT[4 * (tid + n_my) + 3] = UT[4 * tid + 3]; } __syncthreads(); return 2 * n_my; }
    return n_my;
}
__device__ __forceinline__ Unit read_unit(LAS const int* UT, int i) {
    Unit u; u.pm = __builtin_amdgcn_readfirstlane(UT[4 * i]); u.pn = __builtin_amdgcn_readfirstlane(UT[4 * i + 1]); u.e = __builtin_amdgcn_readfirstlane(UT[4 * i + 2]); return u;
}
template <bool GATHER>
__device__ __forceinline__ void a_offsets(unsigned (&v)[2][2], const GemmP& g, const Unit& u, int ui, const int (&Rr)[2], const int (&Cc2)[2], LAS const int* TOK, const int tokn) {
#pragma unroll
    for (int h = 0; h < 2; ++h)
#pragma unroll
        for (int i = 0; i < 2; ++i) {
            const int row = GATHER ? TOK[(ui >= tokn ? ui - tokn : ui) * 256 + h * HALF + Rr[i]] : (u.pm * BM + h * HALF + Rr[i]);
            v[h][i] = (unsigned)row * g.lda2 + (unsigned)Cc2[i] + (unsigned)u.pn * g.acol_pn;
        }
}

template <bool GATHER, bool FP8, class Epi>
__device__ __forceinline__ void gemm_phase(LAS unsigned char* lds, const int tid, const GemmP g, const int n_my, const Epi& E, const int tokn = 1 << 20, unsigned* last_ctr = nullptr) {
    const int wid = __builtin_amdgcn_readfirstlane(tid >> 6), lane = tid & 63, wr = wid >> 2, wc = wid & 3, fr = lane & 15, fq = lane >> 4;
    const int Kb = g.Kb, nt = Kb / (BK * 2);
    if (n_my <= 0) return;
    int Rr[2], Cc2[2]; unsigned voffB[2];
#pragma unroll
    for (int i = 0; i < 2; ++i) { int R, C; stage_rc(tid * 16 + i * 8192, R, C); const int Rb = Epi::PERM ? ((R & ~31) + perm32(R & 31)) : R;
        Rr[i] = R; Cc2[i] = C * 2; voffB[i] = (unsigned)(Rb * Kb + C * 2); }
    const size_t kstep = (size_t)(BK * 2);
    const size_t hstep = (size_t)HALF * Kb;
    const size_t tstepB = 2 * hstep;
    const unsigned ldsw = (unsigned)wid * 1024u;
    const int aoff = lds_byte(wr * 64 + fr, fq * 8), boff = lds_byte(wc * 32 + fr, fq * 8);
    LAS const int* UT = (LAS const int*)(lds + UT_OFF); LAS const int* TOK = (LAS const int*)(lds + TOK_OFF);
#define PG8_SA(b, h) (((b) * 2 + (h)) * HTB)
#define PG8_SB(b, h) ((4 + (b) * 2 + (h)) * HTB)
#define PG8_STAGE(bufoff, gbase, voff) do { _Pragma("unroll") for (int _i = 0; _i < 2; ++_i) \
        __builtin_amdgcn_global_load_lds((const unsigned*)((const char*)(gbase) + (voff)[_i]), (LAS unsigned*)(lds + (bufoff) + ldsw + _i * 8192), 16, 0, 0); } while (0)
#define PG8_LDA(dst, b, h) do { _Pragma("unroll") for (int m = 0; m < 4; ++m) _Pragma("unroll") for (int k = 0; k < 2; ++k) dst[m][k] = *(const LAS bf16x8*)(lds + PG8_SA(b, h) + aoff + m * 2048 + k * 1024); } while (0)
#define PG8_LDB(dst, b, h) do { _Pragma("unroll") for (int n = 0; n < 2; ++n) _Pragma("unroll") for (int k = 0; k < 2; ++k) dst[n][k] = *(const LAS bf16x8*)(lds + PG8_SB(b, h) + boff + n * 2048 + k * 1024); } while (0)
#define PG8_CAT(x) __builtin_shufflevector(__builtin_bit_cast(v4i, (x)[0]), __builtin_bit_cast(v4i, (x)[1]), 0, 1, 2, 3, 4, 5, 6, 7)
#define PG8_MMA(ai, bj, At, Bt) do { __builtin_amdgcn_s_setprio(1); _Pragma("unroll") for (int m = 0; m < 4; ++m) _Pragma("unroll") for (int n = 0; n < 2; ++n) { \
        if constexpr (FP8) { const v8i b8_ = PG8_CAT(Bt[n]), a8_ = PG8_CAT(At[m]); asm volatile("v_mfma_scale_f32_16x16x128_f8f6f4 %0, %1, %2, %0, %3, %4 op_sel_hi:[0,0,0]" : "+v"(acc[ai][bj][m][n]) : "v"(b8_), "v"(a8_), "v"(vsB), "v"(vsA)); } \
        else { _Pragma("unroll") for (int k = 0; k < 2; ++k) acc[ai][bj][m][n] = __builtin_amdgcn_mfma_f32_16x16x32_bf16(Bt[n][k], At[m][k], acc[ai][bj][m][n], 0, 0, 0); } } \
        __builtin_amdgcn_s_setprio(0); } while (0)
#define PG8_MMA0(ai, bj, At, Bt) do { __builtin_amdgcn_s_setprio(1); _Pragma("unroll") for (int m = 0; m < 4; ++m) _Pragma("unroll") for (int n = 0; n < 2; ++n) { \
        if constexpr (FP8) { const v8i b8_ = PG8_CAT(Bt[n]), a8_ = PG8_CAT(At[m]); asm volatile("v_mfma_scale_f32_16x16x128_f8f6f4 %0, %1, %2, 0, %3, %4 op_sel_hi:[0,0,0]" : "=&v"(acc[ai][bj][m][n]) : "v"(b8_), "v"(a8_), "v"(vsB), "v"(vsA)); } \
        else { acc[ai][bj][m][n] = __builtin_amdgcn_mfma_f32_16x16x32_bf16(Bt[n][0], At[m][0], (f32x4){0.f, 0.f, 0.f, 0.f}, 0, 0, 0); acc[ai][bj][m][n] = __builtin_amdgcn_mfma_f32_16x16x32_bf16(Bt[n][1], At[m][1], acc[ai][bj][m][n], 0, 0, 0); } } \
        __builtin_amdgcn_s_setprio(0); } while (0)
#define PG8_WAIT_V(n) asm volatile("s_waitcnt vmcnt(" #n ")" ::: "memory")
#define PG8_WAIT_L(n) asm volatile("s_waitcnt lgkmcnt(" #n ")" ::: "memory")
#define PG8_BAR __builtin_amdgcn_s_barrier()
#define PG8_SCHED __builtin_amdgcn_sched_barrier(0)
    Unit cur = read_unit(UT, 0), nxt; int ui = 0;
    f32x4 acc[2][2][4][2];
    if constexpr (!FP8) {
#pragma unroll
    for (int a = 0; a < 2; ++a)
#pragma unroll
        for (int b = 0; b < 2; ++b)
#pragma unroll
            for (int m = 0; m < 4; ++m)
#pragma unroll
                for (int n = 0; n < 2; ++n) acc[a][b][m][n] = (f32x4){0.f, 0.f, 0.f, 0.f};
    }
#define PG8_PIN_ACC() do { if constexpr (FP8) { _Pragma("unroll") for (int a_ = 0; a_ < 2; ++a_) _Pragma("unroll") for (int b_ = 0; b_ < 2; ++b_) \
        asm volatile("" : "+v"(acc[a_][b_][0][0]), "+v"(acc[a_][b_][0][1]), "+v"(acc[a_][b_][1][0]), "+v"(acc[a_][b_][1][1]), "+v"(acc[a_][b_][2][0]), "+v"(acc[a_][b_][2][1]), "+v"(acc[a_][b_][3][0]), "+v"(acc[a_][b_][3][1])); \
        asm volatile("s_nop 1" ::: "memory"); } } while (0)
    bf16x8 At[4][2], B0[2][2], B1[2][2];
    int vsA = g.sA, vsB = g.sB; asm volatile("" : "+v"(vsA), "+v"(vsB));
    unsigned vAc[2][2], vAn[2][2];
    a_offsets<GATHER>(vAc, g, cur, 0, Rr, Cc2, TOK, tokn);
    const char* const Ab = g.A;
    const char* cB = g.Bt + (size_t)cur.e * g.b_estride + (size_t)cur.pn * tstepB;
    PG8_STAGE(PG8_SB(0, 0), cB, voffB); PG8_STAGE(PG8_SB(0, 1), cB + hstep, voffB); PG8_STAGE(PG8_SA(0, 0), Ab, vAc[0]); PG8_STAGE(PG8_SA(0, 1), Ab, vAc[1]);
    if (wr == 1) PG8_BAR;
    PG8_WAIT_V(2); PG8_BAR;
    PG8_STAGE(PG8_SB(1, 0), cB + kstep, voffB); PG8_STAGE(PG8_SA(1, 0), Ab + kstep, vAc[0]); PG8_STAGE(PG8_SB(1, 1), cB + hstep + kstep, voffB);
    PG8_WAIT_V(6); PG8_BAR;
    for (;;) {
        const bool has_next = (ui + 1 < n_my);
        if (!has_next && last_ctr != nullptr && tid == 0) (void)xb_add(last_ctr, 1u);
        nxt = cur; if (has_next) nxt = read_unit(UT, ui + 1);
        const char* nB = has_next ? g.Bt + (size_t)nxt.e * g.b_estride + (size_t)nxt.pn * tstepB : cB;
        for (int t = 0; t < nt; t += 2) {
            const bool last = (t == nt - 2);
            if (t == 0) E.prefetch(lds + EPI_OFF + (ui & 1) * 4096, cur, wid, lane);
            const char* a1 = Ab + (size_t)(t + 1) * kstep;
            const char* a2 = last ? Ab : Ab + (size_t)(t + 2) * kstep; const char* b2 = last ? nB : cB + (size_t)(t + 2) * kstep;
            const char* a3 = a2 + kstep; const char* b3 = b2 + kstep;
            unsigned o2[2][2];
            if (last) {
                if (has_next) a_offsets<GATHER>(vAn, g, nxt, ui + 1, Rr, Cc2, TOK, tokn);
                else { vAn[0][0] = vAc[0][0]; vAn[0][1] = vAc[0][1]; vAn[1][0] = vAc[1][0]; vAn[1][1] = vAc[1][1]; }
                o2[0][0] = vAn[0][0]; o2[0][1] = vAn[0][1]; o2[1][0] = vAn[1][0]; o2[1][1] = vAn[1][1];
            } else { o2[0][0] = vAc[0][0]; o2[0][1] = vAc[0][1]; o2[1][0] = vAc[1][0]; o2[1][1] = vAc[1][1]; }
            PG8_LDB(B0, 0, 0); PG8_LDB(B1, 0, 1); PG8_SCHED; PG8_LDA(At, 0, 0); PG8_STAGE(PG8_SA(1, 1), a1, vAc[1]);
            PG8_WAIT_V(8); PG8_WAIT_L(0); PG8_BAR; if (FP8 && t == 0) { PG8_MMA0(0, 0, At, B0); PG8_MMA0(0, 1, At, B1); } else { PG8_MMA(0, 0, At, B0); PG8_MMA(0, 1, At, B1); } PG8_BAR; PG8_SCHED;
            PG8_LDA(At, 0, 1); PG8_STAGE(PG8_SB(0, 0), b2, voffB); PG8_STAGE(PG8_SB(0, 1), b2 + hstep, voffB); PG8_STAGE(PG8_SA(0, 0), a2, o2[0]);
            PG8_WAIT_V(8); PG8_WAIT_L(0); PG8_BAR; if (FP8 && t == 0) { PG8_MMA0(1, 0, At, B0); PG8_MMA0(1, 1, At, B1); } else { PG8_MMA(1, 0, At, B0); PG8_MMA(1, 1, At, B1); } PG8_BAR; PG8_SCHED;
            PG8_LDB(B0, 1, 0); PG8_LDB(B1, 1, 1); PG8_SCHED; PG8_LDA(At, 1, 0); PG8_STAGE(PG8_SA(0, 1), a2, o2[1]);
            PG8_WAIT_V(8); PG8_WAIT_L(0); PG8_BAR; PG8_MMA(0, 0, At, B0); PG8_MMA(0, 1, At, B1); PG8_BAR; PG8_SCHED;
            PG8_LDA(At, 1, 1); PG8_STAGE(PG8_SB(1, 0), b3, voffB); PG8_STAGE(PG8_SB(1, 1), b3 + hstep, voffB); PG8_STAGE(PG8_SA(1, 0), a3, o2[0]);
            PG8_WAIT_V(8); PG8_WAIT_L(0); PG8_BAR; PG8_MMA(1, 0, At, B0); PG8_MMA(1, 1, At, B1); PG8_BAR; PG8_SCHED;
        }
        if (wr == 0) PG8_BAR;
        if constexpr (FP8) asm volatile("s_nop 15" ::: "memory");
        for (int re_ = 0; re_ < Epi::REPS; ++re_) E(acc, cur, wr, wc, fr, fq, lds + EPI_OFF + (ui & 1) * 4096);
        if (!has_next) break;
        if constexpr (!FP8) {
#pragma unroll
        for (int a = 0; a < 2; ++a)
#pragma unroll
            for (int b = 0; b < 2; ++b)
#pragma unroll
                for (int m = 0; m < 4; ++m)
#pragma unroll
                    for (int n = 0; n < 2; ++n) acc[a][b][m][n] = (f32x4){0.f, 0.f, 0.f, 0.f};
        }
        cur = nxt; cB = nB; ++ui;
        vAc[0][0] = vAn[0][0]; vAc[0][1] = vAn[0][1]; vAc[1][0] = vAn[1][0]; vAc[1][1] = vAn[1][1];
        if (wr == 1) PG8_BAR;
    }
    PG8_WAIT_V(0);
    PG8_BAR;
#undef PG8_SA
#undef PG8_SB
#undef PG8_STAGE
#undef PG8_LDA
#undef PG8_LDB
#undef PG8_MMA
#undef PG8_MMA0
#undef PG8_PIN_ACC
#undef PG8_CAT
#undef PG8_WAIT_V
#undef PG8_WAIT_L
#undef PG8_BAR
#undef PG8_SCHED
}

__device__ __forceinline__ v4u widen16(const v2u X, const v2u Y) {
    const auto a = __builtin_amdgcn_permlane16_swap(X.x, Y.x, false, false), b = __builtin_amdgcn_permlane16_swap(X.y, Y.y, false, false);
    v4u o; o.x = a[0]; o.y = b[0]; o.z = a[1]; o.w = b[1]; return o;
}
struct EpiOut {
    static constexpr bool PERM = true; static constexpr int REPS = 1;
    const bf16* xres; const float* xres32; bf16* z; const float* bias; const float* scale;
    __device__ __forceinline__ void prefetch(LAS unsigned char*, const Unit&, int, int) const {}
    __device__ __forceinline__ void operator()(const f32x4 (&acc)[2][2][4][2], const Unit& u, int wr, int wc, int fr, int fq, const LAS unsigned char*) const {
        const int row0 = u.pm * BM + wr * 64 + fr, c0 = u.pn * BM + wc * 32 + 8 * fq;
        f32x4 bv[2][2], sv[2][2];
#pragma unroll
        for (int bj = 0; bj < 2; ++bj)
#pragma unroll
            for (int n = 0; n < 2; ++n) {
                bv[bj][n] = bias ? gld<f32x4>(bias + c0 + bj * HALF + 4 * n) : (f32x4){0.f, 0.f, 0.f, 0.f};
                sv[bj][n] = scale ? gld<f32x4>(scale + c0 + bj * HALF + 4 * n) : (f32x4){1.f, 1.f, 1.f, 1.f};
            }
#pragma unroll
        for (int ai = 0; ai < 2; ++ai)
#pragma unroll
            for (int m = 0; m < 4; ++m) { const size_t off = (size_t)(row0 + ai * HALF + m * 16) * D + c0;
#pragma unroll
                for (int bj = 0; bj < 2; ++bj) { f32x4 x0, x1;
                    if (xres32) { x0 = gld<f32x4>(xres32 + off + bj * HALF); x1 = gld<f32x4>(xres32 + off + bj * HALF + 4); }
                    else { const v4u xr = gld<v4u>(xres + off + bj * HALF); x0 = (f32x4){bf_lo(xr.x), bf_hi(xr.x), bf_lo(xr.y), bf_hi(xr.y)}; x1 = (f32x4){bf_lo(xr.z), bf_hi(xr.z), bf_lo(xr.w), bf_hi(xr.w)}; }
                    const f32x4 o0 = x0 * ALPHA + (acc[ai][bj][m][0] + bv[bj][0]) * sv[bj][0], o1 = x1 * ALPHA + (acc[ai][bj][m][1] + bv[bj][1]) * sv[bj][1];
                    v4u w; w.x = cvt_pk_bf16(o0[0], o0[1]); w.y = cvt_pk_bf16(o0[2], o0[3]); w.z = cvt_pk_bf16(o1[0], o1[1]); w.w = cvt_pk_bf16(o1[2], o1[3]);
                    gst<v4u>(z + off + bj * HALF, w); }
                asm volatile("" ::: "memory"); }
    }
};
struct EpiPair {
    static constexpr bool PERM = true; static constexpr int REPS = 1;
    bf16* O1; bf16* O2; const float* bias; int mode;
    __device__ __forceinline__ void prefetch(LAS unsigned char*, const Unit&, int, int) const {}
    __device__ __forceinline__ void operator()(const f32x4 (&acc)[2][2][4][2], const Unit& u, int wr, int wc, int fr, int fq, const LAS unsigned char*) const {
        const int row0 = u.pm * BM + wr * 64 + fr;
        if (u.pn < 8) {
            const int j0 = u.pn * HALF + wc * 32 + 8 * fq;
            f32x4 b1[2], b2[2];
#pragma unroll
            for (int n = 0; n < 2; ++n) { b1[n] = mode ? gld<f32x4>(bias + j0 + 4 * n) : (f32x4){0.f, 0.f, 0.f, 0.f}; b2[n] = mode ? gld<f32x4>(bias + 1024 + j0 + 4 * n) : (f32x4){0.f, 0.f, 0.f, 0.f}; }
#pragma unroll
            for (int ai = 0; ai < 2; ++ai)
#pragma unroll
                for (int m = 0; m < 4; ++m) { bf16* rowp = O1 + (size_t)(row0 + ai * HALF + m * 16) * D + j0; f32x4 r[2];
#pragma unroll
                    for (int n = 0; n < 2; ++n) { const f32x4 g1 = acc[ai][0][m][n] + b1[n], g2 = acc[ai][1][m][n] + b2[n];
                        if (mode) { r[n][0] = g1[0] * sigmoidf_(g2[0]); r[n][1] = g1[1] * sigmoidf_(g2[1]); r[n][2] = g1[2] * sigmoidf_(g2[2]); r[n][3] = g1[3] * sigmoidf_(g2[3]); }
                        else r[n] = g1 * g2; }
                    v4u w; w.x = cvt_pk_bf16(r[0][0], r[0][1]); w.y = cvt_pk_bf16(r[0][2], r[0][3]); w.z = cvt_pk_bf16(r[1][0], r[1][1]); w.w = cvt_pk_bf16(r[1][2], r[1][3]);
                    gst<v4u>(rowp, w); }
        } else {
            const int c0 = (u.pn - 8) * BM + wc * 32 + 8 * fq;
#pragma unroll
            for (int ai = 0; ai < 2; ++ai)
#pragma unroll
                for (int m = 0; m < 4; ++m) { bf16* rowp = O2 + (size_t)(row0 + ai * HALF + m * 16) * D + c0;
#pragma unroll
                    for (int bj = 0; bj < 2; ++bj) { const f32x4 v0 = acc[ai][bj][m][0], v1 = acc[ai][bj][m][1];
                        v4u w; w.x = cvt_pk_bf16(v0[0], v0[1]); w.y = cvt_pk_bf16(v0[2], v0[3]); w.z = cvt_pk_bf16(v1[0], v1[1]); w.w = cvt_pk_bf16(v1[2], v1[3]);
                        gst<v4u>(rowp + bj * HALF, w); } }
        }
    }
};
struct EpiSwiglu {
    static constexpr bool PERM = true; static constexpr int REPS = REP_EPI1;
    unsigned char* act; const float* bgu;
    __device__ __forceinline__ void prefetch(LAS unsigned char* slot, const Unit& u, int wid, int lane) const {
        if (wid == 0) __builtin_amdgcn_global_load_lds((const unsigned*)(bgu + (size_t)u.e * 2048 + 2 * u.pn * HALF + 4 * lane), (LAS unsigned*)slot, 16, 0, 0);
    }
    __device__ __forceinline__ void operator()(const f32x4 (&acc)[2][2][4][2], const Unit& u, int wr, int wc, int fr, int fq, const LAS unsigned char* slot) const {
        const int row0 = u.pm * BM + wr * 64 + fr, j0 = u.pn * HALF + wc * 32 + 8 * fq;
        const LAS float* bp = (const LAS float*)slot + 2 * (wc * 32 + 8 * fq);
        f32x2 gb[4], ub[4];
#pragma unroll
        for (int i = 0; i < 4; ++i) { const f32x4 b = *(const LAS f32x4*)(bp + 4 * i); gb[i] = (f32x2){b[0], b[2]}; ub[i] = (f32x2){b[1], b[3]}; }
        const f32x2 q4 = {1.0f / SACT8, 1.0f / SACT8}, kc = {-1.702f * 1.4426950408889634f, -1.702f * 1.4426950408889634f};
        const int j16 = u.pn * HALF + wc * 32 + 16 * (fq >> 1); v2u wprev = {0u, 0u};
#pragma unroll
        for (int ai = 0; ai < 2; ++ai)
#pragma unroll
            for (int m = 0; m < 4; ++m) { float r[8];
#pragma unroll
                for (int p = 0; p < 4; ++p) { const int n = p >> 1, q = 2 * (p & 1);
                    f32x2 g = (f32x2){acc[ai][0][m][n][q], acc[ai][0][m][n][q + 1]} + gb[p];
                    f32x2 uu = (f32x2){acc[ai][1][m][n][q], acc[ai][1][m][n][q + 1]} + ub[p];
                    g[0] = fminf(g[0], 7.0f); g[1] = fminf(g[1], 7.0f);
                    uu[0] = __builtin_amdgcn_fmed3f(uu[0], -7.0f, 7.0f); uu[1] = __builtin_amdgcn_fmed3f(uu[1], -7.0f, 7.0f);
                    f32x2 t = g * kc; t[0] = __builtin_amdgcn_exp2f(t[0]); t[1] = __builtin_amdgcn_exp2f(t[1]);
                    f32x2 d = __builtin_elementwise_fma(t, q4, q4); d[0] = __builtin_amdgcn_rcpf(d[0]); d[1] = __builtin_amdgcn_rcpf(d[1]);
                    const f32x2 o = __builtin_elementwise_fma(uu, g, g) * d;
                    r[2 * p] = o[0]; r[2 * p + 1] = o[1]; }
                const v2u w8 = pack8_fp8(r);
                if (m & 1) { const v4u o16 = widen16(wprev, w8);
                    gst<v4u>(act + (size_t)(row0 + ai * HALF + (m - 1 + (fq & 1)) * 16) * D + j16, o16); }
                else wprev = w8; }
    }
};
struct EpiMoe2 {
    static constexpr bool PERM = true; static constexpr int REPS = REP_EPI2;
    unsigned char* Y; const float* bdn; const float* rowgate;
    __device__ __forceinline__ void prefetch(LAS unsigned char* slot, const Unit& u, int wid, int lane) const {
        if (wid == 0) __builtin_amdgcn_global_load_lds((const unsigned*)(bdn + (size_t)u.e * D + u.pn * BM + 4 * lane), (LAS unsigned*)slot, 16, 0, 0);
        else if (wid == 1) __builtin_amdgcn_global_load_lds((const unsigned*)(rowgate + u.pm * BM + 4 * lane), (LAS unsigned*)(slot + 1024), 16, 0, 0);
    }
    __device__ __forceinline__ void operator()(const f32x4 (&acc)[2][2][4][2], const Unit& u, int wr, int wc, int fr, int fq, const LAS unsigned char* slot) const {
        const int pos0 = wr * 64 + fr, c16 = u.pn * BM + wc * 32 + 16 * (fq >> 1);
        const LAS float* bp = (const LAS float*)slot + wc * 32 + 8 * fq;
        f32x4 bv[2][2]; v2u wprev[2] = {{0u, 0u}, {0u, 0u}};
#pragma unroll
        for (int bj = 0; bj < 2; ++bj)
#pragma unroll
            for (int n = 0; n < 2; ++n) bv[bj][n] = *(const LAS f32x4*)(bp + bj * HALF + 4 * n);
#pragma unroll
        for (int ai = 0; ai < 2; ++ai)
#pragma unroll
            for (int m = 0; m < 4; ++m) { const int pos = pos0 + ai * HALF + m * 16; const float s = *((const LAS float*)(slot + 1024) + pos) * SY8;
#pragma unroll
                for (int bj = 0; bj < 2; ++bj) { const f32x4 v0 = (acc[ai][bj][m][0] + bv[bj][0]) * s, v1 = (acc[ai][bj][m][1] + bv[bj][1]) * s;
                    const float r[8] = {v0[0], v0[1], v0[2], v0[3], v1[0], v1[1], v1[2], v1[3]};
                    const v2u w8 = pack8_fp8(r);
                    if (m & 1) { const v4u o16 = widen16(wprev[bj], w8);
                        gst<v4u>(Y + (size_t)(u.pm * BM + pos0 + ai * HALF + (m - 1 + (fq & 1)) * 16) * D + c16 + bj * HALF, o16); }
                    else wprev[bj] = w8; } }
    }
};
}

__device__ __forceinline__ int chq(int lane, int q) { return (q >> 1) * 512 + 8 * lane + (q & 1) * 4; }
__device__ __forceinline__ v4u pack8(const float* v) { v4u w; w.x = cvt_pk_bf16(v[0], v[1]); w.y = cvt_pk_bf16(v[2], v[3]); w.z = cvt_pk_bf16(v[4], v[5]); w.w = cvt_pk_bf16(v[6], v[7]); return w; }
__device__ __forceinline__ void unpack8(const v4u w, float* v) { v[0] = bf_lo(w.x); v[1] = bf_hi(w.x); v[2] = bf_lo(w.y); v[3] = bf_hi(w.y); v[4] = bf_lo(w.z); v[5] = bf_hi(w.z); v[6] = bf_lo(w.w); v[7] = bf_hi(w.w); }

__device__ __forceinline__ int drow_of(int mode, int c) {
    if (mode == 1) { const int j = c >> 1, p = c & 1; return (j >> 7) * 256 + p * 128 + (j & 127); }
    if (mode == 2) { if (c < 1024) return 2048 + c; const int j = (c - 1024) & 1023, p = (c - 1024) >> 10; return (j >> 7) * 256 + p * 128 + (j & 127); }
    if (mode == 3) { const int j = c & 1023, p = c >> 10; return (j >> 7) * 256 + p * 128 + (j & 127); }
    return c;
}
struct TItem { const float* src; unsigned char* dst; int N, Kout  , k0, n0, mode, fp8; };
__device__ __forceinline__ void titem_load(const TItem& d, int lane, float (&tmp)[32]) {
#pragma unroll
    for (int i = 0; i < 32; ++i) { const int kk = 2 * i + (lane >> 5); tmp[i] = gld<float>(d.src + (size_t)(d.k0 + kk) * d.N + d.n0 + (lane & 31)); }
}
__device__ __forceinline__ void titem_store(const TItem& d, int lane, LAS float* scr, const float (&tmp)[32]) {
#pragma unroll
    for (int i = 0; i < 32; ++i) { const int kk = 2 * i + (lane >> 5); scr[kk * 33 + (lane & 31)] = tmp[i]; }
    LDS_WAIT(); asm volatile("" ::: "memory");
    const int c = lane & 7;
#pragma unroll
    for (int j = 0; j < 4; ++j) { const int n = (lane >> 3) + 8 * j; const LAS float* s = scr + (8 * c) * 33 + n;
        float v[8];
#pragma unroll
        for (int i = 0; i < 8; ++i) v[i] = s[i * 33];
        const size_t e = (size_t)drow_of(d.mode, d.n0 + n) * d.Kout + d.k0 + 8 * c;
        if (d.fp8) {
#pragma unroll
            for (int i = 0; i < 8; ++i) v[i] *= SW8;
            gst<v2u>(d.dst + e, pack8_fp8_sat(v));
        } else gst<v4u>(d.dst + 2 * e, pack8(v)); }
    LDS_WAIT(); asm volatile("" ::: "memory");
}

struct Args { const float* in[24]; float* out; unsigned char* ws; };
#define CAS __attribute__((address_space(4)))
__device__ __forceinline__ const void* karg_ptr(int off) {
    const CAS char* kp = (const CAS char*)__builtin_amdgcn_kernarg_segment_ptr();
    asm volatile("" : "+s"(off));
    return *(const void* const CAS*)(kp + off);
}
#define ARG_IN(i) ((const float*)karg_ptr(8 * (i)))
#define ARG_OUT() ((float*)karg_ptr(8 * 24))
#define ARG_WS() ((unsigned char*)karg_ptr(8 * 25))

constexpr int TPITCH = 129, TBUF = 128 * TPITCH;
constexpr int NT_GU = 128 * 8 * 16, NT_DN = 128 * 8 * 8, NT = NT_GU + NT_DN;
constexpr int NQ = 4096 + 2048, NT_P0 = 4096, NCONV = 16;
__host__ __device__ __forceinline__ int qtile(int L, int k) { return k < 4096 ? L * 4096 + k : NT_GU + L * 2048 + (k - 4096); }
struct WTile { const float* src; unsigned char* dst; int N, nb, kb, mode; };
#define WT_DECODE(ti_, d_) do { int r_ = (ti_); if (r_ < NT_GU) { const int mt_ = r_ >> 7; r_ &= 127; (d_).kb = r_ >> 4; (d_).nb = r_ & 15; (d_).N = 2048; (d_).mode = 1; \
                (d_).src = ARG_IN(18) + (size_t)mt_ * 1024 * 2048; (d_).dst = ws + WS_WGU + (size_t)mt_ * 2048 * 1024; } \
            else { r_ -= NT_GU; const int mt_ = r_ >> 6; r_ &= 63; (d_).kb = r_ >> 3; (d_).nb = r_ & 7; (d_).N = 1024; (d_).mode = 0; \
                (d_).src = ARG_IN(20) + (size_t)mt_ * 1024 * 1024; (d_).dst = ws + WS_WDN + (size_t)mt_ * 1024 * 1024; } } while (0)
#define WT_LOAD(R_, d_) do { _Pragma("unroll") for (int i = 0; i < 16; ++i) R_[i] = __builtin_nontemporal_load((const GAS v2u*)((d_).src + (size_t)((d_).kb * 128 + wave * 16 + i) * (d_).N + (d_).nb * 128 + 2 * lane)); } while (0)
#define WT_TOLDS(R_, buf_) do { const int col_ = (2 * lane + 4 * wave) & 127; _Pragma("unroll") for (int i = 0; i < 16; ++i) { LAS float* p_ = tl + (buf_) * TBUF + (wave * 16 + i) * TPITCH + col_; \
                p_[0] = __uint_as_float(R_[i].x); p_[1] = __uint_as_float(R_[i].y); } } while (0)
#define WT_OUT(d_, buf_) do { const int kc_ = tid & 7; _Pragma("unroll") for (int p = 0; p < 2; ++p) { const int n_ = (tid >> 3) + 64 * p; const LAS float* s_ = tl + (buf_) * TBUF + (16 * kc_) * TPITCH + ((n_ + 4 * kc_) & 127); \
                float v_[16]; _Pragma("unroll") for (int i = 0; i < 16; ++i) v_[i] = s_[i * TPITCH] * SW8; \
                const v2u a_ = pack8_fp8_sat(v_), b_ = pack8_fp8_sat(v_ + 8); v4u o_; o_.x = a_.x; o_.y = a_.y; o_.z = b_.x; o_.w = b_.y; \
                gst<v4u>((d_).dst + (size_t)drow_of((d_).mode, (d_).nb * 128 + n_) * 1024 + (d_).kb * 128 + 16 * kc_, o_); } } while (0)
#define WT_BAR() do { LDS_WAIT(); __builtin_amdgcn_s_barrier(); asm volatile("" ::: "memory"); } while (0)
constexpr int CBAND = 16 * 512 + 32, CBUF = 8 * CBAND;
static_assert(RING_OFF + 2 * CBUF <= UT_OFF, "converter buffers");
#define CV_DMA(d_, buf_) do { const char* gp_ = (const char*)((d_).src + (size_t)((d_).kb * 128 + wave * 16 + (lane >> 5)) * (d_).N + (d_).nb * 128 + 4 * (lane & 31)); \
        _Pragma("unroll") for (int j = 0; j < 8; ++j) __builtin_amdgcn_global_load_lds((const unsigned*)(gp_ + (size_t)(2 * j) * (d_).N * 4), (LAS unsigned*)(lds + RING_OFF + (buf_) * CBUF + wave * CBAND + j * 1024), 16, 0, 2); } while (0)
#define CV_OUT(d_, buf_) do { const int kq_ = tid & 7; _Pragma("unroll") for (int p = 0; p < 2; ++p) { const int n_ = (tid >> 3) + 64 * p; const LAS float* s_ = (const LAS float*)(lds + RING_OFF + (buf_) * CBUF + kq_ * CBAND) + n_; \
                float v_[16]; _Pragma("unroll") for (int i = 0; i < 16; ++i) v_[i] = s_[i * 128] * SW8; \
                const v2u a_ = pack8_fp8_sat(v_), b_ = pack8_fp8_sat(v_ + 8); v4u o_; o_.x = a_.x; o_.y = a_.y; o_.z = b_.x; o_.w = b_.y; \
                gst<v4u>((d_).dst + (size_t)drow_of((d_).mode, (d_).nb * 128 + n_) * 1024 + (d_).kb * 128 + 16 * kq_, o_); } } while (0)
#define CV_SYNC() do { LDS_WAIT(); __builtin_amdgcn_s_barrier(); asm volatile("" ::: "memory"); } while (0)
#define CONV_RUN(L_, maxpairs_, stopp_, stopn_) CONV_RUN_G(L_, maxpairs_, stopp_, stopn_, NQ, 0)
#define CONV_RUN_LIM(L_, maxpairs_, stopp_, stopn_, lim_) CONV_RUN_G(L_, maxpairs_, stopp_, stopn_, lim_, 0)
#define CONV_RUN_G(L_, maxpairs_, stopp_, stopn_, lim_, minhead_) do { \
    int wv_ = wave0; unsigned z_ = 0u; asm volatile("" : "+s"(wv_), "+s"(z_)); int tid = (wv_ << 6) | (int)__builtin_amdgcn_mbcnt_hi(~0u, __builtin_amdgcn_mbcnt_lo(~0u, z_)); asm volatile("" : "+v"(tid)); const int lane = tid & 63, wave = wave0; (void)lane; (void)wave;   \
    unsigned char* wsq_ = ARG_WS(); asm volatile("" : "+s"(wsq_)); unsigned char* ws = wsq_; unsigned* dq_ = (unsigned*)(ws + WS_CTL) + CW_DQ + (L_); unsigned* sp_ = (stopp_); \
    WTile d0, d1; int left_ = (maxpairs_); unsigned sf_ = 0u; \
    __syncthreads(); \
    const unsigned kofs_ = ((L_) == 0) ? 4096u : 0u; \
    if (tid == 0) { unsigned a_ = 0xFFFFFFFFu, b_ = 0xFFFFFFFFu; if (sp_) sf_ = (xb_ld(sp_) >= (unsigned)(stopn_)) ? 1u : 0u; if ((minhead_) > 0 && xb_ld(dq_) + kofs_ < (unsigned)(minhead_)) sf_ = 1u; if (!sf_) { a_ = xb_add(dq_, 2u) + kofs_; if (a_ >= (unsigned)(lim_)) sf_ = 1u; if (!sf_ && left_ > 1) { b_ = xb_add(dq_, 2u) + kofs_; if (b_ >= (unsigned)(lim_)) sf_ = 1u; } } MISC[4] = a_; MISC[5] = b_; } \
    __syncthreads(); \
    unsigned kcur_ = (unsigned)__builtin_amdgcn_readfirstlane((int)MISC[4]), knxt_ = (unsigned)__builtin_amdgcn_readfirstlane((int)MISC[5]); left_ -= 2; \
    d0.src = nullptr; d1.src = nullptr; \
    if (kcur_ < (unsigned)NQ) { WT_DECODE(qtile((L_), (int)kcur_), d0); WT_DECODE(qtile((L_), (int)kcur_ + 1), d1); CV_DMA(d0, 0); CV_DMA(d1, 1); } \
    while (kcur_ < (unsigned)NQ) { \
        unsigned nk_ = 0xFFFFFFFFu, dv_ = 0u; \
        if (tid == 0) { if (left_ > 0 && !sf_) nk_ = xb_add(dq_, 2u) + kofs_; if (sp_) dv_ = xb_ld(sp_); } \
        --left_; \
        const bool vn_ = knxt_ < (unsigned)NQ; WTile e0 = d0, e1 = d1; \
        if (vn_) { WT_DECODE(qtile((L_), (int)knxt_), e0); WT_DECODE(qtile((L_), (int)knxt_ + 1), e1); } \
        asm volatile("s_waitcnt vmcnt(8)" ::: "memory"); CV_SYNC(); CV_OUT(d0, 0); CV_SYNC(); if (vn_) CV_DMA(e0, 0); \
        if (vn_) asm volatile("s_waitcnt vmcnt(8)" ::: "memory"); else asm volatile("s_waitcnt vmcnt(0)" ::: "memory"); \
        CV_SYNC(); CV_OUT(d1, 1); CV_SYNC(); if (vn_) CV_DMA(e1, 1); \
        if (tid == 0) { MISC[4] = nk_; if ((sp_ && dv_ >= (unsigned)(stopn_)) || nk_ >= (unsigned)(lim_)) sf_ = 1u; } \
        __syncthreads(); kcur_ = knxt_; knxt_ = (unsigned)__builtin_amdgcn_readfirstlane((int)MISC[4]); d0 = e0; d1 = e1; \
    } \
    __syncthreads(); } while (0)

#define PHASE_BEGIN() \
    int wv_ = wave0; unsigned z_ = 0u; asm volatile("" : "+s"(wv_), "+s"(z_)); int tid = (wv_ << 6) | (int)__builtin_amdgcn_mbcnt_hi(~0u, __builtin_amdgcn_mbcnt_lo(~0u, z_)); asm volatile("" : "+v"(tid)); \
    const int lane = tid & 63, wave = wave0; \
    unsigned char* ws_ = ARG_WS(); asm volatile("" : "+s"(ws_)); unsigned char* ws = (unsigned char*)(GAS unsigned char*)ws_; \
    unsigned* ctl = (unsigned*)(ws + WS_CTL); \
    const int gw = vcu * NWAVES + wave, NGW = G * NWAVES; (void)gw; (void)NGW; (void)lane; (void)ctl;

__device__ __forceinline__ float butterfly32(float (&p)[32], int lane) {
#pragma unroll
    for (int i = 0; i < 16; ++i) { const auto r = __builtin_amdgcn_permlane32_swap(__float_as_uint(p[i]), __float_as_uint(p[i + 16]), false, false); p[i] = __uint_as_float(r[0]) + __uint_as_float(r[1]); }
#pragma unroll
    for (int i = 0; i < 8; ++i) { const auto r = __builtin_amdgcn_permlane16_swap(__float_as_uint(p[i]), __float_as_uint(p[i + 8]), false, false); p[i] = __uint_as_float(r[0]) + __uint_as_float(r[1]); }
#pragma unroll
    for (int i = 0; i < 4; ++i) { const bool hi = (lane & 8) != 0; const float snd = hi ? p[i] : p[i + 4]; const float keep = hi ? p[i + 4] : p[i]; p[i] = keep + DPP_F(snd, DPP_ROR8); }
#pragma unroll
    for (int i = 0; i < 2; ++i) { const bool hi = (lane & 4) != 0; const float snd = hi ? p[i] : p[i + 2]; const float keep = hi ? p[i + 2] : p[i]; const float x = DPP_F(snd, DPP_HMIR); p[i] = keep + DPP_F(x, DPP_QREV); }
    { const bool hi = (lane & 2) != 0; const float snd = hi ? p[0] : p[1]; const float keep = hi ? p[1] : p[0]; p[0] = keep + DPP_F(snd, DPP_XOR2); }
    return p[0] + DPP_F(p[0], DPP_XOR1);
}
__device__ __forceinline__ void ln16(float (&v)[16], const float (&lg)[16], const float (&lb)[16], int lane) {
    float sm = 0.f;
#pragma unroll
    for (int i = 0; i < 16; ++i) sm += v[i];
    const float mean = wave_sum(sm, lane) * (1.0f / D);
    float sq = 0.f;
#pragma unroll
    for (int i = 0; i < 16; ++i) { v[i] -= mean; sq += v[i] * v[i]; }
    const float rstd = 1.0f / sqrtf(wave_sum(sq, lane) * (1.0f / D) + LN_EPS);
#pragma unroll
    for (int i = 0; i < 16; ++i) v[i] = v[i] * rstd * lg[i] + lb[i];
}
__device__ __forceinline__ void route_token(const float logit, const int myexp, const int lane, const int t, int* TIDX, float* TGATE, LAS unsigned* hist, const bool count) {
    int rank = 0;
#pragma unroll
    for (int e = 0; e < 32; ++e) rank += (rdlane(logit, 2 * e) > logit) ? 1 : 0;
    unsigned long long mk[4]; bool clean = true;
#pragma unroll
    for (int r = 0; r < 4; ++r) { mk[r] = __ballot(rank == r); clean = clean && (__builtin_popcountll(mk[r]) == 2); }
    if (__builtin_expect(!clean, 0)) {
        asm volatile("" ::: "memory");
        rank = 0;
#pragma unroll
        for (int e = 0; e < 32; ++e) { const float se = rdlane(logit, 2 * e); rank += (se > logit || (se == logit && e < myexp)) ? 1 : 0; }
#pragma unroll
        for (int r = 0; r < 4; ++r) mk[r] = __ballot(rank == r);
    }
    float tv[4]; int tix[4];
#pragma unroll
    for (int r = 0; r < 4; ++r) { const int src = (int)__builtin_ctzll(mk[r] | (1ull << 63)); tv[r] = rdlane(logit, src); tix[r] = src >> 1; }
    const float e1 = __expf(tv[1] - tv[0]), e2 = __expf(tv[2] - tv[0]), e3 = __expf(tv[3] - tv[0]);
    const float inv = 1.0f / (1.0f + e1 + e2 + e3);
    if (lane < 4) {
        const int ix = lane == 0 ? tix[0] : lane == 1 ? tix[1] : lane == 2 ? tix[2] : tix[3];
        const float gv = (lane == 0 ? 1.0f : lane == 1 ? e1 : lane == 2 ? e2 : e3) * inv;
        gst<int>(TIDX + t * 4 + lane, ix); gst<float>(TGATE + t * 4 + lane, gv);
        if (count) __hip_atomic_fetch_add(hist + ix, 1u, __ATOMIC_RELAXED, __HIP_MEMORY_SCOPE_WORKGROUP);
    }
}
__device__ __forceinline__ void ln16_lds(float (&v)[16], const LAS f32x4* lnp, int lane) {
    float sm = 0.f;
#pragma unroll
    for (int i = 0; i < 16; ++i) sm += v[i];
    const float mean = wave_sum(sm, lane) * (1.0f / D);
    float sq = 0.f;
#pragma unroll
    for (int i = 0; i < 16; ++i) { v[i] -= mean; sq += v[i] * v[i]; }
    const float rstd = 1.0f / sqrtf(wave_sum(sq, lane) * (1.0f / D) + LN_EPS);
#pragma unroll
    for (int q = 0; q < 4; ++q) { const f32x4 g4 = lnp[q * 64 + lane], b4 = lnp[(4 + q) * 64 + lane];
#pragma unroll
        for (int i = 0; i < 4; ++i) v[4 * q + i] = v[4 * q + i] * rstd * g4[i] + b4[i]; }
}
template <bool F32IN>
__device__ __forceinline__ void pool_diff_run(const float* xf, const bf16* xb, bf16* M3, int t0, int lane) {
    const int s0 = t0 & (SEQ - 1);
#pragma unroll
    for (int g = 0; g < 4; ++g) {
        const int w = 2 << g, c = 256 * g + 4 * lane;
        f32x4 r[31];
#pragma unroll
        for (int j = 0; j < w + 15; ++j) {
            const int dt = j - (w - 1);
            if (dt >= 0 || s0 != 0) {
                const size_t o = (size_t)(t0 + dt) * D + c;
                if (F32IN) r[j] = gld<f32x4>(xf + o);
                else { const v2u q = gld<v2u>(xb + o); r[j] = (f32x4){bf_lo(q.x), bf_hi(q.x), bf_lo(q.y), bf_hi(q.y)}; }
            } else r[j] = (f32x4){0.f, 0.f, 0.f, 0.f};
        }
#pragma unroll
        for (int i = 0; i < 16; ++i) {
            f32x4 sum = r[i];
#pragma unroll
            for (int j = 1; j < w; ++j) sum += r[i + j];
            const int nv = (s0 + i + 1 < w) ? s0 + i + 1 : w;
            const f32x4 df = sum * (1.0f / (float)nv) - r[i + w - 1];
            v2u o; o.x = cvt_pk_bf16(df[0], df[1]); o.y = cvt_pk_bf16(df[2], df[3]);
            gst<v2u>(M3 + (size_t)(t0 + i) * D + c, o);
        }
    }
}

__global__ void __launch_bounds__(NTHR, 2) mega_fwd(Args args) {
    extern __shared__ __attribute__((aligned(16))) unsigned char lds_raw[];
    LAS unsigned char* lds = (LAS unsigned char*)lds_raw;
    volatile LAS unsigned* MISC = (volatile LAS unsigned*)(lds + MISC_OFF);
    const int G = gridDim.x, bx = blockIdx.x;
    const int wave0 = __builtin_amdgcn_readfirstlane((int)(threadIdx.x >> 6));
    const int vcu = (G % 8 == 0) ? (bx % 8) * (G / 8) + bx / 8 : bx;
    if (threadIdx.x < 128) MISC[threadIdx.x] = 0u;
    __syncthreads();
    (void)xcd_barrier_post((unsigned*)(ARG_WS() + WS_CTL) + CW_BAR, MISC + 0);
#define GRID_BAR() do { XcdBarrier b_; unsigned* bp_ = (unsigned*)(ARG_WS() + WS_CTL) + CW_BAR; asm volatile("" : "+s"(bp_)); b_.bar = (unsigned*)(GAS unsigned*)bp_; b_.x = xb_xcc_id(); b_.st = MISC; for (int rb_ = 0; rb_ < REP_BAR; ++rb_) xcd_barrier(b_); } while (0)
#define GRID_BAR_CONV(Lq_) GRID_BAR_CONVX(Lq_, 1, NQ, 0)
#define GRID_BAR_CONVX(Lq_, np_, lim_, mh_) do { XcdBarrier b_; unsigned* bp_ = (unsigned*)(ARG_WS() + WS_CTL) + CW_BAR; asm volatile("" : "+s"(bp_)); b_.bar = (unsigned*)(GAS unsigned*)bp_; b_.x = xb_xcc_id(); b_.st = MISC; \
    const bool last_ = xcd_barrier_arrive(b_); if (!last_) CONV_RUN_G((Lq_), (np_), nullptr, 0, (lim_), (mh_)); xcd_barrier_finish(b_); } while (0)
#define BAR_L() do { if (layer + 1 < DEPTH) GRID_BAR_CONV(layer + 1); else GRID_BAR(); } while (0)
#define BAR_A() GRID_BAR_CONV(layer)

    {
        PHASE_BEGIN();
        {
            LAS float* tl = (LAS float*)(lds + RING_OFF);
            for (int rep = 0; rep < REP_P0; ++rep) {
                v2u R0[16], R1[16]; WTile d0, d1, dn;
                int ti = vcu;
                d0.src = nullptr; d1.src = nullptr;
                if (ti < NT_P0) { WT_DECODE(qtile(0, ti), d0); WT_LOAD(R0, d0); }
                if (ti + G < NT_P0) { WT_DECODE(qtile(0, ti + G), d1); WT_LOAD(R1, d1); }
                for (; ti < NT_P0; ti += 2 * G) {
                    WT_TOLDS(R0, 0);
                    const bool h2 = (ti + 2 * G < NT_P0);
                    if (h2) { WT_DECODE(qtile(0, ti + 2 * G), dn); WT_LOAD(R0, dn); }
                    WT_BAR();
                    WT_OUT(d0, 0);
                    if (h2) d0 = dn;
                    if (ti + G < NT_P0) {
                        WT_TOLDS(R1, 1);
                        const bool h3 = (ti + 3 * G < NT_P0);
                        if (h3) { WT_DECODE(qtile(0, ti + 3 * G), dn); WT_LOAD(R1, dn); }
                        WT_BAR();
                        WT_OUT(d1, 1);
                        if (h3) d1 = dn;
                    }
                }
                WT_BAR();
            }
        }
        LAS float* scr = (LAS float*)(lds + RING_OFF + wave * 16384);
        constexpr int I_POOL = 4 * 8, I_SCIN = 16 * 96, I_SQ = 16 * 32, I_CFIN = 16 * 64;
        constexpr int N_POOL = 8 * I_POOL;
        constexpr int NITEMS = N_POOL + I_SCIN + I_SQ + I_CFIN + I_SQ;
#define TITEM_SET(d_, src_, K_, N_, dst_, mode_, fp8_, item_) do { const int nb_ = (N_) / 32; (d_).src = (src_); (d_).dst = (unsigned char*)(dst_); (d_).N = (N_); (d_).Kout = (K_); \
        (d_).k0 = 64 * ((item_) / nb_); (d_).n0 = 32 * ((item_) % nb_); (d_).mode = (mode_); (d_).fp8 = (fp8_); } while (0)
#define TITEM_DECODE(it_, d_) do { int r_ = (it_); \
        if (r_ < N_POOL) { const int mt_ = r_ / I_POOL; TITEM_SET(d_, ARG_IN(1) + (size_t)mt_ * 256 * 256, 256, 256, ws + WS_WPOOL + (size_t)mt_ * 256 * 256 * 2, 0, 0, r_ % I_POOL); break; } r_ -= N_POOL; \
        if (r_ < I_SCIN) { TITEM_SET(d_, ARG_IN(3), 1024, 3072, ws + WS_WSCIN, 2, SC_IN_FP8, r_); break; } r_ -= I_SCIN; \
        if (r_ < I_SQ) { TITEM_SET(d_, ARG_IN(5), 1024, 1024, ws + WS_WSCOUT, 0, SC_OUT_FP8, r_); break; } r_ -= I_SQ; \
        if (r_ < I_CFIN) { TITEM_SET(d_, ARG_IN(6), 1024, 2048, ws + WS_WCFIN, 3, CF_IN_FP8, r_); break; } r_ -= I_CFIN; \
        TITEM_SET(d_, ARG_IN(12), 1024, 1024, ws + WS_WCFOUT, 0, CF_OUT_FP8, r_); } while (0)
        for (int it = gw; it < NITEMS; it += NGW) { TItem cur; float ta[32]; TITEM_DECODE(it, cur); titem_load(cur, lane, ta); titem_store(cur, lane, scr, ta); }
#undef TITEM_SET
#undef TITEM_DECODE
        { bf16* M3 = (bf16*)(ws + WS_M3);
          for (int tb = vcu; tb < T / 128; tb += G) pool_diff_run<true>(ARG_IN(0), nullptr, M3, tb * 128 + wave * 16, lane); }
    }
    GRID_BAR_CONV(0);

    for (int layer = 0; layer < DEPTH; ++layer) {
        const int kind = layer % 3;

        if (kind == 0) {
            if (layer != 0) {
                PHASE_BEGIN();
                bf16* M3 = (bf16*)(ws + WS_M3); const bf16* xb = (const bf16*)(ws + WS_XAB);
                for (int rep = 0; rep < REP_THIN; ++rep)
                for (int tb = vcu; tb < T / 128; tb += G) pool_diff_run<false>(nullptr, xb, M3, tb * 128 + wave * 16, lane);
            }
        } else {
            {
                PHASE_BEGIN();
                bf16* M1 = (bf16*)(ws + WS_M1); bf16* M2 = (bf16*)(ws + WS_M2);
                const int nN = (kind == 1) ? 12 : 8;
                const int n_my = pg8::build_units(lds, tid, T / 256, nN, G, bx, false, nullptr, REP_MIXG);
                pg8::EpiPair E; E.O1 = (kind == 1) ? M2 : M1; E.O2 = M1; E.bias = ARG_IN(7); E.mode = (kind == 1) ? 0 : 1;
                if ((CF_IN_FP8 && kind == 2) || (SC_IN_FP8 && kind == 1)) {
                    pg8::GemmP gp; gp.A = (const char*)(ws + WS_X18); gp.lda2 = D; gp.acol_pn = 0; gp.Bt = (const char*)(ws + ((kind == 1) ? WS_WSCIN : WS_WCFIN)); gp.b_estride = 0; gp.Kb = 1024; gp.sA = E8_X; gp.sB = E8_W;
                    pg8::gemm_phase<false, true, pg8::EpiPair>(lds, tid, gp, n_my, E);
                } else {
                    pg8::GemmP gp; gp.A = (const char*)(ws + WS_XAB); gp.lda2 = D * 2; gp.acol_pn = 0; gp.Bt = (const char*)(ws + ((kind == 1) ? WS_WSCIN : WS_WCFIN)); gp.b_estride = 0; gp.Kb = 2048; gp.sA = 0; gp.sB = 0;
                    pg8::gemm_phase<false, false, pg8::EpiPair>(lds, tid, gp, n_my, E);
                }
            }
            BAR_A();
            if (kind == 1) {
                PHASE_BEGIN();
                const bf16* M1 = (const bf16*)(ws + WS_M1); const bf16* M2 = (const bf16*)(ws + WS_M2); bf16* M3 = (bf16*)(ws + WS_M3);
                const float* cw = ARG_IN(4);
                float wk[3][16];
#pragma unroll
                for (int k = 0; k < 3; ++k)
#pragma unroll
                    for (int q = 0; q < 4; ++q) { const f32x4 v = gld<f32x4>(cw + k * D + chq(lane, q)); wk[k][4 * q] = v[0]; wk[k][4 * q + 1] = v[1]; wk[k][4 * q + 2] = v[2]; wk[k][4 * q + 3] = v[3]; }
                for (int rep = 0; rep < REP_THIN; ++rep)
                for (int tb = vcu; tb < T / 128; tb += G) {
                    const int t0 = tb * 128 + wave * 16, s0 = t0 & (SEQ - 1);
                    float p2[16], p1[16];
                    if (s0 != 0) { unpack8(gld<v4u>(M2 + (size_t)(t0 - 2) * D + 8 * lane), p2); unpack8(gld<v4u>(M2 + (size_t)(t0 - 2) * D + 512 + 8 * lane), p2 + 8);
                                   unpack8(gld<v4u>(M2 + (size_t)(t0 - 1) * D + 8 * lane), p1); unpack8(gld<v4u>(M2 + (size_t)(t0 - 1) * D + 512 + 8 * lane), p1 + 8); }
                    else {
#pragma unroll
                        for (int i = 0; i < 16; ++i) { p2[i] = 0.f; p1[i] = 0.f; } }
                    for (int i0 = 0; i0 < 16; i0 += 4) {
                        v4u cv[4][2], gv[4][2];
#pragma unroll
                        for (int u = 0; u < 4; ++u)
#pragma unroll
                            for (int j = 0; j < 2; ++j) { const size_t o = (size_t)(t0 + i0 + u) * D + j * 512 + 8 * lane; cv[u][j] = gld<v4u>(M2 + o); gv[u][j] = gld<v4u>(M1 + o); }
#pragma unroll
                        for (int u = 0; u < 4; ++u) {
                            float c[16], gb[16], o[16];
                            unpack8(cv[u][0], c); unpack8(cv[u][1], c + 8); unpack8(gv[u][0], gb); unpack8(gv[u][1], gb + 8);
#pragma unroll
                            for (int i = 0; i < 16; ++i) { o[i] = gb[i] * (wk[0][i] * p2[i] + wk[1][i] * p1[i] + wk[2][i] * c[i]); p2[i] = p1[i]; p1[i] = c[i]; }
                            if (SC_OUT_FP8) { float s8[16];
#pragma unroll
                                for (int i = 0; i < 16; ++i) s8[i] = o[i] * SX8;
                                unsigned char* m8 = (unsigned char*)M3 + (size_t)(t0 + i0 + u) * D; gst<v2u>(m8 + 8 * lane, pack8_fp8_sat(s8)); gst<v2u>(m8 + 512 + 8 * lane, pack8_fp8_sat(s8 + 8)); }
                            else { gst<v4u>(M3 + (size_t)(t0 + i0 + u) * D + 8 * lane, pack8(o));
                                   gst<v4u>(M3 + (size_t)(t0 + i0 + u) * D + 512 + 8 * lane, pack8(o + 8)); }
                        }
                    }
                }
            } else {
                PHASE_BEGIN();
                const bf16* U = (const bf16*)(ws + WS_M1); bf16* M3 = (bf16*)(ws + WS_M3);
                const int c = 128 * wave + 2 * lane;
                float wk0[31], wk1[31];
#pragma unroll
                for (int k = 0; k < 31; ++k) { const v2u q = gld<v2u>(ARG_IN(8) + k * D + c); wk0[k] = __uint_as_float(q.x); wk1[k] = __uint_as_float(q.y); }
                const v2u qb = gld<v2u>(ARG_IN(9) + c), qg = gld<v2u>(ARG_IN(10) + c), ql = gld<v2u>(ARG_IN(11) + c);
                const float db0 = __uint_as_float(qb.x), db1 = __uint_as_float(qb.y), lg0 = __uint_as_float(qg.x), lg1 = __uint_as_float(qg.y), lb0 = __uint_as_float(ql.x), lb1 = __uint_as_float(ql.y);
                LAS float* part = (LAS float*)(lds + RING_OFF);
                LAS float* stat = part + 256;
                LAS unsigned short* ostg = (LAS unsigned short*)(lds + RING_OFF + 4096 + wave * 2048);
                for (int rep = 0; rep < REP_THIN; ++rep)
                for (int run = vcu; run < T / 16; run += G) {
                    const int t0 = run * 16, s0 = t0 & (SEQ - 1);
                    unsigned r[46];
#pragma unroll
                    for (int j = 0; j < 46; ++j) r[j] = (s0 + j - 30 >= 0) ? gld<unsigned>(U + (size_t)(t0 + j - 30) * D + c) : 0u;
                    float a0[16], a1[16];
#pragma unroll
                    for (int i = 0; i < 16; ++i) { a0[i] = db0; a1[i] = db1; }
#pragma unroll
                    for (int j = 0; j < 46; ++j) { const float x0 = bf_lo(r[j]), x1 = bf_hi(r[j]);
#pragma unroll
                        for (int i = 0; i < 16; ++i) { const int k = j - i; if (k >= 0 && k <= 30) { a0[i] += wk0[k] * x0; a1[i] += wk1[k] * x1; } } }
                    float st[32];
#pragma unroll
                    for (int i = 0; i < 16; ++i) { st[2 * i] = a0[i] + a1[i]; st[2 * i + 1] = a0[i] * a0[i] + a1[i] * a1[i]; }
                    const float tot = butterfly32(st, lane);
                    if ((lane & 1) == 0) part[wave * 32 + (lane >> 1)] = tot;
                    __syncthreads();
                    if (tid < 16) { float S = 0.f, Q = 0.f;
#pragma unroll
                        for (int w8 = 0; w8 < 8; ++w8) { S += part[w8 * 32 + 2 * tid]; Q += part[w8 * 32 + 2 * tid + 1]; }
                        const float mean = S * (1.0f / D); const float var = fmaxf(Q * (1.0f / D) - mean * mean, 0.f);
                        stat[2 * tid] = mean; stat[2 * tid + 1] = 1.0f / sqrtf(var + LN_EPS); }
                    __syncthreads();
#pragma unroll
                    for (int i = 0; i < 16; ++i) { const float mean = stat[2 * i], rstd = stat[2 * i + 1];
                        const float y0 = (a0[i] - mean) * rstd * lg0 + lb0, y1 = (a1[i] - mean) * rstd * lg1 + lb1;
                        const float z0 = y0 * sigmoidf_(y0), z1 = y1 * sigmoidf_(y1);
                        if (CF_OUT_FP8) { const float lim = 448.0f; const int w8 = __builtin_amdgcn_cvt_pk_fp8_f32(__builtin_amdgcn_fmed3f(z0 * SX8, -lim, lim), __builtin_amdgcn_fmed3f(z1 * SX8, -lim, lim), 0, false);
                            ostg[i * 64 + lane] = (unsigned short)(w8 & 0xffff); }
                        else gst<unsigned>(M3 + (size_t)(t0 + i) * D + c, cvt_pk_bf16(z0, z1)); }
                    if (CF_OUT_FP8) {
                        LDS_WAIT();
                        const LAS v4u* rd = (const LAS v4u*)(ostg + (lane >> 2) * 64) + 2 * (lane & 3);
                        const v4u o0 = rd[0], o1 = rd[1];
                        unsigned char* dst = (unsigned char*)M3 + (size_t)(t0 + (lane >> 2)) * D + 128 * wave + 32 * (lane & 3);
                        gst<v4u>(dst, o0); gst<v4u>(dst + 16, o1);
                        LDS_WAIT();
                    }
                }
                __syncthreads();
            }
        }
        if (layer != 0) BAR_A();

        {
            PHASE_BEGIN();
            const int n_my = pg8::build_units(lds, tid, T / 256, 4, G, bx, false, nullptr, REP_MIXG);
            pg8::GemmP gp; gp.A = (const char*)(ws + WS_M3); gp.lda2 = D * 2; gp.b_estride = 0; gp.sA = 0; gp.sB = 0;
            pg8::EpiOut E; E.xres = (const bf16*)(ws + WS_XAB); E.xres32 = (layer == 0) ? ARG_IN(0) : nullptr; E.z = (bf16*)(ws + WS_ZB); E.bias = nullptr; E.scale = nullptr;
            if (kind == 0) { gp.acol_pn = 512; gp.Bt = (const char*)(ws + WS_WPOOL + (size_t)(layer / 3) * 1024 * 256 * 2); gp.Kb = 512; E.scale = ARG_IN(2) + (layer / 3) * D; }
            else if (kind == 1) { gp.acol_pn = 0; gp.Bt = (const char*)(ws + WS_WSCOUT); gp.Kb = 2048; }
            else { gp.acol_pn = 0; gp.Bt = (const char*)(ws + WS_WCFOUT); gp.Kb = 2048; E.bias = ARG_IN(13); }
            if ((SC_OUT_FP8 && kind == 1) || (CF_OUT_FP8 && kind == 2)) {
                gp.lda2 = D; gp.Kb = 1024; gp.sA = E8_X; gp.sB = E8_W;
                pg8::gemm_phase<false, true, pg8::EpiOut>(lds, tid, gp, n_my, E);
            } else
            pg8::gemm_phase<false, false, pg8::EpiOut>(lds, tid, gp, n_my, E);
        }
        if (layer > 0) GRID_BAR_CONVX(layer, 1 << 30, 4096, 0); else BAR_A();

        {
            PHASE_BEGIN();
            const bf16* Zb = (const bf16*)(ws + WS_ZB); unsigned char* X18 = (unsigned char*)(ws + WS_X18);
            int* RTOK = (int*)(ws + WS_RTOK); float* RGATE = (float*)(ws + WS_RGATE); int* APOS = (int*)(ws + WS_RDST);
            unsigned* CUR = ctl + CW_CUR + layer * NE;
            LAS v4u* rwf = (LAS v4u*)(lds + RING_OFF);
            LAS f32x4* lnp = (LAS f32x4*)(lds + TOK_OFF);
            const float* rw = ARG_IN(16) + (size_t)layer * D * NE;
            for (int f = tid; f < 32 * 2 * 64; f += NTHR) { const int s = f >> 7, nt = (f >> 6) & 1, l = f & 63, e = 16 * nt + (l & 15), kq = l >> 4;
                float w[8], hf[8], lo[8];
#pragma unroll
                for (int j = 0; j < 8; ++j) w[j] = gld<float>(rw + (32 * s + 8 * kq + j) * NE + e);
                const v4u hp = pack8(w); unpack8(hp, hf);
#pragma unroll
                for (int j = 0; j < 8; ++j) lo[j] = w[j] - hf[j];
                rwf[((s * 2 + nt) * 2 + 0) * 64 + l] = hp; rwf[((s * 2 + nt) * 2 + 1) * 64 + l] = pack8(lo); }
            if (tid < 256) { lnp[tid] = gld<f32x4>(ARG_IN(14) + layer * D + 4 * tid); lnp[256 + tid] = gld<f32x4>(ARG_IN(15) + layer * D + 4 * tid); }
            if (tid < NE) MISC[32 + tid] = 0u;
            __syncthreads();
            const int tau = lane & 15, kg = lane >> 4;
            float rb8[8];
#pragma unroll
            for (int i = 0; i < 8; ++i) rb8[i] = gld<float>(ARG_IN(17) + layer * NE + 16 * (i >> 2) + 4 * kg + (i & 3));
            LAS unsigned* hist = (LAS unsigned*)(lds + MISC_OFF) + 32;
#define BPERM_F(v, m) __uint_as_float((unsigned)__builtin_amdgcn_ds_bpermute((lane ^ (m)) << 2, (int)__float_as_uint(v)))
#define BPERM_I(v, m) __builtin_amdgcn_ds_bpermute((lane ^ (m)) << 2, (v))
            for (int rep = 0; rep < REP_LNR; ++rep)
            for (int tb = vcu; tb < T / 128; tb += G) {
                const int t = tb * 128 + wave * 16 + tau;
                const size_t rowo = (size_t)t * D + 8 * kg;
                v4u zp[32];
#pragma unroll
                for (int s = 0; s < 32; ++s) zp[s] = gld<v4u>(Zb + rowo + 32 * s);
                f32x2 S2 = {0.f, 0.f}, Q2 = {0.f, 0.f};
#pragma unroll
                for (int s = 0; s < 32; ++s) { float v[8]; unpack8(zp[s], v);
#pragma unroll
                    for (int j = 0; j < 4; ++j) { const f32x2 p = {v[2 * j], v[2 * j + 1]}; S2 += p; Q2 = __builtin_elementwise_fma(p, p, Q2); } }
                float S = S2[0] + S2[1], Q = Q2[0] + Q2[1];
                S += BPERM_F(S, 16); Q += BPERM_F(Q, 16); S += BPERM_F(S, 32); Q += BPERM_F(Q, 32);
                const float mean = S * (1.0f / D);
                const float rstd = 1.0f / sqrtf(fmaxf(Q * (1.0f / D) - mean * mean, 0.f) + LN_EPS);
                f32x4 a0 = {0.f, 0.f, 0.f, 0.f}, a1 = {0.f, 0.f, 0.f, 0.f};
                v2u x8prev = {0u, 0u};
#pragma unroll
                for (int s = 0; s < 32; ++s) {
                    asm volatile("" : "+v"(zp[s]));
                    float v[8]; unpack8(zp[s], v);
                    const f32x4 g0 = lnp[8 * s + 2 * kg], g1 = lnp[8 * s + 2 * kg + 1], b0 = lnp[256 + 8 * s + 2 * kg], b1 = lnp[256 + 8 * s + 2 * kg + 1];
                    { const f32x2 rstd2 = {rstd, rstd}, nmr2 = {-mean * rstd, -mean * rstd};
                      const f32x2 p0 = __builtin_elementwise_fma(__builtin_elementwise_fma((f32x2){v[0], v[1]}, rstd2, nmr2), (f32x2){g0[0], g0[1]}, (f32x2){b0[0], b0[1]});
                      const f32x2 p1 = __builtin_elementwise_fma(__builtin_elementwise_fma((f32x2){v[2], v[3]}, rstd2, nmr2), (f32x2){g0[2], g0[3]}, (f32x2){b0[2], b0[3]});
                      const f32x2 p2 = __builtin_elementwise_fma(__builtin_elementwise_fma((f32x2){v[4], v[5]}, rstd2, nmr2), (f32x2){g1[0], g1[1]}, (f32x2){b1[0], b1[1]});
                      const f32x2 p3 = __builtin_elementwise_fma(__builtin_elementwise_fma((f32x2){v[6], v[7]}, rstd2, nmr2), (f32x2){g1[2], g1[3]}, (f32x2){b1[2], b1[3]});
                      v[0] = p0[0]; v[1] = p0[1]; v[2] = p1[0]; v[3] = p1[1]; v[4] = p2[0]; v[5] = p2[1]; v[6] = p3[0]; v[7] = p3[1]; }
                    const v4u xp = pack8(v);
                    { float s8[8];
#pragma unroll
                      for (int j = 0; j < 4; ++j) { const f32x2 q = (f32x2){v[2 * j], v[2 * j + 1]} * (f32x2){SX8, SX8}; s8[2 * j] = q[0]; s8[2 * j + 1] = q[1]; }
                      const v2u w8 = pack8_fp8_sat(s8);
                      if (s & 1) { const v4u o16 = pg8::widen16(x8prev, w8);
                          gst<v4u>(X18 + (size_t)t * D + 32 * (s - 1 + (kg & 1)) + 8 * (kg & ~1), o16); }
                      else x8prev = w8; }
                    const bf16x8 xb = __builtin_bit_cast(bf16x8, xp);
                    a0 = __builtin_amdgcn_mfma_f32_16x16x32_bf16(__builtin_bit_cast(bf16x8, rwf[((s * 2 + 0) * 2 + 0) * 64 + lane]), xb, a0, 0, 0, 0);
                    a0 = __builtin_amdgcn_mfma_f32_16x16x32_bf16(__builtin_bit_cast(bf16x8, rwf[((s * 2 + 0) * 2 + 1) * 64 + lane]), xb, a0, 0, 0, 0);
                    a1 = __builtin_amdgcn_mfma_f32_16x16x32_bf16(__builtin_bit_cast(bf16x8, rwf[((s * 2 + 1) * 2 + 0) * 64 + lane]), xb, a1, 0, 0, 0);
                    a1 = __builtin_amdgcn_mfma_f32_16x16x32_bf16(__builtin_bit_cast(bf16x8, rwf[((s * 2 + 1) * 2 + 1) * 64 + lane]), xb, a1, 0, 0, 0);
                }
                float val[8]; int eid[8];
#pragma unroll
                for (int r = 0; r < 4; ++r) { val[r] = a0[r] + rb8[r]; eid[r] = 4 * kg + r; val[4 + r] = a1[r] + rb8[4 + r]; eid[4 + r] = 16 + 4 * kg + r; }
                float tv[4]; int tix[4];
#pragma unroll
                for (int k = 0; k < 4; ++k) {
                    float bv = val[0]; int bi = eid[0];
#pragma unroll
                    for (int i = 1; i < 8; ++i) if (val[i] > bv) { bv = val[i]; bi = eid[i]; }
#pragma unroll
                    for (int m = 16; m <= 32; m <<= 1) { const float ov = BPERM_F(bv, m); const int oi = BPERM_I(bi, m); if (ov > bv || (ov == bv && oi < bi)) { bv = ov; bi = oi; } }
                    tv[k] = bv; tix[k] = bi;
#pragma unroll
                    for (int i = 0; i < 8; ++i) if (eid[i] == bi) val[i] = -3.0e38f;
                }
                const float e1 = __expf(tv[1] - tv[0]), e2 = __expf(tv[2] - tv[0]), e3 = __expf(tv[3] - tv[0]);
                const float inv = 1.0f / (1.0f + e1 + e2 + e3);
                unsigned rk[4] = {0u, 0u, 0u, 0u};
                if (kg == 0) {
#pragma unroll
                    for (int k = 0; k < 4; ++k) rk[k] = __hip_atomic_fetch_add(hist + tix[k], 1u, __ATOMIC_RELAXED, __HIP_MEMORY_SCOPE_WORKGROUP);
                }
                __syncthreads();
                if (tid < NE) { const unsigned c = MISC[32 + tid]; MISC[64 + tid] = c ? xb_add(CUR + tid, c) : 0u; MISC[32 + tid] = 0u; }
                __syncthreads();
                if (kg == 0) {
                    const float gk[4] = {inv, e1 * inv, e2 * inv, e3 * inv};
                    v4u ps;
#pragma unroll
                    for (int k = 0; k < 4; ++k) { const int pos = tix[k] * ECAP + (int)MISC[64 + tix[k]] + (int)rk[k]; gst<int>(RTOK + pos, t); gst<float>(RGATE + pos, gk[k]);
                        if (k == 0) ps.x = (unsigned)pos; else if (k == 1) ps.y = (unsigned)pos; else if (k == 2) ps.z = (unsigned)pos; else ps.w = (unsigned)pos; }
                    gst<v4u>(APOS + t * 4, ps);
                }
            }
#undef BPERM_F
#undef BPERM_I
        }
        if (layer + 1 < DEPTH) GRID_BAR_CONVX(layer, 1, NQ, 4096); else GRID_BAR_CONVX(layer, 1 << 30, NQ, 4096);

        {
            const bool conv_layer = (layer + 1 < DEPTH) && (G == 256);
            const int Gg = conv_layer ? G - NCONV : G;
            unsigned* gdone = (unsigned*)(ARG_WS() + WS_CTL) + CW_GDONE + layer * 2;
            if (bx >= Gg) { CONV_RUN(layer, 1 << 30, nullptr, 0); CONV_RUN(layer + 1, 1 << 30, gdone, Gg); }
            else {
            PHASE_BEGIN();
            LAS int* TS = (LAS int*)(lds + TS_OFF);
            unsigned* CUR = ctl + CW_CUR + layer * NE;
            if (tid < NE) MISC[64 + tid] = xb_ld(CUR + tid);
            __syncthreads();
            if (tid == 0) { int a = 0; for (int e = 0; e < NE; ++e) { TS[e] = a; a += (int)((MISC[64 + e] + 255u) >> 8); } TS[NE] = a; }
            __syncthreads();
            const int nM = TS[NE];
            const int n_my = pg8::build_units(lds, tid, nM, 8, Gg, bx, true, (const int*)(ws + WS_RTOK), REP_MOE1);
            pg8::GemmP gp; gp.A = (const char*)(ws + WS_X18); gp.lda2 = D; gp.acol_pn = 0; gp.Bt = (const char*)(ws + WS_WGU + (size_t)layer * NE * 2048 * 1024); gp.b_estride = (size_t)2048 * 1024; gp.Kb = 1024; gp.sA = E8_X; gp.sB = E8_W;
            pg8::EpiSwiglu E; E.act = (unsigned char*)(ws + WS_ACT); E.bgu = ARG_IN(19) + (size_t)layer * NE * 2048;
            if (n_my <= 0 && conv_layer && tid == 0) (void)xb_add(gdone, 1u);
            pg8::gemm_phase<true, true, pg8::EpiSwiglu>(lds, tid, gp, n_my, E, REP_MOE1 > 1 ? n_my / 2 : (1 << 20), conv_layer ? gdone : nullptr);
            if (layer + 1 < DEPTH && n_my < (nM * 8 * REP_MOE1 + Gg - 1) / Gg) CONV_RUN(layer + 1, 2, nullptr, 0);
            if (!conv_layer) CONV_RUN(layer, 1 << 30, nullptr, 0);
            }
        }
        BAR_L();

        {
            const bool conv_layer = (layer + 1 < DEPTH) && (G == 256);
            const int Gg = conv_layer ? G - NCONV : G;
            unsigned* gdone = (unsigned*)(ARG_WS() + WS_CTL) + CW_GDONE + layer * 2 + 1;
            if (bx >= Gg) { CONV_RUN(layer + 1, 1 << 30, gdone, Gg); }
            else {
            PHASE_BEGIN();
            LAS int* TS = (LAS int*)(lds + TS_OFF);
            const int nM = TS[NE];
            const int n_my = pg8::build_units(lds, tid, nM, 4, Gg, bx, true, nullptr, REP_MOE2);
            pg8::GemmP gp; gp.A = (const char*)(ws + WS_ACT); gp.lda2 = D; gp.acol_pn = 0; gp.Bt = (const char*)(ws + WS_WDN + (size_t)layer * NE * 1024 * 1024); gp.b_estride = (size_t)1024 * 1024; gp.Kb = 1024; gp.sA = E8_ACT; gp.sB = E8_W;
            pg8::EpiMoe2 E; E.Y = (unsigned char*)(ws + WS_Y); E.bdn = ARG_IN(21) + (size_t)layer * NE * D; E.rowgate = (const float*)(ws + WS_RGATE);
            if (n_my <= 0 && conv_layer && tid == 0) (void)xb_add(gdone, 1u);
            pg8::gemm_phase<false, true, pg8::EpiMoe2>(lds, tid, gp, n_my, E, 1 << 20, conv_layer ? gdone : nullptr);
            if (layer + 1 < DEPTH && n_my < (nM * 4 * REP_MOE2 + Gg - 1) / Gg) CONV_RUN(layer + 1, 2, nullptr, 0);
            }
        }
        BAR_L();

        {
            PHASE_BEGIN();
            const bf16* Zr = (const bf16*)(ws + WS_ZB); const unsigned char* Y = (const unsigned char*)(ws + WS_Y); const int* APOS = (const int*)(ws + WS_RDST); float* OUT = ARG_OUT(); bf16* XAb = (bf16*)(ws + WS_XAB);
            float lg[16], lb[16], mg[16], mb[16];
#pragma unroll
            for (int q = 0; q < 4; ++q) { const f32x4 b = gld<f32x4>(ARG_IN(22) + layer * D + 16 * lane + 4 * q), c = gld<f32x4>(ARG_IN(23) + layer * D + 16 * lane + 4 * q);
                const f32x4 b1 = gld<f32x4>(ARG_IN(14) + layer * D + 16 * lane + 4 * q), c1 = gld<f32x4>(ARG_IN(15) + layer * D + 16 * lane + 4 * q);
#pragma unroll
                for (int i = 0; i < 4; ++i) { lg[4 * q + i] = b[i]; lb[4 * q + i] = c[i]; mg[4 * q + i] = b1[i]; mb[4 * q + i] = c1[i]; } }
            for (int rep = 0; rep < REP_THIN; ++rep)
            for (int tb = vcu; tb < T / 128; tb += G) {
                const int t0 = tb * 128 + wave * 16;
                const int apos = gld<int>(APOS + t0 * 4 + lane);
#define YROW(ti_, k_) ((size_t)(unsigned)__builtin_amdgcn_readlane(apos, 4 * (ti_) + (k_)) * D)
                v4u nx[2], ny[4];
#pragma unroll
                for (int j = 0; j < 2; ++j) nx[j] = gld<v4u>(Zr + (size_t)t0 * D + 16 * lane + 8 * j);
#pragma unroll
                for (int k = 0; k < 4; ++k) ny[k] = gld<v4u>(Y + YROW(0, k) + 16 * lane);
                for (int ti = 0; ti < 16; ++ti) {
                    const int t = t0 + ti;
                    float v[16], h[16];
                    unpack8(nx[0], v); unpack8(nx[1], v + 8);
#pragma unroll
                    for (int i = 0; i < 16; ++i) h[i] = 0.f;
#pragma unroll
                    for (int k = 0; k < 4; ++k) { const unsigned wd[4] = {ny[k].x, ny[k].y, ny[k].z, ny[k].w};
#pragma unroll
                        for (int d = 0; d < 4; ++d) { const f32x2 lo = __builtin_amdgcn_cvt_pk_f32_fp8((int)wd[d], false), hi = __builtin_amdgcn_cvt_pk_f32_fp8((int)wd[d], true);
                            h[4 * d] += lo[0]; h[4 * d + 1] += lo[1]; h[4 * d + 2] += hi[0]; h[4 * d + 3] += hi[1]; } }
                    if (ti + 1 < 16) {
#pragma unroll
                        for (int j = 0; j < 2; ++j) nx[j] = gld<v4u>(Zr + (size_t)(t + 1) * D + 16 * lane + 8 * j);
#pragma unroll
                        for (int k = 0; k < 4; ++k) ny[k] = gld<v4u>(Y + YROW(ti + 1, k) + 16 * lane); }
                    ln16(v, mg, mb, lane);
#pragma unroll
                    for (int i = 0; i < 16; ++i) v[i] = v[i] * ALPHA + h[i] * (1.0f / SY8);
                    ln16(v, lg, lb, lane);
                    if (layer == DEPTH - 1) {
#pragma unroll
                        for (int q = 0; q < 4; ++q) gst<f32x4>(OUT + (size_t)t * D + 16 * lane + 4 * q, (f32x4){v[4 * q], v[4 * q + 1], v[4 * q + 2], v[4 * q + 3]});
                    } else {
                        gst<v4u>(XAb + (size_t)t * D + 16 * lane, pack8(v));
                        gst<v4u>(XAb + (size_t)t * D + 16 * lane + 8, pack8(v + 8));
                        if ((CF_IN_FP8 && layer == 1) || (SC_IN_FP8 && layer == 0)) {
                            float s8[16];
#pragma unroll
                            for (int i = 0; i < 16; ++i) s8[i] = v[i] * SX8;
                            const v2u a8 = pack8_fp8_sat(s8), b8 = pack8_fp8_sat(s8 + 8); v4u o8; o8.x = a8.x; o8.y = a8.y; o8.z = b8.x; o8.w = b8.y;
                            gst<v4u>((unsigned char*)(ws + WS_X18) + (size_t)t * D + 16 * lane, o8);
                        }
                    }
                }
            }
        }
        if (layer + 1 < DEPTH) GRID_BAR_CONV(layer + 1);
    }
    if (PROBE_CLOCK && bx == 0 && threadIdx.x == 0) {
        const unsigned mhz_ = gld<unsigned>((unsigned*)(ARG_WS() + WS_CTL) + 16); const unsigned long long t0_ = wall_clock64();
        while (wall_clock64() - t0_ < (unsigned long long)mhz_ * 10ull) __builtin_amdgcn_s_sleep(8);
    }
}

extern "C" void kernel_launch(void* const* d_in, const int* in_sizes, int n_in, void* d_out, int out_size, void* d_ws, size_t ws_size, hipStream_t stream) {
    static int grid = 0;
    if (grid == 0) {
        if (n_in != 24 || out_size != T * D || ws_size < WS_END) { fprintf(stderr, "kernel_launch: unexpected shapes (n_in %d out %d ws %zu)\n", n_in, out_size, ws_size); grid = -1; return; }
        if (hipFuncSetAttribute((const void*)mega_fwd, hipFuncAttributeMaxDynamicSharedMemorySize, LDS_BYTES) != hipSuccess) { fprintf(stderr, "kernel_launch: hipFuncSetAttribute failed\n"); grid = -1; return; }
        int dev = 0, cus = 0, per_cu = 0;
        (void)hipGetDevice(&dev); (void)hipDeviceGetAttribute(&cus, hipDeviceAttributeMultiprocessorCount, dev);
        if (hipOccupancyMaxActiveBlocksPerMultiprocessor(&per_cu, (const void*)mega_fwd, NTHR, LDS_BYTES) != hipSuccess || per_cu < 1) fprintf(stderr, "kernel_launch: occupancy query reports %d blocks per CU\n", per_cu);
        (void)hipGetLastError();
        grid = 256; if (cus > 0 && cus < grid) grid = cus;
    }
    if (grid < 0) return;
    (void)hipMemsetAsync((char*)d_ws + WS_CTL, 0, CTL_ZERO_BYTES, stream);
    Args a{};
    for (int i = 0; i < 24; ++i) a.in[i] = (const float*)d_in[i];
    a.out = (float*)d_out; a.ws = (unsigned char*)d_ws;
    hipLaunchKernelGGL(mega_fwd, dim3(grid), dim3(NTHR), LDS_BYTES, stream, a);
    const hipError_t le = hipPeekAtLastError();
    if (le != hipSuccess) fprintf(stderr, "kernel_launch: launch failed: %s\n", hipGetErrorName(le));
}
```

```cpp
#include <hip/hip_runtime.h>
#include <cstdio>
#include <cstdint>

#define GAS __attribute__((address_space(1)))
#define LAS __attribute__((address_space(3)))
typedef unsigned short bf16;
typedef unsigned v4u __attribute__((ext_vector_type(4)));
typedef unsigned v2u __attribute__((ext_vector_type(2)));
typedef float f32x4 __attribute__((ext_vector_type(4)));
typedef float f32x2 __attribute__((ext_vector_type(2)));
typedef short bf16x8 __attribute__((ext_vector_type(8)));
typedef int v4i __attribute__((ext_vector_type(4)));
typedef int v8i __attribute__((ext_vector_type(8)));

template <class V> __device__ __forceinline__ V gld(const void* p) { return *(const GAS V*)p; }
template <class V> __device__ __forceinline__ void gst(void* p, V v) { *(GAS V*)p = v; }

#ifndef REP_P0
#define REP_P0 1
#endif
#ifndef REP_MOE1
#define REP_MOE1 1
#endif
#ifndef REP_MOE2
#define REP_MOE2 1
#endif
#ifndef REP_THIN
#define REP_THIN 1
#endif
#ifndef REP_MIXG
#define REP_MIXG 1
#endif
#ifndef REP_LNR
#define REP_LNR 1
#endif
#ifndef REP_BAR
#define REP_BAR 1
#endif
#ifndef PROBE_CLOCK
#define PROBE_CLOCK 0
#endif
#ifndef SC_OUT_FP8
#define SC_OUT_FP8 0
#endif
#ifndef SC_IN_FP8
#define SC_IN_FP8 1
#endif
#ifndef CF_OUT_FP8
#define CF_OUT_FP8 1
#endif
#ifndef CF_IN_FP8
#define CF_IN_FP8 1
#endif
#ifndef REP_EPI1
#define REP_EPI1 1
#endif
#ifndef REP_EPI2
#define REP_EPI2 1
#endif
constexpr int T = 32768, D = 1024, SEQ = 4096, NE = 32, TOPK = 4, NA = T * TOPK, DEPTH = 4;
constexpr int MAXTILES = NA / 256 + NE;
constexpr int ECAP = T, ETILES = ECAP / 256;
constexpr int NPAD = MAXTILES * 256;
constexpr float LN_EPS = 1e-5f;
constexpr float ALPHA = 1.681792830507429f;
constexpr int NWAVES = 8, NTHR = 512;
constexpr int MAXU = 19;
constexpr float SX8 = 16.0f, SACT8 = 4.0f, SW8 = 256.0f, SY8 = 32.0f;
constexpr int E8_X = 0x7B7B7B7B  , E8_ACT = 0x7D7D7D7D  , E8_W = 0x77777777  ;

constexpr size_t MiB = 1u << 20;
constexpr size_t WS_CTL = 0, CTL_ZERO_BYTES = 64 * 1024;
constexpr size_t WS_IDX = 1 * MiB;
constexpr size_t WS_GATE = 1 * MiB + 512 * 1024;
constexpr size_t WS_RTOK = 1712 * MiB;
constexpr size_t WS_RDST = 3 * MiB;
constexpr size_t WS_RGATE = 1716 * MiB;
constexpr size_t WS_WPOOL = 5 * MiB;
constexpr size_t WS_WSCIN = 6 * MiB;
constexpr size_t WS_WSCOUT = 12 * MiB;
constexpr size_t WS_WCFIN = 14 * MiB;
constexpr size_t WS_WCFOUT = 18 * MiB;
constexpr size_t WS_WGU = 32 * MiB;
constexpr size_t WS_WDN = 544 * MiB;
constexpr size_t WS_X18 = 704 * MiB;
constexpr size_t WS_ZB = 800 * MiB;
constexpr size_t WS_XAB = 864 * MiB;
constexpr size_t WS_M1 = 992 * MiB;
constexpr size_t WS_M2 = 1056 * MiB;
constexpr size_t WS_M3 = 1120 * MiB;
constexpr size_t WS_ACT = 1720 * MiB;
constexpr size_t WS_Y = 2744 * MiB;
constexpr size_t WS_END = 3768 * MiB;
constexpr int CW_BAR = 4096;
constexpr int CW_CNT = 8192;
constexpr int CW_CUR = 8192 + 256;
constexpr int CW_DQ = 8192 + 512;
constexpr int CW_GDONE = 8192 + 512 + 64;

constexpr int RING_OFF = 0, RING_BYTES = 131072;
constexpr int TOK_OFF = RING_BYTES;
constexpr int UT_OFF = TOK_OFF + MAXU * 1024;
constexpr int TS_OFF = UT_OFF + (2 * MAXU + 2) * 16;
constexpr int MISC_OFF = TS_OFF + 36 * 4;
constexpr int EPI_OFF = ((MISC_OFF + 128 * 4 + 255) / 256) * 256;
constexpr int LDS_BYTES = EPI_OFF + 2 * 4096;
static_assert(LDS_BYTES <= 160 * 1024 && (MISC_OFF % 16) == 0, "LDS map");

#define LDS_WAIT() asm volatile("s_waitcnt lgkmcnt(0)" ::: "memory")
#define VM_WAIT() asm volatile("s_waitcnt vmcnt(0)" ::: "memory")

__device__ __forceinline__ unsigned cvt_pk_bf16(float lo, float hi) { unsigned r; asm volatile("v_cvt_pk_bf16_f32 %0, %1, %2" : "=v"(r) : "v"(lo), "v"(hi)); return r; }
__device__ __forceinline__ v2u pack8_fp8(const float* c) {
    int a = __builtin_amdgcn_cvt_pk_fp8_f32(c[0], c[1], 0, false); a = __builtin_amdgcn_cvt_pk_fp8_f32(c[2], c[3], a, true);
    int b = __builtin_amdgcn_cvt_pk_fp8_f32(c[4], c[5], 0, false); b = __builtin_amdgcn_cvt_pk_fp8_f32(c[6], c[7], b, true); v2u w; w.x = (unsigned)a; w.y = (unsigned)b; return w; }
__device__ __forceinline__ v2u pack8_fp8_sat(const float* v) { float c[8];
    float lim = 448.0f; asm volatile("" : "+v"(lim));
#pragma unroll
    for (int i = 0; i < 8; ++i) c[i] = __builtin_amdgcn_fmed3f(v[i], -lim, lim);
    return pack8_fp8(c); }
__device__ __forceinline__ float bf_lo(unsigned u) { return __uint_as_float(u << 16); }
__device__ __forceinline__ float bf_hi(unsigned u) { return __uint_as_float(u & 0xffff0000u); }
__device__ __forceinline__ float sigmoidf_(float x) { return __builtin_amdgcn_rcpf(1.0f + __expf(-x)); }
#define DPP_F(v, ctrl) __int_as_float(__builtin_amdgcn_update_dpp(0, __float_as_int(v), (ctrl), 0xf, 0xf, true))
#define DPP_XOR1 0xB1
#define DPP_XOR2 0x4E
#define DPP_QREV 0x1B
#define DPP_HMIR 0x141
#define DPP_RMIR 0x140
#define DPP_ROR8 0x128
__device__ __forceinline__ float rdlane(float v, int l) { return __uint_as_float((unsigned)__builtin_amdgcn_readlane((int)__float_as_uint(v), l)); }
__device__ __forceinline__ float wave_sum(float v, int lane) {
    (void)lane;
    v += DPP_F(v, DPP_XOR1); v += DPP_F(v, DPP_XOR2); v += DPP_F(v, DPP_HMIR); v += DPP_F(v, DPP_RMIR);
    return (rdlane(v, 0) + rdlane(v, 16)) + (rdlane(v, 32) + rdlane(v, 48));
}

#define XB_TMO      128
#define XB_XCNT(j)  (256  + 64 * (j))
#define XB_XSUB(j)  (1280 + 64 * (j))
#define XB_XGEN(j)  (2304 + 64 * (j))
#define XB_TOP      3328
#define XB_TOPGEN   3392
#define XCD_BAR_WORDS 3456
#define XB_SPIN_CAP (1u << 18)

__device__ __forceinline__ unsigned xb_ld(unsigned* p)              { return __hip_atomic_load((GAS unsigned*)p, __ATOMIC_RELAXED, __HIP_MEMORY_SCOPE_AGENT); }
__device__ __forceinline__ unsigned xb_add(unsigned* p, unsigned v) { return __hip_atomic_fetch_add((GAS unsigned*)p, v, __ATOMIC_RELAXED, __HIP_MEMORY_SCOPE_AGENT); }
__device__ __forceinline__ unsigned xb_xcc_id() { return (unsigned)__builtin_amdgcn_s_getreg((3 << 11) | 20) & 0xFu; }
#define XB_SPIN(cond, bar) do { unsigned _sp = 0; while (cond) { __builtin_amdgcn_s_sleep(1); \
    if ((++_sp & 255u) == 0u) { if (xb_ld(&(bar)[XB_TMO])) break; if (_sp > XB_SPIN_CAP) { (void)xb_add(&(bar)[XB_TMO], 1u); break; } } } } while (0)

struct XcdBarrier { unsigned* bar; unsigned x; volatile LAS unsigned* st; };

__device__ __forceinline__ XcdBarrier xcd_barrier_post(unsigned* bar, volatile LAS unsigned* st) {
    XcdBarrier b; b.bar = bar; b.x = xb_xcc_id(); b.st = st;
    if (threadIdx.x == 0) (void)xb_add(&bar[XB_XCNT(b.x)], 1u);
    return b;
}
__device__ __forceinline__ void xcd_barrier_complete(unsigned* bar, unsigned x, unsigned& nloc, unsigned& nx) {
    const unsigned G = gridDim.x * gridDim.y * gridDim.z;
    unsigned sum, cnt, mine, sp = 0u;
    for (;;) {
        sum = 0u; cnt = 0u; mine = 0u;
#pragma unroll
        for (unsigned j = 0; j < 16; ++j) { const unsigned c = xb_ld(&bar[XB_XCNT(j)]); sum += c; cnt += (c > 0u) ? 1u : 0u; mine = (j == x) ? c : mine; }
        if (sum == G) break;
        __builtin_amdgcn_s_sleep(1);
        if ((++sp & 255u) == 0u) { if (xb_ld(&bar[XB_TMO])) break; if (sp > XB_SPIN_CAP) { (void)xb_add(&bar[XB_TMO], 1u); break; } }
    }
    nloc = mine > 0u ? mine : 1u; nx = cnt > 0u ? cnt : 1u;
}
__device__ __forceinline__ void xcd_barrier(const XcdBarrier& b) {
    asm volatile("s_waitcnt vmcnt(0)" ::: "memory");
    __syncthreads();
    if (threadIdx.x == 0) {
        unsigned* bar = b.bar;
        __builtin_amdgcn_s_waitcnt(0);
        unsigned nloc = b.st[0], nx = b.st[1];
        if (nloc == 0u) { xcd_barrier_complete(bar, b.x, nloc, nx); b.st[0] = nloc; b.st[1] = nx; }
        const unsigned old = xb_add(&bar[XB_XSUB(b.x)], 1u);
        const unsigned gen = old / nloc;
        if (old + 1u == (gen + 1u) * nloc) {
            __builtin_amdgcn_fence(__ATOMIC_RELEASE, "agent");
            asm volatile("s_waitcnt vmcnt(0)" ::: "memory");
            const unsigned og = xb_add(&bar[XB_TOP], 1u);
            const unsigned tg = og / nx;
            if (og + 1u == (tg + 1u) * nx) xb_add(&bar[XB_TOPGEN], 1u);
            else XB_SPIN(xb_ld(&bar[XB_TOPGEN]) == tg, bar);
            __builtin_amdgcn_fence(__ATOMIC_ACQUIRE, "agent");
            xb_add(&bar[XB_XGEN(b.x)], 1u);
            asm volatile("s_waitcnt vmcnt(0)" ::: "memory");
        } else {
            XB_SPIN(xb_ld(&bar[XB_XGEN(b.x)]) == gen, bar);
            __builtin_amdgcn_fence(__ATOMIC_ACQUIRE, "agent");
            asm volatile("s_waitcnt vmcnt(0)" ::: "memory");
        }
    }
    __syncthreads();
}

__device__ __forceinline__ bool xcd_barrier_arrive(const XcdBarrier& b) {
    asm volatile("s_waitcnt vmcnt(0)" ::: "memory");
    __syncthreads();
    if (threadIdx.x == 0) {
        unsigned* bar = b.bar;
        __builtin_amdgcn_s_waitcnt(0);
        unsigned nloc = b.st[0], nx = b.st[1];
        if (nloc == 0u) { xcd_barrier_complete(bar, b.x, nloc, nx); b.st[0] = nloc; b.st[1] = nx; }
        const unsigned old = xb_add(&bar[XB_XSUB(b.x)], 1u);
        const unsigned gen = old / nloc;
        b.st[9] = gen; b.st[10] = (old + 1u == (gen + 1u) * nloc) ? 1u : 0u;
    }
    __syncthreads();
    return __builtin_amdgcn_readfirstlane((int)b.st[10]) != 0;
}
__device__ __forceinline__ void xcd_barrier_finish(const XcdBarrier& b) {
    __syncthreads();
    if (threadIdx.x == 0) {
        unsigned* bar = b.bar;
        const unsigned gen = b.st[9], nx = b.st[1];
        if (b.st[10] != 0u) {
            __builtin_amdgcn_fence(__ATOMIC_RELEASE, "agent");
            asm volatile("s_waitcnt vmcnt(0)" ::: "memory");
            const unsigned og = xb_add(&bar[XB_TOP], 1u);
            const unsigned tg = og / nx;
            if (og + 1u == (tg + 1u) * nx) xb_add(&bar[XB_TOPGEN], 1u);
            else XB_SPIN(xb_ld(&bar[XB_TOPGEN]) == tg, bar);
            __builtin_amdgcn_fence(__ATOMIC_ACQUIRE, "agent");
            xb_add(&bar[XB_XGEN(b.x)], 1u);
            asm volatile("s_waitcnt vmcnt(0)" ::: "memory");
        } else {
            XB_SPIN(xb_ld(&bar[XB_XGEN(b.x)]) == gen, bar);
            __builtin_amdgcn_fence(__ATOMIC_ACQUIRE, "agent");
            asm volatile("s_waitcnt vmcnt(0)" ::: "memory");
        }
    }
    __syncthreads();
}

namespace pg8 {
constexpr int BM = 256, BK = 64, HALF = 128, HTB = HALF * BK * 2, STAGE_BYTES = 8 * HTB, NXCD = 8, WGM = 8;
__host__ __device__ __forceinline__ int lds_byte(int r, int c) { const int st = (r >> 4) * 2 + (c >> 5), rr = r & 15, cc = c & 31, ob = rr * 64 + cc * 2; return st * 1024 + (ob ^ (((ob >> 9) & 1) << 5)); }
__host__ __device__ __forceinline__ void stage_rc(int b, int& R, int& C) { const int st = b / 1024, sb = b % 1024, swz = sb ^ (((sb >> 9) & 1) << 5); R = (st >> 1) * 16 + swz / 64; C = (st & 1) * 32 + (swz % 64) / 2; }
__host__ __device__ __forceinline__ int perm32(int rho) { const int n = rho >> 4, i = rho & 15; return 8 * (i >> 2) + 4 * n + (i & 3); }

struct Unit { int pm, pn, e; };
struct GemmP {
    const char* A; unsigned lda2;
    unsigned acol_pn;
    const char* Bt; size_t b_estride;
    int Kb;
    int sA, sB;
};

__device__ __forceinline__ void unit_of(int L, int nM, int nN, int& pm, int& pn) {
    const int nwg = nM * nN;
    int wgid = L; { const int q = nwg / NXCD, r = nwg % NXCD, xcd = wgid % NXCD, off = wgid / NXCD; wgid = (xcd < r ? xcd * (q + 1) : r * (q + 1) + (xcd - r) * q) + off; }
    const int nig = WGM * nN, gid = wgid / nig, fm = gid * WGM, gsz = (nM - fm) < WGM ? (nM - fm) : WGM;
    pm = fm + ((wgid % nig) % gsz); pn = (wgid % nig) / gsz;
}
__device__ __forceinline__ int build_units(LAS unsigned char* lds, const int tid, int nM, int nN, int G, int c, bool moe, const int* row_tok, const int dup = 1) {
    LAS int* UT = (LAS int*)(lds + UT_OFF); LAS const int* TS = (LAS const int*)(lds + TS_OFF); LAS int* TOK = (LAS int*)(lds + TOK_OFF);
    LAS const int* CNTL = (LAS const int*)(lds + MISC_OFF) + 64;
    const int nwg = nM * nN;
    int n_my = (nwg > c) ? (nwg - c + G - 1) / G : 0; if (n_my > MAXU) n_my = MAXU;
    if (tid < n_my) {
        int pm, pn; unit_of(tid * G + c, nM, nN, pm, pn);
        int e = 0, j = 0; if (moe) { int lo = 1, hi = NE;
#pragma unroll
            for (int it = 0; it < 5; ++it) { const int mid = (lo + hi) >> 1; if (TS[mid] > pm) hi = mid; else lo = mid + 1; }
            e = lo - 1; j = pm - TS[e]; pm = e * ETILES + j; }
        UT[4 * tid + 0] = pm; UT[4 * tid + 1] = pn; UT[4 * tid + 2] = e; UT[4 * tid + 3] = j;
    }
    __syncthreads();
    if (row_tok) {
        for (int idx = tid; idx < n_my * 256; idx += NTHR) { const int i = idx >> 8, r = idx & 255; const bool valid = UT[4 * i + 3] * 256 + r < CNTL[UT[4 * i + 2]];
            TOK[idx] = valid ? gld<int>(row_tok + UT[4 * i] * 256 + r) : 0; }
    }
    __syncthreads();
    if (dup > 1) { if (tid < n_my) { UT[4 * (tid + n_my) + 0] = UT[4 * tid]; UT[4 * (tid + n_my) + 1] = UT[4 * tid + 1]; UT[4 * (tid + n_my) + 2] = UT[4 * tid + 2]; UT[4 * (tid + n_my) + 3] = UT[4 * tid + 3]; } __syncthreads(); return 2 * n_my; }
    return n_my;
}
__device__ __forceinline__ Unit read_unit(LAS const int* UT, int i) {
    Unit u; u.pm = __builtin_amdgcn_readfirstlane(UT[4 * i]); u.pn = __builtin_amdgcn_readfirstlane(UT[4 * i + 1]); u.e = __builtin_amdgcn_readfirstlane(UT[4 * i + 2]); return u;
}
template <bool GATHER>
__device__ __forceinline__ void a_offsets(unsigned (&v)[2][2], const GemmP& g, const Unit& u, int ui, const int (&Rr)[2], const int (&Cc2)[2], LAS const int* TOK, const int tokn) {
#pragma unroll
    for (int h = 0; h < 2; ++h)
#pragma unroll
        for (int i = 0; i < 2; ++i) {
            const int row = GATHER ? TOK[(ui >= tokn ? ui - tokn : ui) * 256 + h * HALF + Rr[i]] : (u.pm * BM + h * HALF + Rr[i]);
            v[h][i] = (unsigned)row * g.lda2 + (unsigned)Cc2[i] + (unsigned)u.pn * g.acol_pn;
        }
}

template <bool GATHER, bool FP8, class Epi>
__device__ __forceinline__ void gemm_phase(LAS unsigned char* lds, const int tid, const GemmP g, const int n_my, const Epi& E, const int tokn = 1 << 20, unsigned* last_ctr = nullptr) {
    const int wid = __builtin_amdgcn_readfirstlane(tid >> 6), lane = tid & 63, wr = wid >> 2, wc = wid & 3, fr = lane & 15, fq = lane >> 4;
    const int Kb = g.Kb, nt = Kb / (BK * 2);
    if (n_my <= 0) return;
    int Rr[2], Cc2[2]; unsigned voffB[2];
#pragma unroll
    for (int i = 0; i < 2; ++i) { int R, C; stage_rc(tid * 16 + i * 8192, R, C); const int Rb = Epi::PERM ? ((R & ~31) + perm32(R & 31)) : R;
        Rr[i] = R; Cc2[i] = C * 2; voffB[i] = (unsigned)(Rb * Kb + C * 2); }
    const size_t kstep = (size_t)(BK * 2);
    const size_t hstep = (size_t)HALF * Kb;
    const size_t tstepB = 2 * hstep;
    const unsigned ldsw = (unsigned)wid * 1024u;
    const int aoff = lds_byte(wr * 64 + fr, fq * 8), boff = lds_byte(wc * 32 + fr, fq * 8);
    LAS const int* UT = (LAS const int*)(lds + UT_OFF); LAS const int* TOK = (LAS const int*)(lds + TOK_OFF);
#define PG8_SA(b, h) (((b) * 2 + (h)) * HTB)
#define PG8_SB(b, h) ((4 + (b) * 2 + (h)) * HTB)
#define PG8_STAGE(bufoff, gbase, voff) do { _Pragma("unroll") for (int _i = 0; _i < 2; ++_i) \
        __builtin_amdgcn_global_load_lds((const unsigned*)((const char*)(gbase) + (voff)[_i]), (LAS unsigned*)(lds + (bufoff) + ldsw + _i * 8192), 16, 0, 0); } while (0)
#define PG8_LDA(dst, b, h) do { _Pragma("unroll") for (int m = 0; m < 4; ++m) _Pragma("unroll") for (int k = 0; k < 2; ++k) dst[m][k] = *(const LAS bf16x8*)(lds + PG8_SA(b, h) + aoff + m * 2048 + k * 1024); } while (0)
#define PG8_LDB(dst, b, h) do { _Pragma("unroll") for (int n = 0; n < 2; ++n) _Pragma("unroll") for (int k = 0; k < 2; ++k) dst[n][k] = *(const LAS bf16x8*)(lds + PG8_SB(b, h) + boff + n * 2048 + k * 1024); } while (0)
#define PG8_CAT(x) __builtin_shufflevector(__builtin_bit_cast(v4i, (x)[0]), __builtin_bit_cast(v4i, (x)[1]), 0, 1, 2, 3, 4, 5, 6, 7)
#define PG8_MMA(ai, bj, At, Bt) do { __builtin_amdgcn_s_setprio(1); _Pragma("unroll") for (int m = 0; m < 4; ++m) _Pragma("unroll") for (int n = 0; n < 2; ++n) { \
        if constexpr (FP8) { const v8i b8_ = PG8_CAT(Bt[n]), a8_ = PG8_CAT(At[m]); asm volatile("v_mfma_scale_f32_16x16x128_f8f6f4 %0, %1, %2, %0, %3, %4 op_sel_hi:[0,0,0]" : "+v"(acc[ai][bj][m][n]) : "v"(b8_), "v"(a8_), "v"(vsB), "v"(vsA)); } \
        else { _Pragma("unroll") for (int k = 0; k < 2; ++k) acc[ai][bj][m][n] = __builtin_amdgcn_mfma_f32_16x16x32_bf16(Bt[n][k], At[m][k], acc[ai][bj][m][n], 0, 0, 0); } } \
        __builtin_amdgcn_s_setprio(0); } while (0)
#define PG8_MMA0(ai, bj, At, Bt) do { __builtin_amdgcn_s_setprio(1); _Pragma("unroll") for (int m = 0; m < 4; ++m) _Pragma("unroll") for (int n = 0; n < 2; ++n) { \
        if constexpr (FP8) { const v8i b8_ = PG8_CAT(Bt[n]), a8_ = PG8_CAT(At[m]); asm volatile("v_mfma_scale_f32_16x16x128_f8f6f4 %0, %1, %2, 0, %3, %4 op_sel_hi:[0,0,0]" : "=&v"(acc[ai][bj][m][n]) : "v"(b8_), "v"(a8_), "v"(vsB), "v"(vsA)); } \
        else { acc[ai][bj][m][n] = __builtin_amdgcn_mfma_f32_16x16x32_bf16(Bt[n][0], At[m][0], (f32x4){0.f, 0.f, 0.f, 0.f}, 0, 0, 0); acc[ai][bj][m][n] = __builtin_amdgcn_mfma_f32_16x16x32_bf16(Bt[n][1], At[m][1], acc[ai][bj][m][n], 0, 0, 0); } } \
        __builtin_amdgcn_s_setprio(0); } while (0)
#define PG8_WAIT_V(n) asm volatile("s_waitcnt vmcnt(" #n ")" ::: "memory")
#define PG8_WAIT_L(n) asm volatile("s_waitcnt lgkmcnt(" #n ")" ::: "memory")
#define PG8_BAR __builtin_amdgcn_s_barrier()
#define PG8_SCHED __builtin_amdgcn_sched_barrier(0)
    Unit cur = read_unit(UT, 0), nxt; int ui = 0;
    f32x4 acc[2][2][4][2];
    if constexpr (!FP8) {
#pragma unroll
    for (int a = 0; a < 2; ++a)
#pragma unroll
        for (int b = 0; b < 2; ++b)
#pragma unroll
            for (int m = 0; m < 4; ++m)
#pragma unroll
                for (int n = 0; n < 2; ++n) acc[a][b][m][n] = (f32x4){0.f, 0.f, 0.f, 0.f};
    }
#define PG8_PIN_ACC() do { if constexpr (FP8) { _Pragma("unroll") for (int a_ = 0; a_ < 2; ++a_) _Pragma("unroll") for (int b_ = 0; b_ < 2; ++b_) \
        asm volatile("" : "+v"(acc[a_][b_][0][0]), "+v"(acc[a_][b_][0][1]), "+v"(acc[a_][b_][1][0]), "+v"(acc[a_][b_][1][1]), "+v"(acc[a_][b_][2][0]), "+v"(acc[a_][b_][2][1]), "+v"(acc[a_][b_][3][0]), "+v"(acc[a_][b_][3][1])); \
        asm volatile("s_nop 1" ::: "memory"); } } while (0)
    bf16x8 At[4][2], B0[2][2], B1[2][2];
    int vsA = g.sA, vsB = g.sB; asm volatile("" : "+v"(vsA), "+v"(vsB));
    unsigned vAc[2][2], vAn[2][2];
    a_offsets<GATHER>(vAc, g, cur, 0, Rr, Cc2, TOK, tokn);
    const char* const Ab = g.A;
    const char* cB = g.Bt + (size_t)cur.e * g.b_estride + (size_t)cur.pn * tstepB;
    PG8_STAGE(PG8_SB(0, 0), cB, voffB); PG8_STAGE(PG8_SB(0, 1), cB + hstep, voffB); PG8_STAGE(PG8_SA(0, 0), Ab, vAc[0]); PG8_STAGE(PG8_SA(0, 1), Ab, vAc[1]);
    if (wr == 1) PG8_BAR;
    PG8_WAIT_V(2); PG8_BAR;
    PG8_STAGE(PG8_SB(1, 0), cB + kstep, voffB); PG8_STAGE(PG8_SA(1, 0), Ab + kstep, vAc[0]); PG8_STAGE(PG8_SB(1, 1), cB + hstep + kstep, voffB);
    PG8_WAIT_V(6); PG8_BAR;
    for (;;) {
        const bool has_next = (ui + 1 < n_my);
        if (!has_next && last_ctr != nullptr && tid == 0) (void)xb_add(last_ctr, 1u);
        nxt = cur; if (has_next) nxt = read_unit(UT, ui + 1);
        const char* nB = has_next ? g.Bt + (size_t)nxt.e * g.b_estride + (size_t)nxt.pn * tstepB : cB;
        for (int t = 0; t < nt; t += 2) {
            const bool last = (t == nt - 2);
            if (t == 0) E.prefetch(lds + EPI_OFF + (ui & 1) * 4096, cur, wid, lane);
            const char* a1 = Ab + (size_t)(t + 1) * kstep;
            const char* a2 = last ? Ab : Ab + (size_t)(t + 2) * kstep; const char* b2 = last ? nB : cB + (size_t)(t + 2) * kstep;
            const char* a3 = a2 + kstep; const char* b3 = b2 + kstep;
            unsigned o2[2][2];
            if (last) {
                if (has_next) a_offsets<GATHER>(vAn, g, nxt, ui + 1, Rr, Cc2, TOK, tokn);
                else { vAn[0][0] = vAc[0][0]; vAn[0][1] = vAc[0][1]; vAn[1][0] = vAc[1][0]; vAn[1][1] = vAc[1][1]; }
                o2[0][0] = vAn[0][0]; o2[0][1] = vAn[0][1]; o2[1][0] = vAn[1][0]; o2[1][1] = vAn[1][1];
            } else { o2[0][0] = vAc[0][0]; o2[0][1] = vAc[0][1]; o2[1][0] = vAc[1][0]; o2[1][1] = vAc[1][1]; }
            PG8_LDB(B0, 0, 0); PG8_LDB(B1, 0, 1); PG8_SCHED; PG8_LDA(At, 0, 0); PG8_STAGE(PG8_SA(1, 1), a1, vAc[1]);
            PG8_WAIT_V(8); PG8_WAIT_L(0); PG8_BAR; if (FP8 && t == 0) { PG8_MMA0(0, 0, At, B0); PG8_MMA0(0, 1, At, B1); } else { PG8_MMA(0, 0, At, B0); PG8_MMA(0, 1, At, B1); } PG8_BAR; PG8_SCHED;
            PG8_LDA(At, 0, 1); PG8_STAGE(PG8_SB(0, 0), b2, voffB); PG8_STAGE(PG8_SB(0, 1), b2 + hstep, voffB); PG8_STAGE(PG8_SA(0, 0), a2, o2[0]);
            PG8_WAIT_V(8); PG8_WAIT_L(0); PG8_BAR; if (FP8 && t == 0) { PG8_MMA0(1, 0, At, B0); PG8_MMA0(1, 1, At, B1); } else { PG8_MMA(1, 0, At, B0); PG8_MMA(1, 1, At, B1); } PG8_BAR; PG8_SCHED;
            PG8_LDB(B0, 1, 0); PG8_LDB(B1, 1, 1); PG8_SCHED; PG8_LDA(At, 1, 0); PG8_STAGE(PG8_SA(0, 1), a2, o2[1]);
            PG8_WAIT_V(8); PG8_WAIT_L(0); PG8_BAR; PG8_MMA(0, 0, At, B0); PG8_MMA(0, 1, At, B1); PG8_BAR; PG8_SCHED;
            PG8_LDA(At, 1, 1); PG8_STAGE(PG8_SB(1, 0), b3, voffB); PG8_STAGE(PG8_SB(1, 1), b3 + hstep, voffB); PG8_STAGE(PG8_SA(1, 0), a3, o2[0]);
            PG8_WAIT_V(8); PG8_WAIT_L(0); PG8_BAR; PG8_MMA(1, 0, At, B0); PG8_MMA(1, 1, At, B1); PG8_BAR; PG8_SCHED;
        }
        if (wr == 0) PG8_BAR;
        if constexpr (FP8) asm volatile("s_nop 15" ::: "memory");
        for (int re_ = 0; re_ < Epi::REPS; ++re_) E(acc, cur, wr, wc, fr, fq, lds + EPI_OFF + (ui & 1) * 4096);
        if (!has_next) break;
        if constexpr (!FP8) {
#pragma unroll
        for (int a = 0; a < 2; ++a)
#pragma unroll
            for (int b = 0; b < 2; ++b)
#pragma unroll
                for (int m = 0; m < 4; ++m)
#pragma unroll
                    for (int n = 0; n < 2; ++n) acc[a][b][m][n] = (f32x4){0.f, 0.f, 0.f, 0.f};
        }
        cur = nxt; cB = nB; ++ui;
        vAc[0][0] = vAn[0][0]; vAc[0][1] = vAn[0][1]; vAc[1][0] = vAn[1][0]; vAc[1][1] = vAn[1][1];
        if (wr == 1) PG8_BAR;
    }
    PG8_WAIT_V(0);
    PG8_BAR;
#undef PG8_SA
#undef PG8_SB
#undef PG8_STAGE
#undef PG8_LDA
#undef PG8_LDB
#undef PG8_MMA
#undef PG8_MMA0
#undef PG8_PIN_ACC
#undef PG8_CAT
#undef PG8_WAIT_V
#undef PG8_WAIT_L
#undef PG8_BAR
#undef PG8_SCHED
}

__device__ __forceinline__ v4u widen16(const v2u X, const v2u Y) {
    const auto a = __builtin_amdgcn_permlane16_swap(X.x, Y.x, false, false), b = __builtin_amdgcn_permlane16_swap(X.y, Y.y, false, false);
    v4u o; o.x = a[0]; o.y = b[0]; o.z = a[1]; o.w = b[1]; return o;
}
struct EpiOut {
    static constexpr bool PERM = true; static constexpr int REPS = 1;
    const bf16* xres; const float* xres32; bf16* z; const float* bias; const float* scale;
    __device__ __forceinline__ void prefetch(LAS unsigned char*, const Unit&, int, int) const {}
    __device__ __forceinline__ void operator()(const f32x4 (&acc)[2][2][4][2], const Unit& u, int wr, int wc, int fr, int fq, const LAS unsigned char*) const {
        const int row0 = u.pm * BM + wr * 64 + fr, c0 = u.pn * BM + wc * 32 + 8 * fq;
        f32x4 bv[2][2], sv[2][2];
#pragma unroll
        for (int bj = 0; bj < 2; ++bj)
#pragma unroll
            for (int n = 0; n < 2; ++n) {
                bv[bj][n] = bias ? gld<f32x4>(bias + c0 + bj * HALF + 4 * n) : (f32x4){0.f, 0.f, 0.f, 0.f};
                sv[bj][n] = scale ? gld<f32x4>(scale + c0 + bj * HALF + 4 * n) : (f32x4){1.f, 1.f, 1.f, 1.f};
            }
#pragma unroll
        for (int ai = 0; ai < 2; ++ai)
#pragma unroll
            for (int m = 0; m < 4; ++m) { const size_t off = (size_t)(row0 + ai * HALF + m * 16) * D + c0;
#pragma unroll
                for (int bj = 0; bj < 2; ++bj) { f32x4 x0, x1;
                    if (xres32) { x0 = gld<f32x4>(xres32 + off + bj * HALF); x1 = gld<f32x4>(xres32 + off + bj * HALF + 4); }
                    else { const v4u xr = gld<v4u>(xres + off + bj * HALF); x0 = (f32x4){bf_lo(xr.x), bf_hi(xr.x), bf_lo(xr.y), bf_hi(xr.y)}; x1 = (f32x4){bf_lo(xr.z), bf_hi(xr.z), bf_lo(xr.w), bf_hi(xr.w)}; }
                    const f32x4 o0 = x0 * ALPHA + (acc[ai][bj][m][0] + bv[bj][0]) * sv[bj][0], o1 = x1 * ALPHA + (acc[ai][bj][m][1] + bv[bj][1]) * sv[bj][1];
                    v4u w; w.x = cvt_pk_bf16(o0[0], o0[1]); w.y = cvt_pk_bf16(o0[2], o0[3]); w.z = cvt_pk_bf16(o1[0], o1[1]); w.w = cvt_pk_bf16(o1[2], o1[3]);
                    gst<v4u>(z + off + bj * HALF, w); }
                asm volatile("" ::: "memory"); }
    }
};
struct EpiPair {
    static constexpr bool PERM = true; static constexpr int REPS = 1;
    bf16* O1; bf16* O2; const float* bias; int mode;
    __device__ __forceinline__ void prefetch(LAS unsigned char*, const Unit&, int, int) const {}
    __device__ __forceinline__ void operator()(const f32x4 (&acc)[2][2][4][2], const Unit& u, int wr, int wc, int fr, int fq, const LAS unsigned char*) const {
        const int row0 = u.pm * BM + wr * 64 + fr;
        if (u.pn < 8) {
            const int j0 = u.pn * HALF + wc * 32 + 8 * fq;
            f32x4 b1[2], b2[2];
#pragma unroll
            for (int n = 0; n < 2; ++n) { b1[n] = mode ? gld<f32x4>(bias + j0 + 4 * n) : (f32x4){0.f, 0.f, 0.f, 0.f}; b2[n] = mode ? gld<f32x4>(bias + 1024 + j0 + 4 * n) : (f32x4){0.f, 0.f, 0.f, 0.f}; }
#pragma unroll
            for (int ai = 0; ai < 2; ++ai)
#pragma unroll
                for (int m = 0; m < 4; ++m) { bf16* rowp = O1 + (size_t)(row0 + ai * HALF + m * 16) * D + j0; f32x4 r[2];
#pragma unroll
                    for (int n = 0; n < 2; ++n) { const f32x4 g1 = acc[ai][0][m][n] + b1[n], g2 = acc[ai][1][m][n] + b2[n];
                        if (mode) { r[n][0] = g1[0] * sigmoidf_(g2[0]); r[n][1] = g1[1] * sigmoidf_(g2[1]); r[n][2] = g1[2] * sigmoidf_(g2[2]); r[n][3] = g1[3] * sigmoidf_(g2[3]); }
                        else r[n] = g1 * g2; }
                    v4u w; w.x = cvt_pk_bf16(r[0][0], r[0][1]); w.y = cvt_pk_bf16(r[0][2], r[0][3]); w.z = cvt_pk_bf16(r[1][0], r[1][1]); w.w = cvt_pk_bf16(r[1][2], r[1][3]);
                    gst<v4u>(rowp, w); }
        } else {
            const int c0 = (u.pn - 8) * BM + wc * 32 + 8 * fq;
#pragma unroll
            for (int ai = 0; ai < 2; ++ai)
#pragma unroll
                for (int m = 0; m < 4; ++m) { bf16* rowp = O2 + (size_t)(row0 + ai * HALF + m * 16) * D + c0;
#pragma unroll
                    for (int bj = 0; bj < 2; ++bj) { const f32x4 v0 = acc[ai][bj][m][0], v1 = acc[ai][bj][m][1];
                        v4u w; w.x = cvt_pk_bf16(v0[0], v0[1]); w.y = cvt_pk_bf16(v0[2], v0[3]); w.z = cvt_pk_bf16(v1[0], v1[1]); w.w = cvt_pk_bf16(v1[2], v1[3]);
                        gst<v4u>(rowp + bj * HALF, w); } }
        }
    }
};
struct EpiSwiglu {
    static constexpr bool PERM = true; static constexpr int REPS = REP_EPI1;
    unsigned char* act; const float* bgu;
    __device__ __forceinline__ void prefetch(LAS unsigned char* slot, const Unit& u, int wid, int lane) const {
        if (wid == 0) __builtin_amdgcn_global_load_lds((const unsigned*)(bgu + (size_t)u.e * 2048 + 2 * u.pn * HALF + 4 * lane), (LAS unsigned*)slot, 16, 0, 0);
    }
    __device__ __forceinline__ void operator()(const f32x4 (&acc)[2][2][4][2], const Unit& u, int wr, int wc, int fr, int fq, const LAS unsigned char* slot) const {
        const int row0 = u.pm * BM + wr * 64 + fr, j0 = u.pn * HALF + wc * 32 + 8 * fq;
        const LAS float* bp = (const LAS float*)slot + 2 * (wc * 32 + 8 * fq);
        f32x2 gb[4], ub[4];
#pragma unroll
        for (int i = 0; i < 4; ++i) { const f32x4 b = *(const LAS f32x4*)(bp + 4 * i); gb[i] = (f32x2){b[0], b[2]}; ub[i] = (f32x2){b[1], b[3]}; }
        const f32x2 q4 = {1.0f / SACT8, 1.0f / SACT8}, kc = {-1.702f * 1.4426950408889634f, -1.702f * 1.4426950408889634f};
        const int j16 = u.pn * HALF + wc * 32 + 16 * (fq >> 1); v2u wprev = {0u, 0u};
#pragma unroll
        for (int ai = 0; ai < 2; ++ai)
#pragma unroll
            for (int m = 0; m < 4; ++m) { float r[8];
#pragma unroll
                for (int p = 0; p < 4; ++p) { const int n = p >> 1, q = 2 * (p & 1);
                    f32x2 g = (f32x2){acc[ai][0][m][n][q], acc[ai][0][m][n][q + 1]} + gb[p];
                    f32x2 uu = (f32x2){acc[ai][1][m][n][q], acc[ai][1][m][n][q + 1]} + ub[p];
                    g[0] = fminf(g[0], 7.0f); g[1] = fminf(g[1], 7.0f);
                    uu[0] = __builtin_amdgcn_fmed3f(uu[0], -7.0f, 7.0f); uu[1] = __builtin_amdgcn_fmed3f(uu[1], -7.0f, 7.0f);
                    f32x2 t = g * kc; t[0] = __builtin_amdgcn_exp2f(t[0]); t[1] = __builtin_amdgcn_exp2f(t[1]);
                    f32x2 d = __builtin_elementwise_fma(t, q4, q4); d[0] = __builtin_amdgcn_rcpf(d[0]); d[1] = __builtin_amdgcn_rcpf(d[1]);
                    const f32x2 o = __builtin_elementwise_fma(uu, g, g) * d;
                    r[2 * p] = o[0]; r[2 * p + 1] = o[1]; }
                const v2u w8 = pack8_fp8(r);
                if (m & 1) { const v4u o16 = widen16(wprev, w8);
                    gst<v4u>(act + (size_t)(row0 + ai * HALF + (m - 1 + (fq & 1)) * 16) * D + j16, o16); }
                else wprev = w8; }
    }
};
struct EpiMoe2 {
    static constexpr bool PERM = true; static constexpr int REPS = REP_EPI2;
    unsigned char* Y; const float* bdn; const float* rowgate;
    __device__ __forceinline__ void prefetch(LAS unsigned char* slot, const Unit& u, int wid, int lane) const {
        if (wid == 0) __builtin_amdgcn_global_load_lds((const unsigned*)(bdn + (size_t)u.e * D + u.pn * BM + 4 * lane), (LAS unsigned*)slot, 16, 0, 0);
        else if (wid == 1) __builtin_amdgcn_global_load_lds((const unsigned*)(rowgate + u.pm * BM + 4 * lane), (LAS unsigned*)(slot + 1024), 16, 0, 0);
    }
    __device__ __forceinline__ void operator()(const f32x4 (&acc)[2][2][4][2], const Unit& u, int wr, int wc, int fr, int fq, const LAS unsigned char* slot) const {
        const int pos0 = wr * 64 + fr, c16 = u.pn * BM + wc * 32 + 16 * (fq >> 1);
        const LAS float* bp = (const LAS float*)slot + wc * 32 + 8 * fq;
        f32x4 bv[2][2]; v2u wprev[2] = {{0u, 0u}, {0u, 0u}};
#pragma unroll
        for (int bj = 0; bj < 2; ++bj)
#pragma unroll
            for (int n = 0; n < 2; ++n) bv[bj][n] = *(const LAS f32x4*)(bp + bj * HALF + 4 * n);
#pragma unroll
        for (int ai = 0; ai < 2; ++ai)
#pragma unroll
            for (int m = 0; m < 4; ++m) { const int pos = pos0 + ai * HALF + m * 16; const float s = *((const LAS float*)(slot + 1024) + pos) * SY8;
#pragma unroll
                for (int bj = 0; bj < 2; ++bj) { const f32x4 v0 = (acc[ai][bj][m][0] + bv[bj][0]) * s, v1 = (acc[ai][bj][m][1] + bv[bj][1]) * s;
                    const float r[8] = {v0[0], v0[1], v0[2], v0[3], v1[0], v1[1], v1[2], v1[3]};
                    const v2u w8 = pack8_fp8(r);
                    if (m & 1) { const v4u o16 = widen16(wprev[bj], w8);
                        gst<v4u>(Y + (size_t)(u.pm * BM + pos0 + ai * HALF + (m - 1 + (fq & 1)) * 16) * D + c16 + bj * HALF, o16); }
                    else wprev[bj] = w8; } }
    }
};
}

__device__ __forceinline__ int chq(int lane, int q) { return (q >> 1) * 512 + 8 * lane + (q & 1) * 4; }
__device__ __forceinline__ v4u pack8(const float* v) { v4u w; w.x = cvt_pk_bf16(v[0], v[1]); w.y = cvt_pk_bf16(v[2], v[3]); w.z = cvt_pk_bf16(v[4], v[5]); w.w = cvt_pk_bf16(v[6], v[7]); return w; }
__device__ __forceinline__ void unpack8(const v4u w, float* v) { v[0] = bf_lo(w.x); v[1] = bf_hi(w.x); v[2] = bf_lo(w.y); v[3] = bf_hi(w.y); v[4] = bf_lo(w.z); v[5] = bf_hi(w.z); v[6] = bf_lo(w.w); v[7] = bf_hi(w.w); }

__device__ __forceinline__ int drow_of(int mode, int c) {
    if (mode == 1) { const int j = c >> 1, p = c & 1; return (j >> 7) * 256 + p * 128 + (j & 127); }
    if (mode == 2) { if (c < 1024) return 2048 + c; const int j = (c - 1024) & 1023, p = (c - 1024) >> 10; return (j >> 7) * 256 + p * 128 + (j & 127); }
    if (mode == 3) { const int j = c & 1023, p = c >> 10; return (j >> 7) * 256 + p * 128 + (j & 127); }
    return c;
}
struct TItem { const float* src; unsigned char* dst; int N, Kout  , k0, n0, mode, fp8; };
__device__ __forceinline__ void titem_load(const TItem& d, int lane, float (&tmp)[32]) {
#pragma unroll
    for (int i = 0; i < 32; ++i) { const int kk = 2 * i + (lane >> 5); tmp[i] = gld<float>(d.src + (size_t)(d.k0 + kk) * d.N + d.n0 + (lane & 31)); }
}
__device__ __forceinline__ void titem_store(const TItem& d, int lane, LAS float* scr, const float (&tmp)[32]) {
#pragma unroll
    for (int i = 0; i < 32; ++i) { const int kk = 2 * i + (lane >> 5); scr[kk * 33 + (lane & 31)] = tmp[i]; }
    LDS_WAIT(); asm volatile("" ::: "memory");
    const int c = lane & 7;
#pragma unroll
    for (int j = 0; j < 4; ++j) { const int n = (lane >> 3) + 8 * j; const LAS float* s = scr + (8 * c) * 33 + n;
        float v[8];
#pragma unroll
        for (int i = 0; i < 8; ++i) v[i] = s[i * 33];
        const size_t e = (size_t)drow_of(d.mode, d.n0 + n) * d.Kout + d.k0 + 8 * c;
        if (d.fp8) {
#pragma unroll
            for (int i = 0; i < 8; ++i) v[i] *= SW8;
            gst<v2u>(d.dst + e, pack8_fp8_sat(v));
        } else gst<v4u>(d.dst + 2 * e, pack8(v)); }
    LDS_WAIT(); asm volatile("" ::: "memory");
}

struct Args { const float* in[24]; float* out; unsigned char* ws; };
#define CAS __attribute__((address_space(4)))
__device__ __forceinline__ const void* karg_ptr(int off) {
    const CAS char* kp = (const CAS char*)__builtin_amdgcn_kernarg_segment_ptr();
    asm volatile("" : "+s"(off));
    return *(const void* const CAS*)(kp + off);
}
#define ARG_IN(i) ((const float*)karg_ptr(8 * (i)))
#define ARG_OUT() ((float*)karg_ptr(8 * 24))
#define ARG_WS() ((unsigned char*)karg_ptr(8 * 25))

constexpr int TPITCH = 129, TBUF = 128 * TPITCH;
constexpr int NT_GU = 128 * 8 * 16, NT_DN = 128 * 8 * 8, NT = NT_GU + NT_DN;
constexpr int NQ = 4096 + 2048, NT_P0 = 3072, NCONV = 16;
__host__ __device__ __forceinline__ int qtile(int L, int k) { return k < 4096 ? L * 4096 + k : NT_GU + L * 2048 + (k - 4096); }
struct WTile { const float* src; unsigned char* dst; int N, nb, kb, mode; };
#define WT_DECODE(ti_, d_) do { int r_ = (ti_); if (r_ < NT_GU) { const int mt_ = r_ >> 7; r_ &= 127; (d_).kb = r_ >> 4; (d_).nb = r_ & 15; (d_).N = 2048; (d_).mode = 1; \
                (d_).src = ARG_IN(18) + (size_t)mt_ * 1024 * 2048; (d_).dst = ws + WS_WGU + (size_t)mt_ * 2048 * 1024; } \
            else { r_ -= NT_GU; const int mt_ = r_ >> 6; r_ &= 63; (d_).kb = r_ >> 3; (d_).nb = r_ & 7; (d_).N = 1024; (d_).mode = 0; \
                (d_).src = ARG_IN(20) + (size_t)mt_ * 1024 * 1024; (d_).dst = ws + WS_WDN + (size_t)mt_ * 1024 * 1024; } } while (0)
#define WT_LOAD(R_, d_) do { _Pragma("unroll") for (int i = 0; i < 16; ++i) R_[i] = __builtin_nontemporal_load((const GAS v2u*)((d_).src + (size_t)((d_).kb * 128 + wave * 16 + i) * (d_).N + (d_).nb * 128 + 2 * lane)); } while (0)
#define WT_TOLDS(R_, buf_) do { const int col_ = (2 * lane + 4 * wave) & 127; _Pragma("unroll") for (int i = 0; i < 16; ++i) { LAS float* p_ = tl + (buf_) * TBUF + (wave * 16 + i) * TPITCH + col_; \
                p_[0] = __uint_as_float(R_[i].x); p_[1] = __uint_as_float(R_[i].y); } } while (0)
#define WT_OUT(d_, buf_) do { const int kc_ = tid & 7; _Pragma("unroll") for (int p = 0; p < 2; ++p) { const int n_ = (tid >> 3) + 64 * p; const LAS float* s_ = tl + (buf_) * TBUF + (16 * kc_) * TPITCH + ((n_ + 4 * kc_) & 127); \
                float v_[16]; _Pragma("unroll") for (int i = 0; i < 16; ++i) v_[i] = s_[i * TPITCH] * SW8; \
                const v2u a_ = pack8_fp8_sat(v_), b_ = pack8_fp8_sat(v_ + 8); v4u o_; o_.x = a_.x; o_.y = a_.y; o_.z = b_.x; o_.w = b_.y; \
                gst<v4u>((d_).dst + (size_t)drow_of((d_).mode, (d_).nb * 128 + n_) * 1024 + (d_).kb * 128 + 16 * kc_, o_); } } while (0)
#define WT_BAR() do { LDS_WAIT(); __builtin_amdgcn_s_barrier(); asm volatile("" ::: "memory"); } while (0)
constexpr int CBAND = 16 * 512 + 32, CBUF = 8 * CBAND;
static_assert(RING_OFF + 2 * CBUF <= UT_OFF, "converter buffers");
#define CV_DMA(d_, buf_) do { const char* gp_ = (const char*)((d_).src + (size_t)((d_).kb * 128 + wave * 16 + (lane >> 5)) * (d_).N + (d_).nb * 128 + 4 * (lane & 31)); \
        _Pragma("unroll") for (int j = 0; j < 8; ++j) __builtin_amdgcn_global_load_lds((const unsigned*)(gp_ + (size_t)(2 * j) * (d_).N * 4), (LAS unsigned*)(lds + RING_OFF + (buf_) * CBUF + wave * CBAND + j * 1024), 16, 0, 2); } while (0)
#define CV_OUT(d_, buf_) do { const int kq_ = tid & 7; _Pragma("unroll") for (int p = 0; p < 2; ++p) { const int n_ = (tid >> 3) + 64 * p; const LAS float* s_ = (const LAS float*)(lds + RING_OFF + (buf_) * CBUF + kq_ * CBAND) + n_; \
                float v_[16]; _Pragma("unroll") for (int i = 0; i < 16; ++i) v_[i] = s_[i * 128] * SW8; \
                const v2u a_ = pack8_fp8_sat(v_), b_ = pack8_fp8_sat(v_ + 8); v4u o_; o_.x = a_.x; o_.y = a_.y; o_.z = b_.x; o_.w = b_.y; \
                gst<v4u>((d_).dst + (size_t)drow_of((d_).mode, (d_).nb * 128 + n_) * 1024 + (d_).kb * 128 + 16 * kq_, o_); } } while (0)
#define CV_SYNC() do { LDS_WAIT(); __builtin_amdgcn_s_barrier(); asm volatile("" ::: "memory"); } while (0)
#define CONV_RUN(L_, maxpairs_, stopp_, stopn_) CONV_RUN_G(L_, maxpairs_, stopp_, stopn_, NQ, 0)
#define CONV_RUN_LIM(L_, maxpairs_, stopp_, stopn_, lim_) CONV_RUN_G(L_, maxpairs_, stopp_, stopn_, lim_, 0)
#define CONV_RUN_G(L_, maxpairs_, stopp_, stopn_, lim_, minhead_) do { \
    int wv_ = wave0; unsigned z_ = 0u; asm volatile("" : "+s"(wv_), "+s"(z_)); int tid = (wv_ << 6) | (int)__builtin_amdgcn_mbcnt_hi(~0u, __builtin_amdgcn_mbcnt_lo(~0u, z_)); asm volatile("" : "+v"(tid)); const int lane = tid & 63, wave = wave0; (void)lane; (void)wave;   \
    unsigned char* wsq_ = ARG_WS(); asm volatile("" : "+s"(wsq_)); unsigned char* ws = wsq_; unsigned* dq_ = (unsigned*)(ws + WS_CTL) + CW_DQ + (L_); unsigned* sp_ = (stopp_); \
    WTile d0, d1; int left_ = (maxpairs_); unsigned sf_ = 0u; \
    __syncthreads(); \
    const unsigned kofs_ = ((L_) == 0) ? (unsigned)NT_P0 : 0u; \
    if (tid == 0) { unsigned a_ = 0xFFFFFFFFu, b_ = 0xFFFFFFFFu; if (sp_) sf_ = (xb_ld(sp_) >= (unsigned)(stopn_)) ? 1u : 0u; if ((minhead_) > 0 && xb_ld(dq_) + kofs_ < (unsigned)(minhead_)) sf_ = 1u; if (!sf_) { a_ = xb_add(dq_, 2u) + kofs_; if (a_ >= (unsigned)(lim_)) sf_ = 1u; if (!sf_ && left_ > 1) { b_ = xb_add(dq_, 2u) + kofs_; if (b_ >= (unsigned)(lim_)) sf_ = 1u; } } MISC[4] = a_; MISC[5] = b_; } \
    __syncthreads(); \
    unsigned kcur_ = (unsigned)__builtin_amdgcn_readfirstlane((int)MISC[4]), knxt_ = (unsigned)__builtin_amdgcn_readfirstlane((int)MISC[5]); left_ -= 2; \
    d0.src = nullptr; d1.src = nullptr; \
    if (kcur_ < (unsigned)NQ) { WT_DECODE(qtile((L_), (int)kcur_), d0); WT_DECODE(qtile((L_), (int)kcur_ + 1), d1); CV_DMA(d0, 0); CV_DMA(d1, 1); } \
    while (kcur_ < (unsigned)NQ) { \
        unsigned nk_ = 0xFFFFFFFFu, dv_ = 0u; \
        if (tid == 0) { if (left_ > 0 && !sf_) nk_ = xb_add(dq_, 2u) + kofs_; if (sp_) dv_ = xb_ld(sp_); } \
        --left_; \
        const bool vn_ = knxt_ < (unsigned)NQ; WTile e0 = d0, e1 = d1; \
        if (vn_) { WT_DECODE(qtile((L_), (int)knxt_), e0); WT_DECODE(qtile((L_), (int)knxt_ + 1), e1); } \
        asm volatile("s_waitcnt vmcnt(8)" ::: "memory"); CV_SYNC(); CV_OUT(d0, 0); CV_SYNC(); if (vn_) CV_DMA(e0, 0); \
        if (vn_) asm volatile("s_waitcnt vmcnt(8)" ::: "memory"); else asm volatile("s_waitcnt vmcnt(0)" ::: "memory"); \
        CV_SYNC(); CV_OUT(d1, 1); CV_SYNC(); if (vn_) CV_DMA(e1, 1); \
        if (tid == 0) { MISC[4] = nk_; if ((sp_ && dv_ >= (unsigned)(stopn_)) || nk_ >= (unsigned)(lim_)) sf_ = 1u; } \
        __syncthreads(); kcur_ = knxt_; knxt_ = (unsigned)__builtin_amdgcn_readfirstlane((int)MISC[4]); d0 = e0; d1 = e1; \
    } \
    __syncthreads(); } while (0)

#define PHASE_BEGIN() \
    int wv_ = wave0; unsigned z_ = 0u; asm volatile("" : "+s"(wv_), "+s"(z_)); int tid = (wv_ << 6) | (int)__builtin_amdgcn_mbcnt_hi(~0u, __builtin_amdgcn_mbcnt_lo(~0u, z_)); asm volatile("" : "+v"(tid)); \
    const int lane = tid & 63, wave = wave0; \
    unsigned char* ws_ = ARG_WS(); asm volatile("" : "+s"(ws_)); unsigned char* ws = (unsigned char*)(GAS unsigned char*)ws_; \
    unsigned* ctl = (unsigned*)(ws + WS_CTL); \
    const int gw = vcu * NWAVES + wave, NGW = G * NWAVES; (void)gw; (void)NGW; (void)lane; (void)ctl;

__device__ __forceinline__ float butterfly32(float (&p)[32], int lane) {
#pragma unroll
    for (int i = 0; i < 16; ++i) { const auto r = __builtin_amdgcn_permlane32_swap(__float_as_uint(p[i]), __float_as_uint(p[i + 16]), false, false); p[i] = __uint_as_float(r[0]) + __uint_as_float(r[1]); }
#pragma unroll
    for (int i = 0; i < 8; ++i) { const auto r = __builtin_amdgcn_permlane16_swap(__float_as_uint(p[i]), __float_as_uint(p[i + 8]), false, false); p[i] = __uint_as_float(r[0]) + __uint_as_float(r[1]); }
#pragma unroll
    for (int i = 0; i < 4; ++i) { const bool hi = (lane & 8) != 0; const float snd = hi ? p[i] : p[i + 4]; const float keep = hi ? p[i + 4] : p[i]; p[i] = keep + DPP_F(snd, DPP_ROR8); }
#pragma unroll
    for (int i = 0; i < 2; ++i) { const bool hi = (lane & 4) != 0; const float snd = hi ? p[i] : p[i + 2]; const float keep = hi ? p[i + 2] : p[i]; const float x = DPP_F(snd, DPP_HMIR); p[i] = keep + DPP_F(x, DPP_QREV); }
    { const bool hi = (lane & 2) != 0; const float snd = hi ? p[0] : p[1]; const float keep = hi ? p[1] : p[0]; p[0] = keep + DPP_F(snd, DPP_XOR2); }
    return p[0] + DPP_F(p[0], DPP_XOR1);
}
__device__ __forceinline__ void ln16(float (&v)[16], const float (&lg)[16], const float (&lb)[16], int lane) {
    float sm = 0.f;
#pragma unroll
    for (int i = 0; i < 16; ++i) sm += v[i];
    const float mean = wave_sum(sm, lane) * (1.0f / D);
    float sq = 0.f;
#pragma unroll
    for (int i = 0; i < 16; ++i) { v[i] -= mean; sq += v[i] * v[i]; }
    const float rstd = 1.0f / sqrtf(wave_sum(sq, lane) * (1.0f / D) + LN_EPS);
#pragma unroll
    for (int i = 0; i < 16; ++i) v[i] = v[i] * rstd * lg[i] + lb[i];
}
__device__ __forceinline__ void route_token(const float logit, const int myexp, const int lane, const int t, int* TIDX, float* TGATE, LAS unsigned* hist, const bool count) {
    int rank = 0;
#pragma unroll
    for (int e = 0; e < 32; ++e) rank += (rdlane(logit, 2 * e) > logit) ? 1 : 0;
    unsigned long long mk[4]; bool clean = true;
#pragma unroll
    for (int r = 0; r < 4; ++r) { mk[r] = __ballot(rank == r); clean = clean && (__builtin_popcountll(mk[r]) == 2); }
    if (__builtin_expect(!clean, 0)) {
        asm volatile("" ::: "memory");
        rank = 0;
#pragma unroll
        for (int e = 0; e < 32; ++e) { const float se = rdlane(logit, 2 * e); rank += (se > logit || (se == logit && e < myexp)) ? 1 : 0; }
#pragma unroll
        for (int r = 0; r < 4; ++r) mk[r] = __ballot(rank == r);
    }
    float tv[4]; int tix[4];
#pragma unroll
    for (int r = 0; r < 4; ++r) { const int src = (int)__builtin_ctzll(mk[r] | (1ull << 63)); tv[r] = rdlane(logit, src); tix[r] = src >> 1; }
    const float e1 = __expf(tv[1] - tv[0]), e2 = __expf(tv[2] - tv[0]), e3 = __expf(tv[3] - tv[0]);
    const float inv = 1.0f / (1.0f + e1 + e2 + e3);
    if (lane < 4) {
        const int ix = lane == 0 ? tix[0] : lane == 1 ? tix[1] : lane == 2 ? tix[2] : tix[3];
        const float gv = (lane == 0 ? 1.0f : lane == 1 ? e1 : lane == 2 ? e2 : e3) * inv;
        gst<int>(TIDX + t * 4 + lane, ix); gst<float>(TGATE + t * 4 + lane, gv);
        if (count) __hip_atomic_fetch_add(hist + ix, 1u, __ATOMIC_RELAXED, __HIP_MEMORY_SCOPE_WORKGROUP);
    }
}
__device__ __forceinline__ void ln16_lds(float (&v)[16], const LAS f32x4* lnp, int lane) {
    float sm = 0.f;
#pragma unroll
    for (int i = 0; i < 16; ++i) sm += v[i];
    const float mean = wave_sum(sm, lane) * (1.0f / D);
    float sq = 0.f;
#pragma unroll
    for (int i = 0; i < 16; ++i) { v[i] -= mean; sq += v[i] * v[i]; }
    const float rstd = 1.0f / sqrtf(wave_sum(sq, lane) * (1.0f / D) + LN_EPS);
#pragma unroll
    for (int q = 0; q < 4; ++q) { const f32x4 g4 = lnp[q * 64 + lane], b4 = lnp[(4 + q) * 64 + lane];
#pragma unroll
        for (int i = 0; i < 4; ++i) v[4 * q + i] = v[4 * q + i] * rstd * g4[i] + b4[i]; }
}
template <bool F32IN>
__device__ __forceinline__ void pool_diff_run(const float* xf, const bf16* xb, bf16* M3, int t0, int lane) {
    const int s0 = t0 & (SEQ - 1);
#pragma unroll
    for (int g = 0; g < 4; ++g) {
        const int w = 2 << g, c = 256 * g + 4 * lane;
        f32x4 r[31];
#pragma unroll
        for (int j = 0; j < w + 15; ++j) {
            const int dt = j - (w - 1);
            if (dt >= 0 || s0 != 0) {
                const size_t o = (size_t)(t0 + dt) * D + c;
                if (F32IN) r[j] = gld<f32x4>(xf + o);
                else { const v2u q = gld<v2u>(xb + o); r[j] = (f32x4){bf_lo(q.x), bf_hi(q.x), bf_lo(q.y), bf_hi(q.y)}; }
            } else r[j] = (f32x4){0.f, 0.f, 0.f, 0.f};
        }
#pragma unroll
        for (int i = 0; i < 16; ++i) {
            f32x4 sum = r[i];
#pragma unroll
            for (int j = 1; j < w; ++j) sum += r[i + j];
            const int nv = (s0 + i + 1 < w) ? s0 + i + 1 : w;
            const f32x4 df = sum * (1.0f / (float)nv) - r[i + w - 1];
            v2u o; o.x = cvt_pk_bf16(df[0], df[1]); o.y = cvt_pk_bf16(df[2], df[3]);
            gst<v2u>(M3 + (size_t)(t0 + i) * D + c, o);
        }
    }
}

__global__ void __launch_bounds__(NTHR, 2) mega_fwd(Args args) {
    extern __shared__ __attribute__((aligned(16))) unsigned char lds_raw[];
    LAS unsigned char* lds = (LAS unsigned char*)lds_raw;
    volatile LAS unsigned* MISC = (volatile LAS unsigned*)(lds + MISC_OFF);
    const int G = gridDim.x, bx = blockIdx.x;
    const int wave0 = __builtin_amdgcn_readfirstlane((int)(threadIdx.x >> 6));
    const int vcu = (G % 8 == 0) ? (bx % 8) * (G / 8) + bx / 8 : bx;
    if (threadIdx.x < 128) MISC[threadIdx.x] = 0u;
    __syncthreads();
    (void)xcd_barrier_post((unsigned*)(ARG_WS() + WS_CTL) + CW_BAR, MISC + 0);
#define GRID_BAR() do { XcdBarrier b_; unsigned* bp_ = (unsigned*)(ARG_WS() + WS_CTL) + CW_BAR; asm volatile("" : "+s"(bp_)); b_.bar = (unsigned*)(GAS unsigned*)bp_; b_.x = xb_xcc_id(); b_.st = MISC; for (int rb_ = 0; rb_ < REP_BAR; ++rb_) xcd_barrier(b_); } while (0)
#define GRID_BAR_CONV(Lq_) GRID_BAR_CONVX(Lq_, 1, NQ, 0)
#define GRID_BAR_CONVX(Lq_, np_, lim_, mh_) do { XcdBarrier b_; unsigned* bp_ = (unsigned*)(ARG_WS() + WS_CTL) + CW_BAR; asm volatile("" : "+s"(bp_)); b_.bar = (unsigned*)(GAS unsigned*)bp_; b_.x = xb_xcc_id(); b_.st = MISC; \
    const bool last_ = xcd_barrier_arrive(b_); if (!last_) CONV_RUN_G((Lq_), (np_), nullptr, 0, (lim_), (mh_)); xcd_barrier_finish(b_); } while (0)
#define BAR_L() do { if (layer + 1 < DEPTH) GRID_BAR_CONV(layer + 1); else GRID_BAR(); } while (0)
#define BAR_A() GRID_BAR_CONV(layer)

    {
        PHASE_BEGIN();
        {
            LAS float* tl = (LAS float*)(lds + RING_OFF);
            for (int rep = 0; rep < REP_P0; ++rep) {
                v2u R0[16], R1[16]; WTile d0, d1, dn;
                int ti = vcu;
                d0.src = nullptr; d1.src = nullptr;
                if (ti < NT_P0) { WT_DECODE(qtile(0, ti), d0); WT_LOAD(R0, d0); }
                if (ti + G < NT_P0) { WT_DECODE(qtile(0, ti + G), d1); WT_LOAD(R1, d1); }
                for (; ti < NT_P0; ti += 2 * G) {
                    WT_TOLDS(R0, 0);
                    const bool h2 = (ti + 2 * G < NT_P0);
                    if (h2) { WT_DECODE(qtile(0, ti + 2 * G), dn); WT_LOAD(R0, dn); }
                    WT_BAR();
                    WT_OUT(d0, 0);
                    if (h2) d0 = dn;
                    if (ti + G < NT_P0) {
                        WT_TOLDS(R1, 1);
                        const bool h3 = (ti + 3 * G < NT_P0);
                        if (h3) { WT_DECODE(qtile(0, ti + 3 * G), dn); WT_LOAD(R1, dn); }
                        WT_BAR();
                        WT_OUT(d1, 1);
                        if (h3) d1 = dn;
                    }
                }
                WT_BAR();
            }
        }
        LAS float* scr = (LAS float*)(lds + RING_OFF + wave * 16384);
        constexpr int I_POOL = 4 * 8, I_SCIN = 16 * 96, I_SQ = 16 * 32, I_CFIN = 16 * 64;
        constexpr int N_POOL = 8 * I_POOL;
        constexpr int NITEMS = N_POOL + I_SCIN + I_SQ + I_CFIN + I_SQ;
#define TITEM_SET(d_, src_, K_, N_, dst_, mode_, fp8_, item_) do { const int nb_ = (N_) / 32; (d_).src = (src_); (d_).dst = (unsigned char*)(dst_); (d_).N = (N_); (d_).Kout = (K_); \
        (d_).k0 = 64 * ((item_) / nb_); (d_).n0 = 32 * ((item_) % nb_); (d_).mode = (mode_); (d_).fp8 = (fp8_); } while (0)
#define TITEM_DECODE(it_, d_) do { int r_ = (it_); \
        if (r_ < N_POOL) { const int mt_ = r_ / I_POOL; TITEM_SET(d_, ARG_IN(1) + (size_t)mt_ * 256 * 256, 256, 256, ws + WS_WPOOL + (size_t)mt_ * 256 * 256 * 2, 0, 0, r_ % I_POOL); break; } r_ -= N_POOL; \
        if (r_ < I_SCIN) { TITEM_SET(d_, ARG_IN(3), 1024, 3072, ws + WS_WSCIN, 2, SC_IN_FP8, r_); break; } r_ -= I_SCIN; \
        if (r_ < I_SQ) { TITEM_SET(d_, ARG_IN(5), 1024, 1024, ws + WS_WSCOUT, 0, SC_OUT_FP8, r_); break; } r_ -= I_SQ; \
        if (r_ < I_CFIN) { TITEM_SET(d_, ARG_IN(6), 1024, 2048, ws + WS_WCFIN, 3, CF_IN_FP8, r_); break; } r_ -= I_CFIN; \
        TITEM_SET(d_, ARG_IN(12), 1024, 1024, ws + WS_WCFOUT, 0, CF_OUT_FP8, r_); } while (0)
        for (int it = gw; it < NITEMS; it += NGW) { TItem cur; float ta[32]; TITEM_DECODE(it, cur); titem_load(cur, lane, ta); titem_store(cur, lane, scr, ta); }
#undef TITEM_SET
#undef TITEM_DECODE
        { bf16* M3 = (bf16*)(ws + WS_M3);
          for (int tb = vcu; tb < T / 128; tb += G) pool_diff_run<true>(ARG_IN(0), nullptr, M3, tb * 128 + wave * 16, lane); }
    }
    GRID_BAR_CONV(0);

    for (int layer = 0; layer < DEPTH; ++layer) {
        const int kind = layer % 3;

        if (kind == 0) {
            if (layer != 0) {
                PHASE_BEGIN();
                bf16* M3 = (bf16*)(ws + WS_M3); const bf16* xb = (const bf16*)(ws + WS_XAB);
                for (int rep = 0; rep < REP_THIN; ++rep)
                for (int tb = vcu; tb < T / 128; tb += G) pool_diff_run<false>(nullptr, xb, M3, tb * 128 + wave * 16, lane);
            }
        } else {
            {
                PHASE_BEGIN();
                bf16* M1 = (bf16*)(ws + WS_M1); bf16* M2 = (bf16*)(ws + WS_M2);
                const int nN = (kind == 1) ? 12 : 8;
                const int n_my = pg8::build_units(lds, tid, T / 256, nN, G, bx, false, nullptr, REP_MIXG);
                pg8::EpiPair E; E.O1 = (kind == 1) ? M2 : M1; E.O2 = M1; E.bias = ARG_IN(7); E.mode = (kind == 1) ? 0 : 1;
                if ((CF_IN_FP8 && kind == 2) || (SC_IN_FP8 && kind == 1)) {
                    pg8::GemmP gp; gp.A = (const char*)(ws + WS_X18); gp.lda2 = D; gp.acol_pn = 0; gp.Bt = (const char*)(ws + ((kind == 1) ? WS_WSCIN : WS_WCFIN)); gp.b_estride = 0; gp.Kb = 1024; gp.sA = E8_X; gp.sB = E8_W;
                    pg8::gemm_phase<false, true, pg8::EpiPair>(lds, tid, gp, n_my, E);
                } else {
                    pg8::GemmP gp; gp.A = (const char*)(ws + WS_XAB); gp.lda2 = D * 2; gp.acol_pn = 0; gp.Bt = (const char*)(ws + ((kind == 1) ? WS_WSCIN : WS_WCFIN)); gp.b_estride = 0; gp.Kb = 2048; gp.sA = 0; gp.sB = 0;
                    pg8::gemm_phase<false, false, pg8::EpiPair>(lds, tid, gp, n_my, E);
                }
            }
            BAR_A();
            if (kind == 1) {
                PHASE_BEGIN();
                const bf16* M1 = (const bf16*)(ws + WS_M1); const bf16* M2 = (const bf16*)(ws + WS_M2); bf16* M3 = (bf16*)(ws + WS_M3);
                const float* cw = ARG_IN(4);
                float wk[3][16];
#pragma unroll
                for (int k = 0; k < 3; ++k)
#pragma unroll
                    for (int q = 0; q < 4; ++q) { const f32x4 v = gld<f32x4>(cw + k * D + chq(lane, q)); wk[k][4 * q] = v[0]; wk[k][4 * q + 1] = v[1]; wk[k][4 * q + 2] = v[2]; wk[k][4 * q + 3] = v[3]; }
                for (int rep = 0; rep < REP_THIN; ++rep)
                for (int tb = vcu; tb < T / 128; tb += G) {
                    const int t0 = tb * 128 + wave * 16, s0 = t0 & (SEQ - 1);
                    float p2[16], p1[16];
                    if (s0 != 0) { unpack8(gld<v4u>(M2 + (size_t)(t0 - 2) * D + 8 * lane), p2); unpack8(gld<v4u>(M2 + (size_t)(t0 - 2) * D + 512 + 8 * lane), p2 + 8);
                                   unpack8(gld<v4u>(M2 + (size_t)(t0 - 1) * D + 8 * lane), p1); unpack8(gld<v4u>(M2 + (size_t)(t0 - 1) * D + 512 + 8 * lane), p1 + 8); }
                    else {
#pragma unroll
                        for (int i = 0; i < 16; ++i) { p2[i] = 0.f; p1[i] = 0.f; } }
                    for (int i0 = 0; i0 < 16; i0 += 4) {
                        v4u cv[4][2], gv[4][2];
#pragma unroll
                        for (int u = 0; u < 4; ++u)
#pragma unroll
                            for (int j = 0; j < 2; ++j) { const size_t o = (size_t)(t0 + i0 + u) * D + j * 512 + 8 * lane; cv[u][j] = gld<v4u>(M2 + o); gv[u][j] = gld<v4u>(M1 + o); }
#pragma unroll
                        for (int u = 0; u < 4; ++u) {
                            float c[16], gb[16], o[16];
                            unpack8(cv[u][0], c); unpack8(cv[u][1], c + 8); unpack8(gv[u][0], gb); unpack8(gv[u][1], gb + 8);
#pragma unroll
                            for (int i = 0; i < 16; ++i) { o[i] = gb[i] * (wk[0][i] * p2[i] + wk[1][i] * p1[i] + wk[2][i] * c[i]); p2[i] = p1[i]; p1[i] = c[i]; }
                            if (SC_OUT_FP8) { float s8[16];
#pragma unroll
                                for (int i = 0; i < 16; ++i) s8[i] = o[i] * SX8;
                                unsigned char* m8 = (unsigned char*)M3 + (size_t)(t0 + i0 + u) * D; gst<v2u>(m8 + 8 * lane, pack8_fp8_sat(s8)); gst<v2u>(m8 + 512 + 8 * lane, pack8_fp8_sat(s8 + 8)); }
                            else { gst<v4u>(M3 + (size_t)(t0 + i0 + u) * D + 8 * lane, pack8(o));
                                   gst<v4u>(M3 + (size_t)(t0 + i0 + u) * D + 512 + 8 * lane, pack8(o + 8)); }
                        }
                    }
                }
            } else {
                PHASE_BEGIN();
                const bf16* U = (const bf16*)(ws + WS_M1); bf16* M3 = (bf16*)(ws + WS_M3);
                const int c = 128 * wave + 2 * lane;
                float wk0[31], wk1[31];
#pragma unroll
                for (int k = 0; k < 31; ++k) { const v2u q = gld<v2u>(ARG_IN(8) + k * D + c); wk0[k] = __uint_as_float(q.x); wk1[k] = __uint_as_float(q.y); }
                const v2u qb = gld<v2u>(ARG_IN(9) + c), qg = gld<v2u>(ARG_IN(10) + c), ql = gld<v2u>(ARG_IN(11) + c);
                const float db0 = __uint_as_float(qb.x), db1 = __uint_as_float(qb.y), lg0 = __uint_as_float(qg.x), lg1 = __uint_as_float(qg.y), lb0 = __uint_as_float(ql.x), lb1 = __uint_as_float(ql.y);
                LAS float* part = (LAS float*)(lds + RING_OFF);
                LAS float* stat = part + 256;
                LAS unsigned short* ostg = (LAS unsigned short*)(lds + RING_OFF + 4096 + wave * 2048);
                for (int rep = 0; rep < REP_THIN; ++rep)
                for (int run = vcu; run < T / 16; run += G) {
                    const int t0 = run * 16, s0 = t0 & (SEQ - 1);
                    unsigned r[46];
#pragma unroll
                    for (int j = 0; j < 46; ++j) r[j] = (s0 + j - 30 >= 0) ? gld<unsigned>(U + (size_t)(t0 + j - 30) * D + c) : 0u;
                    float a0[16], a1[16];
#pragma unroll
                    for (int i = 0; i < 16; ++i) { a0[i] = db0; a1[i] = db1; }
#pragma unroll
                    for (int j = 0; j < 46; ++j) { const float x0 = bf_lo(r[j]), x1 = bf_hi(r[j]);
#pragma unroll
                        for (int i = 0; i < 16; ++i) { const int k = j - i; if (k >= 0 && k <= 30) { a0[i] += wk0[k] * x0; a1[i] += wk1[k] * x1; } } }
                    float st[32];
#pragma unroll
                    for (int i = 0; i < 16; ++i) { st[2 * i] = a0[i] + a1[i]; st[2 * i + 1] = a0[i] * a0[i] + a1[i] * a1[i]; }
                    const float tot = butterfly32(st, lane);
                    if ((lane & 1) == 0) part[wave * 32 + (lane >> 1)] = tot;
                    __syncthreads();
                    if (tid < 16) { float S = 0.f, Q = 0.f;
#pragma unroll
                        for (int w8 = 0; w8 < 8; ++w8) { S += part[w8 * 32 + 2 * tid]; Q += part[w8 * 32 + 2 * tid + 1]; }
                        const float mean = S * (1.0f / D); const float var = fmaxf(Q * (1.0f / D) - mean * mean, 0.f);
                        stat[2 * tid] = mean; stat[2 * tid + 1] = 1.0f / sqrtf(var + LN_EPS); }
                    __syncthreads();
#pragma unroll
                    for (int i = 0; i < 16; ++i) { const float mean = stat[2 * i], rstd = stat[2 * i + 1];
                        const float y0 = (a0[i] - mean) * rstd * lg0 + lb0, y1 = (a1[i] - mean) * rstd * lg1 + lb1;
                        const float z0 = y0 * sigmoidf_(y0), z1 = y1 * sigmoidf_(y1);
                        if (CF_OUT_FP8) { const float lim = 448.0f; const int w8 = __builtin_amdgcn_cvt_pk_fp8_f32(__builtin_amdgcn_fmed3f(z0 * SX8, -lim, lim), __builtin_amdgcn_fmed3f(z1 * SX8, -lim, lim), 0, false);
                            ostg[i * 64 + lane] = (unsigned short)(w8 & 0xffff); }
                        else gst<unsigned>(M3 + (size_t)(t0 + i) * D + c, cvt_pk_bf16(z0, z1)); }
                    if (CF_OUT_FP8) {
                        LDS_WAIT();
                        const LAS v4u* rd = (const LAS v4u*)(ostg + (lane >> 2) * 64) + 2 * (lane & 3);
                        const v4u o0 = rd[0], o1 = rd[1];
                        unsigned char* dst = (unsigned char*)M3 + (size_t)(t0 + (lane >> 2)) * D + 128 * wave + 32 * (lane & 3);
                        gst<v4u>(dst, o0); gst<v4u>(dst + 16, o1);
                        LDS_WAIT();
                    }
                }
                __syncthreads();
            }
        }
        if (layer != 0) BAR_A();

        {
            PHASE_BEGIN();
            const int n_my = pg8::build_units(lds, tid, T / 256, 4, G, bx, false, nullptr, REP_MIXG);
            pg8::GemmP gp; gp.A = (const char*)(ws + WS_M3); gp.lda2 = D * 2; gp.b_estride = 0; gp.sA = 0; gp.sB = 0;
            pg8::EpiOut E; E.xres = (const bf16*)(ws + WS_XAB); E.xres32 = (layer == 0) ? ARG_IN(0) : nullptr; E.z = (bf16*)(ws + WS_ZB); E.bias = nullptr; E.scale = nullptr;
            if (kind == 0) { gp.acol_pn = 512; gp.Bt = (const char*)(ws + WS_WPOOL + (size_t)(layer / 3) * 1024 * 256 * 2); gp.Kb = 512; E.scale = ARG_IN(2) + (layer / 3) * D; }
            else if (kind == 1) { gp.acol_pn = 0; gp.Bt = (const char*)(ws + WS_WSCOUT); gp.Kb = 2048; }
            else { gp.acol_pn = 0; gp.Bt = (const char*)(ws + WS_WCFOUT); gp.Kb = 2048; E.bias = ARG_IN(13); }
            if ((SC_OUT_FP8 && kind == 1) || (CF_OUT_FP8 && kind == 2)) {
                gp.lda2 = D; gp.Kb = 1024; gp.sA = E8_X; gp.sB = E8_W;
                pg8::gemm_phase<false, true, pg8::EpiOut>(lds, tid, gp, n_my, E);
            } else
            pg8::gemm_phase<false, false, pg8::EpiOut>(lds, tid, gp, n_my, E);
        }
        GRID_BAR_CONVX(layer, 1 << 30, 4096, 0);

        {
            PHASE_BEGIN();
            const bf16* Zb = (const bf16*)(ws + WS_ZB); unsigned char* X18 = (unsigned char*)(ws + WS_X18);
            int* RTOK = (int*)(ws + WS_RTOK); float* RGATE = (float*)(ws + WS_RGATE); int* APOS = (int*)(ws + WS_RDST);
            unsigned* CUR = ctl + CW_CUR + layer * NE;
            LAS v4u* rwf = (LAS v4u*)(lds + RING_OFF);
            LAS f32x4* lnp = (LAS f32x4*)(lds + TOK_OFF);
            const float* rw = ARG_IN(16) + (size_t)layer * D * NE;
            for (int f = tid; f < 32 * 2 * 64; f += NTHR) { const int s = f >> 7, nt = (f >> 6) & 1, l = f & 63, e = 16 * nt + (l & 15), kq = l >> 4;
                float w[8], hf[8], lo[8];
#pragma unroll
                for (int j = 0; j < 8; ++j) w[j] = gld<float>(rw + (32 * s + 8 * kq + j) * NE + e);
                const v4u hp = pack8(w); unpack8(hp, hf);
#pragma unroll
                for (int j = 0; j < 8; ++j) lo[j] = w[j] - hf[j];
                rwf[((s * 2 + nt) * 2 + 0) * 64 + l] = hp; rwf[((s * 2 + nt) * 2 + 1) * 64 + l] = pack8(lo); }
            if (tid < 256) { lnp[tid] = gld<f32x4>(ARG_IN(14) + layer * D + 4 * tid); lnp[256 + tid] = gld<f32x4>(ARG_IN(15) + layer * D + 4 * tid); }
            if (tid < NE) MISC[32 + tid] = 0u;
            __syncthreads();
            const int tau = lane & 15, kg = lane >> 4;
            float rb8[8];
#pragma unroll
            for (int i = 0; i < 8; ++i) rb8[i] = gld<float>(ARG_IN(17) + layer * NE + 16 * (i >> 2) + 4 * kg + (i & 3));
            LAS unsigned* hist = (LAS unsigned*)(lds + MISC_OFF) + 32;
#define BPERM_F(v, m) __uint_as_float((unsigned)__builtin_amdgcn_ds_bpermute((lane ^ (m)) << 2, (int)__float_as_uint(v)))
#define BPERM_I(v, m) __builtin_amdgcn_ds_bpermute((lane ^ (m)) << 2, (v))
            for (int rep = 0; rep < REP_LNR; ++rep)
            for (int tb = vcu; tb < T / 128; tb += G) {
                const int t = tb * 128 + wave * 16 + tau;
                const size_t rowo = (size_t)t * D + 8 * kg;
                v4u zp[32];
#pragma unroll
                for (int s = 0; s < 32; ++s) zp[s] = gld<v4u>(Zb + rowo + 32 * s);
                f32x2 S2 = {0.f, 0.f}, Q2 = {0.f, 0.f};
#pragma unroll
                for (int s = 0; s < 32; ++s) { float v[8]; unpack8(zp[s], v);
#pragma unroll
                    for (int j = 0; j < 4; ++j) { const f32x2 p = {v[2 * j], v[2 * j + 1]}; S2 += p; Q2 = __builtin_elementwise_fma(p, p, Q2); } }
                float S = S2[0] + S2[1], Q = Q2[0] + Q2[1];
                S += BPERM_F(S, 16); Q += BPERM_F(Q, 16); S += BPERM_F(S, 32); Q += BPERM_F(Q, 32);
                const float mean = S * (1.0f / D);
                const float rstd = 1.0f / sqrtf(fmaxf(Q * (1.0f / D) - mean * mean, 0.f) + LN_EPS);
                f32x4 a0 = {0.f, 0.f, 0.f, 0.f}, a1 = {0.f, 0.f, 0.f, 0.f};
                v2u x8prev = {0u, 0u};
#pragma unroll
                for (int s = 0; s < 32; ++s) {
                    asm volatile("" : "+v"(zp[s]));
                    float v[8]; unpack8(zp[s], v);
                    const f32x4 g0 = lnp[8 * s + 2 * kg], g1 = lnp[8 * s + 2 * kg + 1], b0 = lnp[256 + 8 * s + 2 * kg], b1 = lnp[256 + 8 * s + 2 * kg + 1];
                    { const f32x2 rstd2 = {rstd, rstd}, nmr2 = {-mean * rstd, -mean * rstd};
                      const f32x2 p0 = __builtin_elementwise_fma(__builtin_elementwise_fma((f32x2){v[0], v[1]}, rstd2, nmr2), (f32x2){g0[0], g0[1]}, (f32x2){b0[0], b0[1]});
                      const f32x2 p1 = __builtin_elementwise_fma(__builtin_elementwise_fma((f32x2){v[2], v[3]}, rstd2, nmr2), (f32x2){g0[2], g0[3]}, (f32x2){b0[2], b0[3]});
                      const f32x2 p2 = __builtin_elementwise_fma(__builtin_elementwise_fma((f32x2){v[4], v[5]}, rstd2, nmr2), (f32x2){g1[0], g1[1]}, (f32x2){b1[0], b1[1]});
                      const f32x2 p3 = __builtin_elementwise_fma(__builtin_elementwise_fma((f32x2){v[6], v[7]}, rstd2, nmr2), (f32x2){g1[2], g1[3]}, (f32x2){b1[2], b1[3]});
                      v[0] = p0[0]; v[1] = p0[1]; v[2] = p1[0]; v[3] = p1[1]; v[4] = p2[0]; v[5] = p2[1]; v[6] = p3[0]; v[7] = p3[1]; }
                    const v4u xp = pack8(v);
                    { float s8[8];
#pragma unroll
                      for (int j = 0; j < 4; ++j) { const f32x2 q = (f32x2){v[2 * j], v[2 * j + 1]} * (f32x2){SX8, SX8}; s8[2 * j] = q[0]; s8[2 * j + 1] = q[1]; }
                      const v2u w8 = pack8_fp8_sat(s8);
                      if (s & 1) { const v4u o16 = pg8::widen16(x8prev, w8);
                          gst<v4u>(X18 + (size_t)t * D + 32 * (s - 1 + (kg & 1)) + 8 * (kg & ~1), o16); }
                      else x8prev = w8; }
                    const bf16x8 xb = __builtin_bit_cast(bf16x8, xp);
                    a0 = __builtin_amdgcn_mfma_f32_16x16x32_bf16(__builtin_bit_cast(bf16x8, rwf[((s * 2 + 0) * 2 + 0) * 64 + lane]), xb, a0, 0, 0, 0);
                    a0 = __builtin_amdgcn_mfma_f32_16x16x32_bf16(__builtin_bit_cast(bf16x8, rwf[((s * 2 + 0) * 2 + 1) * 64 + lane]), xb, a0, 0, 0, 0);
                    a1 = __builtin_amdgcn_mfma_f32_16x16x32_bf16(__builtin_bit_cast(bf16x8, rwf[((s * 2 + 1) * 2 + 0) * 64 + lane]), xb, a1, 0, 0, 0);
                    a1 = __builtin_amdgcn_mfma_f32_16x16x32_bf16(__builtin_bit_cast(bf16x8, rwf[((s * 2 + 1) * 2 + 1) * 64 + lane]), xb, a1, 0, 0, 0);
                }
                float val[8]; int eid[8];
#pragma unroll
                for (int r = 0; r < 4; ++r) { val[r] = a0[r] + rb8[r]; eid[r] = 4 * kg + r; val[4 + r] = a1[r] + rb8[4 + r]; eid[4 + r] = 16 + 4 * kg + r; }
                float tv[4]; int tix[4];
#pragma unroll
                for (int k = 0; k < 4; ++k) {
                    float bv = val[0]; int bi = eid[0];
#pragma unroll
                    for (int i = 1; i < 8; ++i) if (val[i] > bv) { bv = val[i]; bi = eid[i]; }
#pragma unroll
                    for (int m = 16; m <= 32; m <<= 1) { const float ov = BPERM_F(bv, m); const int oi = BPERM_I(bi, m); if (ov > bv || (ov == bv && oi < bi)) { bv = ov; bi = oi; } }
                    tv[k] = bv; tix[k] = bi;
#pragma unroll
                    for (int i = 0; i < 8; ++i) if (eid[i] == bi) val[i] = -3.0e38f;
                }
                const float e1 = __expf(tv[1] - tv[0]), e2 = __expf(tv[2] - tv[0]), e3 = __expf(tv[3] - tv[0]);
                const float inv = 1.0f / (1.0f + e1 + e2 + e3);
                unsigned rk[4] = {0u, 0u, 0u, 0u};
                if (kg == 0) {
#pragma unroll
                    for (int k = 0; k < 4; ++k) rk[k] = __hip_atomic_fetch_add(hist + tix[k], 1u, __ATOMIC_RELAXED, __HIP_MEMORY_SCOPE_WORKGROUP);
                }
                __syncthreads();
                if (tid < NE) { const unsigned c = MISC[32 + tid]; MISC[64 + tid] = c ? xb_add(CUR + tid, c) : 0u; MISC[32 + tid] = 0u; }
                __syncthreads();
                if (kg == 0) {
                    const float gk[4] = {inv, e1 * inv, e2 * inv, e3 * inv};
                    v4u ps;
#pragma unroll
                    for (int k = 0; k < 4; ++k) { const int pos = tix[k] * ECAP + (int)MISC[64 + tix[k]] + (int)rk[k]; gst<int>(RTOK + pos, t); gst<float>(RGATE + pos, gk[k]);
                        if (k == 0) ps.x = (unsigned)pos; else if (k == 1) ps.y = (unsigned)pos; else if (k == 2) ps.z = (unsigned)pos; else ps.w = (unsigned)pos; }
                    gst<v4u>(APOS + t * 4, ps);
                }
            }
#undef BPERM_F
#undef BPERM_I
        }
        if (layer + 1 < DEPTH) GRID_BAR_CONVX(layer, 1, NQ, 4096); else GRID_BAR_CONVX(layer, 1 << 30, NQ, 4096);

        {
            const bool conv_layer = (layer + 1 < DEPTH) && (G == 256);
            const int Gg = conv_layer ? G - NCONV : G;
            unsigned* gdone = (unsigned*)(ARG_WS() + WS_CTL) + CW_GDONE + layer * 2;
            if (bx >= Gg) { CONV_RUN(layer, 1 << 30, nullptr, 0); CONV_RUN(layer + 1, 1 << 30, gdone, Gg); }
            else {
            PHASE_BEGIN();
            LAS int* TS = (LAS int*)(lds + TS_OFF);
            unsigned* CUR = ctl + CW_CUR + layer * NE;
            if (tid < NE) MISC[64 + tid] = xb_ld(CUR + tid);
            __syncthreads();
            if (tid == 0) { int a = 0; for (int e = 0; e < NE; ++e) { TS[e] = a; a += (int)((MISC[64 + e] + 255u) >> 8); } TS[NE] = a; }
            __syncthreads();
            const int nM = TS[NE];
            const int n_my = pg8::build_units(lds, tid, nM, 8, Gg, bx, true, (const int*)(ws + WS_RTOK), REP_MOE1);
            pg8::GemmP gp; gp.A = (const char*)(ws + WS_X18); gp.lda2 = D; gp.acol_pn = 0; gp.Bt = (const char*)(ws + WS_WGU + (size_t)layer * NE * 2048 * 1024); gp.b_estride = (size_t)2048 * 1024; gp.Kb = 1024; gp.sA = E8_X; gp.sB = E8_W;
            pg8::EpiSwiglu E; E.act = (unsigned char*)(ws + WS_ACT); E.bgu = ARG_IN(19) + (size_t)layer * NE * 2048;
            if (n_my <= 0 && conv_layer && tid == 0) (void)xb_add(gdone, 1u);
            pg8::gemm_phase<true, true, pg8::EpiSwiglu>(lds, tid, gp, n_my, E, REP_MOE1 > 1 ? n_my / 2 : (1 << 20), conv_layer ? gdone : nullptr);
            if (layer + 1 < DEPTH && n_my < (nM * 8 * REP_MOE1 + Gg - 1) / Gg) CONV_RUN(layer + 1, 2, nullptr, 0);
            if (!conv_layer) CONV_RUN(layer, 1 << 30, nullptr, 0);
            }
        }
        BAR_L();

        {
            const bool conv_layer = (layer + 1 < DEPTH) && (G == 256);
            const int Gg = conv_layer ? G - NCONV : G;
            unsigned* gdone = (unsigned*)(ARG_WS() + WS_CTL) + CW_GDONE + layer * 2 + 1;
            if (bx >= Gg) { CONV_RUN(layer + 1, 1 << 30, gdone, Gg); }
            else {
            PHASE_BEGIN();
            LAS int* TS = (LAS int*)(lds + TS_OFF);
            const int nM = TS[NE];
            const int n_my = pg8::build_units(lds, tid, nM, 4, Gg, bx, true, nullptr, REP_MOE2);
            pg8::GemmP gp; gp.A = (const char*)(ws + WS_ACT); gp.lda2 = D; gp.acol_pn = 0; gp.Bt = (const char*)(ws + WS_WDN + (size_t)layer * NE * 1024 * 1024); gp.b_estride = (size_t)1024 * 1024; gp.Kb = 1024; gp.sA = E8_ACT; gp.sB = E8_W;
            pg8::EpiMoe2 E; E.Y = (unsigned char*)(ws + WS_Y); E.bdn = ARG_IN(21) + (size_t)layer * NE * D; E.rowgate = (const float*)(ws + WS_RGATE);
            if (n_my <= 0 && conv_layer && tid == 0) (void)xb_add(gdone, 1u);
            pg8::gemm_phase<false, true, pg8::EpiMoe2>(lds, tid, gp, n_my, E, 1 << 20, conv_layer ? gdone : nullptr);
            if (layer + 1 < DEPTH && n_my < (nM * 4 * REP_MOE2 + Gg - 1) / Gg) CONV_RUN(layer + 1, 2, nullptr, 0);
            }
        }
        BAR_L();

        {
            PHASE_BEGIN();
            const bf16* Zr = (const bf16*)(ws + WS_ZB); const unsigned char* Y = (const unsigned char*)(ws + WS_Y); const int* APOS = (const int*)(ws + WS_RDST); float* OUT = ARG_OUT(); bf16* XAb = (bf16*)(ws + WS_XAB);
            float lg[16], lb[16], mg[16], mb[16];
#pragma unroll
            for (int q = 0; q < 4; ++q) { const f32x4 b = gld<f32x4>(ARG_IN(22) + layer * D + 16 * lane + 4 * q), c = gld<f32x4>(ARG_IN(23) + layer * D + 16 * lane + 4 * q);
                const f32x4 b1 = gld<f32x4>(ARG_IN(14) + layer * D + 16 * lane + 4 * q), c1 = gld<f32x4>(ARG_IN(15) + layer * D + 16 * lane + 4 * q);
#pragma unroll
                for (int i = 0; i < 4; ++i) { lg[4 * q + i] = b[i]; lb[4 * q + i] = c[i]; mg[4 * q + i] = b1[i]; mb[4 * q + i] = c1[i]; } }
            for (int rep = 0; rep < REP_THIN; ++rep)
            for (int tb = vcu; tb < T / 128; tb += G) {
                const int t0 = tb * 128 + wave * 16;
                const int apos = gld<int>(APOS + t0 * 4 + lane);
#define YROW(ti_, k_) ((size_t)(unsigned)__builtin_amdgcn_readlane(apos, 4 * (ti_) + (k_)) * D)
                v4u nx[2], ny[4];
#pragma unroll
                for (int j = 0; j < 2; ++j) nx[j] = gld<v4u>(Zr + (size_t)t0 * D + 16 * lane + 8 * j);
#pragma unroll
                for (int k = 0; k < 4; ++k) ny[k] = gld<v4u>(Y + YROW(0, k) + 16 * lane);
                for (int ti = 0; ti < 16; ++ti) {
                    const int t = t0 + ti;
                    float v[16], h[16];
                    unpack8(nx[0], v); unpack8(nx[1], v + 8);
#pragma unroll
                    for (int i = 0; i < 16; ++i) h[i] = 0.f;
#pragma unroll
                    for (int k = 0; k < 4; ++k) { const unsigned wd[4] = {ny[k].x, ny[k].y, ny[k].z, ny[k].w};
#pragma unroll
                        for (int d = 0; d < 4; ++d) { const f32x2 lo = __builtin_amdgcn_cvt_pk_f32_fp8((int)wd[d], false), hi = __builtin_amdgcn_cvt_pk_f32_fp8((int)wd[d], true);
                            h[4 * d] += lo[0]; h[4 * d + 1] += lo[1]; h[4 * d + 2] += hi[0]; h[4 * d + 3] += hi[1]; } }
                    if (ti + 1 < 16) {
#pragma unroll
                        for (int j = 0; j < 2; ++j) nx[j] = gld<v4u>(Zr + (size_t)(t + 1) * D + 16 * lane + 8 * j);
#pragma unroll
                        for (int k = 0; k < 4; ++k) ny[k] = gld<v4u>(Y + YROW(ti + 1, k) + 16 * lane); }
                    ln16(v, mg, mb, lane);
#pragma unroll
                    for (int i = 0; i < 16; ++i) v[i] = v[i] * ALPHA + h[i] * (1.0f / SY8);
                    ln16(v, lg, lb, lane);
                    if (layer == DEPTH - 1) {
#pragma unroll
                        for (int q = 0; q < 4; ++q) gst<f32x4>(OUT + (size_t)t * D + 16 * lane + 4 * q, (f32x4){v[4 * q], v[4 * q + 1], v[4 * q + 2], v[4 * q + 3]});
                    } else {
                        gst<v4u>(XAb + (size_t)t * D + 16 * lane, pack8(v));
                        gst<v4u>(XAb + (size_t)t * D + 16 * lane + 8, pack8(v + 8));
                        if ((CF_IN_FP8 && layer == 1) || (SC_IN_FP8 && layer == 0)) {
                            float s8[16];
#pragma unroll
                            for (int i = 0; i < 16; ++i) s8[i] = v[i] * SX8;
                            const v2u a8 = pack8_fp8_sat(s8), b8 = pack8_fp8_sat(s8 + 8); v4u o8; o8.x = a8.x; o8.y = a8.y; o8.z = b8.x; o8.w = b8.y;
                            gst<v4u>((unsigned char*)(ws + WS_X18) + (size_t)t * D + 16 * lane, o8);
                        }
                    }
                }
            }
        }
        if (layer + 1 < DEPTH) GRID_BAR_CONV(layer + 1);
    }
    if (PROBE_CLOCK && bx == 0 && threadIdx.x == 0) {
        const unsigned mhz_ = gld<unsigned>((unsigned*)(ARG_WS() + WS_CTL) + 16); const unsigned long long t0_ = wall_clock64();
        while (wall_clock64() - t0_ < (unsigned long long)mhz_ * 10ull) __builtin_amdgcn_s_sleep(8);
    }
}

extern "C" void kernel_launch(void* const* d_in, const int* in_sizes, int n_in, void* d_out, int out_size, void* d_ws, size_t ws_size, hipStream_t stream) {
    static int grid = 0;
    if (grid == 0) {
        if (n_in != 24 || out_size != T * D || ws_size < WS_END) { fprintf(stderr, "kernel_launch: unexpected shapes (n_in %d out %d ws %zu)\n", n_in, out_size, ws_size); grid = -1; return; }
        if (hipFuncSetAttribute((const void*)mega_fwd, hipFuncAttributeMaxDynamicSharedMemorySize, LDS_BYTES) != hipSuccess) { fprintf(stderr, "kernel_launch: hipFuncSetAttribute failed\n"); grid = -1; return; }
        int dev = 0, cus = 0, per_cu = 0;
        (void)hipGetDevice(&dev); (void)hipDeviceGetAttribute(&cus, hipDeviceAttributeMultiprocessorCount, dev);
        if (hipOccupancyMaxActiveBlocksPerMultiprocessor(&per_cu, (const void*)mega_fwd, NTHR, LDS_BYTES) != hipSuccess || per_cu < 1) fprintf(stderr, "kernel_launch: occupancy query reports %d blocks per CU\n", per_cu);
        (void)hipGetLastError();
        grid = 256; if (cus > 0 && cus < grid) grid = cus;
    }
    if (grid < 0) return;
    (void)hipMemsetAsync((char*)d_ws + WS_CTL, 0, CTL_ZERO_BYTES, stream);
    Args a{};
    for (int i = 0; i < 24; ++i) a.in[i] = (const float*)d_in[i];
    a.out = (float*)d_out; a.ws = (unsigned char*)d_ws;
    hipLaunchKernelGGL(mega_fwd, dim3(grid), dim3(NTHR), LDS_BYTES, stream, a);
    const hipError_t le = hipPeekAtLastError();
    if (le != hipSuccess) fprintf(stderr, "kernel_launch: launch failed: %s\n", hipGetErrorName(le));
}
```
